# Optimizing an MI355X kernel written in HIP

```python
import math
import jax
import jax.numpy as jnp
from jax import lax
import numpy as np

D_MODEL = 1024
BATCH = 8
SEQ = 4096
DEPTH = 1

NORM_EPS = 1e-5
SSM_WIDTH = 1024
SSM_GROUP_CH = 16
SSM_GROUPS = SSM_WIDTH // SSM_GROUP_CH
SSM_STATE = 64
DT_MIN = 1e-3
DT_MAX = 1e-1
HEAD_DIM = 64
N_Q_HEADS = 16
N_KV_HEADS = 4
Q_PER_KV = N_Q_HEADS // N_KV_HEADS
ATTN_WIDTH = N_Q_HEADS * HEAD_DIM
KV_WIDTH = N_KV_HEADS * HEAD_DIM
WINDOW = 128
BLOCK = 128
IN_WIDTH = SSM_WIDTH + ATTN_WIDTH + 2 * KV_WIDTH + 2 * D_MODEL
N_EXPERTS = 32
TOP_K = 4
D_FF = 1024
SWIGLU_LIMIT = 7.0
SWIGLU_ALPHA = 1.702
MOE_BLOCK = 512

kernel_name = 'hybrid_s5_swa_moe_block'


def rmsnorm(x, g):
    xf = x.astype(jnp.float32)
    y = xf * lax.rsqrt(jnp.mean(xf * xf, axis=-1, keepdims=True) + NORM_EPS)
    return (y * g.astype(jnp.float32)).astype(x.dtype)


def alibi_slopes(n_heads):
    h = jnp.arange(1, n_heads + 1, dtype=jnp.float32)
    return jnp.exp2(-8.0 * h / n_heads)


def s5_discretise(a_re, a_im, log_dt, b_re, b_im):
    a_re = a_re.astype(jnp.float32)
    a_im = a_im.astype(jnp.float32)
    b_re = b_re.astype(jnp.float32)
    b_im = b_im.astype(jnp.float32)
    dt = jnp.exp(log_dt.astype(jnp.float32))[:, None]
    mag = jnp.exp(a_re * dt)
    abar_re = mag * jnp.cos(a_im * dt)
    abar_im = mag * jnp.sin(a_im * dt)
    den = a_re * a_re + a_im * a_im
    q_re = ((abar_re - 1.0) * a_re + abar_im * a_im) / den
    q_im = (abar_im * a_re - (abar_re - 1.0) * a_im) / den
    bbar_re = q_re[..., None] * b_re - q_im[..., None] * b_im
    bbar_im = q_re[..., None] * b_im + q_im[..., None] * b_re
    return abar_re, abar_im, bbar_re, bbar_im


def _ssm_combine(earlier, later):
    ar_i, ai_i, br_i, bi_i = earlier
    ar_j, ai_j, br_j, bi_j = later
    ar = ar_j * ar_i - ai_j * ai_i
    ai = ar_j * ai_i + ai_j * ar_i
    br = ar_j * br_i - ai_j * bi_i + br_j
    bi = ar_j * bi_i + ai_j * br_i + bi_j
    return ar, ai, br, bi


def s5_branch(u, a_re, a_im, log_dt, b_re, b_im, c_re, c_im, d_skip, w_glu):
    abar_re, abar_im, bbar_re, bbar_im = s5_discretise(a_re, a_im, log_dt, b_re, b_im)
    c_re = c_re.astype(jnp.float32)
    c_im = c_im.astype(jnp.float32)
    d_skip = d_skip.astype(jnp.float32)
    seq_len = u.shape[1]
    state_shape = (seq_len, SSM_GROUPS, SSM_STATE)

    def one_sequence(u_seq):
        ug = u_seq.astype(jnp.float32).reshape(seq_len, SSM_GROUPS, SSM_GROUP_CH)
        bu_re = jnp.einsum('lgh,gph->lgp', ug, bbar_re)
        bu_im = jnp.einsum('lgh,gph->lgp', ug, bbar_im)
        _, _, s_re, s_im = lax.associative_scan(
            _ssm_combine,
            (jnp.broadcast_to(abar_re, state_shape), jnp.broadcast_to(abar_im, state_shape), bu_re, bu_im),
            axis=0)
        y = (jnp.einsum('lgp,ghp->lgh', s_re, c_re)
             - jnp.einsum('lgp,ghp->lgh', s_im, c_im)
             + d_skip * ug)
        return y.reshape(seq_len, SSM_WIDTH)

    y = jax.nn.gelu(lax.map(one_sequence, u)).astype(u.dtype)
    val, gate = jnp.split(y @ w_glu, 2, axis=-1)
    return val * jax.nn.sigmoid(gate)


def swa_attention(q, k, v, q_norm_g, k_norm_g, sinks):
    bsz, seq_len = q.shape[0], q.shape[1]
    n_blk = seq_len // BLOCK
    q = rmsnorm(q.reshape(bsz, seq_len, N_Q_HEADS, HEAD_DIM), q_norm_g)
    k = rmsnorm(k.reshape(bsz, seq_len, N_KV_HEADS, HEAD_DIM), k_norm_g)
    v = v.reshape(bsz, seq_len, N_KV_HEADS, HEAD_DIM)
    qb = q.reshape(bsz, n_blk, BLOCK, N_KV_HEADS, Q_PER_KV, HEAD_DIM)

    def with_previous_block(t):
        t = t.reshape(bsz, n_blk, BLOCK, N_KV_HEADS, HEAD_DIM)
        prev = jnp.concatenate([jnp.zeros_like(t[:, :1]), t[:, :-1]], axis=1)
        return jnp.concatenate([prev, t], axis=2)

    kw = with_previous_block(k)
    vw = with_previous_block(v)
    scale = 1.0 / math.sqrt(HEAD_DIM)
    scores = jnp.einsum('bnqkgd,bnskd->bnkgqs', qb, kw,
                        preferred_element_type=jnp.float32) * scale
    qi = jnp.arange(BLOCK)[:, None]
    kj = jnp.arange(2 * BLOCK)[None, :]
    dist = qi - kj + BLOCK
    blk = jnp.arange(n_blk)[:, None, None]
    valid = (dist >= 0) & (dist < WINDOW) & ((blk > 0) | (kj >= BLOCK))
    slopes = alibi_slopes(N_Q_HEADS).reshape(N_KV_HEADS, Q_PER_KV)
    bias = -slopes[:, :, None, None] * dist.astype(jnp.float32)
    scores = jnp.where(valid[None, :, None, None], scores + bias, -jnp.inf)
    sink = sinks.astype(jnp.float32).reshape(N_KV_HEADS, Q_PER_KV)[None, None, :, :, None, None]
    m = jnp.maximum(jnp.max(scores, axis=-1, keepdims=True), sink)
    p = jnp.exp(scores - m)
    probs = (p / (jnp.sum(p, axis=-1, keepdims=True) + jnp.exp(sink - m))).astype(v.dtype)
    out = jnp.einsum('bnkgqs,bnskd->bnqkgd', probs, vw)
    return out.reshape(bsz, seq_len, ATTN_WIDTH)


def moe_ffn(h, w_router, b_router, w_gate_up, b_gate_up, w_down, b_down):
    bsz, seq_len, d = h.shape
    n_tok = bsz * seq_len
    n_assign = n_tok * TOP_K
    xf = h.reshape(n_tok, d)
    logits = (xf @ w_router).astype(jnp.float32) + b_router.astype(jnp.float32)
    top_v, top_i = lax.top_k(logits, TOP_K)
    gate_w = jax.nn.softmax(top_v, axis=-1)
    flat_e = top_i.reshape(-1)
    order = jnp.argsort(flat_e)
    e_sorted = flat_e[order]
    tok_sorted = order // TOP_K
    w_sorted = gate_w.reshape(-1)[order]
    counts = jnp.bincount(flat_e, length=N_EXPERTS)
    padded = (counts + MOE_BLOCK - 1) // MOE_BLOCK * MOE_BLOCK
    starts = jnp.cumsum(counts) - counts
    pad_ends = jnp.cumsum(padded)
    pad_starts = pad_ends - padded
    dest = pad_starts[e_sorted] + (jnp.arange(n_assign) - starts[e_sorted])
    n_blocks = -(-n_assign // MOE_BLOCK) + N_EXPERTS
    n_rows = n_blocks * MOE_BLOCK
    row_tok = jnp.zeros((n_rows,), jnp.int32).at[dest].set(tok_sorted.astype(jnp.int32))
    row_w = jnp.zeros((n_rows,), jnp.float32).at[dest].set(w_sorted)
    block_e = jnp.minimum(
        jnp.searchsorted(pad_ends, jnp.arange(n_blocks) * MOE_BLOCK, side='right'), N_EXPERTS - 1)
    xs = xf[row_tok].reshape(n_blocks, MOE_BLOCK, d)

    def expert_block(args):
        xb, e = args
        gu = xb @ w_gate_up[e] + b_gate_up[e]
        gate, up = jnp.split(gu, 2, axis=-1)
        gate = jnp.minimum(gate, SWIGLU_LIMIT)
        up = jnp.clip(up, -SWIGLU_LIMIT, SWIGLU_LIMIT)
        act = (up + 1.0) * gate * jax.nn.sigmoid(SWIGLU_ALPHA * gate)
        return act @ w_down[e] + b_down[e]

    ys = lax.map(expert_block, (xs, block_e)).reshape(n_rows, d)
    out = jnp.zeros((n_tok, d), ys.dtype).at[row_tok].add(ys * row_w[:, None].astype(ys.dtype))
    return out.reshape(bsz, seq_len, d).astype(h.dtype)


def hybrid_layer(x, norm1_g, w_in, ssm_a_re, ssm_a_im, ssm_log_dt, ssm_b_re, ssm_b_im,
                 ssm_c_re, ssm_c_im, ssm_d, w_glu, w_ssm_proj, q_norm_g, k_norm_g, attn_sinks,
                 w_attn_proj, w_out, norm2_g, w_router, b_router, w_gate_up, b_gate_up,
                 w_down, b_down):
    h = rmsnorm(x, norm1_g)
    proj = h @ w_in
    cuts = [SSM_WIDTH, SSM_WIDTH + ATTN_WIDTH, SSM_WIDTH + ATTN_WIDTH + KV_WIDTH,
            SSM_WIDTH + ATTN_WIDTH + 2 * KV_WIDTH, SSM_WIDTH + ATTN_WIDTH + 2 * KV_WIDTH + D_MODEL]
    u_ssm, q, k, v, g_ssm, g_attn = jnp.split(proj, cuts, axis=-1)
    y_ssm = s5_branch(u_ssm, ssm_a_re, ssm_a_im, ssm_log_dt, ssm_b_re, ssm_b_im,
                      ssm_c_re, ssm_c_im, ssm_d, w_glu) @ w_ssm_proj
    y_attn = swa_attention(q, k, v, q_norm_g, k_norm_g, attn_sinks) @ w_attn_proj
    mixed = jax.nn.sigmoid(g_ssm) * y_ssm + jax.nn.sigmoid(g_attn) * y_attn
    x = x + mixed @ w_out
    x = x + moe_ffn(rmsnorm(x, norm2_g), w_router, b_router, w_gate_up, b_gate_up, w_down, b_down)
    return x


def setup_inputs(seed: int = 0) -> dict:
    key = jax.random.key(seed)
    ks = jax.random.split(key, 25)
    f32 = jnp.float32

    def nrm(k, shape, scale):
        return scale * jax.random.normal(k, shape, f32)

    n_l = DEPTH
    g, p, hc = SSM_GROUPS, SSM_STATE, SSM_GROUP_CH
    return {
        'x': nrm(ks[0], (BATCH, SEQ, D_MODEL), 1.0),
        'norm1_g': 1.0 + nrm(ks[1], (n_l, D_MODEL), 0.02),
        'w_in': nrm(ks[2], (n_l, D_MODEL, IN_WIDTH), D_MODEL ** -0.5),
        'ssm_a_re': -0.5 + nrm(ks[3], (n_l, g, p), 0.01),
        'ssm_a_im': math.pi * jnp.arange(p, dtype=f32) + nrm(ks[4], (n_l, g, p), 0.01),
        'ssm_log_dt': jax.random.uniform(ks[5], (n_l, g), f32, math.log(DT_MIN), math.log(DT_MAX)),
        'ssm_b_re': nrm(ks[6], (n_l, g, p, hc), (2 * hc) ** -0.5),
        'ssm_b_im': nrm(ks[7], (n_l, g, p, hc), (2 * hc) ** -0.5),
        'ssm_c_re': nrm(ks[8], (n_l, g, hc, p), p ** -0.5),
        'ssm_c_im': nrm(ks[9], (n_l, g, hc, p), p ** -0.5),
        'ssm_d': nrm(ks[10], (n_l, g, hc), 1.0),
        'w_glu': nrm(ks[11], (n_l, SSM_WIDTH, 2 * SSM_WIDTH), SSM_WIDTH ** -0.5),
        'w_ssm_proj': nrm(ks[12], (n_l, SSM_WIDTH, D_MODEL), SSM_WIDTH ** -0.5),
        'q_norm_g': 1.0 + nrm(ks[13], (n_l, HEAD_DIM), 0.02),
        'k_norm_g': 1.0 + nrm(ks[14], (n_l, HEAD_DIM), 0.02),
        'attn_sinks': nrm(ks[15], (n_l, N_Q_HEADS), 1.0),
        'w_attn_proj': nrm(ks[16], (n_l, ATTN_WIDTH, D_MODEL), ATTN_WIDTH ** -0.5),
        'w_out': nrm(ks[17], (n_l, D_MODEL, D_MODEL), D_MODEL ** -0.5),
        'norm2_g': 1.0 + nrm(ks[18], (n_l, D_MODEL), 0.02),
        'w_router': nrm(ks[19], (n_l, D_MODEL, N_EXPERTS), D_MODEL ** -0.5),
        'b_router': nrm(ks[20], (n_l, N_EXPERTS), 0.01),
        'w_gate_up': nrm(ks[21], (n_l, N_EXPERTS, D_MODEL, 2 * D_FF), D_MODEL ** -0.5),
        'b_gate_up': nrm(ks[22], (n_l, N_EXPERTS, 2 * D_FF), 0.01),
        'w_down': nrm(ks[23], (n_l, N_EXPERTS, D_FF, D_MODEL), D_FF ** -0.5),
        'b_down': nrm(ks[24], (n_l, N_EXPERTS, D_MODEL), 0.01),
    }


def reference(x, norm1_g, w_in, ssm_a_re, ssm_a_im, ssm_log_dt, ssm_b_re, ssm_b_im,
              ssm_c_re, ssm_c_im, ssm_d, w_glu, w_ssm_proj, q_norm_g, k_norm_g, attn_sinks,
              w_attn_proj, w_out, norm2_g, w_router, b_router, w_gate_up, b_gate_up,
              w_down, b_down):
    for layer in range(DEPTH):
        x = hybrid_layer(
            x, norm1_g[layer], w_in[layer], ssm_a_re[layer], ssm_a_im[layer], ssm_log_dt[layer],
            ssm_b_re[layer], ssm_b_im[layer], ssm_c_re[layer], ssm_c_im[layer], ssm_d[layer],
            w_glu[layer], w_ssm_proj[layer], q_norm_g[layer], k_norm_g[layer], attn_sinks[layer],
            w_attn_proj[layer], w_out[layer], norm2_g[layer], w_router[layer], b_router[layer],
            w_gate_up[layer], b_gate_up[layer], w_down[layer], b_down[layer])
    return x
```

```cpp
#include <hip/hip_runtime.h>
#include <cstdio>
#include <cstdint>
#include <cmath>

constexpr int DM = 1024, BATCH = 8, SEQ = 4096, T = BATCH * SEQ;
constexpr int NG = 64, NP = 64, GCH = 16;
constexpr int HD = 64, NQH = 16, NKVH = 4, WIN = 128;
constexpr int IN_W = 4608;
constexpr int C_U = 0, C_Q = 1024, C_K = 2048, C_V = 2304, C_GS = 2560, C_GA = 3584;
constexpr int NE = 32, TOPK = 4, DFF = 1024, NA = T * TOPK;
constexpr int MAXROWS = NA + NE * 256;
constexpr int MAXMT = MAXROWS / 256;
constexpr float EPS = 1e-5f;

namespace pg8 {
#define PG8_LAS __attribute__((address_space(3)))
typedef unsigned short bf16_t;
typedef short bf16x8 __attribute__((ext_vector_type(8)));
typedef float f32x4 __attribute__((ext_vector_type(4)));
typedef unsigned u32x4 __attribute__((ext_vector_type(4)));
constexpr int BM = 256, BK = 64, HALF = 128, HTB = HALF * BK * 2  , STAGE_BYTES = 8 * HTB, NXCD = 8, WGM = 8;

__host__ __device__ __forceinline__ int lds_byte(int r, int c) { const int st = (r >> 4) * 2 + (c >> 5), rr = r & 15, cc = c & 31, ob = rr * 64 + cc * 2; return st * 1024 + (ob ^ (((ob >> 9) & 1) << 5)); }
__host__ __device__ __forceinline__ void stage_rc(int b, int& R, int& C) { const int st = b / 1024, sb = b % 1024, swz = sb ^ (((sb >> 9) & 1) << 5); R = (st >> 1) * 16 + swz / 64; C = (st & 1) * 32 + (swz % 64) / 2; }
__host__ __device__ __forceinline__ int perm32(int rho) { const int n = rho >> 4, i = rho & 15; return 8 * (i >> 2) + 4 * n + (i & 3); }

struct Unit { int pm, pn, e, pl; };
struct Gemm { const bf16_t* A; const bf16_t* Bt; int M, N, K, pad; };

struct StaticOrder {
    int nM, nN, nwg, G, c;
    __host__ __device__ void init(int M, int N, int G_, int c_) { nM = M / BM; nN = N / BM; nwg = nM * nN; G = G_; c = c_; }
    __host__ __device__ bool next(int i, Unit& u) const {
        const long L = (long)i * G + c; if (L >= nwg) return false;
        int wgid = (int)L; { const int q = nwg / NXCD, r = nwg % NXCD, xcd = wgid % NXCD, off = wgid / NXCD; wgid = (xcd < r ? xcd * (q + 1) : r * (q + 1) + (xcd - r) * q) + off; }
        const int nig = WGM * nN, gid = wgid / nig, fm = gid * WGM, gsz = (nM - fm) < WGM ? (nM - fm) : WGM;
        u.pm = fm + ((wgid % nig) % gsz); u.pn = (wgid % nig) / gsz; u.e = 0; u.pl = u.pn; return true;
    }
    __device__ __forceinline__ void a_ready(const Unit&) const {}
    __device__ __forceinline__ void done(const Unit&) const {}
};


__device__ __forceinline__ unsigned cvt_pk_bf16(float lo, float hi) { unsigned r; asm volatile("v_cvt_pk_bf16_f32 %0, %1, %2" : "=v"(r) : "v"(lo), "v"(hi)); return r; }
__device__ __forceinline__ float bf_lo(unsigned w) { return __uint_as_float(w << 16); }
__device__ __forceinline__ float bf_hi(unsigned w) { return __uint_as_float(w & 0xffff0000u); }
__device__ __forceinline__ float sigm(float x) { return 1.f / (1.f + __expf(-x)); }
__device__ __forceinline__ u32x4 pack8(const f32x4 v0, const f32x4 v1) { u32x4 w; w.x = cvt_pk_bf16(v0[0], v0[1]); w.y = cvt_pk_bf16(v0[2], v0[3]); w.z = cvt_pk_bf16(v1[0], v1[1]); w.w = cvt_pk_bf16(v1[2], v1[3]); return w; }
__device__ __forceinline__ void unpack8(const u32x4 w, f32x4& v0, f32x4& v1) { v0 = (f32x4){bf_lo(w.x), bf_hi(w.x), bf_lo(w.y), bf_hi(w.y)}; v1 = (f32x4){bf_lo(w.z), bf_hi(w.z), bf_lo(w.w), bf_hi(w.w)}; }

struct EpiBf16Plain {
    static constexpr bool PERM = true, AFTER_DRAIN = false;
    bf16_t* O; int ldc, pad;
    __device__ __forceinline__ void operator()(const f32x4 (&acc)[2][2][4][2], const Unit& u, int wr, int wc, int fr, int fq) const {
        const int row0 = u.pm * BM + wr * 64 + fr, col0 = u.pl * BM + wc * 32 + 8 * fq;
#pragma unroll
        for (int ai = 0; ai < 2; ++ai)
#pragma unroll
            for (int m = 0; m < 4; ++m) { bf16_t* rowp = O + (size_t)(row0 + ai * HALF + m * 16) * ldc + col0;
#pragma unroll
                for (int bj = 0; bj < 2; ++bj) *(u32x4*)(rowp + bj * HALF) = pack8(acc[ai][bj][m][0], acc[ai][bj][m][1]); }
    }
};
struct EpiGlu {
    static constexpr bool PERM = true, AFTER_DRAIN = false;
    bf16_t* O; int ldc, pad;
    __device__ __forceinline__ void operator()(const f32x4 (&acc)[2][2][4][2], const Unit& u, int wr, int wc, int fr, int fq) const {
        const int row0 = u.pm * BM + wr * 64 + fr, col0 = u.pl * HALF + wc * 32 + 8 * fq;
#pragma unroll
        for (int ai = 0; ai < 2; ++ai)
#pragma unroll
            for (int m = 0; m < 4; ++m) { bf16_t* rowp = O + (size_t)(row0 + ai * HALF + m * 16) * ldc + col0;
                f32x4 o0, o1;
#pragma unroll
                for (int j = 0; j < 4; ++j) { o0[j] = acc[ai][0][m][0][j] * sigm(acc[ai][1][m][0][j]); o1[j] = acc[ai][0][m][1][j] * sigm(acc[ai][1][m][1][j]); }
                *(u32x4*)rowp = pack8(o0, o1); }
    }
};
template <bool ADD> struct EpiGate {
    static constexpr bool PERM = true, AFTER_DRAIN = false;
    bf16_t* O; const bf16_t* G; int ldc, ldg, gcol, pad;
    __device__ __forceinline__ void operator()(const f32x4 (&acc)[2][2][4][2], const Unit& u, int wr, int wc, int fr, int fq) const {
        const int row0 = u.pm * BM + wr * 64 + fr, col0 = u.pl * BM + wc * 32 + 8 * fq;
#pragma unroll
        for (int ai = 0; ai < 2; ++ai)
#pragma unroll
            for (int m = 0; m < 4; ++m) { const size_t r = (size_t)(row0 + ai * HALF + m * 16);
#pragma unroll
                for (int bj = 0; bj < 2; ++bj) {
                    const u32x4 gw = *(const u32x4*)(G + r * ldg + gcol + col0 + bj * HALF);
                    f32x4 g0, g1; unpack8(gw, g0, g1);
                    f32x4 o0, o1;
#pragma unroll
                    for (int j = 0; j < 4; ++j) { o0[j] = sigm(g0[j]) * acc[ai][bj][m][0][j]; o1[j] = sigm(g1[j]) * acc[ai][bj][m][1][j]; }
                    bf16_t* p = O + r * ldc + col0 + bj * HALF;
                    if (ADD) { const u32x4 ow = __builtin_nontemporal_load((const u32x4*)p); f32x4 p0, p1; unpack8(ow, p0, p1); o0 += p0; o1 += p1; }
                    *(u32x4*)p = pack8(o0, o1); } }
    }
};
struct EpiResid {
    static constexpr bool PERM = false, AFTER_DRAIN = false;
    const float* base; float* out; int ldc, pad;
    __device__ __forceinline__ void operator()(const f32x4 (&acc)[2][2][4][2], const Unit& u, int wr, int wc, int fr, int fq) const {
        const int row0 = u.pm * BM + wr * 64 + fr, col0 = u.pl * BM + wc * 32 + 4 * fq;
#pragma unroll
        for (int ai = 0; ai < 2; ++ai)
#pragma unroll
            for (int m = 0; m < 4; ++m) { const size_t off = (size_t)(row0 + ai * HALF + m * 16) * ldc + col0;
#pragma unroll
                for (int bj = 0; bj < 2; ++bj)
#pragma unroll
                    for (int n = 0; n < 2; ++n) { const f32x4 b = *(const f32x4*)(base + off + bj * HALF + n * 16); *(f32x4*)(out + off + bj * HALF + n * 16) = b + acc[ai][bj][m][n]; } }
    }
};
struct EpiSwiglu {
    static constexpr bool PERM = true, AFTER_DRAIN = false;
    bf16_t* O; const float* bias; int ldc, dff; float limit, alpha;
    __device__ __forceinline__ void operator()(const f32x4 (&acc)[2][2][4][2], const Unit& u, int wr, int wc, int fr, int fq) const {
        const int row0 = u.pm * BM + wr * 64 + fr, col0 = u.pl * HALF + wc * 32 + 8 * fq;
        const float* bg = bias + (size_t)u.e * 2 * dff + col0; const float* bu = bg + dff;
        const f32x4 bg0 = *(const f32x4*)bg, bg1 = *(const f32x4*)(bg + 4), bu0 = *(const f32x4*)bu, bu1 = *(const f32x4*)(bu + 4);
#pragma unroll
        for (int ai = 0; ai < 2; ++ai)
#pragma unroll
            for (int m = 0; m < 4; ++m) { bf16_t* rowp = O + (size_t)(row0 + ai * HALF + m * 16) * ldc + col0;
                f32x4 o0, o1;
#pragma unroll
                for (int j = 0; j < 4; ++j) {
                    float g = fminf(acc[ai][0][m][0][j] + bg0[j], limit), up = fminf(fmaxf(acc[ai][1][m][0][j] + bu0[j], -limit), limit);
                    o0[j] = (up + 1.f) * g * sigm(alpha * g);
                    g = fminf(acc[ai][0][m][1][j] + bg1[j], limit); up = fminf(fmaxf(acc[ai][1][m][1][j] + bu1[j], -limit), limit);
                    o1[j] = (up + 1.f) * g * sigm(alpha * g); }
                *(u32x4*)rowp = pack8(o0, o1); }
    }
};
struct EpiDown {
    static constexpr bool PERM = true, AFTER_DRAIN = false;
    bf16_t* O; const float* bias; int ldc, ncol;
    __device__ __forceinline__ void operator()(const f32x4 (&acc)[2][2][4][2], const Unit& u, int wr, int wc, int fr, int fq) const {
        const int row0 = u.pm * BM + wr * 64 + fr, col0 = u.pl * BM + wc * 32 + 8 * fq;
        const float* bp = bias + (size_t)u.e * ncol + col0;
        f32x4 bv[2][2];
#pragma unroll
        for (int bj = 0; bj < 2; ++bj) { bv[bj][0] = *(const f32x4*)(bp + bj * HALF); bv[bj][1] = *(const f32x4*)(bp + bj * HALF + 4); }
#pragma unroll
        for (int ai = 0; ai < 2; ++ai)
#pragma unroll
            for (int m = 0; m < 4; ++m) { bf16_t* rowp = O + (size_t)(row0 + ai * HALF + m * 16) * ldc + col0;
#pragma unroll
                for (int bj = 0; bj < 2; ++bj) *(u32x4*)(rowp + bj * HALF) = pack8(acc[ai][bj][m][0] + bv[bj][0], acc[ai][bj][m][1] + bv[bj][1]); }
    }
};
struct GroupedOrder {
    const int* tile_e; const int* n_mt; int nN, G, c;
    __device__ __forceinline__ bool next(int i, Unit& u) const {
        const int nmt = __builtin_amdgcn_readfirstlane(*(const volatile int*)n_mt); const long L = (long)i * G + c; if (L >= (long)nmt * nN) return false;
        const int mt = (int)(L / nN), pl = (int)(L % nN); const int e = __builtin_amdgcn_readfirstlane(*(const volatile int*)(tile_e + mt));
        u.pm = mt; u.pn = e * nN + pl; u.e = e; u.pl = pl; return true;
    }
    __device__ __forceinline__ void a_ready(const Unit&) const {}
    __device__ __forceinline__ void done(const Unit&) const {}
};
template <class Epi, class Sched, bool ALIGN_EPI = false, bool SP2 = false>
__device__ __forceinline__ void gemm_phase(PG8_LAS unsigned char* lds, const Gemm g, const Sched& S, const Epi& E) {
    const int tid = threadIdx.x, wid = __builtin_amdgcn_readfirstlane(tid >> 6), lane = tid & 63, wr = wid >> 2, wc = wid & 3, fr = lane & 15, fq = lane >> 4;
    const int K = g.K, nt = K / BK;
    unsigned voffA[2], voffB[2];
#pragma unroll
    for (int i = 0; i < 2; ++i) { int R, C; stage_rc(tid * 16 + i * 8192, R, C); const int Rb = Epi::PERM ? ((R & ~31) + perm32(R & 31)) : R;
        voffA[i] = (unsigned)(R * K + C) * 2u; voffB[i] = (unsigned)(Rb * K + C) * 2u; }
    const size_t kstep = (size_t)(BK * 2);
    const size_t hstep = (size_t)HALF * K * 2;
    const size_t tstep = 2 * hstep;
    const unsigned ldsw = (unsigned)wid * 1024u;
    const int aoff = lds_byte(wr * 64 + fr, fq * 8), boff = lds_byte(wc * 32 + fr, fq * 8);
#define PG8_SA(b, h) (((b) * 2 + (h)) * HTB)
#define PG8_SB(b, h) ((4 + (b) * 2 + (h)) * HTB)
#define PG8_STAGE(bufoff, gbase, voff) do { _Pragma("unroll") for (int _i = 0; _i < 2; ++_i) \
        __builtin_amdgcn_global_load_lds((const unsigned*)((const char*)(gbase) + (voff)[_i]), (PG8_LAS unsigned*)(lds + (bufoff) + ldsw + _i * 8192), 16, 0, 0); } while (0)
#define PG8_LDA(dst, b, h) do { _Pragma("unroll") for (int m = 0; m < 4; ++m) _Pragma("unroll") for (int k = 0; k < 2; ++k) dst[m][k] = *(const PG8_LAS bf16x8*)(lds + PG8_SA(b, h) + aoff + m * 2048 + k * 1024); } while (0)
#define PG8_LDB(dst, b, h) do { _Pragma("unroll") for (int n = 0; n < 2; ++n) _Pragma("unroll") for (int k = 0; k < 2; ++k) dst[n][k] = *(const PG8_LAS bf16x8*)(lds + PG8_SB(b, h) + boff + n * 2048 + k * 1024); } while (0)
#define PG8_MMA(ai, bj, At, Bt) do { __builtin_amdgcn_s_setprio(1); _Pragma("unroll") for (int m = 0; m < 4; ++m) _Pragma("unroll") for (int n = 0; n < 2; ++n) _Pragma("unroll") for (int k = 0; k < 2; ++k) \
        acc[ai][bj][m][n] = __builtin_amdgcn_mfma_f32_16x16x32_bf16(Bt[n][k], At[m][k], acc[ai][bj][m][n], 0, 0, 0); __builtin_amdgcn_s_setprio(0); } while (0)
#define PG8_WAIT_V(n) asm volatile("s_waitcnt vmcnt(" #n ")" ::: "memory")
#define PG8_WAIT_L(n) asm volatile("s_waitcnt lgkmcnt(" #n ")" ::: "memory")
#define PG8_BAR __builtin_amdgcn_s_barrier()
#define PG8_SCHED __builtin_amdgcn_sched_barrier(0)
    Unit cur, nxt; int ui = 0;
    if (!S.next(0, cur)) return;
    f32x4 acc[2][2][4][2];
#pragma unroll
    for (int a = 0; a < 2; ++a)
#pragma unroll
        for (int b = 0; b < 2; ++b)
#pragma unroll
            for (int m = 0; m < 4; ++m)
#pragma unroll
                for (int n = 0; n < 2; ++n) acc[a][b][m][n] = (f32x4){0.f, 0.f, 0.f, 0.f};
    bf16x8 At[4][2], B0[2][2], B1[2][2];
    const char* cA = (const char*)g.A + (size_t)cur.pm * tstep; const char* cB = (const char*)g.Bt + (size_t)cur.pn * tstep;
    S.a_ready(cur);
    if constexpr (SP2) {
        PG8_STAGE(PG8_SB(0, 0), cB, voffB); PG8_STAGE(PG8_SB(0, 1), cB + hstep, voffB); PG8_STAGE(PG8_SA(0, 0), cA, voffA); PG8_STAGE(PG8_SA(0, 1), cA + hstep, voffA);
        if (wr == 1) PG8_BAR;
        PG8_WAIT_V(2); PG8_BAR;
        PG8_STAGE(PG8_SB(1, 0), cB + kstep, voffB); PG8_STAGE(PG8_SA(1, 0), cA + kstep, voffA); PG8_STAGE(PG8_SB(1, 1), cB + hstep + kstep, voffB);
        PG8_WAIT_V(6); PG8_BAR;
    } else {
        PG8_STAGE(PG8_SB(0, 0), cB, voffB); PG8_STAGE(PG8_SA(0, 0), cA, voffA); PG8_STAGE(PG8_SB(0, 1), cB + hstep, voffB); PG8_STAGE(PG8_SA(0, 1), cA + hstep, voffA);
        if (wr == 1) PG8_BAR;
        PG8_WAIT_V(4); PG8_BAR;
        PG8_STAGE(PG8_SB(1, 0), cB + kstep, voffB); PG8_STAGE(PG8_SA(1, 0), cA + kstep, voffA); PG8_STAGE(PG8_SB(1, 1), cB + hstep + kstep, voffB);
        PG8_WAIT_V(6); PG8_BAR;
    }
    for (;;) {
        const bool has_next = S.next(ui + 1, nxt);
        const char* nA = has_next ? (const char*)g.A + (size_t)nxt.pm * tstep : cA; const char* nB = has_next ? (const char*)g.Bt + (size_t)nxt.pn * tstep : cB;
        for (int t = 0; t < nt; t += 2) {
            const bool last = (t == nt - 2);
            const char* a1 = cA + (size_t)(t + 1) * kstep;
            const char* a2 = last ? nA : cA + (size_t)(t + 2) * kstep; const char* b2 = last ? nB : cB + (size_t)(t + 2) * kstep;
            const char* a3 = a2 + kstep; const char* b3 = b2 + kstep;
            if (last && has_next) S.a_ready(nxt);
            if constexpr (SP2) {
            PG8_LDB(B0, 0, 0); PG8_LDB(B1, 0, 1); PG8_SCHED; PG8_LDA(At, 0, 0); PG8_STAGE(PG8_SA(1, 1), a1 + hstep, voffA);
            PG8_WAIT_V(8); PG8_WAIT_L(0); PG8_BAR; PG8_MMA(0, 0, At, B0); PG8_MMA(0, 1, At, B1); PG8_BAR; PG8_SCHED;
            PG8_LDA(At, 0, 1); PG8_STAGE(PG8_SB(0, 0), b2, voffB); PG8_STAGE(PG8_SB(0, 1), b2 + hstep, voffB); PG8_STAGE(PG8_SA(0, 0), a2, voffA);
            PG8_WAIT_V(8); PG8_WAIT_L(0); PG8_BAR; PG8_MMA(1, 0, At, B0); PG8_MMA(1, 1, At, B1); PG8_BAR; PG8_SCHED;
            PG8_LDB(B0, 1, 0); PG8_LDB(B1, 1, 1); PG8_SCHED; PG8_LDA(At, 1, 0); PG8_STAGE(PG8_SA(0, 1), a2 + hstep, voffA);
            PG8_WAIT_V(8); PG8_WAIT_L(0); PG8_BAR; PG8_MMA(0, 0, At, B0); PG8_MMA(0, 1, At, B1); PG8_BAR; PG8_SCHED;
            PG8_LDA(At, 1, 1); PG8_STAGE(PG8_SB(1, 0), b3, voffB); PG8_STAGE(PG8_SB(1, 1), b3 + hstep, voffB); PG8_STAGE(PG8_SA(1, 0), a3, voffA);
            PG8_WAIT_V(8); PG8_WAIT_L(0); PG8_BAR; PG8_MMA(1, 0, At, B0); PG8_MMA(1, 1, At, B1); PG8_BAR; PG8_SCHED;
            } else {
            PG8_LDB(B0, 0, 0); PG8_SCHED; PG8_LDA(At, 0, 0); PG8_STAGE(PG8_SA(1, 1), a1 + hstep, voffA);
            PG8_WAIT_L(8); PG8_BAR; PG8_WAIT_L(0); PG8_MMA(0, 0, At, B0); PG8_BAR; PG8_SCHED;
            PG8_LDB(B1, 0, 1); PG8_STAGE(PG8_SB(0, 0), b2, voffB);
            PG8_BAR; PG8_WAIT_L(0); PG8_MMA(0, 1, At, B1); PG8_BAR;
            PG8_LDA(At, 0, 1); PG8_STAGE(PG8_SA(0, 0), a2, voffA);
            PG8_BAR; PG8_WAIT_L(0); PG8_MMA(1, 0, At, B0); PG8_BAR; PG8_SCHED;
            PG8_STAGE(PG8_SB(0, 1), b2 + hstep, voffB);
            PG8_WAIT_V(6); PG8_BAR; PG8_MMA(1, 1, At, B1); PG8_BAR;
            PG8_LDB(B0, 1, 0); PG8_SCHED; PG8_LDA(At, 1, 0); PG8_STAGE(PG8_SA(0, 1), a2 + hstep, voffA);
            PG8_WAIT_L(8); PG8_BAR; PG8_WAIT_L(0); PG8_MMA(0, 0, At, B0); PG8_BAR; PG8_SCHED;
            PG8_LDB(B1, 1, 1); PG8_STAGE(PG8_SB(1, 0), b3, voffB);
            PG8_BAR; PG8_WAIT_L(0); PG8_MMA(0, 1, At, B1); PG8_BAR;
            PG8_LDA(At, 1, 1); PG8_STAGE(PG8_SA(1, 0), a3, voffA);
            PG8_BAR; PG8_WAIT_L(0); PG8_MMA(1, 0, At, B0); PG8_BAR; PG8_SCHED;
            PG8_STAGE(PG8_SB(1, 1), b3 + hstep, voffB);
            PG8_WAIT_V(6); PG8_BAR; PG8_MMA(1, 1, At, B1); PG8_BAR;
            }
        }
        if constexpr (ALIGN_EPI) { if (wr == 0) PG8_BAR; }
        if constexpr (!Epi::AFTER_DRAIN) { E(acc, cur, wr, wc, fr, fq); S.done(cur); }
        if (!has_next) break;
#pragma unroll
        for (int a = 0; a < 2; ++a)
#pragma unroll
            for (int b = 0; b < 2; ++b)
#pragma unroll
                for (int m = 0; m < 4; ++m)
#pragma unroll
                    for (int n = 0; n < 2; ++n) acc[a][b][m][n] = (f32x4){0.f, 0.f, 0.f, 0.f};
        cur = nxt; cA = nA; cB = nB; ++ui;
        if constexpr (ALIGN_EPI) { if (wr == 1) PG8_BAR; }
    }
    PG8_WAIT_V(0);
    if constexpr (!ALIGN_EPI) { if (wr == 0) PG8_BAR; }
    PG8_BAR;
    if constexpr (Epi::AFTER_DRAIN) { E.fused(acc, cur, wr, wc, fr, fq, lds, wid, lane); S.done(cur); }
#undef PG8_SA
#undef PG8_SB
#undef PG8_STAGE
#undef PG8_LDA
#undef PG8_LDB
#undef PG8_MMA
#undef PG8_WAIT_V
#undef PG8_WAIT_L
#undef PG8_BAR
#undef PG8_SCHED
}
}

#define LAS __attribute__((address_space(3)))
typedef unsigned short bf16;
typedef unsigned v4u __attribute__((ext_vector_type(4)));
typedef float f32x4 __attribute__((ext_vector_type(4)));
__device__ __forceinline__ unsigned f2bf(float f) { unsigned u = __builtin_bit_cast(unsigned, f); return (u + 0x7fffu + ((u >> 16) & 1u)) >> 16; }
__device__ __forceinline__ unsigned pk2(float lo, float hi) { return f2bf(lo) | (f2bf(hi) << 16); }
__device__ __forceinline__ float bf2f(bf16 b) { return __uint_as_float((unsigned)b << 16); }
__device__ __forceinline__ float wave_sum(float v) {
#pragma unroll
    for (int o = 1; o < 64; o <<= 1) v += __shfl_xor(v, o);
    return v;
}
__device__ __forceinline__ float wave_max(float v) {
#pragma unroll
    for (int o = 1; o < 64; o <<= 1) v = fmaxf(v, __shfl_xor(v, o));
    return v;
}
__device__ __forceinline__ float gelu_tanh(float x) { const float z = 1.5957691216f * (x + 0.044715f * x * x * x); return x / (1.f + __expf(-z)); }

constexpr size_t MiB = 1u << 20;
constexpr size_t WS_CTL = 0;
constexpr size_t CTL_ZERO_BYTES = 65536;
constexpr size_t WS_WIN = 1 * MiB, WS_WGLU = 10 * MiB, WS_WSSM = 14 * MiB, WS_WATT = 16 * MiB, WS_WOUT = 18 * MiB;
constexpr size_t WS_WGU = 20 * MiB, WS_WDN = 148 * MiB;
constexpr size_t WS_S5TAB = 212 * MiB;
constexpr size_t WS_ROUTE = 216 * MiB;
constexpr size_t WS_H = 224 * MiB;
constexpr size_t WS_PROJ = 288 * MiB;
constexpr size_t WS_S5OUT = 576 * MiB;
constexpr size_t WS_ATTN = 640 * MiB;
constexpr size_t WS_ACT = 704 * MiB;
constexpr size_t WS_END = 976 * MiB;
static_assert(WS_PROJ + (size_t)T * IN_W * 2 <= WS_S5OUT && WS_PROJ + (size_t)MAXROWS * 1024 * 2 <= WS_S5OUT && WS_ACT + (size_t)MAXROWS * 1024 * 2 <= WS_END, "ws map");
constexpr int CW_CNT = 0;
constexpr int CW_CUR = 64;
constexpr int CW_PADSTART = 128;
constexpr int CW_NMT = 192;
constexpr int CW_TILE_E = 256;
constexpr size_t RT_TOPI = 0, RT_TOPW = (size_t)NA * 4, RT_DEST = 2 * (size_t)NA * 4, RT_ROWTOK = 3 * (size_t)NA * 4;

__device__ __forceinline__ void transpose_item(const float* W, int K, int N, bf16* WT, int mode, LAS float* scr, int item, int lane) {
    const int nblk = N / 32, kb = item / nblk, nb = item % nblk, k0 = 64 * kb, n0 = 32 * nb;
#pragma unroll 8
    for (int i = 0; i < 32; ++i) { const int kk = 2 * i + (lane >> 5); scr[kk * 33 + (lane & 31)] = W[(size_t)(k0 + kk) * N + n0 + (lane & 31)]; }
    asm volatile("s_waitcnt lgkmcnt(0)" ::: "memory");
    int r0 = n0;
    if (mode == 1) { const int nh = N / 2; r0 = (n0 < nh) ? 256 * (n0 / 128) + (n0 % 128) : 256 * ((n0 - nh) / 128) + 128 + ((n0 - nh) % 128); }
    const int c = lane & 7;
#pragma unroll
    for (int j = 0; j < 4; ++j) { const int n = (lane >> 3) + 8 * j; const LAS float* s = scr + (8 * c) * 33 + n;
        v4u o; o.x = pk2(s[0 * 33], s[1 * 33]); o.y = pk2(s[2 * 33], s[3 * 33]); o.z = pk2(s[4 * 33], s[5 * 33]); o.w = pk2(s[6 * 33], s[7 * 33]);
        *(v4u*)(WT + (size_t)(r0 + n) * K + k0 + 8 * c) = o; }
    asm volatile("s_waitcnt lgkmcnt(0)" ::: "memory");
}
struct TrJob { const float* W; bf16* WT; int K, N, mode, nmat; };
__global__ void __launch_bounds__(512) k_transpose(TrJob j) {
    __shared__ float scr_all[8 * 64 * 33];
    const int lane = threadIdx.x & 63, wave = threadIdx.x >> 6;
    LAS float* scr = (LAS float*)scr_all + wave * 64 * 33;
    const int per = (j.K / 64) * (j.N / 32); const long total = (long)per * j.nmat;
    for (long it = (long)blockIdx.x * 8 + wave; it < total; it += (long)gridDim.x * 8) {
        const int mat = (int)(it / per), item = (int)(it % per);
        transpose_item(j.W + (size_t)mat * j.K * j.N, j.K, j.N, j.WT + (size_t)mat * j.K * j.N, j.mode, scr, item, lane);
    }
}
__global__ void __launch_bounds__(512) k_rmsnorm_bf16(const float* x, const float* g, bf16* out, int rows) {
    const int lane = threadIdx.x & 63, gw = blockIdx.x * 8 + (threadIdx.x >> 6), ngw = gridDim.x * 8;
    for (int m = gw; m < rows; m += ngw) {
        const f32x4* xr = (const f32x4*)(x + (size_t)m * DM) + lane; f32x4 v[4]; float s = 0.f;
#pragma unroll
        for (int j = 0; j < 4; ++j) { v[j] = xr[64 * j]; s += (v[j].x * v[j].x + v[j].y * v[j].y) + (v[j].z * v[j].z + v[j].w * v[j].w); }
        const float rs = rsqrtf(wave_sum(s) * (1.f / DM) + EPS);
        unsigned long long* o8 = (unsigned long long*)(out + (size_t)m * DM) + lane;
#pragma unroll
        for (int j = 0; j < 4; ++j) { const f32x4 gg = ((const f32x4*)g)[64 * j + lane];
            o8[64 * j] = (unsigned long long)pk2(v[j].x * rs * gg.x, v[j].y * rs * gg.y) | ((unsigned long long)pk2(v[j].z * rs * gg.z, v[j].w * rs * gg.w) << 32); }
    }
}
__global__ void k_s5_tables(const float* a_re, const float* a_im, const float* log_dt, const float* b_re, const float* b_im, float* tab) {
    const int i = blockIdx.x * blockDim.x + threadIdx.x; if (i >= NG * NP) return;
    const int g = i / NP;
    const double dt = exp((double)log_dt[g]), are = a_re[i], aim = a_im[i];
    const double mag = exp(are * dt), abr = mag * cos(aim * dt), abi = mag * sin(aim * dt), den = are * are + aim * aim;
    const double em1 = abr - 1.0;
    const double qre = (em1 * are + abi * aim) / den, qim = (abi * are - em1 * aim) / den;
    float* ABAR = tab; float* BRE = tab + NG * NP * 2; float* BIM = BRE + NG * NP * GCH;
    ABAR[2 * i] = (float)abr; ABAR[2 * i + 1] = (float)abi;
    for (int h = 0; h < GCH; ++h) { const double br = b_re[i * GCH + h], bi = b_im[i * GCH + h];
        BRE[i * GCH + h] = (float)(qre * br - qim * bi); BIM[i * GCH + h] = (float)(qre * bi + qim * br); }
}
__global__ void __launch_bounds__(64) k_s5_naive(const bf16* proj, const float* tab, const float* c_re, const float* c_im, const float* d_skip, bf16* out) {
    __shared__ float sre[4][64], sim[4][64], us[4][16];
    const int b = blockIdx.x / NG, g = blockIdx.x % NG, p = threadIdx.x, lane = threadIdx.x;
    const float* ABAR = tab; const float* BRE = tab + NG * NP * 2; const float* BIM = BRE + NG * NP * GCH;
    const float ar = ABAR[2 * (g * NP + p)], ai = ABAR[2 * (g * NP + p) + 1];
    float bre[16], bim[16];
#pragma unroll
    for (int h = 0; h < 16; ++h) { bre[h] = BRE[(g * NP + p) * 16 + h]; bim[h] = BIM[(g * NP + p) * 16 + h]; }
    const int ti = lane >> 4, hh = lane & 15;
    const float dsk = d_skip[g * 16 + hh];
    float s_re = 0.f, s_im = 0.f;
    for (int t0 = 0; t0 < SEQ; t0 += 4) {
        us[ti][hh] = bf2f(proj[(size_t)(b * SEQ + t0 + ti) * IN_W + C_U + g * 16 + hh]);
        __syncthreads();
#pragma unroll
        for (int i = 0; i < 4; ++i) {
            float bur = 0.f, bui = 0.f;
#pragma unroll
            for (int h = 0; h < 16; ++h) { const float u = us[i][h]; bur += u * bre[h]; bui += u * bim[h]; }
            const float nr = ar * s_re - ai * s_im + bur, ni = ar * s_im + ai * s_re + bui;
            s_re = nr; s_im = ni; sre[i][p] = nr; sim[i][p] = ni;
        }
        __syncthreads();
        float y = dsk * us[ti][hh];
        const float* cr = c_re + (size_t)(g * 16 + hh) * NP; const float* ci = c_im + (size_t)(g * 16 + hh) * NP;
#pragma unroll 8
        for (int q = 0; q < 64; ++q) y += sre[ti][q] * cr[q] - sim[ti][q] * ci[q];
        out[(size_t)(b * SEQ + t0 + ti) * 1024 + g * 16 + hh] = (bf16)f2bf(gelu_tanh(y));
        __syncthreads();
    }
}
__global__ void __launch_bounds__(256) k_qknorm(bf16* proj, const float* qg, const float* kg) {
    const int lane = threadIdx.x & 63; const long gw = (long)blockIdx.x * 4 + (threadIdx.x >> 6); const long total = (long)T * 20;
    if (gw >= total) return;
    const int tok = (int)(gw / 20), hd = (int)(gw % 20);
    bf16* p = proj + (size_t)tok * IN_W + C_Q + hd * 64 + lane;
    const float v = bf2f(*p); const float rs = rsqrtf(wave_sum(v * v) * (1.f / 64.f) + EPS);
    const float g = hd < 16 ? qg[lane] : kg[lane];
    *p = (bf16)f2bf(v * rs * g);
}
__global__ void __launch_bounds__(256) k_attn_naive(const bf16* proj, const float* sinks, bf16* out) {
    __shared__ float qs[4][64], ps[4][128];
    const int lane = threadIdx.x & 63, w = threadIdx.x >> 6;
    const int tok = blockIdx.x / 4, kvh = blockIdx.x % 4, h = kvh * 4 + w;
    const int b = tok / SEQ, t = tok % SEQ;
    qs[w][lane] = bf2f(proj[(size_t)tok * IN_W + C_Q + h * 64 + lane]);
    __syncthreads();
    const float slope = exp2f(-0.5f * (float)(h + 1));
    float sc[2];
#pragma unroll
    for (int r = 0; r < 2; ++r) {
        const int dist = lane + 64 * r, s = t - dist;
        float a = -INFINITY;
        if (s >= 0) { const bf16* kp = proj + (size_t)(b * SEQ + s) * IN_W + C_K + kvh * 64; float d = 0.f;
            const v4u* kp4 = (const v4u*)kp;
#pragma unroll
            for (int i = 0; i < 8; ++i) { const v4u kw = kp4[i]; const float* qq = &qs[w][8 * i];
                d += qq[0] * __uint_as_float(kw.x << 16) + qq[1] * __uint_as_float(kw.x & 0xffff0000u) + qq[2] * __uint_as_float(kw.y << 16) + qq[3] * __uint_as_float(kw.y & 0xffff0000u)
                   + qq[4] * __uint_as_float(kw.z << 16) + qq[5] * __uint_as_float(kw.z & 0xffff0000u) + qq[6] * __uint_as_float(kw.w << 16) + qq[7] * __uint_as_float(kw.w & 0xffff0000u); }
            a = d * 0.125f - slope * (float)dist; }
        sc[r] = a;
    }
    const float sink = sinks[h];
    const float m = fmaxf(wave_max(fmaxf(sc[0], sc[1])), sink);
    const float p0 = __expf(sc[0] - m), p1 = __expf(sc[1] - m);
    const float denom = wave_sum(p0 + p1) + __expf(sink - m);
    ps[w][lane] = p0; ps[w][lane + 64] = p1;
    __syncthreads();
    float o = 0.f;
    const int nk = (t + 1 < 128) ? t + 1 : 128;
    for (int dist = 0; dist < nk; ++dist) o += ps[w][dist] * bf2f(proj[(size_t)(b * SEQ + t - dist) * IN_W + C_V + kvh * 64 + lane]);
    out[(size_t)tok * 1024 + h * 64 + lane] = (bf16)f2bf(o / denom);
}

__global__ void __launch_bounds__(512) k_router(const float* x1, const float* g2, const float* w_router, const float* b_router, bf16* h2, int* top_i, float* top_w, unsigned* ctl) {
    __shared__ float hn[8][1024];
    const int lane = threadIdx.x & 63, w = threadIdx.x >> 6;
    const int gw = blockIdx.x * 8 + w, ngw = gridDim.x * 8;
    for (int tok = gw; tok < T; tok += ngw) {
        const f32x4* xr = (const f32x4*)(x1 + (size_t)tok * DM) + lane; f32x4 v[4]; float s = 0.f;
#pragma unroll
        for (int j = 0; j < 4; ++j) { v[j] = xr[64 * j]; s += (v[j].x * v[j].x + v[j].y * v[j].y) + (v[j].z * v[j].z + v[j].w * v[j].w); }
        const float rs = rsqrtf(wave_sum(s) * (1.f / DM) + EPS);
        unsigned long long* o8 = (unsigned long long*)(h2 + (size_t)tok * DM) + lane;
#pragma unroll
        for (int j = 0; j < 4; ++j) { const f32x4 gg = ((const f32x4*)g2)[64 * j + lane];
            const f32x4 y = (f32x4){v[j].x * rs * gg.x, v[j].y * rs * gg.y, v[j].z * rs * gg.z, v[j].w * rs * gg.w};
            *(f32x4*)&hn[w][256 * j + 4 * lane] = y;
            o8[64 * j] = (unsigned long long)pk2(y.x, y.y) | ((unsigned long long)pk2(y.z, y.w) << 32); }
        __builtin_amdgcn_wave_barrier(); asm volatile("s_waitcnt lgkmcnt(0)" ::: "memory");
        const int e = lane & 31, half = lane >> 5;
        float acc = 0.f;
        const float* wr = w_router + (size_t)(512 * half) * NE + e; const float* hv = &hn[w][512 * half];
#pragma unroll 8
        for (int d = 0; d < 512; ++d) acc += hv[d] * wr[(size_t)d * NE];
        acc += __shfl_xor(acc, 32);
        float logit = acc + b_router[e];
        float tv[4]; int ti[4];
#pragma unroll
        for (int k = 0; k < 4; ++k) {
            const float mx = wave_max(logit);
            const unsigned long long bal = __ballot(logit == mx);
            const int idx = __ffsll((long long)bal) - 1;
            tv[k] = mx; ti[k] = idx & 31;
            if (e == (idx & 31)) logit = -INFINITY;
        }
        const float e1 = __expf(tv[1] - tv[0]), e2 = __expf(tv[2] - tv[0]), e3 = __expf(tv[3] - tv[0]); const float inv = 1.f / (1.f + e1 + e2 + e3);
        if (lane < 4) { const int k = lane; const int ei = k == 0 ? ti[0] : k == 1 ? ti[1] : k == 2 ? ti[2] : ti[3]; const float wv = (k == 0 ? 1.f : k == 1 ? e1 : k == 2 ? e2 : e3) * inv;
            top_i[tok * 4 + k] = ei; top_w[tok * 4 + k] = wv; atomicAdd(ctl + CW_CNT + ei, 1u); }
        __builtin_amdgcn_wave_barrier(); asm volatile("s_waitcnt lgkmcnt(0)" ::: "memory");
    }
}
__global__ void k_route_offsets(unsigned* ctl) {
    if (threadIdx.x == 0) { unsigned run = 0; int mt = 0;
        for (int e = 0; e < NE; ++e) { const unsigned c = ctl[CW_CNT + e]; const unsigned padded = (c + 255u) / 256u * 256u; ctl[CW_PADSTART + e] = run;
            for (unsigned i = 0; i < padded / 256u; ++i) ctl[CW_TILE_E + mt++] = (unsigned)e; run += padded; }
        ctl[CW_PADSTART + NE] = run; ctl[CW_NMT] = (unsigned)mt; }
}
__global__ void k_route_scatter(const int* top_i, unsigned* ctl, int* dest) {
    const int a = blockIdx.x * blockDim.x + threadIdx.x; if (a >= NA) return;
    const int e = top_i[a]; const unsigned pos = atomicAdd(ctl + CW_CUR + e, 1u);
    dest[a] = (int)(ctl[CW_PADSTART + e] + pos);
}
__global__ void __launch_bounds__(256) k_gather_rows(const bf16* h2, const int* dest, bf16* hs) {
    const int lane = threadIdx.x & 63; const int a = blockIdx.x * 4 + (threadIdx.x >> 6); if (a >= NA) return;
    const v4u* s = (const v4u*)(h2 + (size_t)(a >> 2) * DM); v4u* d = (v4u*)(hs + (size_t)dest[a] * DM);
    d[lane] = s[lane]; d[lane + 64] = s[lane + 64];
}
__global__ void __launch_bounds__(256) k_combine(float* out, const bf16* ys, const int* dest, const float* top_w) {
    const int lane = threadIdx.x & 63; const int tok = blockIdx.x * 4 + (threadIdx.x >> 6); if (tok >= T) return;
    f32x4* o = (f32x4*)(out + (size_t)tok * DM);
    f32x4 acc[4];
#pragma unroll
    for (int j = 0; j < 4; ++j) acc[j] = o[64 * j + lane];
#pragma unroll
    for (int k = 0; k < 4; ++k) { const float wv = top_w[tok * 4 + k]; const unsigned long long* y8 = (const unsigned long long*)(ys + (size_t)dest[tok * 4 + k] * DM);
#pragma unroll
        for (int j = 0; j < 4; ++j) { const unsigned long long q = y8[64 * j + lane]; const unsigned lo = (unsigned)q, hi = (unsigned)(q >> 32);
            acc[j].x += wv * __uint_as_float(lo << 16); acc[j].y += wv * __uint_as_float(lo & 0xffff0000u); acc[j].z += wv * __uint_as_float(hi << 16); acc[j].w += wv * __uint_as_float(hi & 0xffff0000u); } }
#pragma unroll
    for (int j = 0; j < 4; ++j) o[64 * j + lane] = acc[j];
}

template <class Epi>
__global__ void __launch_bounds__(512, 2) k_gemm_static(pg8::Gemm g, Epi E) {
    extern __shared__ __attribute__((aligned(16))) unsigned char lds[];
    pg8::StaticOrder S; S.init(g.M, g.N, (int)gridDim.x, (int)blockIdx.x);
    pg8::gemm_phase<Epi, pg8::StaticOrder, true, true>((PG8_LAS unsigned char*)lds, g, S, E);
}
template <class Epi>
__global__ void __launch_bounds__(512, 2) k_gemm_grouped(pg8::Gemm g, const int* tile_e, const int* n_mt, int nN, int pad, Epi E) {
    extern __shared__ __attribute__((aligned(16))) unsigned char lds[];
    pg8::GroupedOrder S; S.tile_e = tile_e; S.n_mt = n_mt; S.nN = nN; S.G = (int)gridDim.x; S.c = (int)blockIdx.x;
    pg8::gemm_phase<Epi, pg8::GroupedOrder, true, true>((PG8_LAS unsigned char*)lds, g, S, E);
}
constexpr int GEMM_LDS = 131072;

extern "C" void kernel_launch(void* const* d_in, const int* in_sizes, int n_in, void* d_out, int out_size, void* d_ws, size_t ws_size, hipStream_t stream) {
    static int ok = 0;
    if (ok == 0) {
        if (n_in != 25 || in_sizes[0] != T * DM || out_size != T * DM || ws_size < WS_END) { fprintf(stderr, "kernel_launch: unexpected shapes / workspace (n_in %d, ws %zu)\n", n_in, ws_size); ok = -1; return; }
        hipFuncSetAttribute((const void*)k_gemm_static<pg8::EpiBf16Plain>, hipFuncAttributeMaxDynamicSharedMemorySize, GEMM_LDS);
        hipFuncSetAttribute((const void*)k_gemm_static<pg8::EpiGlu>, hipFuncAttributeMaxDynamicSharedMemorySize, GEMM_LDS);
        hipFuncSetAttribute((const void*)k_gemm_static<pg8::EpiGate<false>>, hipFuncAttributeMaxDynamicSharedMemorySize, GEMM_LDS);
        hipFuncSetAttribute((const void*)k_gemm_static<pg8::EpiGate<true>>, hipFuncAttributeMaxDynamicSharedMemorySize, GEMM_LDS);
        hipFuncSetAttribute((const void*)k_gemm_static<pg8::EpiResid>, hipFuncAttributeMaxDynamicSharedMemorySize, GEMM_LDS);
        hipFuncSetAttribute((const void*)k_gemm_grouped<pg8::EpiSwiglu>, hipFuncAttributeMaxDynamicSharedMemorySize, GEMM_LDS);
        hipFuncSetAttribute((const void*)k_gemm_grouped<pg8::EpiDown>, hipFuncAttributeMaxDynamicSharedMemorySize, GEMM_LDS);
        ok = 1;
    }
    if (ok < 0) return;
    const float* x = (const float*)d_in[0]; const float* norm1_g = (const float*)d_in[1]; const float* w_in = (const float*)d_in[2];
    const float* a_re = (const float*)d_in[3]; const float* a_im = (const float*)d_in[4]; const float* log_dt = (const float*)d_in[5];
    const float* b_re = (const float*)d_in[6]; const float* b_im = (const float*)d_in[7]; const float* c_re = (const float*)d_in[8]; const float* c_im = (const float*)d_in[9];
    const float* ssm_d = (const float*)d_in[10]; const float* w_glu = (const float*)d_in[11]; const float* w_ssm = (const float*)d_in[12];
    const float* qg = (const float*)d_in[13]; const float* kg = (const float*)d_in[14]; const float* sinks = (const float*)d_in[15];
    const float* w_att = (const float*)d_in[16]; const float* w_out = (const float*)d_in[17]; const float* norm2_g = (const float*)d_in[18];
    const float* w_router = (const float*)d_in[19]; const float* b_router = (const float*)d_in[20]; const float* w_gu = (const float*)d_in[21];
    const float* b_gu = (const float*)d_in[22]; const float* w_dn = (const float*)d_in[23]; const float* b_dn = (const float*)d_in[24];
    float* out = (float*)d_out; unsigned char* ws = (unsigned char*)d_ws;
    unsigned* ctl = (unsigned*)(ws + WS_CTL);
    bf16* WIN = (bf16*)(ws + WS_WIN); bf16* WGLU = (bf16*)(ws + WS_WGLU); bf16* WSSM = (bf16*)(ws + WS_WSSM); bf16* WATT = (bf16*)(ws + WS_WATT); bf16* WOUT = (bf16*)(ws + WS_WOUT);
    bf16* WGU = (bf16*)(ws + WS_WGU); bf16* WDN = (bf16*)(ws + WS_WDN); float* S5TAB = (float*)(ws + WS_S5TAB);
    bf16* H = (bf16*)(ws + WS_H); bf16* PROJ = (bf16*)(ws + WS_PROJ); bf16* S5OUT = (bf16*)(ws + WS_S5OUT); bf16* ATTN = (bf16*)(ws + WS_ATTN);
    bf16* GLU = H; bf16* MIXED = S5OUT; bf16* H2 = ATTN; bf16* HS = PROJ; bf16* YS = PROJ; bf16* ACT = (bf16*)(ws + WS_ACT);
    int* top_i = (int*)(ws + WS_ROUTE + RT_TOPI); float* top_w = (float*)(ws + WS_ROUTE + RT_TOPW); int* dest = (int*)(ws + WS_ROUTE + RT_DEST);

    hipMemsetAsync(ws + WS_CTL, 0, CTL_ZERO_BYTES, stream);
    { TrJob j{}; j.W = w_in; j.WT = WIN; j.K = DM; j.N = IN_W; j.mode = 0; j.nmat = 1; k_transpose<<<512, 512, 0, stream>>>(j); }
    { TrJob j{}; j.W = w_glu; j.WT = WGLU; j.K = 1024; j.N = 2048; j.mode = 1; j.nmat = 1; k_transpose<<<512, 512, 0, stream>>>(j); }
    { TrJob j{}; j.W = w_ssm; j.WT = WSSM; j.K = 1024; j.N = 1024; j.mode = 0; j.nmat = 1; k_transpose<<<512, 512, 0, stream>>>(j); }
    { TrJob j{}; j.W = w_att; j.WT = WATT; j.K = 1024; j.N = 1024; j.mode = 0; j.nmat = 1; k_transpose<<<512, 512, 0, stream>>>(j); }
    { TrJob j{}; j.W = w_out; j.WT = WOUT; j.K = 1024; j.N = 1024; j.mode = 0; j.nmat = 1; k_transpose<<<512, 512, 0, stream>>>(j); }
    { TrJob j{}; j.W = w_gu; j.WT = WGU; j.K = 1024; j.N = 2048; j.mode = 1; j.nmat = NE; k_transpose<<<2048, 512, 0, stream>>>(j); }
    { TrJob j{}; j.W = w_dn; j.WT = WDN; j.K = 1024; j.N = 1024; j.mode = 0; j.nmat = NE; k_transpose<<<2048, 512, 0, stream>>>(j); }
    k_rmsnorm_bf16<<<2048, 512, 0, stream>>>(x, norm1_g, H, T);
    k_s5_tables<<<16, 256, 0, stream>>>(a_re, a_im, log_dt, b_re, b_im, S5TAB);
    { pg8::Gemm g{}; g.A = H; g.Bt = WIN; g.M = T; g.N = IN_W; g.K = DM; pg8::EpiBf16Plain e{}; e.O = PROJ; e.ldc = IN_W;
      k_gemm_static<pg8::EpiBf16Plain><<<256, 512, GEMM_LDS, stream>>>(g, e); }
    k_qknorm<<<(T * 20 + 3) / 4, 256, 0, stream>>>(PROJ, qg, kg);
    k_s5_naive<<<BATCH * NG, 64, 0, stream>>>(PROJ, S5TAB, c_re, c_im, ssm_d, S5OUT);
    k_attn_naive<<<T * 4, 256, 0, stream>>>(PROJ, sinks, ATTN);
    { pg8::Gemm g{}; g.A = S5OUT; g.Bt = WGLU; g.M = T; g.N = 2048; g.K = 1024; pg8::EpiGlu e{}; e.O = GLU; e.ldc = 1024;
      k_gemm_static<pg8::EpiGlu><<<256, 512, GEMM_LDS, stream>>>(g, e); }
    { pg8::Gemm g{}; g.A = GLU; g.Bt = WSSM; g.M = T; g.N = 1024; g.K = 1024; pg8::EpiGate<false> e{}; e.O = MIXED; e.ldc = 1024; e.G = PROJ; e.ldg = IN_W; e.gcol = C_GS;
      k_gemm_static<pg8::EpiGate<false>><<<256, 512, GEMM_LDS, stream>>>(g, e); }
    { pg8::Gemm g{}; g.A = ATTN; g.Bt = WATT; g.M = T; g.N = 1024; g.K = 1024; pg8::EpiGate<true> e{}; e.O = MIXED; e.ldc = 1024; e.G = PROJ; e.ldg = IN_W; e.gcol = C_GA;
      k_gemm_static<pg8::EpiGate<true>><<<256, 512, GEMM_LDS, stream>>>(g, e); }
    { pg8::Gemm g{}; g.A = MIXED; g.Bt = WOUT; g.M = T; g.N = 1024; g.K = 1024; pg8::EpiResid e{}; e.base = x; e.out = out; e.ldc = 1024;
      k_gemm_static<pg8::EpiResid><<<256, 512, GEMM_LDS, stream>>>(g, e); }
    k_router<<<512, 512, 0, stream>>>(out, norm2_g, w_router, b_router, H2, top_i, top_w, ctl);
    k_route_offsets<<<1, 64, 0, stream>>>(ctl);
    k_route_scatter<<<NA / 256, 256, 0, stream>>>(top_i, ctl, dest);
    k_gather_rows<<<NA / 4, 256, 0, stream>>>(H2, dest, HS);
    { pg8::Gemm g{}; g.A = HS; g.Bt = WGU; g.M = MAXROWS; g.N = 2048; g.K = 1024; pg8::EpiSwiglu e{}; e.O = ACT; e.ldc = 1024; e.bias = b_gu; e.dff = DFF; e.limit = 7.0f; e.alpha = 1.702f;
      k_gemm_grouped<pg8::EpiSwiglu><<<256, 512, GEMM_LDS, stream>>>(g, (const int*)(ctl + CW_TILE_E), (const int*)(ctl + CW_NMT), 8, 0, e); }
    { pg8::Gemm g{}; g.A = ACT; g.Bt = WDN; g.M = MAXROWS; g.N = 1024; g.K = 1024; pg8::EpiDown e{}; e.O = YS; e.ldc = 1024; e.bias = b_dn; e.ncol = 1024;
      k_gemm_grouped<pg8::EpiDown><<<256, 512, GEMM_LDS, stream>>>(g, (const int*)(ctl + CW_TILE_E), (const int*)(ctl + CW_NMT), 4, 0, e); }
    k_combine<<<T / 4, 256, 0, stream>>>(out, YS, dest, top_w);
}
```

```cpp
#include <hip/hip_runtime.h>
#include <cstdio>
#include <cstdint>
#include <cmath>

constexpr int DM = 1024, BATCH = 8, SEQ = 4096, T = BATCH * SEQ;
constexpr int NG = 64, NP = 64, GCH = 16;
constexpr int HD = 64, NQH = 16, NKVH = 4, WIN = 128;
constexpr int IN_W = 4608;
constexpr int C_U = 0, C_Q = 1024, C_K = 2048, C_V = 2304, C_GS = 2560, C_GA = 3584;
constexpr int NE = 32, TOPK = 4, DFF = 1024, NA = T * TOPK;
constexpr int MAXROWS = NA + NE * 256;
constexpr int MAXMT = MAXROWS / 256;
constexpr float EPS = 1e-5f;

namespace pg8 {
#define PG8_LAS __attribute__((address_space(3)))
typedef unsigned short bf16_t;
typedef short bf16x8 __attribute__((ext_vector_type(8)));
typedef float f32x4 __attribute__((ext_vector_type(4)));
typedef unsigned u32x4 __attribute__((ext_vector_type(4)));
constexpr int BM = 256, BK = 64, HALF = 128, HTB = HALF * BK * 2  , STAGE_BYTES = 8 * HTB, NXCD = 8, WGM = 8;

__host__ __device__ __forceinline__ int lds_byte(int r, int c) { const int st = (r >> 4) * 2 + (c >> 5), rr = r & 15, cc = c & 31, ob = rr * 64 + cc * 2; return st * 1024 + (ob ^ (((ob >> 9) & 1) << 5)); }
__host__ __device__ __forceinline__ void stage_rc(int b, int& R, int& C) { const int st = b / 1024, sb = b % 1024, swz = sb ^ (((sb >> 9) & 1) << 5); R = (st >> 1) * 16 + swz / 64; C = (st & 1) * 32 + (swz % 64) / 2; }
__host__ __device__ __forceinline__ int perm32(int rho) { const int n = rho >> 4, i = rho & 15; return 8 * (i >> 2) + 4 * n + (i & 3); }

struct Unit { int pm, pn, e, pl; };
struct Gemm { const bf16_t* A; const bf16_t* Bt; int M, N, K, pad; };

struct StaticOrder {
    int nM, nN, nwg, G, c;
    __host__ __device__ void init(int M, int N, int G_, int c_) { nM = M / BM; nN = N / BM; nwg = nM * nN; G = G_; c = c_; }
    __host__ __device__ bool next(int i, Unit& u) const {
        const long L = (long)i * G + c; if (L >= nwg) return false;
        int wgid = (int)L; { const int q = nwg / NXCD, r = nwg % NXCD, xcd = wgid % NXCD, off = wgid / NXCD; wgid = (xcd < r ? xcd * (q + 1) : r * (q + 1) + (xcd - r) * q) + off; }
        const int nig = WGM * nN, gid = wgid / nig, fm = gid * WGM, gsz = (nM - fm) < WGM ? (nM - fm) : WGM;
        u.pm = fm + ((wgid % nig) % gsz); u.pn = (wgid % nig) / gsz; u.e = 0; u.pl = u.pn; return true;
    }
    __device__ __forceinline__ void a_ready(const Unit&) const {}
    __device__ __forceinline__ void done(const Unit&) const {}
};


__device__ __forceinline__ unsigned cvt_pk_bf16(float lo, float hi) { unsigned r; asm volatile("v_cvt_pk_bf16_f32 %0, %1, %2" : "=v"(r) : "v"(lo), "v"(hi)); return r; }
__device__ __forceinline__ float bf_lo(unsigned w) { return __uint_as_float(w << 16); }
__device__ __forceinline__ float bf_hi(unsigned w) { return __uint_as_float(w & 0xffff0000u); }
__device__ __forceinline__ float sigm(float x) { return 1.f / (1.f + __expf(-x)); }
__device__ __forceinline__ u32x4 pack8(const f32x4 v0, const f32x4 v1) { u32x4 w; w.x = cvt_pk_bf16(v0[0], v0[1]); w.y = cvt_pk_bf16(v0[2], v0[3]); w.z = cvt_pk_bf16(v1[0], v1[1]); w.w = cvt_pk_bf16(v1[2], v1[3]); return w; }
__device__ __forceinline__ void unpack8(const u32x4 w, f32x4& v0, f32x4& v1) { v0 = (f32x4){bf_lo(w.x), bf_hi(w.x), bf_lo(w.y), bf_hi(w.y)}; v1 = (f32x4){bf_lo(w.z), bf_hi(w.z), bf_lo(w.w), bf_hi(w.w)}; }

struct EpiBf16Plain {
    static constexpr bool PERM = true, AFTER_DRAIN = false;
    bf16_t* O; int ldc, pad;
    __device__ __forceinline__ void operator()(const f32x4 (&acc)[2][2][4][2], const Unit& u, int wr, int wc, int fr, int fq) const {
        const int row0 = u.pm * BM + wr * 64 + fr, col0 = u.pl * BM + wc * 32 + 8 * fq;
#pragma unroll
        for (int ai = 0; ai < 2; ++ai)
#pragma unroll
            for (int m = 0; m < 4; ++m) { bf16_t* rowp = O + (size_t)(row0 + ai * HALF + m * 16) * ldc + col0;
#pragma unroll
                for (int bj = 0; bj < 2; ++bj) *(u32x4*)(rowp + bj * HALF) = pack8(acc[ai][bj][m][0], acc[ai][bj][m][1]); }
    }
};
struct EpiGlu {
    static constexpr bool PERM = true, AFTER_DRAIN = false;
    bf16_t* O; int ldc, pad;
    __device__ __forceinline__ void operator()(const f32x4 (&acc)[2][2][4][2], const Unit& u, int wr, int wc, int fr, int fq) const {
        const int row0 = u.pm * BM + wr * 64 + fr, col0 = u.pl * HALF + wc * 32 + 8 * fq;
#pragma unroll
        for (int ai = 0; ai < 2; ++ai)
#pragma unroll
            for (int m = 0; m < 4; ++m) { bf16_t* rowp = O + (size_t)(row0 + ai * HALF + m * 16) * ldc + col0;
                f32x4 o0, o1;
#pragma unroll
                for (int j = 0; j < 4; ++j) { o0[j] = acc[ai][0][m][0][j] * sigm(acc[ai][1][m][0][j]); o1[j] = acc[ai][0][m][1][j] * sigm(acc[ai][1][m][1][j]); }
                *(u32x4*)rowp = pack8(o0, o1); }
    }
};
template <bool ADD> struct EpiGate {
    static constexpr bool PERM = true, AFTER_DRAIN = false;
    bf16_t* O; const bf16_t* G; int ldc, ldg, gcol, pad;
    __device__ __forceinline__ void operator()(const f32x4 (&acc)[2][2][4][2], const Unit& u, int wr, int wc, int fr, int fq) const {
        const int row0 = u.pm * BM + wr * 64 + fr, col0 = u.pl * BM + wc * 32 + 8 * fq;
#pragma unroll
        for (int ai = 0; ai < 2; ++ai)
#pragma unroll
            for (int m = 0; m < 4; ++m) { const size_t r = (size_t)(row0 + ai * HALF + m * 16);
#pragma unroll
                for (int bj = 0; bj < 2; ++bj) {
                    const u32x4 gw = *(const u32x4*)(G + r * ldg + gcol + col0 + bj * HALF);
                    f32x4 g0, g1; unpack8(gw, g0, g1);
                    f32x4 o0, o1;
#pragma unroll
                    for (int j = 0; j < 4; ++j) { o0[j] = sigm(g0[j]) * acc[ai][bj][m][0][j]; o1[j] = sigm(g1[j]) * acc[ai][bj][m][1][j]; }
                    bf16_t* p = O + r * ldc + col0 + bj * HALF;
                    if (ADD) { const u32x4 ow = __builtin_nontemporal_load((const u32x4*)p); f32x4 p0, p1; unpack8(ow, p0, p1); o0 += p0; o1 += p1; }
                    *(u32x4*)p = pack8(o0, o1); } }
    }
};
struct EpiResid {
    static constexpr bool PERM = false, AFTER_DRAIN = false;
    const float* base; float* out; int ldc, pad;
    __device__ __forceinline__ void operator()(const f32x4 (&acc)[2][2][4][2], const Unit& u, int wr, int wc, int fr, int fq) const {
        const int row0 = u.pm * BM + wr * 64 + fr, col0 = u.pl * BM + wc * 32 + 4 * fq;
#pragma unroll
        for (int ai = 0; ai < 2; ++ai)
#pragma unroll
            for (int m = 0; m < 4; ++m) { const size_t off = (size_t)(row0 + ai * HALF + m * 16) * ldc + col0;
#pragma unroll
                for (int bj = 0; bj < 2; ++bj)
#pragma unroll
                    for (int n = 0; n < 2; ++n) { const f32x4 b = *(const f32x4*)(base + off + bj * HALF + n * 16); *(f32x4*)(out + off + bj * HALF + n * 16) = b + acc[ai][bj][m][n]; } }
    }
};
struct EpiSwiglu {
    static constexpr bool PERM = true, AFTER_DRAIN = false;
    bf16_t* O; const float* bias; int ldc, dff; float limit, alpha;
    __device__ __forceinline__ void operator()(const f32x4 (&acc)[2][2][4][2], const Unit& u, int wr, int wc, int fr, int fq) const {
        const int row0 = u.pm * BM + wr * 64 + fr, col0 = u.pl * HALF + wc * 32 + 8 * fq;
        const float* bg = bias + (size_t)u.e * 2 * dff + col0; const float* bu = bg + dff;
        const f32x4 bg0 = *(const f32x4*)bg, bg1 = *(const f32x4*)(bg + 4), bu0 = *(const f32x4*)bu, bu1 = *(const f32x4*)(bu + 4);
#pragma unroll
        for (int ai = 0; ai < 2; ++ai)
#pragma unroll
            for (int m = 0; m < 4; ++m) { bf16_t* rowp = O + (size_t)(row0 + ai * HALF + m * 16) * ldc + col0;
                f32x4 o0, o1;
#pragma unroll
                for (int j = 0; j < 4; ++j) {
                    float g = fminf(acc[ai][0][m][0][j] + bg0[j], limit), up = fminf(fmaxf(acc[ai][1][m][0][j] + bu0[j], -limit), limit);
                    o0[j] = (up + 1.f) * g * sigm(alpha * g);
                    g = fminf(acc[ai][0][m][1][j] + bg1[j], limit); up = fminf(fmaxf(acc[ai][1][m][1][j] + bu1[j], -limit), limit);
                    o1[j] = (up + 1.f) * g * sigm(alpha * g); }
                *(u32x4*)rowp = pack8(o0, o1); }
    }
};
struct EpiDown {
    static constexpr bool PERM = true, AFTER_DRAIN = false;
    bf16_t* O; const float* bias; int ldc, ncol;
    __device__ __forceinline__ void operator()(const f32x4 (&acc)[2][2][4][2], const Unit& u, int wr, int wc, int fr, int fq) const {
        const int row0 = u.pm * BM + wr * 64 + fr, col0 = u.pl * BM + wc * 32 + 8 * fq;
        const float* bp = bias + (size_t)u.e * ncol + col0;
        f32x4 bv[2][2];
#pragma unroll
        for (int bj = 0; bj < 2; ++bj) { bv[bj][0] = *(const f32x4*)(bp + bj * HALF); bv[bj][1] = *(const f32x4*)(bp + bj * HALF + 4); }
#pragma unroll
        for (int ai = 0; ai < 2; ++ai)
#pragma unroll
            for (int m = 0; m < 4; ++m) { bf16_t* rowp = O + (size_t)(row0 + ai * HALF + m * 16) * ldc + col0;
#pragma unroll
                for (int bj = 0; bj < 2; ++bj) *(u32x4*)(rowp + bj * HALF) = pack8(acc[ai][bj][m][0] + bv[bj][0], acc[ai][bj][m][1] + bv[bj][1]); }
    }
};
struct GroupedOrder {
    const int* tile_e; const int* n_mt; int nN, G, c;
    __device__ __forceinline__ bool next(int i, Unit& u) const {
        const int nmt = __builtin_amdgcn_readfirstlane(*(const volatile int*)n_mt); const long L = (long)i * G + c; if (L >= (long)nmt * nN) return false;
        const int mt = (int)(L / nN), pl = (int)(L % nN); const int e = __builtin_amdgcn_readfirstlane(*(const volatile int*)(tile_e + mt));
        u.pm = mt; u.pn = e * nN + pl; u.e = e; u.pl = pl; return true;
    }
    __device__ __forceinline__ void a_ready(const Unit&) const {}
    __device__ __forceinline__ void done(const Unit&) const {}
};
template <class Epi, class Sched, bool ALIGN_EPI = false, bool SP2 = false>
__device__ __forceinline__ void gemm_phase(PG8_LAS unsigned char* lds, const Gemm g, const Sched& S, const Epi& E) {
    const int tid = threadIdx.x, wid = __builtin_amdgcn_readfirstlane(tid >> 6), lane = tid & 63, wr = wid >> 2, wc = wid & 3, fr = lane & 15, fq = lane >> 4;
    const int K = g.K, nt = K / BK;
    unsigned voffA[2], voffB[2];
#pragma unroll
    for (int i = 0; i < 2; ++i) { int R, C; stage_rc(tid * 16 + i * 8192, R, C); const int Rb = Epi::PERM ? ((R & ~31) + perm32(R & 31)) : R;
        voffA[i] = (unsigned)(R * K + C) * 2u; voffB[i] = (unsigned)(Rb * K + C) * 2u; }
    const size_t kstep = (size_t)(BK * 2);
    const size_t hstep = (size_t)HALF * K * 2;
    const size_t tstep = 2 * hstep;
    const unsigned ldsw = (unsigned)wid * 1024u;
    const int aoff = lds_byte(wr * 64 + fr, fq * 8), boff = lds_byte(wc * 32 + fr, fq * 8);
#define PG8_SA(b, h) (((b) * 2 + (h)) * HTB)
#define PG8_SB(b, h) ((4 + (b) * 2 + (h)) * HTB)
#define PG8_STAGE(bufoff, gbase, voff) do { _Pragma("unroll") for (int _i = 0; _i < 2; ++_i) \
        __builtin_amdgcn_global_load_lds((const unsigned*)((const char*)(gbase) + (voff)[_i]), (PG8_LAS unsigned*)(lds + (bufoff) + ldsw + _i * 8192), 16, 0, 0); } while (0)
#define PG8_LDA(dst, b, h) do { _Pragma("unroll") for (int m = 0; m < 4; ++m) _Pragma("unroll") for (int k = 0; k < 2; ++k) dst[m][k] = *(const PG8_LAS bf16x8*)(lds + PG8_SA(b, h) + aoff + m * 2048 + k * 1024); } while (0)
#define PG8_LDB(dst, b, h) do { _Pragma("unroll") for (int n = 0; n < 2; ++n) _Pragma("unroll") for (int k = 0; k < 2; ++k) dst[n][k] = *(const PG8_LAS bf16x8*)(lds + PG8_SB(b, h) + boff + n * 2048 + k * 1024); } while (0)
#define PG8_MMA(ai, bj, At, Bt) do { __builtin_amdgcn_s_setprio(1); _Pragma("unroll") for (int m = 0; m < 4; ++m) _Pragma("unroll") for (int n = 0; n < 2; ++n) _Pragma("unroll") for (int k = 0; k < 2; ++k) \
        acc[ai][bj][m][n] = __builtin_amdgcn_mfma_f32_16x16x32_bf16(Bt[n][k], At[m][k], acc[ai][bj][m][n], 0, 0, 0); __builtin_amdgcn_s_setprio(0); } while (0)
#define PG8_WAIT_V(n) asm volatile("s_waitcnt vmcnt(" #n ")" ::: "memory")
#define PG8_WAIT_L(n) asm volatile("s_waitcnt lgkmcnt(" #n ")" ::: "memory")
#define PG8_BAR __builtin_amdgcn_s_barrier()
#define PG8_SCHED __builtin_amdgcn_sched_barrier(0)
    Unit cur, nxt; int ui = 0;
    if (!S.next(0, cur)) return;
    f32x4 acc[2][2][4][2];
#pragma unroll
    for (int a = 0; a < 2; ++a)
#pragma unroll
        for (int b = 0; b < 2; ++b)
#pragma unroll
            for (int m = 0; m < 4; ++m)
#pragma unroll
                for (int n = 0; n < 2; ++n) acc[a][b][m][n] = (f32x4){0.f, 0.f, 0.f, 0.f};
    bf16x8 At[4][2], B0[2][2], B1[2][2];
    const char* cA = (const char*)g.A + (size_t)cur.pm * tstep; const char* cB = (const char*)g.Bt + (size_t)cur.pn * tstep;
    S.a_ready(cur);
    if constexpr (SP2) {
        PG8_STAGE(PG8_SB(0, 0), cB, voffB); PG8_STAGE(PG8_SB(0, 1), cB + hstep, voffB); PG8_STAGE(PG8_SA(0, 0), cA, voffA); PG8_STAGE(PG8_SA(0, 1), cA + hstep, voffA);
        if (wr == 1) PG8_BAR;
        PG8_WAIT_V(2); PG8_BAR;
        PG8_STAGE(PG8_SB(1, 0), cB + kstep, voffB); PG8_STAGE(PG8_SA(1, 0), cA + kstep, voffA); PG8_STAGE(PG8_SB(1, 1), cB + hstep + kstep, voffB);
        PG8_WAIT_V(6); PG8_BAR;
    } else {
        PG8_STAGE(PG8_SB(0, 0), cB, voffB); PG8_STAGE(PG8_SA(0, 0), cA, voffA); PG8_STAGE(PG8_SB(0, 1), cB + hstep, voffB); PG8_STAGE(PG8_SA(0, 1), cA + hstep, voffA);
        if (wr == 1) PG8_BAR;
        PG8_WAIT_V(4); PG8_BAR;
        PG8_STAGE(PG8_SB(1, 0), cB + kstep, voffB); PG8_STAGE(PG8_SA(1, 0), cA + kstep, voffA); PG8_STAGE(PG8_SB(1, 1), cB + hstep + kstep, voffB);
        PG8_WAIT_V(6); PG8_BAR;
    }
    for (;;) {
        const bool has_next = S.next(ui + 1, nxt);
        const char* nA = has_next ? (const char*)g.A + (size_t)nxt.pm * tstep : cA; const char* nB = has_next ? (const char*)g.Bt + (size_t)nxt.pn * tstep : cB;
        for (int t = 0; t < nt; t += 2) {
            const bool last = (t == nt - 2);
            const char* a1 = cA + (size_t)(t + 1) * kstep;
            const char* a2 = last ? nA : cA + (size_t)(t + 2) * kstep; const char* b2 = last ? nB : cB + (size_t)(t + 2) * kstep;
            const char* a3 = a2 + kstep; const char* b3 = b2 + kstep;
            if (last && has_next) S.a_ready(nxt);
            if constexpr (SP2) {
            PG8_LDB(B0, 0, 0); PG8_LDB(B1, 0, 1); PG8_SCHED; PG8_LDA(At, 0, 0); PG8_STAGE(PG8_SA(1, 1), a1 + hstep, voffA);
            PG8_WAIT_V(8); PG8_WAIT_L(0); PG8_BAR; PG8_MMA(0, 0, At, B0); PG8_MMA(0, 1, At, B1); PG8_BAR; PG8_SCHED;
            PG8_LDA(At, 0, 1); PG8_STAGE(PG8_SB(0, 0), b2, voffB); PG8_STAGE(PG8_SB(0, 1), b2 + hstep, voffB); PG8_STAGE(PG8_SA(0, 0), a2, voffA);
            PG8_WAIT_V(8); PG8_WAIT_L(0); PG8_BAR; PG8_MMA(1, 0, At, B0); PG8_MMA(1, 1, At, B1); PG8_BAR; PG8_SCHED;
            PG8_LDB(B0, 1, 0); PG8_LDB(B1, 1, 1); PG8_SCHED; PG8_LDA(At, 1, 0); PG8_STAGE(PG8_SA(0, 1), a2 + hstep, voffA);
            PG8_WAIT_V(8); PG8_WAIT_L(0); PG8_BAR; PG8_MMA(0, 0, At, B0); PG8_MMA(0, 1, At, B1); PG8_BAR; PG8_SCHED;
            PG8_LDA(At, 1, 1); PG8_STAGE(PG8_SB(1, 0), b3, voffB); PG8_STAGE(PG8_SB(1, 1), b3 + hstep, voffB); PG8_STAGE(PG8_SA(1, 0), a3, voffA);
            PG8_WAIT_V(8); PG8_WAIT_L(0); PG8_BAR; PG8_MMA(1, 0, At, B0); PG8_MMA(1, 1, At, B1); PG8_BAR; PG8_SCHED;
            } else {
            PG8_LDB(B0, 0, 0); PG8_SCHED; PG8_LDA(At, 0, 0); PG8_STAGE(PG8_SA(1, 1), a1 + hstep, voffA);
            PG8_WAIT_L(8); PG8_BAR; PG8_WAIT_L(0); PG8_MMA(0, 0, At, B0); PG8_BAR; PG8_SCHED;
            PG8_LDB(B1, 0, 1); PG8_STAGE(PG8_SB(0, 0), b2, voffB);
            PG8_BAR; PG8_WAIT_L(0); PG8_MMA(0, 1, At, B1); PG8_BAR;
            PG8_LDA(At, 0, 1); PG8_STAGE(PG8_SA(0, 0), a2, voffA);
            PG8_BAR; PG8_WAIT_L(0); PG8_MMA(1, 0, At, B0); PG8_BAR; PG8_SCHED;
            PG8_STAGE(PG8_SB(0, 1), b2 + hstep, voffB);
            PG8_WAIT_V(6); PG8_BAR; PG8_MMA(1, 1, At, B1); PG8_BAR;
            PG8_LDB(B0, 1, 0); PG8_SCHED; PG8_LDA(At, 1, 0); PG8_STAGE(PG8_SA(0, 1), a2 + hstep, voffA);
            PG8_WAIT_L(8); PG8_BAR; PG8_WAIT_L(0); PG8_MMA(0, 0, At, B0); PG8_BAR; PG8_SCHED;
            PG8_LDB(B1, 1, 1); PG8_STAGE(PG8_SB(1, 0), b3, voffB);
            PG8_BAR; PG8_WAIT_L(0); PG8_MMA(0, 1, At, B1); PG8_BAR;
            PG8_LDA(At, 1, 1); PG8_STAGE(PG8_SA(1, 0), a3, voffA);
            PG8_BAR; PG8_WAIT_L(0); PG8_MMA(1, 0, At, B0); PG8_BAR; PG8_SCHED;
            PG8_STAGE(PG8_SB(1, 1), b3 + hstep, voffB);
            PG8_WAIT_V(6); PG8_BAR; PG8_MMA(1, 1, At, B1); PG8_BAR;
            }
        }
        if constexpr (ALIGN_EPI) { if (wr == 0) PG8_BAR; }
        if constexpr (!Epi::AFTER_DRAIN) { E(acc, cur, wr, wc, fr, fq); S.done(cur); }
        if (!has_next) break;
#pragma unroll
        for (int a = 0; a < 2; ++a)
#pragma unroll
            for (int b = 0; b < 2; ++b)
#pragma unroll
                for (int m = 0; m < 4; ++m)
#pragma unroll
                    for (int n = 0; n < 2; ++n) acc[a][b][m][n] = (f32x4){0.f, 0.f, 0.f, 0.f};
        cur = nxt; cA = nA; cB = nB; ++ui;
        if constexpr (ALIGN_EPI) { if (wr == 1) PG8_BAR; }
    }
    PG8_WAIT_V(0);
    if constexpr (!ALIGN_EPI) { if (wr == 0) PG8_BAR; }
    PG8_BAR;
    if constexpr (Epi::AFTER_DRAIN) { E.fused(acc, cur, wr, wc, fr, fq, lds, wid, lane); S.done(cur); }
#undef PG8_SA
#undef PG8_SB
#undef PG8_STAGE
#undef PG8_LDA
#undef PG8_LDB
#undef PG8_MMA
#undef PG8_WAIT_V
#undef PG8_WAIT_L
#undef PG8_BAR
#undef PG8_SCHED
}
}

#define GAS __attribute__((address_space(1)))
#define LAS __attribute__((address_space(3)))
typedef unsigned short bf16;
typedef unsigned v4u __attribute__((ext_vector_type(4)));
typedef float f32x4 __attribute__((ext_vector_type(4)));
typedef short bf16x8 __attribute__((ext_vector_type(8)));
typedef GAS unsigned gu32;
typedef GAS unsigned long long gu64;
#define RLX_AGENT __ATOMIC_RELAXED, __HIP_MEMORY_SCOPE_AGENT
#define LDS_WAIT() asm volatile("s_waitcnt lgkmcnt(0)" ::: "memory")
#define VM_WAIT() asm volatile("s_waitcnt vmcnt(0)" ::: "memory")
__device__ __forceinline__ unsigned long long rt() { return __builtin_amdgcn_s_memrealtime(); }
__device__ __forceinline__ unsigned f2bf(float f) { unsigned u = __builtin_bit_cast(unsigned, f); return (u + 0x7fffu + ((u >> 16) & 1u)) >> 16; }
__device__ __forceinline__ unsigned pk2(float lo, float hi) { return f2bf(lo) | (f2bf(hi) << 16); }

#define XB_TMO      128
#define XB_XCNT(j)  (256  + 64 * (j))
#define XB_XSUB(j)  (1280 + 64 * (j))
#define XB_XGEN(j)  (2304 + 64 * (j))
#define XB_TOP      3328
#define XB_TOPGEN   3392
#define XCD_BAR_WORDS 3456
#define XB_SPIN_CAP (1u << 18)

__device__ __forceinline__ unsigned xb_ld(unsigned* p)              { return __hip_atomic_load(p, __ATOMIC_RELAXED, __HIP_MEMORY_SCOPE_AGENT); }
__device__ __forceinline__ unsigned xb_add(unsigned* p, unsigned v) { return __hip_atomic_fetch_add(p, v, __ATOMIC_RELAXED, __HIP_MEMORY_SCOPE_AGENT); }
__device__ __forceinline__ unsigned xb_xcc_id() { return (unsigned)__builtin_amdgcn_s_getreg((3 << 11) | 20) & 0xFu; }
#define XB_SPIN(cond, bar) do { unsigned _sp = 0; while (cond) { __builtin_amdgcn_s_sleep(1); \
    if ((++_sp & 255u) == 0u) { if (xb_ld(&(bar)[XB_TMO])) break; if (_sp > XB_SPIN_CAP) { atomicAdd(&(bar)[XB_TMO], 1u); break; } } } } while (0)

struct XcdBarrier {
    unsigned* bar; unsigned x;
    volatile LAS unsigned* st;
};

__device__ __forceinline__ XcdBarrier xcd_barrier_post(unsigned* bar, volatile LAS unsigned* st) {
    XcdBarrier b; b.bar = bar; b.x = xb_xcc_id(); b.st = st;
    if (threadIdx.x == 0) (void)xb_add(&bar[XB_XCNT(b.x)], 1u);
    return b;
}
__device__ __forceinline__ void xcd_barrier_complete(unsigned* bar, unsigned x, unsigned& nloc, unsigned& nx) {
    const unsigned G = gridDim.x * gridDim.y * gridDim.z;
    unsigned sum, cnt, mine, sp = 0u;
    for (;;) {
        sum = 0u; cnt = 0u; mine = 0u;
#pragma unroll
        for (unsigned j = 0; j < 16; ++j) { const unsigned c = xb_ld(&bar[XB_XCNT(j)]); sum += c; cnt += (c > 0u) ? 1u : 0u; mine = (j == x) ? c : mine; }
        if (sum == G) break;
        __builtin_amdgcn_s_sleep(1);
        if ((++sp & 255u) == 0u) { if (xb_ld(&bar[XB_TMO])) break; if (sp > XB_SPIN_CAP) { atomicAdd(&bar[XB_TMO], 1u); break; } }
    }
    nloc = mine > 0u ? mine : 1u; nx = cnt > 0u ? cnt : 1u;
}

__device__ __forceinline__ void xcd_barrier(const XcdBarrier& b) {
    asm volatile("s_waitcnt vmcnt(0)" ::: "memory");
    __syncthreads();
    if (threadIdx.x == 0) {
        unsigned* bar = b.bar;
        __builtin_amdgcn_s_waitcnt(0);
        unsigned nloc = b.st[0], nx = b.st[1];
        if (nloc == 0u) { xcd_barrier_complete(bar, b.x, nloc, nx); b.st[0] = nloc; b.st[1] = nx; }
        const unsigned old = xb_add(&bar[XB_XSUB(b.x)], 1u);
        const unsigned gen = old / nloc;
        if (old + 1u == (gen + 1u) * nloc) {
            __builtin_amdgcn_fence(__ATOMIC_RELEASE, "agent");
            asm volatile("s_waitcnt vmcnt(0)" ::: "memory");
            const unsigned og = xb_add(&bar[XB_TOP], 1u);
            const unsigned tg = og / nx;
            if (og + 1u == (tg + 1u) * nx) xb_add(&bar[XB_TOPGEN], 1u);
            else XB_SPIN(xb_ld(&bar[XB_TOPGEN]) == tg, bar);
            __builtin_amdgcn_fence(__ATOMIC_ACQUIRE, "agent");
            xb_add(&bar[XB_XGEN(b.x)], 1u);
            asm volatile("s_waitcnt vmcnt(0)" ::: "memory");
        } else {
            XB_SPIN(xb_ld(&bar[XB_XGEN(b.x)]) == gen, bar);
            __builtin_amdgcn_fence(__ATOMIC_ACQUIRE, "agent");
            asm volatile("s_waitcnt vmcnt(0)" ::: "memory");
        }
    }
    __syncthreads();
}

constexpr size_t MiB = 1u << 20;
constexpr size_t WS_CTL = 0;
constexpr size_t CTL_ZERO_BYTES = 65536;
constexpr size_t WS_WIN = 1 * MiB, WS_WGLU = 10 * MiB, WS_WSSM = 14 * MiB, WS_WATT = 16 * MiB, WS_WOUT = 18 * MiB;
constexpr size_t WS_WGU = 20 * MiB, WS_WDN = 148 * MiB;
constexpr size_t WS_S5TAB = 212 * MiB;
constexpr size_t WS_ROUTE = 216 * MiB;
constexpr size_t WS_H = 224 * MiB;
constexpr size_t WS_PROJ = 288 * MiB;
constexpr size_t WS_S5OUT = 576 * MiB;
constexpr size_t WS_ATTN = 640 * MiB;
constexpr size_t WS_ACT = 704 * MiB;
constexpr size_t WS_END = 976 * MiB;
static_assert(WS_PROJ + (size_t)T * IN_W * 2 <= WS_S5OUT && WS_PROJ + (size_t)MAXROWS * 1024 * 2 <= WS_S5OUT && WS_ACT + (size_t)MAXROWS * 1024 * 2 <= WS_END, "ws map");
constexpr int CW_CNT = 0;
constexpr int CW_CUR = 64;
constexpr int CW_NMT = 192;
constexpr int CW_TILE_E = 256;
constexpr int CW_BAR = 4096;
static_assert((CW_BAR + XCD_BAR_WORDS) * 4 <= (int)CTL_ZERO_BYTES && CW_TILE_E + MAXMT <= CW_BAR, "ctl map");
constexpr size_t RT_TOPI = 0, RT_TOPW = (size_t)NA * 4, RT_DEST = 2 * (size_t)NA * 4;

constexpr int LDS_BYTES = 163840;
constexpr int RING_OFF = 0;
constexpr int MISC_OFF = LDS_BYTES - 256;

__device__ __forceinline__ float bf2f(bf16 b) { return __uint_as_float((unsigned)b << 16); }
__device__ __forceinline__ float wave_sum(float v) {
#pragma unroll
    for (int o = 1; o < 64; o <<= 1) v += __shfl_xor(v, o);
    return v;
}
__device__ __forceinline__ float wave_max(float v) {
#pragma unroll
    for (int o = 1; o < 64; o <<= 1) v = fmaxf(v, __shfl_xor(v, o));
    return v;
}
__device__ __forceinline__ float gelu_tanh(float x) { const float z = 1.5957691216f * (x + 0.044715f * x * x * x); return x / (1.f + __expf(-z)); }
#define WAVE_SYNC() do { __builtin_amdgcn_wave_barrier(); asm volatile("s_waitcnt lgkmcnt(0)" ::: "memory"); } while (0)

struct Args { const float* in[25]; float* out; unsigned char* ws; int ph_lo, ph_hi; };
struct Ctx { int tid, lane, wave, vcu, G, gw, ngw; LAS unsigned char* lds; };

__device__ __forceinline__ void transpose_item(const float* W, int K, int N, bf16* WT, int mode, LAS float* scr, int item, int lane) {
    const int nblk = N / 32, kb = item / nblk, nb = item % nblk, k0 = 64 * kb, n0 = 32 * nb;
#pragma unroll 8
    for (int i = 0; i < 32; ++i) { const int kk = 2 * i + (lane >> 5); scr[kk * 33 + (lane & 31)] = W[(size_t)(k0 + kk) * N + n0 + (lane & 31)]; }
    LDS_WAIT(); asm volatile("" ::: "memory");
    int r0 = n0;
    if (mode == 1) { const int nh = N / 2; r0 = (n0 < nh) ? 256 * (n0 / 128) + (n0 % 128) : 256 * ((n0 - nh) / 128) + 128 + ((n0 - nh) % 128); }
    const int c = lane & 7;
#pragma unroll
    for (int j = 0; j < 4; ++j) { const int n = (lane >> 3) + 8 * j; const LAS float* s = scr + (8 * c) * 33 + n;
        v4u o; o.x = pk2(s[0 * 33], s[1 * 33]); o.y = pk2(s[2 * 33], s[3 * 33]); o.z = pk2(s[4 * 33], s[5 * 33]); o.w = pk2(s[6 * 33], s[7 * 33]);
        *(v4u*)(WT + (size_t)(r0 + n) * K + k0 + 8 * c) = o; }
    LDS_WAIT(); asm volatile("" ::: "memory");
}
__device__ __forceinline__ void transpose_job(const Ctx& C, const float* W, bf16* WT, int K, int N, int mode, int nmat) {
    LAS float* scr = (LAS float*)(C.lds + RING_OFF + C.wave * 16384);
    const int per = (K / 64) * (N / 32); const int total = per * nmat;
    for (int it = C.gw; it < total; it += C.ngw) { const int mat = it / per, item = it % per;
        transpose_item(W + (size_t)mat * K * N, K, N, WT + (size_t)mat * K * N, mode, scr, item, C.lane); }
}
__device__ __forceinline__ void rmsnorm_rows(const Ctx& C, const float* x, const float* g, bf16* out) {
    for (int m = C.gw; m < T; m += C.ngw) {
        const f32x4* xr = (const f32x4*)(x + (size_t)m * DM) + C.lane; f32x4 v[4]; float s = 0.f;
#pragma unroll
        for (int j = 0; j < 4; ++j) { v[j] = xr[64 * j]; s += (v[j].x * v[j].x + v[j].y * v[j].y) + (v[j].z * v[j].z + v[j].w * v[j].w); }
        const float rs = rsqrtf(wave_sum(s) * (1.f / DM) + EPS);
        unsigned long long* o8 = (unsigned long long*)(out + (size_t)m * DM) + C.lane;
#pragma unroll
        for (int j = 0; j < 4; ++j) { const f32x4 gg = ((const f32x4*)g)[64 * j + C.lane];
            o8[64 * j] = (unsigned long long)pk2(v[j].x * rs * gg.x, v[j].y * rs * gg.y) | ((unsigned long long)pk2(v[j].z * rs * gg.z, v[j].w * rs * gg.w) << 32); }
    }
}
__device__ __forceinline__ void s5_tables(int i, const float* a_re, const float* a_im, const float* log_dt, const float* b_re, const float* b_im, float* tab) {
    const int g = i / NP;
    const double dt = exp((double)log_dt[g]), are = a_re[i], aim = a_im[i];
    const double mag = exp(are * dt), abr = mag * cos(aim * dt), abi = mag * sin(aim * dt), den = are * are + aim * aim;
    const double em1 = abr - 1.0;
    const double qre = (em1 * are + abi * aim) / den, qim = (abi * are - em1 * aim) / den;
    float* ABAR = tab; float* BRE = tab + NG * NP * 2; float* BIM = BRE + NG * NP * GCH;
    ABAR[2 * i] = (float)abr; ABAR[2 * i + 1] = (float)abi;
    for (int h = 0; h < GCH; ++h) { const double br = b_re[i * GCH + h], bi = b_im[i * GCH + h];
        BRE[i * GCH + h] = (float)(qre * br - qim * bi); BIM[i * GCH + h] = (float)(qre * bi + qim * br); }
}
__device__ __forceinline__ void s5_naive_job(const Ctx& C, int job, const bf16* proj, const float* tab, const float* c_re, const float* c_im, const float* d_skip, bf16* out) {
    LAS float* sre = (LAS float*)(C.lds + RING_OFF + C.wave * 16384); LAS float* sim = sre + 256; LAS float* us = sim + 256;
    const int b = job / NG, g = job % NG, p = C.lane, lane = C.lane;
    const float* ABAR = tab; const float* BRE = tab + NG * NP * 2; const float* BIM = BRE + NG * NP * GCH;
    const float ar = ABAR[2 * (g * NP + p)], ai = ABAR[2 * (g * NP + p) + 1];
    float bre[16], bim[16];
#pragma unroll
    for (int h = 0; h < 16; ++h) { bre[h] = BRE[(g * NP + p) * 16 + h]; bim[h] = BIM[(g * NP + p) * 16 + h]; }
    const int ti = lane >> 4, hh = lane & 15;
    const float dsk = d_skip[g * 16 + hh];
    float s_re = 0.f, s_im = 0.f;
    for (int t0 = 0; t0 < SEQ; t0 += 4) {
        us[ti * 16 + hh] = bf2f(proj[(size_t)(b * SEQ + t0 + ti) * IN_W + C_U + g * 16 + hh]);
        WAVE_SYNC();
#pragma unroll
        for (int i = 0; i < 4; ++i) {
            float bur = 0.f, bui = 0.f;
#pragma unroll
            for (int h = 0; h < 16; ++h) { const float u = us[i * 16 + h]; bur += u * bre[h]; bui += u * bim[h]; }
            const float nr = ar * s_re - ai * s_im + bur, ni = ar * s_im + ai * s_re + bui;
            s_re = nr; s_im = ni; sre[i * 64 + p] = nr; sim[i * 64 + p] = ni;
        }
        WAVE_SYNC();
        float y = dsk * us[ti * 16 + hh];
        const float* cr = c_re + (size_t)(g * 16 + hh) * NP; const float* ci = c_im + (size_t)(g * 16 + hh) * NP;
#pragma unroll 8
        for (int q = 0; q < 64; ++q) y += sre[ti * 64 + q] * cr[q] - sim[ti * 64 + q] * ci[q];
        out[(size_t)(b * SEQ + t0 + ti) * 1024 + g * 16 + hh] = (bf16)f2bf(gelu_tanh(y));
        WAVE_SYNC();
    }
}
__device__ __forceinline__ void qknorm_pass(const Ctx& C, bf16* proj, const float* qg, const float* kg) {
    const float gq = qg[C.lane], gk = kg[C.lane];
    for (int j = C.gw; j < T * 20; j += C.ngw) {
        const int tok = j / 20, hd = j % 20;
        bf16* p = proj + (size_t)tok * IN_W + C_Q + hd * 64 + C.lane;
        const float v = bf2f(*p); const float rs = rsqrtf(wave_sum(v * v) * (1.f / 64.f) + EPS);
        *p = (bf16)f2bf(v * rs * (hd < 16 ? gq : gk));
    }
}
__device__ __forceinline__ void attn_naive_job(const Ctx& C, int job, const bf16* proj, const float* sinks, bf16* out) {
    LAS float* qs = (LAS float*)(C.lds + RING_OFF + C.wave * 16384 + 4096); LAS float* ps = qs + 64;
    const int lane = C.lane, tok = job >> 4, h = job & 15, kvh = h >> 2;
    const int b = tok / SEQ, t = tok % SEQ;
    qs[lane] = bf2f(proj[(size_t)tok * IN_W + C_Q + h * 64 + lane]);
    WAVE_SYNC();
    const float slope = exp2f(-0.5f * (float)(h + 1));
    float sc[2];
#pragma unroll
    for (int r = 0; r < 2; ++r) {
        const int dist = lane + 64 * r, s = t - dist;
        float a = -INFINITY;
        if (s >= 0) { const bf16* kp = proj + (size_t)(b * SEQ + s) * IN_W + C_K + kvh * 64; float d = 0.f;
            const v4u* kp4 = (const v4u*)kp;
#pragma unroll
            for (int i = 0; i < 8; ++i) { const v4u kw = kp4[i]; const LAS float* qq = qs + 8 * i;
                d += qq[0] * __uint_as_float(kw.x << 16) + qq[1] * __uint_as_float(kw.x & 0xffff0000u) + qq[2] * __uint_as_float(kw.y << 16) + qq[3] * __uint_as_float(kw.y & 0xffff0000u)
                   + qq[4] * __uint_as_float(kw.z << 16) + qq[5] * __uint_as_float(kw.z & 0xffff0000u) + qq[6] * __uint_as_float(kw.w << 16) + qq[7] * __uint_as_float(kw.w & 0xffff0000u); }
            a = d * 0.125f - slope * (float)dist; }
        sc[r] = a;
    }
    const float sink = sinks[h];
    const float m = fmaxf(wave_max(fmaxf(sc[0], sc[1])), sink);
    const float p0 = __expf(sc[0] - m), p1 = __expf(sc[1] - m);
    const float denom = wave_sum(p0 + p1) + __expf(sink - m);
    ps[lane] = p0; ps[lane + 64] = p1;
    WAVE_SYNC();
    float o = 0.f;
    const int nk = (t + 1 < 128) ? t + 1 : 128;
    for (int dist = 0; dist < nk; ++dist) o += ps[dist] * bf2f(proj[(size_t)(b * SEQ + t - dist) * IN_W + C_V + kvh * 64 + lane]);
    out[(size_t)tok * 1024 + h * 64 + lane] = (bf16)f2bf(o / denom);
    WAVE_SYNC();
}
__device__ __forceinline__ void router_pass(const Ctx& C, const float* x1, const float* g2, const float* w_router, const float* b_router, bf16* h2, int* top_i, float* top_w, unsigned* ctl) {
    LAS float* hn = (LAS float*)(C.lds + RING_OFF + C.wave * 16384);
    const int lane = C.lane;
    for (int tok = C.gw; tok < T; tok += C.ngw) {
        const f32x4* xr = (const f32x4*)(x1 + (size_t)tok * DM) + lane; f32x4 v[4]; float s = 0.f;
#pragma unroll
        for (int j = 0; j < 4; ++j) { v[j] = xr[64 * j]; s += (v[j].x * v[j].x + v[j].y * v[j].y) + (v[j].z * v[j].z + v[j].w * v[j].w); }
        const float rs = rsqrtf(wave_sum(s) * (1.f / DM) + EPS);
        unsigned long long* o8 = (unsigned long long*)(h2 + (size_t)tok * DM) + lane;
#pragma unroll
        for (int j = 0; j < 4; ++j) { const f32x4 gg = ((const f32x4*)g2)[64 * j + lane];
            const f32x4 y = (f32x4){v[j].x * rs * gg.x, v[j].y * rs * gg.y, v[j].z * rs * gg.z, v[j].w * rs * gg.w};
            *(LAS f32x4*)(hn + 256 * j + 4 * lane) = y;
            o8[64 * j] = (unsigned long long)pk2(y.x, y.y) | ((unsigned long long)pk2(y.z, y.w) << 32); }
        WAVE_SYNC();
        const int e = lane & 31, half = lane >> 5;
        float acc = 0.f;
        const float* wr = w_router + (size_t)(512 * half) * NE + e; const LAS float* hv = hn + 512 * half;
#pragma unroll 8
        for (int d = 0; d < 512; ++d) acc += hv[d] * wr[(size_t)d * NE];
        acc += __shfl_xor(acc, 32);
        float logit = acc + b_router[e];
        float tv[4]; int ti[4];
#pragma unroll
        for (int k = 0; k < 4; ++k) {
            const float mx = wave_max(logit);
            const unsigned long long bal = __ballot(logit == mx);
            const int idx = (__ffsll((long long)bal) - 1) & 31;
            tv[k] = mx; ti[k] = idx;
            if (e == idx) logit = -INFINITY;
        }
        const float e1 = __expf(tv[1] - tv[0]), e2 = __expf(tv[2] - tv[0]), e3 = __expf(tv[3] - tv[0]); const float inv = 1.f / (1.f + e1 + e2 + e3);
        if (lane < 4) { const int k = lane; const int ei = k == 0 ? ti[0] : k == 1 ? ti[1] : k == 2 ? ti[2] : ti[3]; const float wv = (k == 0 ? 1.f : k == 1 ? e1 : k == 2 ? e2 : e3) * inv;
            top_i[tok * 4 + k] = ei; top_w[tok * 4 + k] = wv; atomicAdd(ctl + CW_CNT + ei, 1u); }
        WAVE_SYNC();
    }
}
__device__ __forceinline__ void scatter_gather_pass(const Ctx& C, const int* top_i, unsigned* ctl, int* dest, const bf16* h2, bf16* hs) {
    LAS unsigned* pst = (LAS unsigned*)(C.lds + RING_OFF + 8 * 16384 - 1024);
    if (C.tid == 0) { unsigned run = 0; int mt = 0;
        for (int e = 0; e < NE; ++e) { const unsigned c = __hip_atomic_load(ctl + CW_CNT + e, RLX_AGENT); const unsigned padded = (c + 255u) / 256u * 256u; pst[e] = run;
            if (blockIdx.x == 0) for (unsigned i = 0; i < padded / 256u; ++i) ctl[CW_TILE_E + mt + i] = (unsigned)e;
            mt += padded / 256u; run += padded; }
        pst[NE] = run; if (blockIdx.x == 0) ctl[CW_NMT] = (unsigned)mt; }
    __syncthreads();
    for (int a = C.gw; a < NA; a += C.ngw) {
        int d = 0;
        if (C.lane == 0) { const int e = top_i[a]; const unsigned pos = atomicAdd(ctl + CW_CUR + e, 1u); d = (int)(pst[e] + pos); dest[a] = d; }
        d = __builtin_amdgcn_readfirstlane(d);
        const v4u* s = (const v4u*)(h2 + (size_t)(a >> 2) * DM); v4u* o = (v4u*)(hs + (size_t)d * DM);
        o[C.lane] = s[C.lane]; o[C.lane + 64] = s[C.lane + 64];
    }
}
__device__ __forceinline__ void combine_pass(const Ctx& C, float* out, const bf16* ys, const int* dest, const float* top_w) {
    const int lane = C.lane;
    for (int tok = C.gw; tok < T; tok += C.ngw) {
        f32x4* o = (f32x4*)(out + (size_t)tok * DM);
        f32x4 acc[4];
#pragma unroll
        for (int j = 0; j < 4; ++j) acc[j] = o[64 * j + lane];
#pragma unroll
        for (int k = 0; k < 4; ++k) { const float wv = top_w[tok * 4 + k]; const unsigned long long* y8 = (const unsigned long long*)(ys + (size_t)dest[tok * 4 + k] * DM);
#pragma unroll
            for (int j = 0; j < 4; ++j) { const unsigned long long q = y8[64 * j + lane]; const unsigned lo = (unsigned)q, hi = (unsigned)(q >> 32);
                acc[j].x += wv * __uint_as_float(lo << 16); acc[j].y += wv * __uint_as_float(lo & 0xffff0000u); acc[j].z += wv * __uint_as_float(hi << 16); acc[j].w += wv * __uint_as_float(hi & 0xffff0000u); } }
#pragma unroll
        for (int j = 0; j < 4; ++j) o[64 * j + lane] = acc[j];
    }
}

constexpr int NPH = 12;
#ifndef MK_PER_PHASE
#define MK_PER_PHASE 0
#endif
__global__ void __launch_bounds__(512, 2) mk_fwd(Args args) {
    extern __shared__ __attribute__((aligned(16))) unsigned char lds_raw[];
    Ctx C; C.lds = (LAS unsigned char*)lds_raw; C.tid = threadIdx.x; C.lane = C.tid & 63; C.wave = __builtin_amdgcn_readfirstlane(C.tid >> 6);
    C.G = gridDim.x; { const int bx = blockIdx.x; C.vcu = (C.G % 8 == 0) ? (bx % 8) * (C.G / 8) + bx / 8 : bx; }
    C.gw = C.vcu * 8 + C.wave; C.ngw = C.G * 8;
    volatile LAS unsigned* MISC = (volatile LAS unsigned*)(C.lds + MISC_OFF);
    if (C.tid < 64) MISC[C.tid] = 0u;
    __syncthreads();
    unsigned char* ws = args.ws; unsigned* ctl = (unsigned*)(ws + WS_CTL);
    const int lo = args.ph_lo, hi = args.ph_hi;
    XcdBarrier bar; bar.bar = ctl + CW_BAR; bar.x = 0; bar.st = nullptr;
    if (hi - lo > 1) bar = xcd_barrier_post(ctl + CW_BAR, MISC + 8);
#define IN(k) (lo <= (k) && (k) < hi)
#define SEAM(k) do { if (IN(k) && IN((k) + 1)) xcd_barrier(bar); } while (0)
    const float* x = args.in[0]; float* out = args.out;
    bf16* WIN = (bf16*)(ws + WS_WIN); bf16* WGLU = (bf16*)(ws + WS_WGLU); bf16* WSSM = (bf16*)(ws + WS_WSSM); bf16* WATT = (bf16*)(ws + WS_WATT); bf16* WOUT = (bf16*)(ws + WS_WOUT);
    bf16* WGU = (bf16*)(ws + WS_WGU); bf16* WDN = (bf16*)(ws + WS_WDN); float* S5TAB = (float*)(ws + WS_S5TAB);
    bf16* H = (bf16*)(ws + WS_H); bf16* PROJ = (bf16*)(ws + WS_PROJ); bf16* S5OUT = (bf16*)(ws + WS_S5OUT); bf16* ATTN = (bf16*)(ws + WS_ATTN);
    bf16* GLU = H; bf16* MIXED = S5OUT; bf16* H2 = ATTN; bf16* HS = PROJ; bf16* YS = PROJ; bf16* ACT = (bf16*)(ws + WS_ACT);
    int* top_i = (int*)(ws + WS_ROUTE + RT_TOPI); float* top_w = (float*)(ws + WS_ROUTE + RT_TOPW); int* dest = (int*)(ws + WS_ROUTE + RT_DEST);
    LAS unsigned char* ring = C.lds + RING_OFF;

    if (IN(0)) {
        transpose_job(C, args.in[2], WIN, DM, IN_W, 0, 1);
        transpose_job(C, args.in[11], WGLU, 1024, 2048, 1, 1);
        transpose_job(C, args.in[12], WSSM, 1024, 1024, 0, 1);
        transpose_job(C, args.in[16], WATT, 1024, 1024, 0, 1);
        transpose_job(C, args.in[17], WOUT, 1024, 1024, 0, 1);
        transpose_job(C, args.in[21], WGU, 1024, 2048, 1, NE);
        transpose_job(C, args.in[23], WDN, 1024, 1024, 0, NE);
        rmsnorm_rows(C, x, args.in[1], H);
        { const int i = blockIdx.x * 512 + C.tid; if (i < NG * NP) s5_tables(i, args.in[3], args.in[4], args.in[5], args.in[6], args.in[7], S5TAB); }
        __syncthreads();
    }
    SEAM(0);
    if (IN(1)) { pg8::Gemm g{}; g.A = H; g.Bt = WIN; g.M = T; g.N = IN_W; g.K = DM; pg8::StaticOrder S; S.init(T, IN_W, C.G, (int)blockIdx.x);
        pg8::EpiBf16Plain e{}; e.O = PROJ; e.ldc = IN_W; pg8::gemm_phase<pg8::EpiBf16Plain, pg8::StaticOrder, true, true>(ring, g, S, e); }
    SEAM(1);
    if (IN(2)) { qknorm_pass(C, PROJ, args.in[13], args.in[14]); }
    SEAM(2);
    if (IN(3)) {
        if (C.wave < 2) { const int job = C.vcu * 2 + C.wave; if (job < BATCH * NG) s5_naive_job(C, job, PROJ, S5TAB, args.in[8], args.in[9], args.in[10], S5OUT); }
        for (int job = C.gw; job < T * NQH; job += C.ngw) attn_naive_job(C, job, PROJ, args.in[15], ATTN);
        __syncthreads();
    }
    SEAM(3);
    if (IN(4)) { pg8::Gemm g{}; g.A = S5OUT; g.Bt = WGLU; g.M = T; g.N = 2048; g.K = 1024; pg8::StaticOrder S; S.init(T, 2048, C.G, (int)blockIdx.x);
        pg8::EpiGlu e{}; e.O = GLU; e.ldc = 1024; pg8::gemm_phase<pg8::EpiGlu, pg8::StaticOrder, true, true>(ring, g, S, e); }
    SEAM(4);
    if (IN(5)) {
        { pg8::Gemm g{}; g.A = GLU; g.Bt = WSSM; g.M = T; g.N = 1024; g.K = 1024; pg8::StaticOrder S; S.init(T, 1024, C.G, (int)blockIdx.x);
          pg8::EpiGate<false> e{}; e.O = MIXED; e.ldc = 1024; e.G = PROJ; e.ldg = IN_W; e.gcol = C_GS; pg8::gemm_phase<pg8::EpiGate<false>, pg8::StaticOrder, true, true>(ring, g, S, e); }
        VM_WAIT(); __syncthreads();
        { pg8::Gemm g{}; g.A = ATTN; g.Bt = WATT; g.M = T; g.N = 1024; g.K = 1024; pg8::StaticOrder S; S.init(T, 1024, C.G, (int)blockIdx.x);
          pg8::EpiGate<true> e{}; e.O = MIXED; e.ldc = 1024; e.G = PROJ; e.ldg = IN_W; e.gcol = C_GA; pg8::gemm_phase<pg8::EpiGate<true>, pg8::StaticOrder, true, true>(ring, g, S, e); }
    }
    SEAM(5);
    if (IN(6)) { pg8::Gemm g{}; g.A = MIXED; g.Bt = WOUT; g.M = T; g.N = 1024; g.K = 1024; pg8::StaticOrder S; S.init(T, 1024, C.G, (int)blockIdx.x);
        pg8::EpiResid e{}; e.base = x; e.out = out; e.ldc = 1024; pg8::gemm_phase<pg8::EpiResid, pg8::StaticOrder, true, true>(ring, g, S, e); }
    SEAM(6);
    if (IN(7)) { router_pass(C, out, args.in[18], args.in[19], args.in[20], H2, top_i, top_w, ctl); __syncthreads(); }
    SEAM(7);
    if (IN(8)) { scatter_gather_pass(C, top_i, ctl, dest, H2, HS); __syncthreads(); }
    SEAM(8);
    if (IN(9)) { pg8::Gemm g{}; g.A = HS; g.Bt = WGU; g.M = MAXROWS; g.N = 2048; g.K = 1024;
        pg8::GroupedOrder S; S.tile_e = (const int*)(ctl + CW_TILE_E); S.n_mt = (const int*)(ctl + CW_NMT); S.nN = 8; S.G = C.G; S.c = (int)blockIdx.x;
        pg8::EpiSwiglu e{}; e.O = ACT; e.ldc = 1024; e.bias = args.in[22]; e.dff = DFF; e.limit = 7.0f; e.alpha = 1.702f;
        pg8::gemm_phase<pg8::EpiSwiglu, pg8::GroupedOrder, true, true>(ring, g, S, e); }
    SEAM(9);
    if (IN(10)) { pg8::Gemm g{}; g.A = ACT; g.Bt = WDN; g.M = MAXROWS; g.N = 1024; g.K = 1024;
        pg8::GroupedOrder S; S.tile_e = (const int*)(ctl + CW_TILE_E); S.n_mt = (const int*)(ctl + CW_NMT); S.nN = 4; S.G = C.G; S.c = (int)blockIdx.x;
        pg8::EpiDown e{}; e.O = YS; e.ldc = 1024; e.bias = args.in[24]; e.ncol = 1024;
        pg8::gemm_phase<pg8::EpiDown, pg8::GroupedOrder, true, true>(ring, g, S, e); }
    SEAM(10);
    if (IN(11)) { combine_pass(C, out, YS, dest, top_w); }
#undef IN
#undef SEAM
}

extern "C" void kernel_launch(void* const* d_in, const int* in_sizes, int n_in, void* d_out, int out_size, void* d_ws, size_t ws_size, hipStream_t stream) {
    static int grid = 0;
    if (grid == 0) {
        if (n_in != 25 || in_sizes[0] != T * DM || out_size != T * DM || ws_size < WS_END) { fprintf(stderr, "kernel_launch: unexpected shapes / workspace (n_in %d, ws %zu)\n", n_in, ws_size); grid = -1; return; }
        int dev = 0, cus = 0, per_cu = 0;
        if (hipGetDevice(&dev) != hipSuccess || hipDeviceGetAttribute(&cus, hipDeviceAttributeMultiprocessorCount, dev) != hipSuccess) { grid = -1; return; }
        if (hipFuncSetAttribute((const void*)mk_fwd, hipFuncAttributeMaxDynamicSharedMemorySize, LDS_BYTES) != hipSuccess) { fprintf(stderr, "kernel_launch: hipFuncSetAttribute failed\n"); grid = -1; return; }
        if (hipOccupancyMaxActiveBlocksPerMultiprocessor(&per_cu, (const void*)mk_fwd, 512, LDS_BYTES) != hipSuccess || per_cu < 1) { fprintf(stderr, "kernel_launch: occupancy query says %d workgroups per CU\n", per_cu); grid = -1; (void)hipGetLastError(); return; }
        grid = cus;
    }
    if (grid < 0) return;
    if (hipMemsetAsync((char*)d_ws + WS_CTL, 0, CTL_ZERO_BYTES, stream) != hipSuccess) return;
    Args a{};
    for (int i = 0; i < 25; ++i) a.in[i] = (const float*)d_in[i];
    a.out = (float*)d_out; a.ws = (unsigned char*)d_ws;
#if MK_PER_PHASE
    for (int p = 0; p < NPH; ++p) { a.ph_lo = p; a.ph_hi = p + 1; hipLaunchKernelGGL(mk_fwd, dim3(grid), dim3(512), LDS_BYTES, stream, a); }
#else
    a.ph_lo = 0; a.ph_hi = NPH; hipLaunchKernelGGL(mk_fwd, dim3(grid), dim3(512), LDS_BYTES, stream, a);
#endif
}
```

```cpp
#include <hip/hip_runtime.h>
#include <cstdio>
#include <cstdint>
#include <cmath>

constexpr int DM = 1024, BATCH = 8, SEQ = 4096, T = BATCH * SEQ;
constexpr int NG = 64, NP = 64, GCH = 16;
constexpr int HD = 64, NQH = 16, NKVH = 4, WIN = 128;
constexpr int IN_W = 4608;
constexpr int C_U = 0, C_Q = 1024, C_K = 2048, C_V = 2304, C_GS = 2560, C_GA = 3584;
constexpr int NE = 32, TOPK = 4, DFF = 1024, NA = T * TOPK;
constexpr int MAXROWS = NA + NE * 256;
constexpr int MAXMT = MAXROWS / 256;
constexpr float EPS = 1e-5f;

namespace pg8 {
#define PG8_LAS __attribute__((address_space(3)))
typedef unsigned short bf16_t;
typedef short bf16x8 __attribute__((ext_vector_type(8)));
typedef float f32x4 __attribute__((ext_vector_type(4)));
typedef unsigned u32x4 __attribute__((ext_vector_type(4)));
constexpr int BM = 256, BK = 64, HALF = 128, HTB = HALF * BK * 2  , STAGE_BYTES = 8 * HTB, NXCD = 8, WGM = 8;

__host__ __device__ __forceinline__ int lds_byte(int r, int c) { const int st = (r >> 4) * 2 + (c >> 5), rr = r & 15, cc = c & 31, ob = rr * 64 + cc * 2; return st * 1024 + (ob ^ (((ob >> 9) & 1) << 5)); }
__host__ __device__ __forceinline__ void stage_rc(int b, int& R, int& C) { const int st = b / 1024, sb = b % 1024, swz = sb ^ (((sb >> 9) & 1) << 5); R = (st >> 1) * 16 + swz / 64; C = (st & 1) * 32 + (swz % 64) / 2; }
__host__ __device__ __forceinline__ int perm32(int rho) { const int n = rho >> 4, i = rho & 15; return 8 * (i >> 2) + 4 * n + (i & 3); }

struct Unit { int pm, pn, e, pl; };
struct Gemm { const bf16_t* A; const bf16_t* Bt; int M, N, K, pad; };

struct StaticOrder {
    int nM, nN, nwg, G, c;
    __host__ __device__ void init(int M, int N, int G_, int c_) { nM = M / BM; nN = N / BM; nwg = nM * nN; G = G_; c = c_; }
    __host__ __device__ bool next(int i, Unit& u) const {
        const long L = (long)i * G + c; if (L >= nwg) return false;
        int wgid = (int)L; { const int q = nwg / NXCD, r = nwg % NXCD, xcd = wgid % NXCD, off = wgid / NXCD; wgid = (xcd < r ? xcd * (q + 1) : r * (q + 1) + (xcd - r) * q) + off; }
        const int nig = WGM * nN, gid = wgid / nig, fm = gid * WGM, gsz = (nM - fm) < WGM ? (nM - fm) : WGM;
        u.pm = fm + ((wgid % nig) % gsz); u.pn = (wgid % nig) / gsz; u.e = 0; u.pl = u.pn; return true;
    }
    __device__ __forceinline__ void a_ready(const Unit&) const {}
    __device__ __forceinline__ void done(const Unit&) const {}
};


__device__ __forceinline__ unsigned cvt_pk_bf16(float lo, float hi) { unsigned r; asm volatile("v_cvt_pk_bf16_f32 %0, %1, %2" : "=v"(r) : "v"(lo), "v"(hi)); return r; }
__device__ __forceinline__ float bf_lo(unsigned w) { return __uint_as_float(w << 16); }
__device__ __forceinline__ float bf_hi(unsigned w) { return __uint_as_float(w & 0xffff0000u); }
__device__ __forceinline__ float sigm(float x) { return 1.f / (1.f + __expf(-x)); }
__device__ __forceinline__ u32x4 pack8(const f32x4 v0, const f32x4 v1) { u32x4 w; w.x = cvt_pk_bf16(v0[0], v0[1]); w.y = cvt_pk_bf16(v0[2], v0[3]); w.z = cvt_pk_bf16(v1[0], v1[1]); w.w = cvt_pk_bf16(v1[2], v1[3]); return w; }
__device__ __forceinline__ void unpack8(const u32x4 w, f32x4& v0, f32x4& v1) { v0 = (f32x4){bf_lo(w.x), bf_hi(w.x), bf_lo(w.y), bf_hi(w.y)}; v1 = (f32x4){bf_lo(w.z), bf_hi(w.z), bf_lo(w.w), bf_hi(w.w)}; }

struct EpiBf16Plain {
    static constexpr bool PERM = true, AFTER_DRAIN = false;
    bf16_t* O; int ldc, pad;
    __device__ __forceinline__ void operator()(const f32x4 (&acc)[2][2][4][2], const Unit& u, int wr, int wc, int fr, int fq) const {
        const int row0 = u.pm * BM + wr * 64 + fr, col0 = u.pl * BM + wc * 32 + 8 * fq;
#pragma unroll
        for (int ai = 0; ai < 2; ++ai)
#pragma unroll
            for (int m = 0; m < 4; ++m) { bf16_t* rowp = O + (size_t)(row0 + ai * HALF + m * 16) * ldc + col0;
#pragma unroll
                for (int bj = 0; bj < 2; ++bj) *(u32x4*)(rowp + bj * HALF) = pack8(acc[ai][bj][m][0], acc[ai][bj][m][1]); }
    }
};
struct EpiGlu {
    static constexpr bool PERM = true, AFTER_DRAIN = false;
    bf16_t* O; int ldc, pad;
    __device__ __forceinline__ void operator()(const f32x4 (&acc)[2][2][4][2], const Unit& u, int wr, int wc, int fr, int fq) const {
        const int row0 = u.pm * BM + wr * 64 + fr, col0 = u.pl * HALF + wc * 32 + 8 * fq;
#pragma unroll
        for (int ai = 0; ai < 2; ++ai)
#pragma unroll
            for (int m = 0; m < 4; ++m) { bf16_t* rowp = O + (size_t)(row0 + ai * HALF + m * 16) * ldc + col0;
                f32x4 o0, o1;
#pragma unroll
                for (int j = 0; j < 4; ++j) { o0[j] = acc[ai][0][m][0][j] * sigm(acc[ai][1][m][0][j]); o1[j] = acc[ai][0][m][1][j] * sigm(acc[ai][1][m][1][j]); }
                *(u32x4*)rowp = pack8(o0, o1); }
    }
};
template <bool ADD> struct EpiGate {
    static constexpr bool PERM = true, AFTER_DRAIN = false;
    bf16_t* O; const bf16_t* G; int ldc, ldg, gcol, pad;
    __device__ __forceinline__ void operator()(const f32x4 (&acc)[2][2][4][2], const Unit& u, int wr, int wc, int fr, int fq) const {
        const int row0 = u.pm * BM + wr * 64 + fr, col0 = u.pl * BM + wc * 32 + 8 * fq;
#pragma unroll
        for (int ai = 0; ai < 2; ++ai)
#pragma unroll
            for (int m = 0; m < 4; ++m) { const size_t r = (size_t)(row0 + ai * HALF + m * 16);
#pragma unroll
                for (int bj = 0; bj < 2; ++bj) {
                    const u32x4 gw = *(const u32x4*)(G + r * ldg + gcol + col0 + bj * HALF);
                    f32x4 g0, g1; unpack8(gw, g0, g1);
                    f32x4 o0, o1;
#pragma unroll
                    for (int j = 0; j < 4; ++j) { o0[j] = sigm(g0[j]) * acc[ai][bj][m][0][j]; o1[j] = sigm(g1[j]) * acc[ai][bj][m][1][j]; }
                    bf16_t* p = O + r * ldc + col0 + bj * HALF;
                    if (ADD) { const u32x4 ow = __builtin_nontemporal_load((const u32x4*)p); f32x4 p0, p1; unpack8(ow, p0, p1); o0 += p0; o1 += p1; }
                    *(u32x4*)p = pack8(o0, o1); } }
    }
};
struct EpiResid {
    static constexpr bool PERM = false, AFTER_DRAIN = false;
    const float* base; float* out; int ldc, pad;
    __device__ __forceinline__ void operator()(const f32x4 (&acc)[2][2][4][2], const Unit& u, int wr, int wc, int fr, int fq) const {
        const int row0 = u.pm * BM + wr * 64 + fr, col0 = u.pl * BM + wc * 32 + 4 * fq;
#pragma unroll
        for (int ai = 0; ai < 2; ++ai)
#pragma unroll
            for (int m = 0; m < 4; ++m) { const size_t off = (size_t)(row0 + ai * HALF + m * 16) * ldc + col0;
#pragma unroll
                for (int bj = 0; bj < 2; ++bj)
#pragma unroll
                    for (int n = 0; n < 2; ++n) { const f32x4 b = *(const f32x4*)(base + off + bj * HALF + n * 16); *(f32x4*)(out + off + bj * HALF + n * 16) = b + acc[ai][bj][m][n]; } }
    }
};
struct EpiSwiglu {
    static constexpr bool PERM = true, AFTER_DRAIN = false;
    bf16_t* O; const float* bias; int ldc, dff; float limit, alpha;
    __device__ __forceinline__ void operator()(const f32x4 (&acc)[2][2][4][2], const Unit& u, int wr, int wc, int fr, int fq) const {
        const int row0 = u.pm * BM + wr * 64 + fr, col0 = u.pl * HALF + wc * 32 + 8 * fq;
        const float* bg = bias + (size_t)u.e * 2 * dff + col0; const float* bu = bg + dff;
        const f32x4 bg0 = *(const f32x4*)bg, bg1 = *(const f32x4*)(bg + 4), bu0 = *(const f32x4*)bu, bu1 = *(const f32x4*)(bu + 4);
#pragma unroll
        for (int ai = 0; ai < 2; ++ai)
#pragma unroll
            for (int m = 0; m < 4; ++m) { bf16_t* rowp = O + (size_t)(row0 + ai * HALF + m * 16) * ldc + col0;
                f32x4 o0, o1;
#pragma unroll
                for (int j = 0; j < 4; ++j) {
                    float g = fminf(acc[ai][0][m][0][j] + bg0[j], limit), up = fminf(fmaxf(acc[ai][1][m][0][j] + bu0[j], -limit), limit);
                    o0[j] = (up + 1.f) * g * sigm(alpha * g);
                    g = fminf(acc[ai][0][m][1][j] + bg1[j], limit); up = fminf(fmaxf(acc[ai][1][m][1][j] + bu1[j], -limit), limit);
                    o1[j] = (up + 1.f) * g * sigm(alpha * g); }
                *(u32x4*)rowp = pack8(o0, o1); }
    }
};
struct EpiDown {
    static constexpr bool PERM = true, AFTER_DRAIN = false;
    bf16_t* O; const float* bias; int ldc, ncol;
    __device__ __forceinline__ void operator()(const f32x4 (&acc)[2][2][4][2], const Unit& u, int wr, int wc, int fr, int fq) const {
        const int row0 = u.pm * BM + wr * 64 + fr, col0 = u.pl * BM + wc * 32 + 8 * fq;
        const float* bp = bias + (size_t)u.e * ncol + col0;
        f32x4 bv[2][2];
#pragma unroll
        for (int bj = 0; bj < 2; ++bj) { bv[bj][0] = *(const f32x4*)(bp + bj * HALF); bv[bj][1] = *(const f32x4*)(bp + bj * HALF + 4); }
#pragma unroll
        for (int ai = 0; ai < 2; ++ai)
#pragma unroll
            for (int m = 0; m < 4; ++m) { bf16_t* rowp = O + (size_t)(row0 + ai * HALF + m * 16) * ldc + col0;
#pragma unroll
                for (int bj = 0; bj < 2; ++bj) *(u32x4*)(rowp + bj * HALF) = pack8(acc[ai][bj][m][0] + bv[bj][0], acc[ai][bj][m][1] + bv[bj][1]); }
    }
};
struct GroupedOrder {
    const int* tile_e; const int* n_mt; int nN, G, c;
    __device__ __forceinline__ bool next(int i, Unit& u) const {
        const int nmt = __builtin_amdgcn_readfirstlane(*(const volatile int*)n_mt); const long L = (long)i * G + c; if (L >= (long)nmt * nN) return false;
        const int mt = (int)(L / nN), pl = (int)(L % nN); const int e = __builtin_amdgcn_readfirstlane(*(const volatile int*)(tile_e + mt));
        u.pm = mt; u.pn = e * nN + pl; u.e = e; u.pl = pl; return true;
    }
    __device__ __forceinline__ void a_ready(const Unit&) const {}
    __device__ __forceinline__ void done(const Unit&) const {}
};
template <class Epi, class Sched, bool ALIGN_EPI = false, bool SP2 = false>
__device__ __forceinline__ void gemm_phase(PG8_LAS unsigned char* lds, const Gemm g, const Sched& S, const Epi& E) {
    const int tid = threadIdx.x, wid = __builtin_amdgcn_readfirstlane(tid >> 6), lane = tid & 63, wr = wid >> 2, wc = wid & 3, fr = lane & 15, fq = lane >> 4;
    const int K = g.K, nt = K / BK;
    unsigned voffA[2], voffB[2];
#pragma unroll
    for (int i = 0; i < 2; ++i) { int R, C; stage_rc(tid * 16 + i * 8192, R, C); const int Rb = Epi::PERM ? ((R & ~31) + perm32(R & 31)) : R;
        voffA[i] = (unsigned)(R * K + C) * 2u; voffB[i] = (unsigned)(Rb * K + C) * 2u; }
    const size_t kstep = (size_t)(BK * 2);
    const size_t hstep = (size_t)HALF * K * 2;
    const size_t tstep = 2 * hstep;
    const unsigned ldsw = (unsigned)wid * 1024u;
    const int aoff = lds_byte(wr * 64 + fr, fq * 8), boff = lds_byte(wc * 32 + fr, fq * 8);
#define PG8_SA(b, h) (((b) * 2 + (h)) * HTB)
#define PG8_SB(b, h) ((4 + (b) * 2 + (h)) * HTB)
#define PG8_STAGE(bufoff, gbase, voff) do { _Pragma("unroll") for (int _i = 0; _i < 2; ++_i) \
        __builtin_amdgcn_global_load_lds((const unsigned*)((const char*)(gbase) + (voff)[_i]), (PG8_LAS unsigned*)(lds + (bufoff) + ldsw + _i * 8192), 16, 0, 0); } while (0)
#define PG8_LDA(dst, b, h) do { _Pragma("unroll") for (int m = 0; m < 4; ++m) _Pragma("unroll") for (int k = 0; k < 2; ++k) dst[m][k] = *(const PG8_LAS bf16x8*)(lds + PG8_SA(b, h) + aoff + m * 2048 + k * 1024); } while (0)
#define PG8_LDB(dst, b, h) do { _Pragma("unroll") for (int n = 0; n < 2; ++n) _Pragma("unroll") for (int k = 0; k < 2; ++k) dst[n][k] = *(const PG8_LAS bf16x8*)(lds + PG8_SB(b, h) + boff + n * 2048 + k * 1024); } while (0)
#define PG8_MMA(ai, bj, At, Bt) do { __builtin_amdgcn_s_setprio(1); _Pragma("unroll") for (int m = 0; m < 4; ++m) _Pragma("unroll") for (int n = 0; n < 2; ++n) _Pragma("unroll") for (int k = 0; k < 2; ++k) \
        acc[ai][bj][m][n] = __builtin_amdgcn_mfma_f32_16x16x32_bf16(Bt[n][k], At[m][k], acc[ai][bj][m][n], 0, 0, 0); __builtin_amdgcn_s_setprio(0); } while (0)
#define PG8_WAIT_V(n) asm volatile("s_waitcnt vmcnt(" #n ")" ::: "memory")
#define PG8_WAIT_L(n) asm volatile("s_waitcnt lgkmcnt(" #n ")" ::: "memory")
#define PG8_BAR __builtin_amdgcn_s_barrier()
#define PG8_SCHED __builtin_amdgcn_sched_barrier(0)
    Unit cur, nxt; int ui = 0;
    if (!S.next(0, cur)) return;
    f32x4 acc[2][2][4][2];
#pragma unroll
    for (int a = 0; a < 2; ++a)
#pragma unroll
        for (int b = 0; b < 2; ++b)
#pragma unroll
            for (int m = 0; m < 4; ++m)
#pragma unroll
                for (int n = 0; n < 2; ++n) acc[a][b][m][n] = (f32x4){0.f, 0.f, 0.f, 0.f};
    bf16x8 At[4][2], B0[2][2], B1[2][2];
    const char* cA = (const char*)g.A + (size_t)cur.pm * tstep; const char* cB = (const char*)g.Bt + (size_t)cur.pn * tstep;
    S.a_ready(cur);
    if constexpr (SP2) {
        PG8_STAGE(PG8_SB(0, 0), cB, voffB); PG8_STAGE(PG8_SB(0, 1), cB + hstep, voffB); PG8_STAGE(PG8_SA(0, 0), cA, voffA); PG8_STAGE(PG8_SA(0, 1), cA + hstep, voffA);
        if (wr == 1) PG8_BAR;
        PG8_WAIT_V(2); PG8_BAR;
        PG8_STAGE(PG8_SB(1, 0), cB + kstep, voffB); PG8_STAGE(PG8_SA(1, 0), cA + kstep, voffA); PG8_STAGE(PG8_SB(1, 1), cB + hstep + kstep, voffB);
        PG8_WAIT_V(6); PG8_BAR;
    } else {
        PG8_STAGE(PG8_SB(0, 0), cB, voffB); PG8_STAGE(PG8_SA(0, 0), cA, voffA); PG8_STAGE(PG8_SB(0, 1), cB + hstep, voffB); PG8_STAGE(PG8_SA(0, 1), cA + hstep, voffA);
        if (wr == 1) PG8_BAR;
        PG8_WAIT_V(4); PG8_BAR;
        PG8_STAGE(PG8_SB(1, 0), cB + kstep, voffB); PG8_STAGE(PG8_SA(1, 0), cA + kstep, voffA); PG8_STAGE(PG8_SB(1, 1), cB + hstep + kstep, voffB);
        PG8_WAIT_V(6); PG8_BAR;
    }
    for (;;) {
        const bool has_next = S.next(ui + 1, nxt);
        const char* nA = has_next ? (const char*)g.A + (size_t)nxt.pm * tstep : cA; const char* nB = has_next ? (const char*)g.Bt + (size_t)nxt.pn * tstep : cB;
        for (int t = 0; t < nt; t += 2) {
            const bool last = (t == nt - 2);
            const char* a1 = cA + (size_t)(t + 1) * kstep;
            const char* a2 = last ? nA : cA + (size_t)(t + 2) * kstep; const char* b2 = last ? nB : cB + (size_t)(t + 2) * kstep;
            const char* a3 = a2 + kstep; const char* b3 = b2 + kstep;
            if (last && has_next) S.a_ready(nxt);
            if constexpr (SP2) {
            PG8_LDB(B0, 0, 0); PG8_LDB(B1, 0, 1); PG8_SCHED; PG8_LDA(At, 0, 0); PG8_STAGE(PG8_SA(1, 1), a1 + hstep, voffA);
            PG8_WAIT_V(8); PG8_WAIT_L(0); PG8_BAR; PG8_MMA(0, 0, At, B0); PG8_MMA(0, 1, At, B1); PG8_BAR; PG8_SCHED;
            PG8_LDA(At, 0, 1); PG8_STAGE(PG8_SB(0, 0), b2, voffB); PG8_STAGE(PG8_SB(0, 1), b2 + hstep, voffB); PG8_STAGE(PG8_SA(0, 0), a2, voffA);
            PG8_WAIT_V(8); PG8_WAIT_L(0); PG8_BAR; PG8_MMA(1, 0, At, B0); PG8_MMA(1, 1, At, B1); PG8_BAR; PG8_SCHED;
            PG8_LDB(B0, 1, 0); PG8_LDB(B1, 1, 1); PG8_SCHED; PG8_LDA(At, 1, 0); PG8_STAGE(PG8_SA(0, 1), a2 + hstep, voffA);
            PG8_WAIT_V(8); PG8_WAIT_L(0); PG8_BAR; PG8_MMA(0, 0, At, B0); PG8_MMA(0, 1, At, B1); PG8_BAR; PG8_SCHED;
            PG8_LDA(At, 1, 1); PG8_STAGE(PG8_SB(1, 0), b3, voffB); PG8_STAGE(PG8_SB(1, 1), b3 + hstep, voffB); PG8_STAGE(PG8_SA(1, 0), a3, voffA);
            PG8_WAIT_V(8); PG8_WAIT_L(0); PG8_BAR; PG8_MMA(1, 0, At, B0); PG8_MMA(1, 1, At, B1); PG8_BAR; PG8_SCHED;
            } else {
            PG8_LDB(B0, 0, 0); PG8_SCHED; PG8_LDA(At, 0, 0); PG8_STAGE(PG8_SA(1, 1), a1 + hstep, voffA);
            PG8_WAIT_L(8); PG8_BAR; PG8_WAIT_L(0); PG8_MMA(0, 0, At, B0); PG8_BAR; PG8_SCHED;
            PG8_LDB(B1, 0, 1); PG8_STAGE(PG8_SB(0, 0), b2, voffB);
            PG8_BAR; PG8_WAIT_L(0); PG8_MMA(0, 1, At, B1); PG8_BAR;
            PG8_LDA(At, 0, 1); PG8_STAGE(PG8_SA(0, 0), a2, voffA);
            PG8_BAR; PG8_WAIT_L(0); PG8_MMA(1, 0, At, B0); PG8_BAR; PG8_SCHED;
            PG8_STAGE(PG8_SB(0, 1), b2 + hstep, voffB);
            PG8_WAIT_V(6); PG8_BAR; PG8_MMA(1, 1, At, B1); PG8_BAR;
            PG8_LDB(B0, 1, 0); PG8_SCHED; PG8_LDA(At, 1, 0); PG8_STAGE(PG8_SA(0, 1), a2 + hstep, voffA);
            PG8_WAIT_L(8); PG8_BAR; PG8_WAIT_L(0); PG8_MMA(0, 0, At, B0); PG8_BAR; PG8_SCHED;
            PG8_LDB(B1, 1, 1); PG8_STAGE(PG8_SB(1, 0), b3, voffB);
            PG8_BAR; PG8_WAIT_L(0); PG8_MMA(0, 1, At, B1); PG8_BAR;
            PG8_LDA(At, 1, 1); PG8_STAGE(PG8_SA(1, 0), a3, voffA);
            PG8_BAR; PG8_WAIT_L(0); PG8_MMA(1, 0, At, B0); PG8_BAR; PG8_SCHED;
            PG8_STAGE(PG8_SB(1, 1), b3 + hstep, voffB);
            PG8_WAIT_V(6); PG8_BAR; PG8_MMA(1, 1, At, B1); PG8_BAR;
            }
        }
        if constexpr (ALIGN_EPI) { if (wr == 0) PG8_BAR; }
        if constexpr (!Epi::AFTER_DRAIN) { E(acc, cur, wr, wc, fr, fq); S.done(cur); }
        if (!has_next) break;
#pragma unroll
        for (int a = 0; a < 2; ++a)
#pragma unroll
            for (int b = 0; b < 2; ++b)
#pragma unroll
                for (int m = 0; m < 4; ++m)
#pragma unroll
                    for (int n = 0; n < 2; ++n) acc[a][b][m][n] = (f32x4){0.f, 0.f, 0.f, 0.f};
        cur = nxt; cA = nA; cB = nB; ++ui;
        if constexpr (ALIGN_EPI) { if (wr == 1) PG8_BAR; }
    }
    PG8_WAIT_V(0);
    if constexpr (!ALIGN_EPI) { if (wr == 0) PG8_BAR; }
    PG8_BAR;
    if constexpr (Epi::AFTER_DRAIN) { E.fused(acc, cur, wr, wc, fr, fq, lds, wid, lane); S.done(cur); }
#undef PG8_SA
#undef PG8_SB
#undef PG8_STAGE
#undef PG8_LDA
#undef PG8_LDB
#undef PG8_MMA
#undef PG8_WAIT_V
#undef PG8_WAIT_L
#undef PG8_BAR
#undef PG8_SCHED
}
}

#define GAS __attribute__((address_space(1)))
#define LAS __attribute__((address_space(3)))
typedef unsigned short bf16;
typedef unsigned v4u __attribute__((ext_vector_type(4)));
typedef float f32x4 __attribute__((ext_vector_type(4)));
typedef short bf16x8 __attribute__((ext_vector_type(8)));
typedef GAS unsigned gu32;
typedef GAS unsigned long long gu64;
#define RLX_AGENT __ATOMIC_RELAXED, __HIP_MEMORY_SCOPE_AGENT
#define LDS_WAIT() asm volatile("s_waitcnt lgkmcnt(0)" ::: "memory")
#define VM_WAIT() asm volatile("s_waitcnt vmcnt(0)" ::: "memory")
__device__ __forceinline__ unsigned long long rt() { return __builtin_amdgcn_s_memrealtime(); }
__device__ __forceinline__ unsigned f2bf(float f) { unsigned u = __builtin_bit_cast(unsigned, f); return (u + 0x7fffu + ((u >> 16) & 1u)) >> 16; }
__device__ __forceinline__ unsigned pk2(float lo, float hi) { return f2bf(lo) | (f2bf(hi) << 16); }

#define XB_TMO      128
#define XB_XCNT(j)  (256  + 64 * (j))
#define XB_XSUB(j)  (1280 + 64 * (j))
#define XB_XGEN(j)  (2304 + 64 * (j))
#define XB_TOP      3328
#define XB_TOPGEN   3392
#define XCD_BAR_WORDS 3456
#define XB_SPIN_CAP (1u << 18)

__device__ __forceinline__ unsigned xb_ld(unsigned* p)              { return __hip_atomic_load(p, __ATOMIC_RELAXED, __HIP_MEMORY_SCOPE_AGENT); }
__device__ __forceinline__ unsigned xb_add(unsigned* p, unsigned v) { return __hip_atomic_fetch_add(p, v, __ATOMIC_RELAXED, __HIP_MEMORY_SCOPE_AGENT); }
__device__ __forceinline__ unsigned xb_xcc_id() { return (unsigned)__builtin_amdgcn_s_getreg((3 << 11) | 20) & 0xFu; }
#define XB_SPIN(cond, bar) do { unsigned _sp = 0; while (cond) { __builtin_amdgcn_s_sleep(1); \
    if ((++_sp & 255u) == 0u) { if (xb_ld(&(bar)[XB_TMO])) break; if (_sp > XB_SPIN_CAP) { atomicAdd(&(bar)[XB_TMO], 1u); break; } } } } while (0)

struct XcdBarrier {
    unsigned* bar; unsigned x;
    volatile LAS unsigned* st;
};

__device__ __forceinline__ XcdBarrier xcd_barrier_post(unsigned* bar, volatile LAS unsigned* st) {
    XcdBarrier b; b.bar = bar; b.x = xb_xcc_id(); b.st = st;
    if (threadIdx.x == 0) (void)xb_add(&bar[XB_XCNT(b.x)], 1u);
    return b;
}
__device__ __forceinline__ void xcd_barrier_complete(unsigned* bar, unsigned x, unsigned& nloc, unsigned& nx) {
    const unsigned G = gridDim.x * gridDim.y * gridDim.z;
    unsigned sum, cnt, mine, sp = 0u;
    for (;;) {
        sum = 0u; cnt = 0u; mine = 0u;
#pragma unroll
        for (unsigned j = 0; j < 16; ++j) { const unsigned c = xb_ld(&bar[XB_XCNT(j)]); sum += c; cnt += (c > 0u) ? 1u : 0u; mine = (j == x) ? c : mine; }
        if (sum == G) break;
        __builtin_amdgcn_s_sleep(1);
        if ((++sp & 255u) == 0u) { if (xb_ld(&bar[XB_TMO])) break; if (sp > XB_SPIN_CAP) { atomicAdd(&bar[XB_TMO], 1u); break; } }
    }
    nloc = mine > 0u ? mine : 1u; nx = cnt > 0u ? cnt : 1u;
}

__device__ __forceinline__ void xcd_barrier(const XcdBarrier& b) {
    asm volatile("s_waitcnt vmcnt(0)" ::: "memory");
    __syncthreads();
    if (threadIdx.x == 0) {
        unsigned* bar = b.bar;
        __builtin_amdgcn_s_waitcnt(0);
        unsigned nloc = b.st[0], nx = b.st[1];
        if (nloc == 0u) { xcd_barrier_complete(bar, b.x, nloc, nx); b.st[0] = nloc; b.st[1] = nx; }
        const unsigned old = xb_add(&bar[XB_XSUB(b.x)], 1u);
        const unsigned gen = old / nloc;
        if (old + 1u == (gen + 1u) * nloc) {
            __builtin_amdgcn_fence(__ATOMIC_RELEASE, "agent");
            asm volatile("s_waitcnt vmcnt(0)" ::: "memory");
            const unsigned og = xb_add(&bar[XB_TOP], 1u);
            const unsigned tg = og / nx;
            if (og + 1u == (tg + 1u) * nx) xb_add(&bar[XB_TOPGEN], 1u);
            else XB_SPIN(xb_ld(&bar[XB_TOPGEN]) == tg, bar);
            __builtin_amdgcn_fence(__ATOMIC_ACQUIRE, "agent");
            xb_add(&bar[XB_XGEN(b.x)], 1u);
            asm volatile("s_waitcnt vmcnt(0)" ::: "memory");
        } else {
            XB_SPIN(xb_ld(&bar[XB_XGEN(b.x)]) == gen, bar);
            __builtin_amdgcn_fence(__ATOMIC_ACQUIRE, "agent");
            asm volatile("s_waitcnt vmcnt(0)" ::: "memory");
        }
    }
    __syncthreads();
}

constexpr size_t MiB = 1u << 20;
constexpr size_t WS_CTL = 0;
constexpr size_t CTL_ZERO_BYTES = 65536;
constexpr size_t WS_WIN = 1 * MiB, WS_WGLU = 10 * MiB, WS_WSSM = 14 * MiB, WS_WATT = 16 * MiB, WS_WOUT = 18 * MiB;
constexpr size_t WS_WGU = 20 * MiB, WS_WDN = 148 * MiB;
constexpr size_t WS_ROUTE = 216 * MiB;
constexpr size_t WS_H = 224 * MiB;
constexpr size_t WS_PROJ = 288 * MiB;
constexpr size_t WS_S5OUT = 576 * MiB;
constexpr size_t WS_ATTN = 640 * MiB;
constexpr size_t WS_ACT = 704 * MiB;
constexpr size_t WS_BTAB = 976 * MiB, WS_CTAB = 980 * MiB, WS_KTAB = 984 * MiB, WS_A16 = 985 * MiB;
constexpr size_t WS_END = 986 * MiB;
static_assert(WS_PROJ + (size_t)T * IN_W * 2 <= WS_S5OUT && WS_PROJ + (size_t)MAXROWS * 1024 * 2 <= WS_S5OUT && WS_ACT + (size_t)MAXROWS * 1024 * 2 <= WS_END, "ws map");
constexpr int CW_CNT = 0;
constexpr int CW_CUR = 64;
constexpr int CW_NMT = 192;
constexpr int CW_TILE_E = 256;
constexpr int CW_BAR = 4096;
static_assert((CW_BAR + XCD_BAR_WORDS) * 4 <= (int)CTL_ZERO_BYTES && CW_TILE_E + MAXMT <= CW_BAR, "ctl map");
constexpr size_t RT_TOPI = 0, RT_TOPW = (size_t)NA * 4, RT_DEST = 2 * (size_t)NA * 4;

constexpr int LDS_BYTES = 163840;
constexpr int RING_OFF = 0;
constexpr int MISC_OFF = LDS_BYTES - 256;

__device__ __forceinline__ float bf2f(bf16 b) { return __uint_as_float((unsigned)b << 16); }
__device__ __forceinline__ float wave_sum(float v) {
#pragma unroll
    for (int o = 1; o < 64; o <<= 1) v += __shfl_xor(v, o);
    return v;
}
__device__ __forceinline__ float wave_max(float v) {
#pragma unroll
    for (int o = 1; o < 64; o <<= 1) v = fmaxf(v, __shfl_xor(v, o));
    return v;
}
__device__ __forceinline__ float gelu_tanh(float x) { const float z = 1.5957691216f * (x + 0.044715f * x * x * x); return x / (1.f + __expf(-z)); }
#define WAVE_SYNC() do { __builtin_amdgcn_wave_barrier(); asm volatile("s_waitcnt lgkmcnt(0)" ::: "memory"); } while (0)

struct Args { const float* in[25]; float* out; unsigned char* ws; int ph_lo, ph_hi; };
struct Ctx { int tid, lane, wave, vcu, G, gw, ngw; LAS unsigned char* lds; };

__device__ __forceinline__ void transpose_item(const float* W, int K, int N, bf16* WT, int mode, LAS float* scr, int item, int lane) {
    const int nblk = N / 32, kb = item / nblk, nb = item % nblk, k0 = 64 * kb, n0 = 32 * nb;
#pragma unroll 8
    for (int i = 0; i < 32; ++i) { const int kk = 2 * i + (lane >> 5); scr[kk * 33 + (lane & 31)] = W[(size_t)(k0 + kk) * N + n0 + (lane & 31)]; }
    LDS_WAIT(); asm volatile("" ::: "memory");
    int r0 = n0;
    if (mode == 1) { const int nh = N / 2; r0 = (n0 < nh) ? 256 * (n0 / 128) + (n0 % 128) : 256 * ((n0 - nh) / 128) + 128 + ((n0 - nh) % 128); }
    const int c = lane & 7;
#pragma unroll
    for (int j = 0; j < 4; ++j) { const int n = (lane >> 3) + 8 * j; const LAS float* s = scr + (8 * c) * 33 + n;
        v4u o; o.x = pk2(s[0 * 33], s[1 * 33]); o.y = pk2(s[2 * 33], s[3 * 33]); o.z = pk2(s[4 * 33], s[5 * 33]); o.w = pk2(s[6 * 33], s[7 * 33]);
        *(v4u*)(WT + (size_t)(r0 + n) * K + k0 + 8 * c) = o; }
    LDS_WAIT(); asm volatile("" ::: "memory");
}
__device__ __forceinline__ void transpose_job(const Ctx& C, const float* W, bf16* WT, int K, int N, int mode, int nmat) {
    LAS float* scr = (LAS float*)(C.lds + RING_OFF + C.wave * 16384);
    const int per = (K / 64) * (N / 32); const int total = per * nmat;
    for (int it = C.gw; it < total; it += C.ngw) { const int mat = it / per, item = it % per;
        transpose_item(W + (size_t)mat * K * N, K, N, WT + (size_t)mat * K * N, mode, scr, item, C.lane); }
}
__device__ __forceinline__ void rmsnorm_rows(const Ctx& C, const float* x, const float* g, bf16* out) {
    for (int m = C.gw; m < T; m += C.ngw) {
        const f32x4* xr = (const f32x4*)(x + (size_t)m * DM) + C.lane; f32x4 v[4]; float s = 0.f;
#pragma unroll
        for (int j = 0; j < 4; ++j) { v[j] = xr[64 * j]; s += (v[j].x * v[j].x + v[j].y * v[j].y) + (v[j].z * v[j].z + v[j].w * v[j].w); }
        const float rs = rsqrtf(wave_sum(s) * (1.f / DM) + EPS);
        unsigned long long* o8 = (unsigned long long*)(out + (size_t)m * DM) + C.lane;
#pragma unroll
        for (int j = 0; j < 4; ++j) { const f32x4 gg = ((const f32x4*)g)[64 * j + C.lane];
            o8[64 * j] = (unsigned long long)pk2(v[j].x * rs * gg.x, v[j].y * rs * gg.y) | ((unsigned long long)pk2(v[j].z * rs * gg.z, v[j].w * rs * gg.w) << 32); }
    }
}
__device__ __forceinline__ void qknorm_pass(const Ctx& C, bf16* proj, const float* qg, const float* kg) {
    const float gq = qg[C.lane], gk = kg[C.lane];
    for (int j = C.gw; j < T * 20; j += C.ngw) {
        const int tok = j / 20, hd = j % 20;
        bf16* p = proj + (size_t)tok * IN_W + C_Q + hd * 64 + C.lane;
        const float v = bf2f(*p); const float rs = rsqrtf(wave_sum(v * v) * (1.f / 64.f) + EPS);
        *p = (bf16)f2bf(v * rs * (hd < 16 ? gq * (0.125f * 1.4426950408889634f) : gk));
    }
}
__device__ __forceinline__ void router_pass(const Ctx& C, const float* x1, const float* g2, const float* w_router, const float* b_router, bf16* h2, int* top_i, float* top_w, unsigned* ctl) {
    LAS float* hn = (LAS float*)(C.lds + RING_OFF + C.wave * 16384);
    const int lane = C.lane;
    for (int tok = C.gw; tok < T; tok += C.ngw) {
        const f32x4* xr = (const f32x4*)(x1 + (size_t)tok * DM) + lane; f32x4 v[4]; float s = 0.f;
#pragma unroll
        for (int j = 0; j < 4; ++j) { v[j] = xr[64 * j]; s += (v[j].x * v[j].x + v[j].y * v[j].y) + (v[j].z * v[j].z + v[j].w * v[j].w); }
        const float rs = rsqrtf(wave_sum(s) * (1.f / DM) + EPS);
        unsigned long long* o8 = (unsigned long long*)(h2 + (size_t)tok * DM) + lane;
#pragma unroll
        for (int j = 0; j < 4; ++j) { const f32x4 gg = ((const f32x4*)g2)[64 * j + lane];
            const f32x4 y = (f32x4){v[j].x * rs * gg.x, v[j].y * rs * gg.y, v[j].z * rs * gg.z, v[j].w * rs * gg.w};
            *(LAS f32x4*)(hn + 256 * j + 4 * lane) = y;
            o8[64 * j] = (unsigned long long)pk2(y.x, y.y) | ((unsigned long long)pk2(y.z, y.w) << 32); }
        WAVE_SYNC();
        const int e = lane & 31, half = lane >> 5;
        float acc = 0.f;
        const float* wr = w_router + (size_t)(512 * half) * NE + e; const LAS float* hv = hn + 512 * half;
#pragma unroll 8
        for (int d = 0; d < 512; ++d) acc += hv[d] * wr[(size_t)d * NE];
        acc += __shfl_xor(acc, 32);
        float logit = acc + b_router[e];
        float tv[4]; int ti[4];
#pragma unroll
        for (int k = 0; k < 4; ++k) {
            const float mx = wave_max(logit);
            const unsigned long long bal = __ballot(logit == mx);
            const int idx = (__ffsll((long long)bal) - 1) & 31;
            tv[k] = mx; ti[k] = idx;
            if (e == idx) logit = -INFINITY;
        }
        const float e1 = __expf(tv[1] - tv[0]), e2 = __expf(tv[2] - tv[0]), e3 = __expf(tv[3] - tv[0]); const float inv = 1.f / (1.f + e1 + e2 + e3);
        if (lane < 4) { const int k = lane; const int ei = k == 0 ? ti[0] : k == 1 ? ti[1] : k == 2 ? ti[2] : ti[3]; const float wv = (k == 0 ? 1.f : k == 1 ? e1 : k == 2 ? e2 : e3) * inv;
            top_i[tok * 4 + k] = ei; top_w[tok * 4 + k] = wv; atomicAdd(ctl + CW_CNT + ei, 1u); }
        WAVE_SYNC();
    }
}
__device__ __forceinline__ void scatter_gather_pass(const Ctx& C, const int* top_i, unsigned* ctl, int* dest, const bf16* h2, bf16* hs) {
    LAS unsigned* pst = (LAS unsigned*)(C.lds + RING_OFF + 8 * 16384 - 1024);
    if (C.tid == 0) { unsigned run = 0; int mt = 0;
        for (int e = 0; e < NE; ++e) { const unsigned c = __hip_atomic_load(ctl + CW_CNT + e, RLX_AGENT); const unsigned padded = (c + 255u) / 256u * 256u; pst[e] = run;
            if (blockIdx.x == 0) for (unsigned i = 0; i < padded / 256u; ++i) ctl[CW_TILE_E + mt + i] = (unsigned)e;
            mt += padded / 256u; run += padded; }
        pst[NE] = run; if (blockIdx.x == 0) ctl[CW_NMT] = (unsigned)mt; }
    __syncthreads();
    for (int a = C.gw; a < NA; a += C.ngw) {
        int d = 0;
        if (C.lane == 0) { const int e = top_i[a]; const unsigned pos = atomicAdd(ctl + CW_CUR + e, 1u); d = (int)(pst[e] + pos); dest[a] = d; }
        d = __builtin_amdgcn_readfirstlane(d);
        const v4u* s = (const v4u*)(h2 + (size_t)(a >> 2) * DM); v4u* o = (v4u*)(hs + (size_t)d * DM);
        o[C.lane] = s[C.lane]; o[C.lane + 64] = s[C.lane + 64];
    }
}
__device__ __forceinline__ void combine_pass(const Ctx& C, float* out, const bf16* ys, const int* dest, const float* top_w) {
    const int lane = C.lane;
    for (int tok = C.gw; tok < T; tok += C.ngw) {
        f32x4* o = (f32x4*)(out + (size_t)tok * DM);
        f32x4 acc[4];
#pragma unroll
        for (int j = 0; j < 4; ++j) acc[j] = o[64 * j + lane];
#pragma unroll
        for (int k = 0; k < 4; ++k) { const float wv = top_w[tok * 4 + k]; const unsigned long long* y8 = (const unsigned long long*)(ys + (size_t)dest[tok * 4 + k] * DM);
#pragma unroll
            for (int j = 0; j < 4; ++j) { const unsigned long long q = y8[64 * j + lane]; const unsigned lo = (unsigned)q, hi = (unsigned)(q >> 32);
                acc[j].x += wv * __uint_as_float(lo << 16); acc[j].y += wv * __uint_as_float(lo & 0xffff0000u); acc[j].z += wv * __uint_as_float(hi << 16); acc[j].w += wv * __uint_as_float(hi & 0xffff0000u); } }
#pragma unroll
        for (int j = 0; j < 4; ++j) o[64 * j + lane] = acc[j];
    }
}

namespace att {
using bf16x8 = __attribute__((ext_vector_type(8))) short;
using s16x4 = __attribute__((ext_vector_type(4))) short;
using f32x16 = __attribute__((ext_vector_type(16))) float;
using u32x4 = __attribute__((ext_vector_type(4))) unsigned;
typedef float f32x2_t __attribute__((ext_vector_type(2))); typedef __bf16 bf16x2_t __attribute__((ext_vector_type(2)));
constexpr float LOG2E = 1.4426950408889634f, QSCALE = 0.125f * LOG2E;
constexpr int SLOTB = 8192, NSLOT = 4;
constexpr int L_K = 0, L_V = NSLOT * SLOTB, L_WS = 2 * NSLOT * SLOTB, L_OST = L_WS + 8 * 256, L_BYTES = L_OST + 8 * 4096;
__device__ __forceinline__ int crow(int r, int hi) { return (r & 3) + 8 * (r >> 2) + 4 * hi; }
__device__ __forceinline__ void glds16(const void* gsrc, unsigned lds_dst) { unsigned keep;
    asm volatile("s_mov_b32 %0, m0\n\ts_mov_b32 m0, %2\n\ts_nop 0\n\tglobal_load_lds_dwordx4 %1, off\n\ts_mov_b32 m0, %0" : "=&s"(keep) : "v"(gsrc), "s"(lds_dst) : "memory"); }
__device__ __forceinline__ unsigned cvtpk_s(float lo, float hi) { f32x2_t v = {lo, hi}; bf16x2_t b = __builtin_convertvector(v, bf16x2_t); return __builtin_bit_cast(unsigned, b); }
typedef __attribute__((address_space(3))) const char* lds_cptr;
__device__ __forceinline__ void qkt_half(f32x16& p, lds_cptr kb, const bf16x8* qr) {
    const f32x16 z = f32x16{};
#pragma unroll
    for (int d0 = 0; d0 < 4; ++d0) {
        const bf16x8 b0 = *(const __attribute__((address_space(3))) bf16x8*)(kb + d0 * 2048);
        p = __builtin_amdgcn_mfma_f32_32x32x16_bf16(b0, qr[d0], d0 == 0 ? z : p, 0, 0, 0); }
}
__device__ __forceinline__ void pv_half(f32x16* o, int vb, bf16x8 pa0, bf16x8 pa1) {
#pragma unroll
    for (int d0 = 0; d0 < 2; ++d0) { s16x4 lo[2], hi[2];
#pragma unroll
        for (int ks = 0; ks < 2; ++ks) {
            asm volatile("ds_read_b64_tr_b16 %0,%1 offset:%c2" : "=&v"(lo[ks]) : "v"(vb), "i"(d0 * 4096 + ks * 1024) : "memory");
            asm volatile("ds_read_b64_tr_b16 %0,%1 offset:%c2" : "=&v"(hi[ks]) : "v"(vb), "i"(d0 * 4096 + ks * 1024 + 512) : "memory"); }
        asm volatile("s_waitcnt lgkmcnt(0)" ::: "memory"); __builtin_amdgcn_sched_barrier(0);
#define ATT_PK(k) (bf16x8){lo[k][0], lo[k][1], lo[k][2], lo[k][3], hi[k][0], hi[k][1], hi[k][2], hi[k][3]}
        o[d0] = __builtin_amdgcn_mfma_f32_32x32x16_bf16(pa0, ATT_PK(0), o[d0], 0, 0, 0);
        o[d0] = __builtin_amdgcn_mfma_f32_32x32x16_bf16(pa1, ATT_PK(1), o[d0], 0, 0, 0);
#undef ATT_PK
    }
}
__device__ __forceinline__ void dma_tile(const bf16* proj, int b, int kvh, int ti, unsigned lds0, int wid, int lane) {
    const unsigned slot = (unsigned)((ti + 2) & 3) * SLOTB;
    int kr = 64 * ti + lane; kr = kr < 0 ? 0 : kr;
    int vr = 64 * ti + 16 * (wid & 3) + (lane >> 2); vr = vr < 0 ? 0 : vr;
    const bf16* ksrc = proj + (size_t)(b * SEQ + kr) * IN_W + C_K + kvh * 64 + wid * 8;
    const bf16* vsrc = proj + (size_t)(b * SEQ + vr) * IN_W + C_V + kvh * 64 + (wid >> 2) * 32 + (lane & 3) * 8;
    glds16(ksrc, (unsigned)__builtin_amdgcn_readfirstlane(lds0 + L_K + slot + wid * 1024));
    glds16(vsrc, (unsigned)__builtin_amdgcn_readfirstlane(lds0 + L_V + slot + wid * 1024));
}
#define ATT_WAIT_BAR() asm volatile("s_waitcnt vmcnt(0) lgkmcnt(0)\n\ts_barrier" ::: "memory")
__device__ __forceinline__ void attn_run(int b, int kvh, int qb0, int nqb, const bf16* proj, const float* sinks, bf16* O, LAS unsigned char* shm) {
    const int tid = threadIdx.x, lane = tid & 63, r32 = lane & 31, hi = lane >> 5; const int wid = __builtin_amdgcn_readfirstlane(tid >> 6);
    const int h = kvh * 4 + (wid & 3), sub = wid >> 2;
    const unsigned lds0 = (unsigned)(uintptr_t)shm;
    LAS float* wsf = (LAS float*)(shm + L_WS) + wid * 64;
    const lds_cptr shm3 = (lds_cptr)shm;
    const int vb0 = (int)(lds0 + L_V) + ((lane >> 4) & 1) * 32 + (lane & 3) * 8 + (4 * hi + ((lane & 15) >> 2)) * 64;
    const float slope2 = exp2f(-0.5f * (float)(h + 1)) * LOG2E, sink2 = sinks[h] * LOG2E;
    dma_tile(proj, b, kvh, qb0 - 2, lds0, wid, lane); dma_tile(proj, b, kvh, qb0 - 1, lds0, wid, lane); dma_tile(proj, b, kvh, qb0, lds0, wid, lane);
    for (int qi = 0; qi < nqb; ++qi) {
        const int qb = qb0 + qi, tq0 = qb * 64 + 32 * sub;
        const bf16* Qw = proj + (size_t)(b * SEQ + tq0) * IN_W + C_Q + h * 64;
        bf16x8 qr[4];
#pragma unroll
        for (int d0 = 0; d0 < 4; ++d0) qr[d0] = *(const bf16x8*)(Qw + (size_t)r32 * IN_W + d0 * 16 + hi * 8);
        ATT_WAIT_BAR();
        if (qi + 1 < nqb) dma_tile(proj, b, kvh, qb + 1, lds0, wid, lane);
        f32x16 p[5];
#pragma unroll
        for (int i = 0; i < 5; ++i) { const int g = i + sub; qkt_half(p[i], shm3 + L_K + ((qb + (g >> 1)) & 3) * SLOTB + (g & 1) * 512 + hi * 1024 + r32 * 16, qr); }
        float dbase = (float)(128 + r32 - 4 * hi); asm volatile("" : "+v"(dbase));
        const float dmax = (float)(tq0 + r32);
        float mx = -INFINITY;
#pragma unroll
        for (int i = 0; i < 5; ++i)
#pragma unroll
            for (int r = 0; r < 16; ++r) { const float d = dbase - (float)(32 * i + (r & 3) + 8 * (r >> 2));
                float v = p[i][r] - slope2 * d;
                if (i == 0) v = (d < 128.f) ? v : -INFINITY;
                if (i == 4) v = (d >= 0.f) ? v : -INFINITY;
                if (qb < 2) v = (d <= dmax) ? v : -INFINITY;
                p[i][r] = v; mx = fmaxf(mx, v); }
        { auto rr = __builtin_amdgcn_permlane32_swap(__float_as_uint(mx), __float_as_uint(mx), false, false); mx = fmaxf(__uint_as_float(rr[0]), __uint_as_float(rr[1])); }
        mx = fmaxf(mx, sink2);
        float ls = 0.f;
        f32x16 o[2]; o[0] = f32x16{}; o[1] = f32x16{};
#pragma unroll
        for (int i = 0; i < 5; ++i) { const int g = i + sub;
#pragma unroll
            for (int r = 0; r < 16; ++r) { const float e = __builtin_amdgcn_exp2f(p[i][r] - mx); p[i][r] = e; ls += e; }
            u32x4 pw0, pw1;
#define ATT_PKW(P, B) cvtpk_s(P[B], P[B + 1])
            pw0 = (u32x4){ATT_PKW(p[i], 0), ATT_PKW(p[i], 2), ATT_PKW(p[i], 4), ATT_PKW(p[i], 6)}; pw1 = (u32x4){ATT_PKW(p[i], 8), ATT_PKW(p[i], 10), ATT_PKW(p[i], 12), ATT_PKW(p[i], 14)};
#undef ATT_PKW
            __builtin_amdgcn_sched_barrier(0);
            pv_half(o, vb0 + ((qb + (g >> 1)) & 3) * SLOTB + (g & 1) * 2048, __builtin_bit_cast(bf16x8, pw0), __builtin_bit_cast(bf16x8, pw1));
        }
        { auto rr = __builtin_amdgcn_permlane32_swap(__float_as_uint(ls), __float_as_uint(ls), false, false); ls = __uint_as_float(rr[0]) + __uint_as_float(rr[1]); }
        ls += __builtin_amdgcn_exp2f(sink2 - mx);
        if (hi == 0) wsf[32 + r32] = ls;
        asm volatile("s_waitcnt lgkmcnt(0)" ::: "memory");
        float rli[16];
#pragma unroll
        for (int r = 0; r < 16; ++r) rli[r] = __builtin_amdgcn_rcpf(wsf[32 + crow(r, hi)]);
        bf16* Ow = O + (size_t)(b * SEQ + tq0) * 1024 + h * 64;
        { LAS bf16* stg = (LAS bf16*)(shm + L_OST) + wid * 2048;
#pragma unroll
            for (int r = 0; r < 16; ++r) { const int orow = crow(r, hi);
#pragma unroll
                for (int d0 = 0; d0 < 2; ++d0) stg[orow * 64 + d0 * 32 + r32] = (bf16)f2bf(o[d0][r] * rli[r]); }
            asm volatile("s_waitcnt lgkmcnt(0)" ::: "memory");
#pragma unroll
            for (int i = 0; i < 4; ++i) { const int row = i * 8 + (lane >> 3), ch = lane & 7; const u32x4 v = *(const LAS u32x4*)(stg + row * 64 + ch * 8); *(u32x4*)(Ow + (size_t)row * 1024 + ch * 8) = v; } }
    }
    ATT_WAIT_BAR();
}
#undef ATT_WAIT_BAR
}

namespace s5 {
using bf16x8 = __attribute__((ext_vector_type(8))) short;
using f32x16 = __attribute__((ext_vector_type(16))) float;
struct cf { float re, im; };
__device__ __forceinline__ cf cmul(cf a, cf b) { return cf{a.re * b.re - a.im * b.im, a.re * b.im + a.im * b.re}; }
__device__ __forceinline__ cf cfma(cf a, cf b, cf c) { return cf{c.re + a.re * b.re - a.im * b.im, c.im + a.re * b.im + a.im * b.re}; }
__device__ __forceinline__ int crow(int r, int hi) { return (r & 3) + 8 * (r >> 2) + 4 * hi; }
__device__ __forceinline__ bf16x8 ldg16(const bf16* ubase, unsigned lane_off) { return *(const bf16x8*)((const char*)ubase + lane_off); }
constexpr size_t BT_G = 128 * 256, KT_G = 16 * 16 * 16, CT_G = 256 * 128;
constexpr int IMG_STRIDE = 136;
constexpr int L_IMG = 0, L_T = 8 * 32 * IMG_STRIDE * 2, L_BYTES = L_T + 8 * 2 * 2 * 32 * 4;

__device__ __forceinline__ void build_tables(int g, int part, const float* a_re, const float* a_im, const float* log_dt, const float* b_re, const float* b_im, const float* c_re, const float* c_im, const float* d_skip,
                                             bf16* Btab, bf16* Ktab, bf16* Ctab, float* A16tab, LAS unsigned char* scr, int tid) {
    LAS double* LA = (LAS double*)scr; LAS double* TH = LA + 64;
    LAS float* bbr = (LAS float*)(scr + 1024); LAS float* bbi = bbr + 1024;
    LAS float* pwr = bbi + 1024; LAS float* pwi = pwr + 17 * 64;
    if (tid < 64) { const int i = g * NP + tid;
        const double dt = exp((double)log_dt[g]), are = a_re[i], aim = a_im[i];
        const double la = are * dt, th = aim * dt, mag = exp(la), abr = mag * cos(th), abi = mag * sin(th), den = are * are + aim * aim, em1 = abr - 1.0;
        const double qre = (em1 * are + abi * aim) / den, qim = (abi * are - em1 * aim) / den;
        LA[tid] = la; TH[tid] = th;
        for (int h = 0; h < GCH; ++h) { const double br = b_re[i * GCH + h], bi = b_im[i * GCH + h]; bbr[tid * 16 + h] = (float)(qre * br - qim * bi); bbi[tid * 16 + h] = (float)(qre * bi + qim * br); } }
    __syncthreads();
    for (int e = tid; e < 17 * 64; e += 512) { const int n = e >> 6, p = e & 63; const double m = exp((double)n * LA[p]), t = (double)n * TH[p]; pwr[e] = (float)(m * cos(t)); pwi[e] = (float)(m * sin(t)); }
    __syncthreads();
    if (part == 0 && tid < 64) { A16tab[(g * 64 + tid) * 2] = pwr[16 * 64 + tid]; A16tab[(g * 64 + tid) * 2 + 1] = pwi[16 * 64 + tid]; }
    for (int e = tid; e < 32 * 256; e += 512) { const int pl = e >> 8, k = e & 255, j = k >> 4, hp = k & 15, pp = 32 * part + pl, p = pp & 63;
        const float wr = pwr[(15 - j) * 64 + p], wi = pwi[(15 - j) * 64 + p], br = bbr[p * 16 + hp], bi = bbi[p * 16 + hp];
        const float v = (pp < 64) ? (wr * br - wi * bi) : (wr * bi + wi * br);
        Btab[(size_t)g * BT_G + (size_t)pp * 256 + k] = (bf16)f2bf(v); }
    for (int e = tid; e < 64 * 128; e += 512) { const int nl = e >> 7, pp = e & 127, n = 64 * part + nl, i = n >> 4, h = n & 15, p = pp & 63;
        const float cr = c_re[(size_t)(g * 16 + h) * NP + p], ci = c_im[(size_t)(g * 16 + h) * NP + p], wr = pwr[(i + 1) * 64 + p], wi = pwi[(i + 1) * 64 + p];
        const float v = (pp < 64) ? (cr * wr - ci * wi) : -(cr * wi + ci * wr);
        Ctab[(size_t)g * CT_G + (size_t)n * 128 + pp] = (bf16)f2bf(v); }
    for (int e = tid; e < 4 * 256; e += 512) { const int d = 4 * part + (e >> 8), h = (e >> 4) & 15, hp = e & 15; float acc = 0.f;
        for (int p = 0; p < 64; ++p) { const float cr = c_re[(size_t)(g * 16 + h) * NP + p], ci = c_im[(size_t)(g * 16 + h) * NP + p], wr = pwr[d * 64 + p], wi = pwi[d * 64 + p], br = bbr[p * 16 + hp], bi = bbi[p * 16 + hp];
            const float tr = wr * br - wi * bi, ti = wr * bi + wi * br; acc += cr * tr - ci * ti; }
        if (d == 0 && h == hp) acc += d_skip[g * 16 + h];
        Ktab[(size_t)g * KT_G + (size_t)(d * 16 + h) * 16 + hp] = (bf16)f2bf(acc); }
    __syncthreads();
}

__device__ __forceinline__ void scan_local(f32x16& re, f32x16& im, const cf p1, const cf p4, const int hi, cf (&em)[4], cf& T) {
#pragma unroll
    for (int q = 0; q < 4; ++q)
#pragma unroll
        for (int k = 1; k < 4; ++k) { const int r = 4 * q + k; const cf v = cfma(p1, cf{re[r - 1], im[r - 1]}, cf{re[r], im[r]}); re[r] = v.re; im[r] = v.im; }
    cf E = cf{0.f, 0.f};
#pragma unroll
    for (int q = 0; q < 4; ++q) {
        auto sr = __builtin_amdgcn_permlane32_swap(__float_as_uint(re[4 * q + 3]), __float_as_uint(re[4 * q + 3]), false, false);
        auto si = __builtin_amdgcn_permlane32_swap(__float_as_uint(im[4 * q + 3]), __float_as_uint(im[4 * q + 3]), false, false);
        const cf elo = cf{__uint_as_float(sr[0]), __uint_as_float(si[0])}, ehi = cf{__uint_as_float(sr[1]), __uint_as_float(si[1])};
        const cf Elo = E; E = cfma(p4, E, elo); const cf Ehi = E; E = cfma(p4, E, ehi);
        em[q] = hi ? Ehi : Elo; }
    T = E;
}
__device__ __forceinline__ void scan_finish(f32x16& re, f32x16& im, const cf p1, const cf p2, const cf p3, const cf p4, const cf g2, const int hi, const cf (&em)[4], const cf X) {
    cf cur = hi ? p4 : cf{1.f, 0.f};
#pragma unroll
    for (int q = 0; q < 4; ++q) { const cf carry = cfma(cur, X, em[q]); cur = cmul(cur, g2);
        cf v;
        v = cfma(p1, carry, cf{re[4 * q + 0], im[4 * q + 0]}); re[4 * q + 0] = v.re; im[4 * q + 0] = v.im;
        v = cfma(p2, carry, cf{re[4 * q + 1], im[4 * q + 1]}); re[4 * q + 1] = v.re; im[4 * q + 1] = v.im;
        v = cfma(p3, carry, cf{re[4 * q + 2], im[4 * q + 2]}); re[4 * q + 2] = v.re; im[4 * q + 2] = v.im;
        v = cfma(p4, carry, cf{re[4 * q + 3], im[4 * q + 3]}); re[4 * q + 3] = v.re; im[4 * q + 3] = v.im; }
}

__device__ __forceinline__ void s5_unit(int b, int g, const bf16* proj, const bf16* Btab, const bf16* Ktab, const bf16* Ctab, const float* A16tab, bf16* out, LAS unsigned char* shm) {
    int tid = threadIdx.x; asm volatile("" : "+v"(tid));
    const int lane = tid & 63, col = lane & 31, hi = lane >> 5; const int wid = __builtin_amdgcn_readfirstlane(tid >> 6);
    const bf16* ub = proj + (size_t)(b * SEQ + 512 * wid) * IN_W + C_U + 16 * g;
    const unsigned uoff = (unsigned)((16 * col * IN_W + 8 * hi) * 2);
    const bf16* bt = Btab + (size_t)g * BT_G; const unsigned boff = (unsigned)((col * 256 + 8 * hi) * 2);
    f32x16 zt[4];
#pragma unroll
    for (int nt = 0; nt < 4; ++nt) zt[nt] = f32x16{};
#pragma unroll
    for (int j = 0; j < 16; ++j) { const bf16x8 uj = ldg16(ub + (size_t)j * IN_W, uoff);
#pragma unroll
        for (int nt = 0; nt < 4; ++nt) { const bf16x8 bfr = ldg16(bt + (size_t)(32 * nt) * 256 + 16 * j, boff); zt[nt] = __builtin_amdgcn_mfma_f32_32x32x16_bf16(uj, bfr, zt[nt], 0, 0, 0); } }
    LAS float* Tb = (LAS float*)(shm + L_T);
    LAS bf16* img = (LAS bf16*)(shm + L_IMG) + wid * 32 * IMG_STRIDE;
    {
        cf P1[2], P2[2], P3[2], P4[2], G2[2], EM[2][4], TT[2];
#pragma unroll
        for (int s = 0; s < 2; ++s) { const float2 a = ((const float2*)A16tab)[g * 64 + 32 * s + col]; P1[s] = cf{a.x, a.y}; P2[s] = cmul(P1[s], P1[s]); P3[s] = cmul(P2[s], P1[s]); P4[s] = cmul(P2[s], P2[s]); G2[s] = cmul(P4[s], P4[s]); }
        scan_local(zt[0], zt[2], P1[0], P4[0], hi, EM[0], TT[0]);
        scan_local(zt[1], zt[3], P1[1], P4[1], hi, EM[1], TT[1]);
        if (hi == 0) {
#pragma unroll
            for (int s = 0; s < 2; ++s) { Tb[((wid * 2 + s) * 2 + 0) * 32 + col] = TT[s].re; Tb[((wid * 2 + s) * 2 + 1) * 32 + col] = TT[s].im; } }
        __syncthreads();
#pragma unroll
        for (int s = 0; s < 2; ++s) {
            const cf g4 = cmul(G2[s], G2[s]), g8 = cmul(g4, g4);
            cf X = cf{0.f, 0.f};
            for (int v = 0; v < wid; ++v) X = cfma(g8, X, cf{Tb[((v * 2 + s) * 2 + 0) * 32 + col], Tb[((v * 2 + s) * 2 + 1) * 32 + col]});
            scan_finish(zt[s], zt[2 + s], P1[s], P2[s], P3[s], P4[s], G2[s], hi, EM[s], X);
            if (hi == 0) { img[32 * s + col] = (bf16)f2bf(X.re); img[64 + 32 * s + col] = (bf16)f2bf(X.im); }
#pragma unroll
            for (int r = 0; r < 16; ++r) { const int row = crow(r, hi) + 1;
                if (row < 32) { img[row * IMG_STRIDE + 32 * s + col] = (bf16)f2bf(zt[s][r]); img[row * IMG_STRIDE + 64 + 32 * s + col] = (bf16)f2bf(zt[2 + s][r]); } }
        }
    }
    asm volatile("s_waitcnt lgkmcnt(0)" ::: "memory"); __builtin_amdgcn_wave_barrier();
    bf16x8 sa[8];
#pragma unroll
    for (int ks = 0; ks < 8; ++ks) sa[ks] = *(const LAS bf16x8*)(img + col * IMG_STRIDE + 16 * ks + 8 * hi);
    const int ih = col >> 4, h = col & 15;
    const bf16* kt = Ktab + (size_t)g * KT_G; const unsigned koff = (unsigned)(((ih * 16 + h) * 16 + 8 * hi) * 2);
    const bf16* ct = Ctab + (size_t)g * CT_G; const unsigned coff = (unsigned)((col * 128 + 8 * hi) * 2);
    bf16* ob = out + (size_t)(b * SEQ + 512 * wid + ih) * 1024 + 16 * g + h;
#pragma unroll
    for (int ps = 0; ps < 2; ++ps) {
        f32x16 acc[4];
#pragma unroll
        for (int n = 0; n < 4; ++n) acc[n] = f32x16{};
#pragma unroll
        for (int j = 0; j < 8 * ps + 8; ++j) { const bf16x8 uj = ldg16(ub + (size_t)j * IN_W, uoff);
#pragma unroll
            for (int n = 0; n < 4; ++n) { const int nt = 4 * ps + n;
                if (j <= 2 * nt + 1) {
                    bf16x8 kf;
                    if (j == 2 * nt + 1) { kf = ldg16(kt, (unsigned)((h * 16 + 8 * hi) * 2)); if (ih == 0) kf = bf16x8{}; }
                    else kf = ldg16(kt + (size_t)(2 * nt - j) * 256, koff);
                    acc[n] = __builtin_amdgcn_mfma_f32_32x32x16_bf16(uj, kf, acc[n], 0, 0, 0); } } }
#pragma unroll
        for (int ks = 0; ks < 8; ++ks)
#pragma unroll
            for (int n = 0; n < 4; ++n) { const bf16x8 cfr = ldg16(ct + (size_t)(32 * (4 * ps + n)) * 128 + 16 * ks, coff); acc[n] = __builtin_amdgcn_mfma_f32_32x32x16_bf16(sa[ks], cfr, acc[n], 0, 0, 0); }
#pragma unroll
        for (int n = 0; n < 4; ++n)
#pragma unroll
            for (int r = 0; r < 16; ++r) ob[(size_t)(16 * crow(r, hi) + 2 * (4 * ps + n)) * 1024] = (bf16)f2bf(gelu_tanh(acc[n][r]));
    }
    __syncthreads();
}
}

constexpr int NPH = 12;
#ifndef MK_PER_PHASE
#define MK_PER_PHASE 0
#endif
__global__ void __launch_bounds__(512, 2) mk_fwd(Args args) {
    extern __shared__ __attribute__((aligned(16))) unsigned char lds_raw[];
    Ctx C; C.lds = (LAS unsigned char*)lds_raw; C.tid = threadIdx.x; C.lane = C.tid & 63; C.wave = __builtin_amdgcn_readfirstlane(C.tid >> 6);
    C.G = gridDim.x; { const int bx = blockIdx.x; C.vcu = (C.G % 8 == 0) ? (bx % 8) * (C.G / 8) + bx / 8 : bx; }
    C.gw = C.vcu * 8 + C.wave; C.ngw = C.G * 8;
    volatile LAS unsigned* MISC = (volatile LAS unsigned*)(C.lds + MISC_OFF);
    if (C.tid < 64) MISC[C.tid] = 0u;
    __syncthreads();
    unsigned char* ws = args.ws; unsigned* ctl = (unsigned*)(ws + WS_CTL);
    const int lo = args.ph_lo, hi = args.ph_hi;
    XcdBarrier bar; bar.bar = ctl + CW_BAR; bar.x = 0; bar.st = nullptr;
    if (hi - lo > 1) bar = xcd_barrier_post(ctl + CW_BAR, MISC + 8);
#define IN(k) (lo <= (k) && (k) < hi)
#define SEAM(k) do { if (IN(k) && IN((k) + 1)) xcd_barrier(bar); } while (0)
    const float* x = args.in[0]; float* out = args.out;
    bf16* WIN = (bf16*)(ws + WS_WIN); bf16* WGLU = (bf16*)(ws + WS_WGLU); bf16* WSSM = (bf16*)(ws + WS_WSSM); bf16* WATT = (bf16*)(ws + WS_WATT); bf16* WOUT = (bf16*)(ws + WS_WOUT);
    bf16* WGU = (bf16*)(ws + WS_WGU); bf16* WDN = (bf16*)(ws + WS_WDN); bf16* BTAB = (bf16*)(ws + WS_BTAB); bf16* CTAB = (bf16*)(ws + WS_CTAB); bf16* KTAB = (bf16*)(ws + WS_KTAB); float* A16TAB = (float*)(ws + WS_A16);
    bf16* H = (bf16*)(ws + WS_H); bf16* PROJ = (bf16*)(ws + WS_PROJ); bf16* S5OUT = (bf16*)(ws + WS_S5OUT); bf16* ATTN = (bf16*)(ws + WS_ATTN);
    bf16* GLU = H; bf16* MIXED = S5OUT; bf16* H2 = ATTN; bf16* HS = PROJ; bf16* YS = PROJ; bf16* ACT = (bf16*)(ws + WS_ACT);
    int* top_i = (int*)(ws + WS_ROUTE + RT_TOPI); float* top_w = (float*)(ws + WS_ROUTE + RT_TOPW); int* dest = (int*)(ws + WS_ROUTE + RT_DEST);
    LAS unsigned char* ring = C.lds + RING_OFF;

    if (IN(0)) {
        for (int blk = C.vcu; blk < NG * 4; blk += C.G) s5::build_tables(blk >> 2, blk & 3, args.in[3], args.in[4], args.in[5], args.in[6], args.in[7], args.in[8], args.in[9], args.in[10], BTAB, KTAB, CTAB, A16TAB, ring, C.tid);
        transpose_job(C, args.in[2], WIN, DM, IN_W, 0, 1);
        transpose_job(C, args.in[11], WGLU, 1024, 2048, 1, 1);
        transpose_job(C, args.in[12], WSSM, 1024, 1024, 0, 1);
        transpose_job(C, args.in[16], WATT, 1024, 1024, 0, 1);
        transpose_job(C, args.in[17], WOUT, 1024, 1024, 0, 1);
        transpose_job(C, args.in[21], WGU, 1024, 2048, 1, NE);
        transpose_job(C, args.in[23], WDN, 1024, 1024, 0, NE);
        rmsnorm_rows(C, x, args.in[1], H);
        __syncthreads();
    }
    SEAM(0);
    if (IN(1)) { pg8::Gemm g{}; g.A = H; g.Bt = WIN; g.M = T; g.N = IN_W; g.K = DM; pg8::StaticOrder S; S.init(T, IN_W, C.G, (int)blockIdx.x);
        pg8::EpiBf16Plain e{}; e.O = PROJ; e.ldc = IN_W; pg8::gemm_phase<pg8::EpiBf16Plain, pg8::StaticOrder, true, true>(ring, g, S, e); }
    SEAM(1);
    if (IN(2)) { qknorm_pass(C, PROJ, args.in[13], args.in[14]); }
    SEAM(2);
    if (IN(3)) {
        for (int uu = C.vcu; uu < BATCH * NG / 2; uu += C.G) for (int i = 0; i < 2; ++i) { const int unit = 2 * uu + i; s5::s5_unit(unit & 7, unit >> 3, PROJ, BTAB, KTAB, CTAB, A16TAB, S5OUT, ring); }
        for (int run = C.vcu; run < BATCH * NKVH * 8; run += C.G) att::attn_run(run >> 5, (run >> 3) & 3, (run & 7) * 8, 8, PROJ, args.in[15], ATTN, ring);
    }
    SEAM(3);
    if (IN(4)) { pg8::Gemm g{}; g.A = S5OUT; g.Bt = WGLU; g.M = T; g.N = 2048; g.K = 1024; pg8::StaticOrder S; S.init(T, 2048, C.G, (int)blockIdx.x);
        pg8::EpiGlu e{}; e.O = GLU; e.ldc = 1024; pg8::gemm_phase<pg8::EpiGlu, pg8::StaticOrder, true, true>(ring, g, S, e); }
    SEAM(4);
    if (IN(5)) {
        { pg8::Gemm g{}; g.A = GLU; g.Bt = WSSM; g.M = T; g.N = 1024; g.K = 1024; pg8::StaticOrder S; S.init(T, 1024, C.G, (int)blockIdx.x);
          pg8::EpiGate<false> e{}; e.O = MIXED; e.ldc = 1024; e.G = PROJ; e.ldg = IN_W; e.gcol = C_GS; pg8::gemm_phase<pg8::EpiGate<false>, pg8::StaticOrder, true, true>(ring, g, S, e); }
        VM_WAIT(); __syncthreads();
        { pg8::Gemm g{}; g.A = ATTN; g.Bt = WATT; g.M = T; g.N = 1024; g.K = 1024; pg8::StaticOrder S; S.init(T, 1024, C.G, (int)blockIdx.x);
          pg8::EpiGate<true> e{}; e.O = MIXED; e.ldc = 1024; e.G = PROJ; e.ldg = IN_W; e.gcol = C_GA; pg8::gemm_phase<pg8::EpiGate<true>, pg8::StaticOrder, true, true>(ring, g, S, e); }
    }
    SEAM(5);
    if (IN(6)) { pg8::Gemm g{}; g.A = MIXED; g.Bt = WOUT; g.M = T; g.N = 1024; g.K = 1024; pg8::StaticOrder S; S.init(T, 1024, C.G, (int)blockIdx.x);
        pg8::EpiResid e{}; e.base = x; e.out = out; e.ldc = 1024; pg8::gemm_phase<pg8::EpiResid, pg8::StaticOrder, true, true>(ring, g, S, e); }
    SEAM(6);
    if (IN(7)) { router_pass(C, out, args.in[18], args.in[19], args.in[20], H2, top_i, top_w, ctl); __syncthreads(); }
    SEAM(7);
    if (IN(8)) { scatter_gather_pass(C, top_i, ctl, dest, H2, HS); __syncthreads(); }
    SEAM(8);
    if (IN(9)) { pg8::Gemm g{}; g.A = HS; g.Bt = WGU; g.M = MAXROWS; g.N = 2048; g.K = 1024;
        pg8::GroupedOrder S; S.tile_e = (const int*)(ctl + CW_TILE_E); S.n_mt = (const int*)(ctl + CW_NMT); S.nN = 8; S.G = C.G; S.c = (int)blockIdx.x;
        pg8::EpiSwiglu e{}; e.O = ACT; e.ldc = 1024; e.bias = args.in[22]; e.dff = DFF; e.limit = 7.0f; e.alpha = 1.702f;
        pg8::gemm_phase<pg8::EpiSwiglu, pg8::GroupedOrder, true, true>(ring, g, S, e); }
    SEAM(9);
    if (IN(10)) { pg8::Gemm g{}; g.A = ACT; g.Bt = WDN; g.M = MAXROWS; g.N = 1024; g.K = 1024;
        pg8::GroupedOrder S; S.tile_e = (const int*)(ctl + CW_TILE_E); S.n_mt = (const int*)(ctl + CW_NMT); S.nN = 4; S.G = C.G; S.c = (int)blockIdx.x;
        pg8::EpiDown e{}; e.O = YS; e.ldc = 1024; e.bias = args.in[24]; e.ncol = 1024;
        pg8::gemm_phase<pg8::EpiDown, pg8::GroupedOrder, true, true>(ring, g, S, e); }
    SEAM(10);
    if (IN(11)) { combine_pass(C, out, YS, dest, top_w); }
#undef IN
#undef SEAM
}

extern "C" void kernel_launch(void* const* d_in, const int* in_sizes, int n_in, void* d_out, int out_size, void* d_ws, size_t ws_size, hipStream_t stream) {
    static int grid = 0;
    if (grid == 0) {
        if (n_in != 25 || in_sizes[0] != T * DM || out_size != T * DM || ws_size < WS_END) { fprintf(stderr, "kernel_launch: unexpected shapes / workspace (n_in %d, ws %zu)\n", n_in, ws_size); grid = -1; return; }
        int dev = 0, cus = 0, per_cu = 0;
        if (hipGetDevice(&dev) != hipSuccess || hipDeviceGetAttribute(&cus, hipDeviceAttributeMultiprocessorCount, dev) != hipSuccess) { grid = -1; return; }
        if (hipFuncSetAttribute((const void*)mk_fwd, hipFuncAttributeMaxDynamicSharedMemorySize, LDS_BYTES) != hipSuccess) { fprintf(stderr, "kernel_launch: hipFuncSetAttribute failed\n"); grid = -1; return; }
        if (hipOccupancyMaxActiveBlocksPerMultiprocessor(&per_cu, (const void*)mk_fwd, 512, LDS_BYTES) != hipSuccess || per_cu < 1) { fprintf(stderr, "kernel_launch: occupancy query says %d workgroups per CU\n", per_cu); grid = -1; (void)hipGetLastError(); return; }
        grid = cus;
    }
    if (grid < 0) return;
    if (hipMemsetAsync((char*)d_ws + WS_CTL, 0, CTL_ZERO_BYTES, stream) != hipSuccess) return;
    Args a{};
    for (int i = 0; i < 25; ++i) a.in[i] = (const float*)d_in[i];
    a.out = (float*)d_out; a.ws = (unsigned char*)d_ws;
#if MK_PER_PHASE
    for (int p = 0; p < NPH; ++p) { a.ph_lo = p; a.ph_hi = p + 1; hipLaunchKernelGGL(mk_fwd, dim3(grid), dim3(512), LDS_BYTES, stream, a); }
#else
    a.ph_lo = 0; a.ph_hi = NPH; hipLaunchKernelGGL(mk_fwd, dim3(grid), dim3(512), LDS_BYTES, stream, a);
#endif
}
```

```cpp
#include <hip/hip_runtime.h>
#include <cstdio>
#include <cstdint>
#include <cmath>

constexpr int DM = 1024, BATCH = 8, SEQ = 4096, T = BATCH * SEQ;
constexpr int NG = 64, NP = 64, GCH = 16;
constexpr int HD = 64, NQH = 16, NKVH = 4, WIN = 128;
constexpr int IN_W = 4608;
constexpr int C_U = 0, C_Q = 1024, C_K = 2048, C_V = 2304, C_GS = 2560, C_GA = 3584;
constexpr int NE = 32, TOPK = 4, DFF = 1024, NA = T * TOPK;
constexpr int MAXROWS = NA + NE * 256;
constexpr int MAXMT = MAXROWS / 256;
constexpr float EPS = 1e-5f;

namespace pg8 {
#define PG8_LAS __attribute__((address_space(3)))
typedef unsigned short bf16_t;
typedef short bf16x8 __attribute__((ext_vector_type(8)));
typedef float f32x4 __attribute__((ext_vector_type(4)));
typedef unsigned u32x4 __attribute__((ext_vector_type(4)));
constexpr int BM = 256, BK = 64, HALF = 128, HTB = HALF * BK * 2  , STAGE_BYTES = 8 * HTB, NXCD = 8, WGM = 8;

__host__ __device__ __forceinline__ int lds_byte(int r, int c) { const int st = (r >> 4) * 2 + (c >> 5), rr = r & 15, cc = c & 31, ob = rr * 64 + cc * 2; return st * 1024 + (ob ^ (((ob >> 9) & 1) << 5)); }
__host__ __device__ __forceinline__ void stage_rc(int b, int& R, int& C) { const int st = b / 1024, sb = b % 1024, swz = sb ^ (((sb >> 9) & 1) << 5); R = (st >> 1) * 16 + swz / 64; C = (st & 1) * 32 + (swz % 64) / 2; }
__host__ __device__ __forceinline__ int perm32(int rho) { const int n = rho >> 4, i = rho & 15; return 8 * (i >> 2) + 4 * n + (i & 3); }

struct Unit { int pm, pn, e, pl, rows; };
struct Gemm { const bf16_t* A; const bf16_t* Bt; int M, N, K, pad; };

struct StaticOrder {
    static constexpr bool GATHER = false;
    int nM, nN, nwg, G, c;
    __host__ __device__ void init(int M, int N, int G_, int c_) { nM = M / BM; nN = N / BM; nwg = nM * nN; G = G_; c = c_; }
    __host__ __device__ bool next(int i, Unit& u) const {
        const long L = (long)i * G + c; if (L >= nwg) return false;
        int wgid = (int)L; { const int q = nwg / NXCD, r = nwg % NXCD, xcd = wgid % NXCD, off = wgid / NXCD; wgid = (xcd < r ? xcd * (q + 1) : r * (q + 1) + (xcd - r) * q) + off; }
        const int nig = WGM * nN, gid = wgid / nig, fm = gid * WGM, gsz = (nM - fm) < WGM ? (nM - fm) : WGM;
        u.pm = fm + ((wgid % nig) % gsz); u.pn = (wgid % nig) / gsz; u.e = 0; u.pl = u.pn; u.rows = BM; return true;
    }
    __device__ __forceinline__ void a_ready(const Unit&) const {}
    __device__ __forceinline__ void done(const Unit&) const {}
};


__device__ __forceinline__ unsigned cvt_pk_bf16(float lo, float hi) { unsigned r; asm volatile("v_cvt_pk_bf16_f32 %0, %1, %2" : "=v"(r) : "v"(lo), "v"(hi)); return r; }
__device__ __forceinline__ float bf_lo(unsigned w) { return __uint_as_float(w << 16); }
__device__ __forceinline__ float bf_hi(unsigned w) { return __uint_as_float(w & 0xffff0000u); }
__device__ __forceinline__ float sigm(float x) { return 1.f / (1.f + __expf(-x)); }
__device__ __forceinline__ u32x4 pack8(const f32x4 v0, const f32x4 v1) { u32x4 w; w.x = cvt_pk_bf16(v0[0], v0[1]); w.y = cvt_pk_bf16(v0[2], v0[3]); w.z = cvt_pk_bf16(v1[0], v1[1]); w.w = cvt_pk_bf16(v1[2], v1[3]); return w; }
__device__ __forceinline__ void unpack8(const u32x4 w, f32x4& v0, f32x4& v1) { v0 = (f32x4){bf_lo(w.x), bf_hi(w.x), bf_lo(w.y), bf_hi(w.y)}; v1 = (f32x4){bf_lo(w.z), bf_hi(w.z), bf_lo(w.w), bf_hi(w.w)}; }

struct EpiProj {
    static constexpr bool PERM = true;
    bf16_t* O; const float* qg; const float* kg; int ldc; float qscale;
    __device__ __forceinline__ void operator()(f32x4 (&acc)[2][2][4][2], const Unit& u, int wr, int wc, int fr, int fq) const {
        const int row0 = u.pm * BM + wr * 64 + fr, col0 = u.pl * BM + wc * 64 + 8 * fq;
        if (u.pl >= 4 && u.pl <= 8) {
            const float* gp = (u.pl == 8 ? kg : qg) + 8 * fq; const float sc = (u.pl == 8) ? 1.f : qscale;
            f32x4 gv[2][2];
#pragma unroll
            for (int bj = 0; bj < 2; ++bj)
#pragma unroll
                for (int n = 0; n < 2; ++n) gv[bj][n] = *(const f32x4*)(gp + 32 * bj + 4 * n) * sc;
#pragma unroll
            for (int ai = 0; ai < 2; ++ai)
#pragma unroll
                for (int m = 0; m < 4; ++m) { float ss = 0.f;
#pragma unroll
                    for (int bj = 0; bj < 2; ++bj)
#pragma unroll
                        for (int n = 0; n < 2; ++n) { const f32x4 v = acc[ai][bj][m][n]; ss += (v[0] * v[0] + v[1] * v[1]) + (v[2] * v[2] + v[3] * v[3]); }
                    ss += __shfl_xor(ss, 16); ss += __shfl_xor(ss, 32);
                    const float rs = rsqrtf(ss * (1.f / 64.f) + 1e-5f);
#pragma unroll
                    for (int bj = 0; bj < 2; ++bj)
#pragma unroll
                        for (int n = 0; n < 2; ++n) acc[ai][bj][m][n] = acc[ai][bj][m][n] * rs * gv[bj][n]; }
        }
#pragma unroll
        for (int ai = 0; ai < 2; ++ai)
#pragma unroll
            for (int m = 0; m < 4; ++m) { bf16_t* rowp = O + (size_t)(row0 + ai * HALF + m * 16) * ldc + col0;
#pragma unroll
                for (int bj = 0; bj < 2; ++bj) *(u32x4*)(rowp + bj * 32) = pack8(acc[ai][bj][m][0], acc[ai][bj][m][1]); }
    }
};
struct EpiGlu {
    static constexpr bool PERM = true;
    bf16_t* O; int ldc, pad;
    __device__ __forceinline__ void operator()(f32x4 (&acc)[2][2][4][2], const Unit& u, int wr, int wc, int fr, int fq) const {
        const int row0 = u.pm * BM + wr * 64 + fr, col0 = u.pl * HALF + wc * 32 + 8 * fq;
#pragma unroll
        for (int ai = 0; ai < 2; ++ai)
#pragma unroll
            for (int m = 0; m < 4; ++m) { bf16_t* rowp = O + (size_t)(row0 + ai * HALF + m * 16) * ldc + col0;
                f32x4 o0, o1;
#pragma unroll
                for (int j = 0; j < 4; ++j) { o0[j] = acc[ai][0][m][0][j] * sigm(acc[ai][1][m][0][j]); o1[j] = acc[ai][0][m][1][j] * sigm(acc[ai][1][m][1][j]); }
                *(u32x4*)rowp = pack8(o0, o1); }
    }
};
template <bool ADD> struct EpiGate {
    static constexpr bool PERM = true;
    bf16_t* O; const bf16_t* G; int ldc, ldg, gcol, pad;
    __device__ __forceinline__ void operator()(f32x4 (&acc)[2][2][4][2], const Unit& u, int wr, int wc, int fr, int fq) const {
        const int row0 = u.pm * BM + wr * 64 + fr, col0 = u.pl * BM + wc * 64 + 8 * fq;
#pragma unroll
        for (int ai = 0; ai < 2; ++ai)
#pragma unroll
            for (int m = 0; m < 4; ++m) { const size_t r = (size_t)(row0 + ai * HALF + m * 16);
#pragma unroll
                for (int bj = 0; bj < 2; ++bj) {
                    const u32x4 gw = *(const u32x4*)(G + r * ldg + gcol + col0 + bj * 32);
                    f32x4 g0, g1; unpack8(gw, g0, g1);
                    f32x4 o0, o1;
#pragma unroll
                    for (int j = 0; j < 4; ++j) { o0[j] = sigm(g0[j]) * acc[ai][bj][m][0][j]; o1[j] = sigm(g1[j]) * acc[ai][bj][m][1][j]; }
                    bf16_t* p = O + r * ldc + col0 + bj * 32;
                    if (ADD) { const u32x4 ow = __builtin_nontemporal_load((const u32x4*)p); f32x4 p0, p1; unpack8(ow, p0, p1); o0 += p0; o1 += p1; }
                    *(u32x4*)p = pack8(o0, o1); } }
    }
};
struct EpiResid {
    static constexpr bool PERM = false;
    const float* base; float* out; int ldc, pad;
    __device__ __forceinline__ void operator()(f32x4 (&acc)[2][2][4][2], const Unit& u, int wr, int wc, int fr, int fq) const {
        const int row0 = u.pm * BM + wr * 64 + fr, col0 = u.pl * BM + wc * 64 + 4 * fq;
#pragma unroll
        for (int ai = 0; ai < 2; ++ai)
#pragma unroll
            for (int m = 0; m < 4; ++m) { const size_t off = (size_t)(row0 + ai * HALF + m * 16) * ldc + col0;
#pragma unroll
                for (int bj = 0; bj < 2; ++bj)
#pragma unroll
                    for (int n = 0; n < 2; ++n) { const f32x4 b = *(const f32x4*)(base + off + bj * 32 + n * 16); *(f32x4*)(out + off + bj * 32 + n * 16) = b + acc[ai][bj][m][n]; } }
    }
};
struct EpiSwiglu {
    static constexpr bool PERM = true;
    bf16_t* O; const float* bias; const int* list; int ldc, dff; float limit, alpha; int lstride, pad;
    __device__ __forceinline__ void operator()(f32x4 (&acc)[2][2][4][2], const Unit& u, int wr, int wc, int fr, int fq) const {
        const int col0 = u.pl * HALF + wc * 32 + 8 * fq;
        const float* bg = bias + (size_t)u.e * 2 * dff + col0; const float* bu = bg + dff;
        const f32x4 bg0 = *(const f32x4*)bg, bg1 = *(const f32x4*)(bg + 4), bu0 = *(const f32x4*)bu, bu1 = *(const f32x4*)(bu + 4);
        const int* lp = list + (size_t)u.e * lstride + u.pm * BM;
#pragma unroll
        for (int ai = 0; ai < 2; ++ai)
#pragma unroll
            for (int m = 0; m < 4; ++m) { const int r = ai * HALF + wr * 64 + m * 16 + fr;
                if (r < u.rows) { const int a = lp[r]; bf16_t* rowp = O + (size_t)a * ldc + col0;
                f32x4 o0, o1;
#pragma unroll
                for (int j = 0; j < 4; ++j) {
                    float gt = fminf(acc[ai][0][m][0][j] + bg0[j], limit), up = fminf(fmaxf(acc[ai][1][m][0][j] + bu0[j], -limit), limit);
                    o0[j] = (up + 1.f) * gt * sigm(alpha * gt);
                    gt = fminf(acc[ai][0][m][1][j] + bg1[j], limit); up = fminf(fmaxf(acc[ai][1][m][1][j] + bu1[j], -limit), limit);
                    o1[j] = (up + 1.f) * gt * sigm(alpha * gt); }
                *(u32x4*)rowp = pack8(o0, o1); } }
    }
};
struct EpiDown {
    static constexpr bool PERM = true;
    bf16_t* O; const float* bias; const int* list; int ldc, ncol, lstride, pad;
    __device__ __forceinline__ void operator()(f32x4 (&acc)[2][2][4][2], const Unit& u, int wr, int wc, int fr, int fq) const {
        const int col0 = u.pl * BM + wc * 64 + 8 * fq;
        const float* bp = bias + (size_t)u.e * ncol + col0;
        f32x4 bv[2][2];
#pragma unroll
        for (int bj = 0; bj < 2; ++bj) { bv[bj][0] = *(const f32x4*)(bp + bj * 32); bv[bj][1] = *(const f32x4*)(bp + bj * 32 + 4); }
        const int* lp = list + (size_t)u.e * lstride + u.pm * BM;
#pragma unroll
        for (int ai = 0; ai < 2; ++ai)
#pragma unroll
            for (int m = 0; m < 4; ++m) { const int r = ai * HALF + wr * 64 + m * 16 + fr;
                if (r < u.rows) { const int a = lp[r]; bf16_t* rowp = O + (size_t)a * ldc + col0;
#pragma unroll
                for (int bj = 0; bj < 2; ++bj) *(u32x4*)(rowp + bj * 32) = pack8(acc[ai][bj][m][0] + bv[bj][0], acc[ai][bj][m][1] + bv[bj][1]); } }
    }
};
struct GroupedOrder {
    static constexpr bool GATHER = true;
    const PG8_LAS unsigned char* tile_e; const PG8_LAS int* pref; const PG8_LAS int* cnt; const int* list; int nN, G, c, nM, lstride, ashift;
    __device__ __forceinline__ bool next(int i, Unit& u) const {
        const int nwg = nM * nN; const long L = (long)i * G + c; if (L >= nwg) return false;
        int wgid = (int)L; { const int q = nwg / NXCD, r = nwg % NXCD, xcd = wgid % NXCD, off = wgid / NXCD; wgid = (xcd < r ? xcd * (q + 1) : r * (q + 1) + (xcd - r) * q) + off; }
        const int nig = WGM * nN, gid = wgid / nig, fm = gid * WGM, gsz = (nM - fm) < WGM ? (nM - fm) : WGM;
        const int mt = fm + ((wgid % nig) % gsz), pl = (wgid % nig) / gsz;
        const int e = tile_e[mt]; const int mtl = mt - pref[e]; const int left = cnt[e] - 256 * mtl;
        u.pm = mtl; u.pn = e * nN + pl; u.e = e; u.pl = pl; u.rows = left < 256 ? left : 256; return true;
    }
    __device__ __forceinline__ int arow(const Unit& u, int r) const { const int rr = r < u.rows ? r : u.rows - 1; return list[(size_t)u.e * lstride + u.pm * BM + rr] >> ashift; }
    __device__ __forceinline__ void a_ready(const Unit&) const {}
    __device__ __forceinline__ void done(const Unit&) const {}
};
template <class Epi, class Sched, bool ALIGN_EPI = true>
__device__ __forceinline__ void gemm_phase(PG8_LAS unsigned char* lds, const Gemm g, const Sched& S, const Epi& E) {
    int tid = threadIdx.x; asm volatile("" : "+v"(tid));
    const int wid = __builtin_amdgcn_readfirstlane(tid >> 6), lane = tid & 63, wr = wid >> 2, wc = wid & 3, fr = lane & 15, fq = lane >> 4;
    const int K = g.K, nt = K / BK;
    constexpr bool GATHER = Sched::GATHER;
    int RA[2], CA[2]; unsigned voffA0[2], voffA1[2], voffB[2];
#pragma unroll
    for (int i = 0; i < 2; ++i) { int R, C; stage_rc(tid * 16 + i * 8192, R, C); RA[i] = R; CA[i] = C;
        const int Rb = 2 * (R & ~31) + (Epi::PERM ? perm32(R & 31) : (R & 31));
        voffB[i] = (unsigned)(Rb * K + C) * 2u; voffA0[i] = (unsigned)(R * K + C) * 2u; voffA1[i] = (unsigned)((R + HALF) * K + C) * 2u; }
    const size_t kstep = (size_t)(BK * 2);
    const size_t hstepB = (size_t)32 * K * 2;
    const size_t tstep = (size_t)BM * K * 2;
    const unsigned ldsw = (unsigned)wid * 1024u;
    const int aoff = lds_byte(wr * 64 + fr, fq * 8), boff = lds_byte(wc * 32 + fr, fq * 8);
#define PG8_SA(b, h) (((b) * 2 + (h)) * HTB)
#define PG8_SB(b, h) ((4 + (b) * 2 + (h)) * HTB)
#define PG8_STAGE(bufoff, gbase, voff) do { _Pragma("unroll") for (int _i = 0; _i < 2; ++_i) \
        __builtin_amdgcn_global_load_lds((const unsigned*)((const char*)(gbase) + (voff)[_i]), (PG8_LAS unsigned*)(lds + (bufoff) + ldsw + _i * 8192), 16, 0, 0); } while (0)
#define PG8_LDA(dst, b, h) do { _Pragma("unroll") for (int m = 0; m < 4; ++m) _Pragma("unroll") for (int k = 0; k < 2; ++k) dst[m][k] = *(const PG8_LAS bf16x8*)(lds + PG8_SA(b, h) + aoff + m * 2048 + k * 1024); } while (0)
#define PG8_LDB(dst, b, h) do { _Pragma("unroll") for (int n = 0; n < 2; ++n) _Pragma("unroll") for (int k = 0; k < 2; ++k) dst[n][k] = *(const PG8_LAS bf16x8*)(lds + PG8_SB(b, h) + boff + n * 2048 + k * 1024); } while (0)
#define PG8_MMA(ai, bj, At, Bt) do { __builtin_amdgcn_s_setprio(1); _Pragma("unroll") for (int m = 0; m < 4; ++m) _Pragma("unroll") for (int n = 0; n < 2; ++n) _Pragma("unroll") for (int k = 0; k < 2; ++k) \
        acc[ai][bj][m][n] = __builtin_amdgcn_mfma_f32_16x16x32_bf16(Bt[n][k], At[m][k], acc[ai][bj][m][n], 0, 0, 0); __builtin_amdgcn_s_setprio(0); } while (0)
#define PG8_WAIT_V(n) asm volatile("s_waitcnt vmcnt(" #n ")" ::: "memory")
#define PG8_WAIT_L(n) asm volatile("s_waitcnt lgkmcnt(" #n ")" ::: "memory")
#define PG8_BAR __builtin_amdgcn_s_barrier()
#define PG8_SCHED __builtin_amdgcn_sched_barrier(0)
    Unit cur, nxt; int ui = 0;
    if (!S.next(0, cur)) return;
    f32x4 acc[2][2][4][2];
#pragma unroll
    for (int a = 0; a < 2; ++a)
#pragma unroll
        for (int b = 0; b < 2; ++b)
#pragma unroll
            for (int m = 0; m < 4; ++m)
#pragma unroll
                for (int n = 0; n < 2; ++n) acc[a][b][m][n] = (f32x4){0.f, 0.f, 0.f, 0.f};
    bf16x8 At[4][2], B0[2][2], B1[2][2];
    if constexpr (GATHER) {
#pragma unroll
        for (int i = 0; i < 2; ++i) { voffA0[i] = (unsigned)S.arow(cur, RA[i]) * (unsigned)(K * 2) + (unsigned)(CA[i] * 2); voffA1[i] = (unsigned)S.arow(cur, HALF + RA[i]) * (unsigned)(K * 2) + (unsigned)(CA[i] * 2); } }
    const char* cA = GATHER ? (const char*)g.A : (const char*)g.A + (size_t)cur.pm * tstep; const char* cB = (const char*)g.Bt + (size_t)cur.pn * tstep;
    S.a_ready(cur);
    PG8_STAGE(PG8_SB(0, 0), cB, voffB); PG8_STAGE(PG8_SB(0, 1), cB + hstepB, voffB); PG8_STAGE(PG8_SA(0, 0), cA, voffA0); PG8_STAGE(PG8_SA(0, 1), cA, voffA1);
    if (wr == 1) PG8_BAR;
    PG8_WAIT_V(2); PG8_BAR;
    PG8_STAGE(PG8_SB(1, 0), cB + kstep, voffB); PG8_STAGE(PG8_SA(1, 0), cA + kstep, voffA0); PG8_STAGE(PG8_SB(1, 1), cB + hstepB + kstep, voffB);
    PG8_WAIT_V(6); PG8_BAR;
    for (;;) {
        const bool has_next = S.next(ui + 1, nxt);
        const char* nA = GATHER ? cA : (has_next ? (const char*)g.A + (size_t)nxt.pm * tstep : cA); const char* nB = has_next ? (const char*)g.Bt + (size_t)nxt.pn * tstep : cB;
        unsigned nvA0[2], nvA1[2];
#pragma unroll
        for (int i = 0; i < 2; ++i) { nvA0[i] = voffA0[i]; nvA1[i] = voffA1[i]; }
        if constexpr (GATHER) { if (has_next) {
#pragma unroll
            for (int i = 0; i < 2; ++i) { nvA0[i] = (unsigned)S.arow(nxt, RA[i]) * (unsigned)(K * 2) + (unsigned)(CA[i] * 2); nvA1[i] = (unsigned)S.arow(nxt, HALF + RA[i]) * (unsigned)(K * 2) + (unsigned)(CA[i] * 2); } } }
        for (int t = 0; t < nt; t += 2) {
            const bool last = (t == nt - 2);
            const char* a1 = cA + (size_t)(t + 1) * kstep;
            const char* a2 = last ? nA : cA + (size_t)(t + 2) * kstep; const char* b2 = last ? nB : cB + (size_t)(t + 2) * kstep;
            const char* a3 = a2 + kstep; const char* b3 = b2 + kstep;
            if (last && has_next) S.a_ready(nxt);
            PG8_LDB(B0, 0, 0); PG8_LDB(B1, 0, 1); PG8_SCHED; PG8_LDA(At, 0, 0); PG8_STAGE(PG8_SA(1, 1), a1, voffA1);
            if constexpr (GATHER) { if (last) {
#pragma unroll
                for (int i = 0; i < 2; ++i) { voffA0[i] = nvA0[i]; voffA1[i] = nvA1[i]; } } }
            PG8_WAIT_V(8); PG8_WAIT_L(0); PG8_BAR; PG8_MMA(0, 0, At, B0); PG8_MMA(0, 1, At, B1); PG8_BAR; PG8_SCHED;
            PG8_LDA(At, 0, 1); PG8_STAGE(PG8_SB(0, 0), b2, voffB); PG8_STAGE(PG8_SB(0, 1), b2 + hstepB, voffB); PG8_STAGE(PG8_SA(0, 0), a2, voffA0);
            PG8_WAIT_V(8); PG8_WAIT_L(0); PG8_BAR; PG8_MMA(1, 0, At, B0); PG8_MMA(1, 1, At, B1); PG8_BAR; PG8_SCHED;
            PG8_LDB(B0, 1, 0); PG8_LDB(B1, 1, 1); PG8_SCHED; PG8_LDA(At, 1, 0); PG8_STAGE(PG8_SA(0, 1), a2, voffA1);
            PG8_WAIT_V(8); PG8_WAIT_L(0); PG8_BAR; PG8_MMA(0, 0, At, B0); PG8_MMA(0, 1, At, B1); PG8_BAR; PG8_SCHED;
            PG8_LDA(At, 1, 1); PG8_STAGE(PG8_SB(1, 0), b3, voffB); PG8_STAGE(PG8_SB(1, 1), b3 + hstepB, voffB); PG8_STAGE(PG8_SA(1, 0), a3, voffA0);
            PG8_WAIT_V(8); PG8_WAIT_L(0); PG8_BAR; PG8_MMA(1, 0, At, B0); PG8_MMA(1, 1, At, B1); PG8_BAR; PG8_SCHED;
        }
        if constexpr (ALIGN_EPI) { if (wr == 0) PG8_BAR; }
        E(acc, cur, wr, wc, fr, fq); S.done(cur);
        if (!has_next) break;
#pragma unroll
        for (int a = 0; a < 2; ++a)
#pragma unroll
            for (int b = 0; b < 2; ++b)
#pragma unroll
                for (int m = 0; m < 4; ++m)
#pragma unroll
                    for (int n = 0; n < 2; ++n) acc[a][b][m][n] = (f32x4){0.f, 0.f, 0.f, 0.f};
        cur = nxt; cA = nA; cB = nB; ++ui;
        if constexpr (ALIGN_EPI) { if (wr == 1) PG8_BAR; }
    }
    PG8_WAIT_V(0);
    if constexpr (!ALIGN_EPI) { if (wr == 0) PG8_BAR; }
    PG8_BAR;
#undef PG8_SA
#undef PG8_SB
#undef PG8_STAGE
#undef PG8_LDA
#undef PG8_LDB
#undef PG8_MMA
#undef PG8_WAIT_V
#undef PG8_WAIT_L
#undef PG8_BAR
#undef PG8_SCHED
}
}

#define GAS __attribute__((address_space(1)))
#define LAS __attribute__((address_space(3)))
typedef unsigned short bf16;
typedef unsigned v4u __attribute__((ext_vector_type(4)));
typedef float f32x4 __attribute__((ext_vector_type(4)));
typedef short bf16x8 __attribute__((ext_vector_type(8)));
typedef GAS unsigned gu32;
typedef GAS unsigned long long gu64;
#define RLX_AGENT __ATOMIC_RELAXED, __HIP_MEMORY_SCOPE_AGENT
#define LDS_WAIT() asm volatile("s_waitcnt lgkmcnt(0)" ::: "memory")
#define VM_WAIT() asm volatile("s_waitcnt vmcnt(0)" ::: "memory")
__device__ __forceinline__ unsigned long long rt() { return __builtin_amdgcn_s_memrealtime(); }
__device__ __forceinline__ unsigned f2bf(float f) { unsigned u = __builtin_bit_cast(unsigned, f); return (u + 0x7fffu + ((u >> 16) & 1u)) >> 16; }
__device__ __forceinline__ unsigned pk2(float lo, float hi) { return f2bf(lo) | (f2bf(hi) << 16); }

#define XB_TMO      128
#define XB_XCNT(j)  (256  + 64 * (j))
#define XB_XSUB(j)  (1280 + 64 * (j))
#define XB_XGEN(j)  (2304 + 64 * (j))
#define XB_TOP      3328
#define XB_TOPGEN   3392
#define XCD_BAR_WORDS 3456
#define XB_SPIN_CAP (1u << 18)

__device__ __forceinline__ unsigned xb_ld(unsigned* p)              { return __hip_atomic_load(p, __ATOMIC_RELAXED, __HIP_MEMORY_SCOPE_AGENT); }
__device__ __forceinline__ unsigned xb_add(unsigned* p, unsigned v) { return __hip_atomic_fetch_add(p, v, __ATOMIC_RELAXED, __HIP_MEMORY_SCOPE_AGENT); }
__device__ __forceinline__ unsigned xb_xcc_id() { return (unsigned)__builtin_amdgcn_s_getreg((3 << 11) | 20) & 0xFu; }
#define XB_SPIN(cond, bar) do { unsigned _sp = 0; while (cond) { __builtin_amdgcn_s_sleep(1); \
    if ((++_sp & 255u) == 0u) { if (xb_ld(&(bar)[XB_TMO])) break; if (_sp > XB_SPIN_CAP) { atomicAdd(&(bar)[XB_TMO], 1u); break; } } } } while (0)

struct XcdBarrier {
    unsigned* bar; unsigned x;
    volatile LAS unsigned* st;
};

__device__ __forceinline__ XcdBarrier xcd_barrier_post(unsigned* bar, volatile LAS unsigned* st) {
    XcdBarrier b; b.bar = bar; b.x = xb_xcc_id(); b.st = st;
    if (threadIdx.x == 0) (void)xb_add(&bar[XB_XCNT(b.x)], 1u);
    return b;
}
__device__ __forceinline__ void xcd_barrier_complete(unsigned* bar, unsigned x, unsigned& nloc, unsigned& nx) {
    const unsigned G = gridDim.x * gridDim.y * gridDim.z;
    unsigned sum, cnt, mine, sp = 0u;
    for (;;) {
        sum = 0u; cnt = 0u; mine = 0u;
#pragma unroll
        for (unsigned j = 0; j < 16; ++j) { const unsigned c = xb_ld(&bar[XB_XCNT(j)]); sum += c; cnt += (c > 0u) ? 1u : 0u; mine = (j == x) ? c : mine; }
        if (sum == G) break;
        __builtin_amdgcn_s_sleep(1);
        if ((++sp & 255u) == 0u) { if (xb_ld(&bar[XB_TMO])) break; if (sp > XB_SPIN_CAP) { atomicAdd(&bar[XB_TMO], 1u); break; } }
    }
    nloc = mine > 0u ? mine : 1u; nx = cnt > 0u ? cnt : 1u;
}

__device__ __forceinline__ void xcd_barrier(const XcdBarrier& b) {
    asm volatile("s_waitcnt vmcnt(0)" ::: "memory");
    __syncthreads();
    if (threadIdx.x == 0) {
        unsigned* bar = b.bar;
        __builtin_amdgcn_s_waitcnt(0);
        unsigned nloc = b.st[0], nx = b.st[1];
        if (nloc == 0u) { xcd_barrier_complete(bar, b.x, nloc, nx); b.st[0] = nloc; b.st[1] = nx; }
        const unsigned old = xb_add(&bar[XB_XSUB(b.x)], 1u);
        const unsigned gen = old / nloc;
        if (old + 1u == (gen + 1u) * nloc) {
            __builtin_amdgcn_fence(__ATOMIC_RELEASE, "agent");
            asm volatile("s_waitcnt vmcnt(0)" ::: "memory");
            const unsigned og = xb_add(&bar[XB_TOP], 1u);
            const unsigned tg = og / nx;
            if (og + 1u == (tg + 1u) * nx) xb_add(&bar[XB_TOPGEN], 1u);
            else XB_SPIN(xb_ld(&bar[XB_TOPGEN]) == tg, bar);
            __builtin_amdgcn_fence(__ATOMIC_ACQUIRE, "agent");
            xb_add(&bar[XB_XGEN(b.x)], 1u);
            asm volatile("s_waitcnt vmcnt(0)" ::: "memory");
        } else {
            XB_SPIN(xb_ld(&bar[XB_XGEN(b.x)]) == gen, bar);
            __builtin_amdgcn_fence(__ATOMIC_ACQUIRE, "agent");
            asm volatile("s_waitcnt vmcnt(0)" ::: "memory");
        }
    }
    __syncthreads();
}

constexpr size_t MiB = 1u << 20;
constexpr size_t WS_CTL = 0;
constexpr size_t CTL_ZERO_BYTES = 65536;
constexpr size_t WS_WIN = 1 * MiB, WS_WGLU = 10 * MiB, WS_WSSM = 14 * MiB, WS_WATT = 16 * MiB, WS_WOUT = 18 * MiB;
constexpr size_t WS_WGU = 20 * MiB, WS_WDN = 148 * MiB;
constexpr size_t WS_ROUTE = 216 * MiB;
constexpr size_t WS_H = 224 * MiB;
constexpr size_t WS_PROJ = 288 * MiB;
constexpr size_t WS_S5OUT = 576 * MiB;
constexpr size_t WS_ATTN = 640 * MiB;
constexpr size_t WS_ACT = 704 * MiB;
constexpr size_t WS_BTAB = 976 * MiB, WS_CTAB = 980 * MiB, WS_KTAB = 984 * MiB, WS_A16 = 985 * MiB;
constexpr size_t WS_END = 986 * MiB;
static_assert(WS_PROJ + (size_t)T * IN_W * 2 <= WS_S5OUT && WS_PROJ + (size_t)NA * 1024 * 2 <= WS_S5OUT && WS_ACT + (size_t)NA * 1024 * 2 <= WS_BTAB, "ws map");
constexpr int CW_CNT = 0;
constexpr int CW_BAR = 4096;
static_assert((CW_BAR + 3 * XCD_BAR_WORDS) * 4 <= (int)CTL_ZERO_BYTES, "ctl map");
constexpr size_t RT_TOPW = 0, RT_LIST = 1 * MiB;

constexpr int LDS_BYTES = 163840;
constexpr int RING_OFF = 0;
constexpr int MISC_OFF = LDS_BYTES - 256;
constexpr int GT_OFF = 131072;

__device__ __forceinline__ float bf2f(bf16 b) { return __uint_as_float((unsigned)b << 16); }
__device__ __forceinline__ float wave_sum(float v) {
#pragma unroll
    for (int o = 1; o < 64; o <<= 1) v += __shfl_xor(v, o);
    return v;
}
__device__ __forceinline__ float wave_max(float v) {
#pragma unroll
    for (int o = 1; o < 64; o <<= 1) v = fmaxf(v, __shfl_xor(v, o));
    return v;
}
__device__ __forceinline__ float gelu_tanh(float x) { const float z = 1.5957691216f * (x + 0.044715f * x * x * x); return x / (1.f + __expf(-z)); }
#define WAVE_SYNC() do { __builtin_amdgcn_wave_barrier(); asm volatile("s_waitcnt lgkmcnt(0)" ::: "memory"); } while (0)

struct Args { const float* in[25]; float* out; unsigned char* ws; int ph_lo, ph_hi, bar_idx, pad; };
struct Ctx { int tid, lane, wave, vcu, G, gw, ngw; LAS unsigned char* lds; };

__device__ __forceinline__ void transpose_item(const float* W, int K, int N, bf16* WT, int mode, LAS float* scr, int item, int lane) {
    const int nblk = N / 32, kb = item / nblk, nb = item % nblk, k0 = 64 * kb, n0 = 32 * nb;
#pragma unroll 8
    for (int i = 0; i < 32; ++i) { const int kk = 2 * i + (lane >> 5); scr[kk * 33 + (lane & 31)] = W[(size_t)(k0 + kk) * N + n0 + (lane & 31)]; }
    LDS_WAIT(); asm volatile("" ::: "memory");
    int r0 = n0;
    if (mode == 1) { const int nh = N / 2, hf = (n0 >= nh) ? 1 : 0, np = n0 - hf * nh; r0 = 256 * (np / 128) + 64 * ((np % 128) / 32) + 32 * hf; }
    const int c = lane & 7;
#pragma unroll
    for (int j = 0; j < 4; ++j) { const int n = (lane >> 3) + 8 * j; const LAS float* s = scr + (8 * c) * 33 + n;
        v4u o; o.x = pk2(s[0 * 33], s[1 * 33]); o.y = pk2(s[2 * 33], s[3 * 33]); o.z = pk2(s[4 * 33], s[5 * 33]); o.w = pk2(s[6 * 33], s[7 * 33]);
        *(v4u*)(WT + (size_t)(r0 + n) * K + k0 + 8 * c) = o; }
    LDS_WAIT(); asm volatile("" ::: "memory");
}
__device__ __forceinline__ void transpose_job(const Ctx& C, const float* W, bf16* WT, int K, int N, int mode, int nmat) {
    LAS float* scr = (LAS float*)(C.lds + RING_OFF + C.wave * 16384);
    const int per = (K / 64) * (N / 32); const int total = per * nmat;
    for (int it = C.gw; it < total; it += C.ngw) { const int mat = it / per, item = it % per;
        transpose_item(W + (size_t)mat * K * N, K, N, WT + (size_t)mat * K * N, mode, scr, item, C.lane); }
}
__device__ __forceinline__ void rmsnorm_rows(const Ctx& C, const float* x, const float* g, bf16* out) {
    for (int m = C.gw; m < T; m += C.ngw) {
        const f32x4* xr = (const f32x4*)(x + (size_t)m * DM) + C.lane; f32x4 v[4]; float s = 0.f;
#pragma unroll
        for (int j = 0; j < 4; ++j) { v[j] = xr[64 * j]; s += (v[j].x * v[j].x + v[j].y * v[j].y) + (v[j].z * v[j].z + v[j].w * v[j].w); }
        const float rs = rsqrtf(wave_sum(s) * (1.f / DM) + EPS);
        unsigned long long* o8 = (unsigned long long*)(out + (size_t)m * DM) + C.lane;
#pragma unroll
        for (int j = 0; j < 4; ++j) { const f32x4 gg = ((const f32x4*)g)[64 * j + C.lane];
            o8[64 * j] = (unsigned long long)pk2(v[j].x * rs * gg.x, v[j].y * rs * gg.y) | ((unsigned long long)pk2(v[j].z * rs * gg.z, v[j].w * rs * gg.w) << 32); }
    }
}
__device__ __forceinline__ void router_pass(const Ctx& C, const float* x1, const float* g2, const float* w_router, const float* b_router, bf16* h2, float* top_w, int* list, unsigned* ctl) {
    LAS float* HN = (LAS float*)(C.lds + RING_OFF); LAS float* PART = HN + 16 * 1024; LAS unsigned* HIST = (LAS unsigned*)(PART + 8 * 2 * 16 * 32); LAS unsigned* BASE = HIST + 32; LAS unsigned* RK = BASE + 32;
    LAS unsigned char* EIDS = (LAS unsigned char*)(RK + 32);
    int tid = C.tid; asm volatile("" : "+v"(tid));
    const int lane = tid & 63, wave = C.wave, e = lane & 31, dh = lane >> 5;
    float wreg[64];
#pragma unroll
    for (int i = 0; i < 64; ++i) wreg[i] = w_router[(size_t)(128 * wave + 64 * dh + i) * NE + e];
    const float bias = b_router[e];
    if (tid < 32) HIST[tid] = 0u;
    __syncthreads();
    int nrounds = 0;
    for (int grp = C.vcu; grp < T / 16; grp += C.G, ++nrounds) {
        f32x4 v[2][4];
#pragma unroll
        for (int q = 0; q < 2; ++q) { const f32x4* xr = (const f32x4*)(x1 + (size_t)(grp * 16 + 2 * wave + q) * DM) + lane;
#pragma unroll
            for (int j = 0; j < 4; ++j) v[q][j] = xr[64 * j]; }
#pragma unroll
        for (int q = 0; q < 2; ++q) { const int tl = 2 * wave + q; float s = 0.f;
#pragma unroll
            for (int j = 0; j < 4; ++j) s += (v[q][j].x * v[q][j].x + v[q][j].y * v[q][j].y) + (v[q][j].z * v[q][j].z + v[q][j].w * v[q][j].w);
            const float rs = rsqrtf(wave_sum(s) * (1.f / DM) + EPS);
            unsigned long long* o8 = (unsigned long long*)(h2 + (size_t)(grp * 16 + tl) * DM) + lane;
#pragma unroll
            for (int j = 0; j < 4; ++j) { const f32x4 gg = ((const f32x4*)g2)[64 * j + lane];
                const f32x4 y = (f32x4){v[q][j].x * rs * gg.x, v[q][j].y * rs * gg.y, v[q][j].z * rs * gg.z, v[q][j].w * rs * gg.w};
                *(LAS f32x4*)(HN + tl * 1024 + 256 * j + 4 * lane) = y;
                o8[64 * j] = (unsigned long long)pk2(y.x, y.y) | ((unsigned long long)pk2(y.z, y.w) << 32); } }
        __syncthreads();
        const LAS float* hb = HN + 128 * wave + 64 * dh;
#pragma unroll 1
        for (int t = 0; t < 16; t += 4) { float a0 = 0.f, a1 = 0.f, a2 = 0.f, a3 = 0.f;
#pragma unroll
            for (int i4 = 0; i4 < 16; ++i4) {
                const f32x4 h0 = *(const LAS f32x4*)(hb + (t + 0) * 1024 + 4 * i4), h1 = *(const LAS f32x4*)(hb + (t + 1) * 1024 + 4 * i4), h2v = *(const LAS f32x4*)(hb + (t + 2) * 1024 + 4 * i4), h3 = *(const LAS f32x4*)(hb + (t + 3) * 1024 + 4 * i4);
                a0 += h0.x * wreg[4 * i4] + h0.y * wreg[4 * i4 + 1] + h0.z * wreg[4 * i4 + 2] + h0.w * wreg[4 * i4 + 3];
                a1 += h1.x * wreg[4 * i4] + h1.y * wreg[4 * i4 + 1] + h1.z * wreg[4 * i4 + 2] + h1.w * wreg[4 * i4 + 3];
                a2 += h2v.x * wreg[4 * i4] + h2v.y * wreg[4 * i4 + 1] + h2v.z * wreg[4 * i4 + 2] + h2v.w * wreg[4 * i4 + 3];
                a3 += h3.x * wreg[4 * i4] + h3.y * wreg[4 * i4 + 1] + h3.z * wreg[4 * i4 + 2] + h3.w * wreg[4 * i4 + 3]; }
            LAS float* pp = PART + ((wave * 2 + dh) * 16 + t) * 32 + e; pp[0] = a0; pp[32] = a1; pp[64] = a2; pp[96] = a3; }
        __syncthreads();
#pragma unroll 1
        for (int q = 0; q < 2; ++q) { const int tl = 2 * wave + q; float acc = 0.f;
#pragma unroll
            for (int w8 = 0; w8 < 8; ++w8) acc += PART[((4 * dh * 2 + w8) * 16 + tl) * 32 + e];
            acc += __shfl_xor(acc, 32);
            float logit = acc + bias;
            float tv[4]; int ti[4];
#pragma unroll
            for (int k = 0; k < 4; ++k) { const float mx = wave_max(logit); const unsigned long long bal = __ballot(logit == mx); const int idx = (__ffsll((long long)bal) - 1) & 31;
                tv[k] = mx; ti[k] = idx; if (e == idx) logit = -INFINITY; }
            const float e1 = __expf(tv[1] - tv[0]), e2 = __expf(tv[2] - tv[0]), e3 = __expf(tv[3] - tv[0]); const float inv = 1.f / (1.f + e1 + e2 + e3);
            if (lane < 4) { const int k = lane; const int ei = k == 0 ? ti[0] : k == 1 ? ti[1] : k == 2 ? ti[2] : ti[3]; const float wv = (k == 0 ? 1.f : k == 1 ? e1 : k == 2 ? e2 : e3) * inv;
                top_w[(size_t)(grp * 16 + tl) * 4 + k] = wv; EIDS[(nrounds * 16 + tl) * 4 + k] = (unsigned char)ei;
                __hip_atomic_fetch_add(HIST + ei, 1u, __ATOMIC_RELAXED, __HIP_MEMORY_SCOPE_WORKGROUP); } }
    }
    __syncthreads();
    if (tid < 32) { BASE[tid] = atomicAdd(ctl + CW_CNT + tid, HIST[tid]); RK[tid] = 0u; }
    __syncthreads();
    for (int idx = tid; idx < nrounds * 64; idx += 512) { const int ei = EIDS[idx]; const unsigned rank = __hip_atomic_fetch_add(RK + ei, 1u, __ATOMIC_RELAXED, __HIP_MEMORY_SCOPE_WORKGROUP);
        const int r = idx >> 6, tl = (idx >> 2) & 15, k = idx & 3; list[(size_t)ei * T + BASE[ei] + rank] = ((C.vcu + r * C.G) * 16 + tl) * 4 + k; }
    __syncthreads();
}
__device__ __forceinline__ int grouped_tables(const Ctx& C, const unsigned* ctl) {
    LAS int* cnt = (LAS int*)(C.lds + GT_OFF); LAS int* pref = cnt + 32; LAS unsigned char* tile_e = (LAS unsigned char*)(pref + 36);
    if (C.tid == 0) { int run = 0;
        for (int e = 0; e < NE; ++e) { const int c = (int)__hip_atomic_load(ctl + CW_CNT + e, RLX_AGENT); cnt[e] = c; pref[e] = run; const int n = (c + 255) >> 8; for (int i = 0; i < n; ++i) tile_e[run + i] = (unsigned char)e; run += n; }
        pref[NE] = run; }
    __syncthreads();
    return pref[NE];
}
__device__ __forceinline__ void combine_pass(const Ctx& C, float* out, const bf16* ys, const float* top_w) {
    const int lane = C.lane;
    for (int tok = C.gw; tok < T; tok += C.ngw) {
        f32x4* o = (f32x4*)(out + (size_t)tok * DM);
        f32x4 acc[4];
#pragma unroll
        for (int j = 0; j < 4; ++j) acc[j] = o[64 * j + lane];
        const f32x4 wv4 = *(const f32x4*)(top_w + (size_t)tok * 4);
#pragma unroll
        for (int k = 0; k < 4; ++k) { const float wv = wv4[k]; const unsigned long long* y8 = (const unsigned long long*)(ys + ((size_t)tok * 4 + k) * DM);
#pragma unroll
            for (int j = 0; j < 4; ++j) { const unsigned long long q = y8[64 * j + lane]; const unsigned lo = (unsigned)q, hi = (unsigned)(q >> 32);
                acc[j].x += wv * __uint_as_float(lo << 16); acc[j].y += wv * __uint_as_float(lo & 0xffff0000u); acc[j].z += wv * __uint_as_float(hi << 16); acc[j].w += wv * __uint_as_float(hi & 0xffff0000u); } }
#pragma unroll
        for (int j = 0; j < 4; ++j) o[64 * j + lane] = acc[j];
    }
}

namespace att {
using bf16x8 = __attribute__((ext_vector_type(8))) short;
using s16x4 = __attribute__((ext_vector_type(4))) short;
using f32x16 = __attribute__((ext_vector_type(16))) float;
using u32x4 = __attribute__((ext_vector_type(4))) unsigned;
typedef float f32x2_t __attribute__((ext_vector_type(2))); typedef __bf16 bf16x2_t __attribute__((ext_vector_type(2)));
constexpr float LOG2E = 1.4426950408889634f, QSCALE = 0.125f * LOG2E;
constexpr int SLOTB = 8192, NSLOT = 4;
constexpr int L_K = 0, L_V = NSLOT * SLOTB, L_WS = 2 * NSLOT * SLOTB, L_OST = L_WS + 8 * 256, L_BYTES = L_OST + 8 * 4096;
__device__ __forceinline__ int crow(int r, int hi) { return (r & 3) + 8 * (r >> 2) + 4 * hi; }
__device__ __forceinline__ void glds16(const void* gsrc, unsigned lds_dst) { unsigned keep;
    asm volatile("s_mov_b32 %0, m0\n\ts_mov_b32 m0, %2\n\ts_nop 0\n\tglobal_load_lds_dwordx4 %1, off\n\ts_mov_b32 m0, %0" : "=&s"(keep) : "v"(gsrc), "s"(lds_dst) : "memory"); }
__device__ __forceinline__ unsigned cvtpk_s(float lo, float hi) { f32x2_t v = {lo, hi}; bf16x2_t b = __builtin_convertvector(v, bf16x2_t); return __builtin_bit_cast(unsigned, b); }
typedef __attribute__((address_space(3))) const char* lds_cptr;
__device__ __forceinline__ void qkt_half(f32x16& p, lds_cptr kb, const bf16x8* qr) {
    const f32x16 z = f32x16{};
#pragma unroll
    for (int d0 = 0; d0 < 4; ++d0) {
        const bf16x8 b0 = *(const __attribute__((address_space(3))) bf16x8*)(kb + d0 * 2048);
        p = __builtin_amdgcn_mfma_f32_32x32x16_bf16(b0, qr[d0], d0 == 0 ? z : p, 0, 0, 0); }
}
__device__ __forceinline__ void pv_half(f32x16* o, int vb, bf16x8 pa0, bf16x8 pa1) {
#pragma unroll
    for (int d0 = 0; d0 < 2; ++d0) { s16x4 lo[2], hi[2];
#pragma unroll
        for (int ks = 0; ks < 2; ++ks) {
            asm volatile("ds_read_b64_tr_b16 %0,%1 offset:%c2" : "=&v"(lo[ks]) : "v"(vb), "i"(d0 * 4096 + ks * 1024) : "memory");
            asm volatile("ds_read_b64_tr_b16 %0,%1 offset:%c2" : "=&v"(hi[ks]) : "v"(vb), "i"(d0 * 4096 + ks * 1024 + 512) : "memory"); }
        asm volatile("s_waitcnt lgkmcnt(0)" ::: "memory"); __builtin_amdgcn_sched_barrier(0);
#define ATT_PK(k) (bf16x8){lo[k][0], lo[k][1], lo[k][2], lo[k][3], hi[k][0], hi[k][1], hi[k][2], hi[k][3]}
        o[d0] = __builtin_amdgcn_mfma_f32_32x32x16_bf16(pa0, ATT_PK(0), o[d0], 0, 0, 0);
        o[d0] = __builtin_amdgcn_mfma_f32_32x32x16_bf16(pa1, ATT_PK(1), o[d0], 0, 0, 0);
#undef ATT_PK
    }
}
__device__ __forceinline__ void dma_tile(const bf16* proj, int b, int kvh, int ti, unsigned lds0, int wid, int lane) {
    const unsigned slot = (unsigned)((ti + 2) & 3) * SLOTB;
    int kr = 64 * ti + lane; kr = kr < 0 ? 0 : kr;
    int vr = 64 * ti + 16 * (wid & 3) + (lane >> 2); vr = vr < 0 ? 0 : vr;
    const bf16* ksrc = proj + (size_t)(b * SEQ + kr) * IN_W + C_K + kvh * 64 + wid * 8;
    const bf16* vsrc = proj + (size_t)(b * SEQ + vr) * IN_W + C_V + kvh * 64 + (wid >> 2) * 32 + (lane & 3) * 8;
    glds16(ksrc, (unsigned)__builtin_amdgcn_readfirstlane(lds0 + L_K + slot + wid * 1024));
    glds16(vsrc, (unsigned)__builtin_amdgcn_readfirstlane(lds0 + L_V + slot + wid * 1024));
}
#define ATT_WAIT_BAR() asm volatile("s_waitcnt vmcnt(0) lgkmcnt(0)\n\ts_barrier" ::: "memory")
__device__ __forceinline__ void attn_run(int b, int kvh, int qb0, int nqb, const bf16* proj, const float* sinks, bf16* O, LAS unsigned char* shm) {
    const int tid = threadIdx.x, lane = tid & 63, r32 = lane & 31, hi = lane >> 5; const int wid = __builtin_amdgcn_readfirstlane(tid >> 6);
    const int h = kvh * 4 + (wid & 3), sub = wid >> 2;
    const unsigned lds0 = (unsigned)(uintptr_t)shm;
    LAS float* wsf = (LAS float*)(shm + L_WS) + wid * 64;
    const lds_cptr shm3 = (lds_cptr)shm;
    const int vb0 = (int)(lds0 + L_V) + ((lane >> 4) & 1) * 32 + (lane & 3) * 8 + (4 * hi + ((lane & 15) >> 2)) * 64;
    const float slope2 = exp2f(-0.5f * (float)(h + 1)) * LOG2E, sink2 = sinks[h] * LOG2E;
    dma_tile(proj, b, kvh, qb0 - 2, lds0, wid, lane); dma_tile(proj, b, kvh, qb0 - 1, lds0, wid, lane); dma_tile(proj, b, kvh, qb0, lds0, wid, lane);
    for (int qi = 0; qi < nqb; ++qi) {
        const int qb = qb0 + qi, tq0 = qb * 64 + 32 * sub;
        const bf16* Qw = proj + (size_t)(b * SEQ + tq0) * IN_W + C_Q + h * 64;
        bf16x8 qr[4];
#pragma unroll
        for (int d0 = 0; d0 < 4; ++d0) qr[d0] = *(const bf16x8*)(Qw + (size_t)r32 * IN_W + d0 * 16 + hi * 8);
        ATT_WAIT_BAR();
        if (qi + 1 < nqb) dma_tile(proj, b, kvh, qb + 1, lds0, wid, lane);
        f32x16 p[5];
#pragma unroll
        for (int i = 0; i < 5; ++i) { const int g = i + sub; qkt_half(p[i], shm3 + L_K + ((qb + (g >> 1)) & 3) * SLOTB + (g & 1) * 512 + hi * 1024 + r32 * 16, qr); }
        float dbase = (float)(128 + r32 - 4 * hi); asm volatile("" : "+v"(dbase));
        const float dmax = (float)(tq0 + r32);
        float mx = -INFINITY;
#pragma unroll
        for (int i = 0; i < 5; ++i)
#pragma unroll
            for (int r = 0; r < 16; ++r) { const float d = dbase - (float)(32 * i + (r & 3) + 8 * (r >> 2));
                float v = p[i][r] - slope2 * d;
                if (i == 0) v = (d < 128.f) ? v : -INFINITY;
                if (i == 4) v = (d >= 0.f) ? v : -INFINITY;
                if (qb < 2) v = (d <= dmax) ? v : -INFINITY;
                p[i][r] = v; mx = fmaxf(mx, v); }
        { auto rr = __builtin_amdgcn_permlane32_swap(__float_as_uint(mx), __float_as_uint(mx), false, false); mx = fmaxf(__uint_as_float(rr[0]), __uint_as_float(rr[1])); }
        mx = fmaxf(mx, sink2);
        float ls = 0.f;
        f32x16 o[2]; o[0] = f32x16{}; o[1] = f32x16{};
#pragma unroll
        for (int i = 0; i < 5; ++i) { const int g = i + sub;
#pragma unroll
            for (int r = 0; r < 16; ++r) { const float e = __builtin_amdgcn_exp2f(p[i][r] - mx); p[i][r] = e; ls += e; }
            u32x4 pw0, pw1;
#define ATT_PKW(P, B) cvtpk_s(P[B], P[B + 1])
            pw0 = (u32x4){ATT_PKW(p[i], 0), ATT_PKW(p[i], 2), ATT_PKW(p[i], 4), ATT_PKW(p[i], 6)}; pw1 = (u32x4){ATT_PKW(p[i], 8), ATT_PKW(p[i], 10), ATT_PKW(p[i], 12), ATT_PKW(p[i], 14)};
#undef ATT_PKW
            __builtin_amdgcn_sched_barrier(0);
            pv_half(o, vb0 + ((qb + (g >> 1)) & 3) * SLOTB + (g & 1) * 2048, __builtin_bit_cast(bf16x8, pw0), __builtin_bit_cast(bf16x8, pw1));
        }
        { auto rr = __builtin_amdgcn_permlane32_swap(__float_as_uint(ls), __float_as_uint(ls), false, false); ls = __uint_as_float(rr[0]) + __uint_as_float(rr[1]); }
        ls += __builtin_amdgcn_exp2f(sink2 - mx);
        if (hi == 0) wsf[32 + r32] = ls;
        asm volatile("s_waitcnt lgkmcnt(0)" ::: "memory");
        float rli[16];
#pragma unroll
        for (int r = 0; r < 16; ++r) rli[r] = __builtin_amdgcn_rcpf(wsf[32 + crow(r, hi)]);
        bf16* Ow = O + (size_t)(b * SEQ + tq0) * 1024 + h * 64;
        { LAS bf16* stg = (LAS bf16*)(shm + L_OST) + wid * 2048;
#pragma unroll
            for (int r = 0; r < 16; ++r) { const int orow = crow(r, hi);
#pragma unroll
                for (int d0 = 0; d0 < 2; ++d0) stg[orow * 64 + d0 * 32 + r32] = (bf16)f2bf(o[d0][r] * rli[r]); }
            asm volatile("s_waitcnt lgkmcnt(0)" ::: "memory");
#pragma unroll
            for (int i = 0; i < 4; ++i) { const int row = i * 8 + (lane >> 3), ch = lane & 7; const u32x4 v = *(const LAS u32x4*)(stg + row * 64 + ch * 8); *(u32x4*)(Ow + (size_t)row * 1024 + ch * 8) = v; } }
    }
    ATT_WAIT_BAR();
}
#undef ATT_WAIT_BAR
}

namespace s5 {
using bf16x8 = __attribute__((ext_vector_type(8))) short;
using f32x16 = __attribute__((ext_vector_type(16))) float;
struct cf { float re, im; };
__device__ __forceinline__ cf cmul(cf a, cf b) { return cf{a.re * b.re - a.im * b.im, a.re * b.im + a.im * b.re}; }
__device__ __forceinline__ cf cfma(cf a, cf b, cf c) { return cf{c.re + a.re * b.re - a.im * b.im, c.im + a.re * b.im + a.im * b.re}; }
__device__ __forceinline__ int crow(int r, int hi) { return (r & 3) + 8 * (r >> 2) + 4 * hi; }
__device__ __forceinline__ bf16x8 ldg16(const bf16* ubase, unsigned lane_off) { return *(const bf16x8*)((const char*)ubase + lane_off); }
constexpr size_t BT_G = 128 * 256, KT_G = 16 * 16 * 16, CT_G = 256 * 128;
constexpr int IMG_STRIDE = 136;
constexpr int L_IMG = 0, L_T = 8 * 32 * IMG_STRIDE * 2, L_BYTES = L_T + 8 * 2 * 2 * 32 * 4;

__device__ __forceinline__ void build_tables(int g, int part, const float* a_re, const float* a_im, const float* log_dt, const float* b_re, const float* b_im, const float* c_re, const float* c_im, const float* d_skip,
                                             bf16* Btab, bf16* Ktab, bf16* Ctab, float* A16tab, LAS unsigned char* scr, int tid) {
    LAS double* LA = (LAS double*)scr; LAS double* TH = LA + 64;
    LAS float* bbr = (LAS float*)(scr + 1024); LAS float* bbi = bbr + 1024;
    LAS float* pwr = bbi + 1024; LAS float* pwi = pwr + 17 * 64;
    if (tid < 64) { const int i = g * NP + tid;
        const double dt = exp((double)log_dt[g]), are = a_re[i], aim = a_im[i];
        const double la = are * dt, th = aim * dt, mag = exp(la), abr = mag * cos(th), abi = mag * sin(th), den = are * are + aim * aim, em1 = abr - 1.0;
        const double qre = (em1 * are + abi * aim) / den, qim = (abi * are - em1 * aim) / den;
        LA[tid] = la; TH[tid] = th;
        for (int h = 0; h < GCH; ++h) { const double br = b_re[i * GCH + h], bi = b_im[i * GCH + h]; bbr[tid * 16 + h] = (float)(qre * br - qim * bi); bbi[tid * 16 + h] = (float)(qre * bi + qim * br); } }
    __syncthreads();
    for (int e = tid; e < 17 * 64; e += 512) { const int n = e >> 6, p = e & 63; const double m = exp((double)n * LA[p]), t = (double)n * TH[p]; pwr[e] = (float)(m * cos(t)); pwi[e] = (float)(m * sin(t)); }
    __syncthreads();
    if (part == 0 && tid < 64) { A16tab[(g * 64 + tid) * 2] = pwr[16 * 64 + tid]; A16tab[(g * 64 + tid) * 2 + 1] = pwi[16 * 64 + tid]; }
    for (int e = tid; e < 32 * 256; e += 512) { const int pl = e >> 8, k = e & 255, j = k >> 4, hp = k & 15, pp = 32 * part + pl, p = pp & 63;
        const float wr = pwr[(15 - j) * 64 + p], wi = pwi[(15 - j) * 64 + p], br = bbr[p * 16 + hp], bi = bbi[p * 16 + hp];
        const float v = (pp < 64) ? (wr * br - wi * bi) : (wr * bi + wi * br);
        Btab[(size_t)g * BT_G + (size_t)pp * 256 + k] = (bf16)f2bf(v); }
    for (int e = tid; e < 64 * 128; e += 512) { const int nl = e >> 7, pp = e & 127, n = 64 * part + nl, i = n >> 4, h = n & 15, p = pp & 63;
        const float cr = c_re[(size_t)(g * 16 + h) * NP + p], ci = c_im[(size_t)(g * 16 + h) * NP + p], wr = pwr[(i + 1) * 64 + p], wi = pwi[(i + 1) * 64 + p];
        const float v = (pp < 64) ? (cr * wr - ci * wi) : -(cr * wi + ci * wr);
        Ctab[(size_t)g * CT_G + (size_t)n * 128 + pp] = (bf16)f2bf(v); }
    for (int e = tid; e < 4 * 256; e += 512) { const int d = 4 * part + (e >> 8), h = (e >> 4) & 15, hp = e & 15; float acc = 0.f;
        for (int p = 0; p < 64; ++p) { const float cr = c_re[(size_t)(g * 16 + h) * NP + p], ci = c_im[(size_t)(g * 16 + h) * NP + p], wr = pwr[d * 64 + p], wi = pwi[d * 64 + p], br = bbr[p * 16 + hp], bi = bbi[p * 16 + hp];
            const float tr = wr * br - wi * bi, ti = wr * bi + wi * br; acc += cr * tr - ci * ti; }
        if (d == 0 && h == hp) acc += d_skip[g * 16 + h];
        Ktab[(size_t)g * KT_G + (size_t)(d * 16 + h) * 16 + hp] = (bf16)f2bf(acc); }
    __syncthreads();
}

__device__ __forceinline__ void scan_local(f32x16& re, f32x16& im, const cf p1, const cf p4, const int hi, cf (&em)[4], cf& T) {
#pragma unroll
    for (int q = 0; q < 4; ++q)
#pragma unroll
        for (int k = 1; k < 4; ++k) { const int r = 4 * q + k; const cf v = cfma(p1, cf{re[r - 1], im[r - 1]}, cf{re[r], im[r]}); re[r] = v.re; im[r] = v.im; }
    cf E = cf{0.f, 0.f};
#pragma unroll
    for (int q = 0; q < 4; ++q) {
        auto sr = __builtin_amdgcn_permlane32_swap(__float_as_uint(re[4 * q + 3]), __float_as_uint(re[4 * q + 3]), false, false);
        auto si = __builtin_amdgcn_permlane32_swap(__float_as_uint(im[4 * q + 3]), __float_as_uint(im[4 * q + 3]), false, false);
        const cf elo = cf{__uint_as_float(sr[0]), __uint_as_float(si[0])}, ehi = cf{__uint_as_float(sr[1]), __uint_as_float(si[1])};
        const cf Elo = E; E = cfma(p4, E, elo); const cf Ehi = E; E = cfma(p4, E, ehi);
        em[q] = hi ? Ehi : Elo; }
    T = E;
}
__device__ __forceinline__ void scan_finish(f32x16& re, f32x16& im, const cf p1, const cf p2, const cf p3, const cf p4, const cf g2, const int hi, const cf (&em)[4], const cf X) {
    cf cur = hi ? p4 : cf{1.f, 0.f};
#pragma unroll
    for (int q = 0; q < 4; ++q) { const cf carry = cfma(cur, X, em[q]); cur = cmul(cur, g2);
        cf v;
        v = cfma(p1, carry, cf{re[4 * q + 0], im[4 * q + 0]}); re[4 * q + 0] = v.re; im[4 * q + 0] = v.im;
        v = cfma(p2, carry, cf{re[4 * q + 1], im[4 * q + 1]}); re[4 * q + 1] = v.re; im[4 * q + 1] = v.im;
        v = cfma(p3, carry, cf{re[4 * q + 2], im[4 * q + 2]}); re[4 * q + 2] = v.re; im[4 * q + 2] = v.im;
        v = cfma(p4, carry, cf{re[4 * q + 3], im[4 * q + 3]}); re[4 * q + 3] = v.re; im[4 * q + 3] = v.im; }
}

__device__ __forceinline__ void s5_unit(int b, int g, const bf16* proj, const bf16* Btab, const bf16* Ktab, const bf16* Ctab, const float* A16tab, bf16* out, LAS unsigned char* shm) {
    int tid = threadIdx.x; asm volatile("" : "+v"(tid));
    const int lane = tid & 63, col = lane & 31, hi = lane >> 5; const int wid = __builtin_amdgcn_readfirstlane(tid >> 6);
    const bf16* ub = proj + (size_t)(b * SEQ + 512 * wid) * IN_W + C_U + 16 * g;
    const unsigned uoff = (unsigned)((16 * col * IN_W + 8 * hi) * 2);
    const bf16* bt = Btab + (size_t)g * BT_G; const unsigned boff = (unsigned)((col * 256 + 8 * hi) * 2);
    f32x16 zt[4];
#pragma unroll
    for (int nt = 0; nt < 4; ++nt) zt[nt] = f32x16{};
#pragma unroll
    for (int j = 0; j < 16; ++j) { const bf16x8 uj = ldg16(ub + (size_t)j * IN_W, uoff);
#pragma unroll
        for (int nt = 0; nt < 4; ++nt) { const bf16x8 bfr = ldg16(bt + (size_t)(32 * nt) * 256 + 16 * j, boff); zt[nt] = __builtin_amdgcn_mfma_f32_32x32x16_bf16(uj, bfr, zt[nt], 0, 0, 0); } }
    LAS float* Tb = (LAS float*)(shm + L_T);
    LAS bf16* img = (LAS bf16*)(shm + L_IMG) + wid * 32 * IMG_STRIDE;
    {
        cf P1[2], P2[2], P3[2], P4[2], G2[2], EM[2][4], TT[2];
#pragma unroll
        for (int s = 0; s < 2; ++s) { const float2 a = ((const float2*)A16tab)[g * 64 + 32 * s + col]; P1[s] = cf{a.x, a.y}; P2[s] = cmul(P1[s], P1[s]); P3[s] = cmul(P2[s], P1[s]); P4[s] = cmul(P2[s], P2[s]); G2[s] = cmul(P4[s], P4[s]); }
        scan_local(zt[0], zt[2], P1[0], P4[0], hi, EM[0], TT[0]);
        scan_local(zt[1], zt[3], P1[1], P4[1], hi, EM[1], TT[1]);
        if (hi == 0) {
#pragma unroll
            for (int s = 0; s < 2; ++s) { Tb[((wid * 2 + s) * 2 + 0) * 32 + col] = TT[s].re; Tb[((wid * 2 + s) * 2 + 1) * 32 + col] = TT[s].im; } }
        __syncthreads();
#pragma unroll
        for (int s = 0; s < 2; ++s) {
            const cf g4 = cmul(G2[s], G2[s]), g8 = cmul(g4, g4);
            cf X = cf{0.f, 0.f};
            for (int v = 0; v < wid; ++v) X = cfma(g8, X, cf{Tb[((v * 2 + s) * 2 + 0) * 32 + col], Tb[((v * 2 + s) * 2 + 1) * 32 + col]});
            scan_finish(zt[s], zt[2 + s], P1[s], P2[s], P3[s], P4[s], G2[s], hi, EM[s], X);
            if (hi == 0) { img[32 * s + col] = (bf16)f2bf(X.re); img[64 + 32 * s + col] = (bf16)f2bf(X.im); }
#pragma unroll
            for (int r = 0; r < 16; ++r) { const int row = crow(r, hi) + 1;
                if (row < 32) { img[row * IMG_STRIDE + 32 * s + col] = (bf16)f2bf(zt[s][r]); img[row * IMG_STRIDE + 64 + 32 * s + col] = (bf16)f2bf(zt[2 + s][r]); } }
        }
    }
    asm volatile("s_waitcnt lgkmcnt(0)" ::: "memory"); __builtin_amdgcn_wave_barrier();
    bf16x8 sa[8];
#pragma unroll
    for (int ks = 0; ks < 8; ++ks) sa[ks] = *(const LAS bf16x8*)(img + col * IMG_STRIDE + 16 * ks + 8 * hi);
    const int ih = col >> 4, h = col & 15;
    const bf16* kt = Ktab + (size_t)g * KT_G; const unsigned koff = (unsigned)(((ih * 16 + h) * 16 + 8 * hi) * 2);
    const bf16* ct = Ctab + (size_t)g * CT_G; const unsigned coff = (unsigned)((col * 128 + 8 * hi) * 2);
    bf16* ob = out + (size_t)(b * SEQ + 512 * wid + ih) * 1024 + 16 * g + h;
#pragma unroll
    for (int ps = 0; ps < 2; ++ps) {
        f32x16 acc[4];
#pragma unroll
        for (int n = 0; n < 4; ++n) acc[n] = f32x16{};
#pragma unroll
        for (int j = 0; j < 8 * ps + 8; ++j) { const bf16x8 uj = ldg16(ub + (size_t)j * IN_W, uoff);
#pragma unroll
            for (int n = 0; n < 4; ++n) { const int nt = 4 * ps + n;
                if (j <= 2 * nt + 1) {
                    bf16x8 kf;
                    if (j == 2 * nt + 1) { kf = ldg16(kt, (unsigned)((h * 16 + 8 * hi) * 2)); if (ih == 0) kf = bf16x8{}; }
                    else kf = ldg16(kt + (size_t)(2 * nt - j) * 256, koff);
                    acc[n] = __builtin_amdgcn_mfma_f32_32x32x16_bf16(uj, kf, acc[n], 0, 0, 0); } } }
#pragma unroll
        for (int ks = 0; ks < 8; ++ks)
#pragma unroll
            for (int n = 0; n < 4; ++n) { const bf16x8 cfr = ldg16(ct + (size_t)(32 * (4 * ps + n)) * 128 + 16 * ks, coff); acc[n] = __builtin_amdgcn_mfma_f32_32x32x16_bf16(sa[ks], cfr, acc[n], 0, 0, 0); }
#pragma unroll
        for (int n = 0; n < 4; ++n)
#pragma unroll
            for (int r = 0; r < 16; ++r) ob[(size_t)(16 * crow(r, hi) + 2 * (4 * ps + n)) * 1024] = (bf16)f2bf(gelu_tanh(acc[n][r]));
    }
    __syncthreads();
}
}

constexpr int NPH = 10;
__global__ void __launch_bounds__(512, 2) mk_fwd(Args args) {
    extern __shared__ __attribute__((aligned(16))) unsigned char lds_raw[];
    Ctx C; C.lds = (LAS unsigned char*)lds_raw; C.tid = threadIdx.x; C.lane = C.tid & 63; C.wave = __builtin_amdgcn_readfirstlane(C.tid >> 6);
    C.G = gridDim.x; { const int bx = blockIdx.x; C.vcu = (C.G % 8 == 0) ? (bx % 8) * (C.G / 8) + bx / 8 : bx; }
    C.gw = C.vcu * 8 + C.wave; C.ngw = C.G * 8;
    volatile LAS unsigned* MISC = (volatile LAS unsigned*)(C.lds + MISC_OFF);
    if (C.tid < 64) MISC[C.tid] = 0u;
    __syncthreads();
    unsigned char* ws = args.ws; unsigned* ctl = (unsigned*)(ws + WS_CTL);
    const int lo = args.ph_lo, hi = args.ph_hi;
    XcdBarrier bar; bar.bar = ctl + CW_BAR + args.bar_idx * XCD_BAR_WORDS; bar.x = 0; bar.st = nullptr;
    if (hi - lo > 1) bar = xcd_barrier_post(ctl + CW_BAR + args.bar_idx * XCD_BAR_WORDS, MISC + 8);
#define IN(k) (lo <= (k) && (k) < hi)
#define SEAM(k) do { if (IN(k) && IN((k) + 1)) xcd_barrier(bar); } while (0)
    const float* x = args.in[0]; float* out = args.out;
    bf16* WIN = (bf16*)(ws + WS_WIN); bf16* WGLU = (bf16*)(ws + WS_WGLU); bf16* WSSM = (bf16*)(ws + WS_WSSM); bf16* WATT = (bf16*)(ws + WS_WATT); bf16* WOUT = (bf16*)(ws + WS_WOUT);
    bf16* WGU = (bf16*)(ws + WS_WGU); bf16* WDN = (bf16*)(ws + WS_WDN); bf16* BTAB = (bf16*)(ws + WS_BTAB); bf16* CTAB = (bf16*)(ws + WS_CTAB); bf16* KTAB = (bf16*)(ws + WS_KTAB); float* A16TAB = (float*)(ws + WS_A16);
    bf16* H = (bf16*)(ws + WS_H); bf16* PROJ = (bf16*)(ws + WS_PROJ); bf16* S5OUT = (bf16*)(ws + WS_S5OUT); bf16* ATTN = (bf16*)(ws + WS_ATTN);
    bf16* GLU = H; bf16* MIXED = S5OUT; bf16* H2 = ATTN; bf16* YS = PROJ; bf16* ACT = (bf16*)(ws + WS_ACT);
    float* top_w = (float*)(ws + WS_ROUTE + RT_TOPW); int* list = (int*)(ws + WS_ROUTE + RT_LIST);
    LAS unsigned char* ring = C.lds + RING_OFF;

    if (IN(0)) {
        for (int blk = C.vcu; blk < NG * 4; blk += C.G) s5::build_tables(blk >> 2, blk & 3, args.in[3], args.in[4], args.in[5], args.in[6], args.in[7], args.in[8], args.in[9], args.in[10], BTAB, KTAB, CTAB, A16TAB, ring, C.tid);
        transpose_job(C, args.in[2], WIN, DM, IN_W, 0, 1);
        transpose_job(C, args.in[11], WGLU, 1024, 2048, 1, 1);
        transpose_job(C, args.in[12], WSSM, 1024, 1024, 0, 1);
        transpose_job(C, args.in[16], WATT, 1024, 1024, 0, 1);
        transpose_job(C, args.in[17], WOUT, 1024, 1024, 0, 1);
        transpose_job(C, args.in[21], WGU, 1024, 2048, 1, NE);
        transpose_job(C, args.in[23], WDN, 1024, 1024, 0, NE);
        rmsnorm_rows(C, x, args.in[1], H);
        __syncthreads();
    }
    SEAM(0);
    if (IN(1)) { pg8::Gemm g{}; g.A = H; g.Bt = WIN; g.M = T; g.N = IN_W; g.K = DM; pg8::StaticOrder S; S.init(T, IN_W, C.G, (int)blockIdx.x);
        pg8::EpiProj e{}; e.O = PROJ; e.ldc = IN_W; e.qg = args.in[13]; e.kg = args.in[14]; e.qscale = att::QSCALE; pg8::gemm_phase<pg8::EpiProj, pg8::StaticOrder>(ring, g, S, e); }
    SEAM(1);
    if (IN(2)) {
        for (int uu = C.vcu; uu < BATCH * NG / 2; uu += C.G) for (int i = 0; i < 2; ++i) { const int unit = 2 * uu + i; s5::s5_unit(unit & 7, unit >> 3, PROJ, BTAB, KTAB, CTAB, A16TAB, S5OUT, ring); }
        for (int run = C.vcu; run < BATCH * NKVH * 8; run += C.G) att::attn_run(run >> 5, (run >> 3) & 3, (run & 7) * 8, 8, PROJ, args.in[15], ATTN, ring);
        __syncthreads();
    }
    SEAM(2);
    if (IN(3)) { pg8::Gemm g{}; g.A = S5OUT; g.Bt = WGLU; g.M = T; g.N = 2048; g.K = 1024; pg8::StaticOrder S; S.init(T, 2048, C.G, (int)blockIdx.x);
        pg8::EpiGlu e{}; e.O = GLU; e.ldc = 1024; pg8::gemm_phase<pg8::EpiGlu, pg8::StaticOrder>(ring, g, S, e); }
    SEAM(3);
    if (IN(4)) {
        { pg8::Gemm g{}; g.A = GLU; g.Bt = WSSM; g.M = T; g.N = 1024; g.K = 1024; pg8::StaticOrder S; S.init(T, 1024, C.G, (int)blockIdx.x);
          pg8::EpiGate<false> e{}; e.O = MIXED; e.ldc = 1024; e.G = PROJ; e.ldg = IN_W; e.gcol = C_GS; pg8::gemm_phase<pg8::EpiGate<false>, pg8::StaticOrder>(ring, g, S, e); }
        VM_WAIT(); __syncthreads();
        { pg8::Gemm g{}; g.A = ATTN; g.Bt = WATT; g.M = T; g.N = 1024; g.K = 1024; pg8::StaticOrder S; S.init(T, 1024, C.G, (int)blockIdx.x);
          pg8::EpiGate<true> e{}; e.O = MIXED; e.ldc = 1024; e.G = PROJ; e.ldg = IN_W; e.gcol = C_GA; pg8::gemm_phase<pg8::EpiGate<true>, pg8::StaticOrder>(ring, g, S, e); }
    }
    SEAM(4);
    if (IN(5)) { pg8::Gemm g{}; g.A = MIXED; g.Bt = WOUT; g.M = T; g.N = 1024; g.K = 1024; pg8::StaticOrder S; S.init(T, 1024, C.G, (int)blockIdx.x);
        pg8::EpiResid e{}; e.base = x; e.out = out; e.ldc = 1024; pg8::gemm_phase<pg8::EpiResid, pg8::StaticOrder>(ring, g, S, e); }
    SEAM(5);
    if (IN(6)) { router_pass(C, out, args.in[18], args.in[19], args.in[20], H2, top_w, list, ctl); }
    SEAM(6);
    if (IN(7)) { const int nM = grouped_tables(C, ctl);
        pg8::Gemm g{}; g.A = H2; g.Bt = WGU; g.M = NA; g.N = 2048; g.K = 1024;
        pg8::GroupedOrder S; S.cnt = (const LAS int*)(C.lds + GT_OFF); S.pref = S.cnt + 32; S.tile_e = (const LAS unsigned char*)(S.pref + 36); S.list = list; S.nN = 8; S.G = C.G; S.c = (int)blockIdx.x; S.nM = nM; S.lstride = T; S.ashift = 2;
        pg8::EpiSwiglu e{}; e.O = ACT; e.ldc = 1024; e.bias = args.in[22]; e.dff = DFF; e.limit = 7.0f; e.alpha = 1.702f; e.list = list; e.lstride = T;
        pg8::gemm_phase<pg8::EpiSwiglu, pg8::GroupedOrder>(ring, g, S, e); }
    SEAM(7);
    if (IN(8)) { const int nM = grouped_tables(C, ctl);
        pg8::Gemm g{}; g.A = ACT; g.Bt = WDN; g.M = NA; g.N = 1024; g.K = 1024;
        pg8::GroupedOrder S; S.cnt = (const LAS int*)(C.lds + GT_OFF); S.pref = S.cnt + 32; S.tile_e = (const LAS unsigned char*)(S.pref + 36); S.list = list; S.nN = 4; S.G = C.G; S.c = (int)blockIdx.x; S.nM = nM; S.lstride = T; S.ashift = 0;
        pg8::EpiDown e{}; e.O = YS; e.ldc = 1024; e.bias = args.in[24]; e.ncol = 1024; e.list = list; e.lstride = T;
        pg8::gemm_phase<pg8::EpiDown, pg8::GroupedOrder>(ring, g, S, e); }
    SEAM(8);
    if (IN(9)) { combine_pass(C, out, YS, top_w); }
#undef IN
#undef SEAM
}

extern "C" void kernel_launch(void* const* d_in, const int* in_sizes, int n_in, void* d_out, int out_size, void* d_ws, size_t ws_size, hipStream_t stream) {
    static int grid = 0;
    if (grid == 0) {
        if (n_in != 25 || in_sizes[0] != T * DM || out_size != T * DM || ws_size < WS_END) { fprintf(stderr, "kernel_launch: unexpected shapes / workspace (n_in %d, ws %zu)\n", n_in, ws_size); grid = -1; return; }
        int dev = 0, cus = 0, per_cu = 0;
        if (hipGetDevice(&dev) != hipSuccess || hipDeviceGetAttribute(&cus, hipDeviceAttributeMultiprocessorCount, dev) != hipSuccess) { grid = -1; return; }
        if (hipFuncSetAttribute((const void*)mk_fwd, hipFuncAttributeMaxDynamicSharedMemorySize, LDS_BYTES) != hipSuccess) { fprintf(stderr, "kernel_launch: hipFuncSetAttribute failed\n"); grid = -1; return; }
        if (hipOccupancyMaxActiveBlocksPerMultiprocessor(&per_cu, (const void*)mk_fwd, 512, LDS_BYTES) != hipSuccess || per_cu < 1) { fprintf(stderr, "kernel_launch: occupancy query says %d workgroups per CU\n", per_cu); grid = -1; (void)hipGetLastError(); return; }
        grid = cus;
    }
    if (grid < 0) return;
    if (hipMemsetAsync((char*)d_ws + WS_CTL, 0, CTL_ZERO_BYTES, stream) != hipSuccess) return;
    Args a{};
    for (int i = 0; i < 25; ++i) a.in[i] = (const float*)d_in[i];
    a.out = (float*)d_out; a.ws = (unsigned char*)d_ws;
#ifdef MK_RANGES
    { const int rg[] = MK_RANGES; int nb = 0; for (unsigned i = 0; i + 1 < sizeof(rg) / sizeof(int); i += 2) { a.ph_lo = rg[i]; a.ph_hi = rg[i + 1]; a.bar_idx = (rg[i + 1] - rg[i] > 1) ? nb++ : 0;
        hipLaunchKernelGGL(mk_fwd, dim3(grid), dim3(512), LDS_BYTES, stream, a); } }
#else
    a.ph_lo = 0; a.ph_hi = NPH; a.bar_idx = 0; hipLaunchKernelGGL(mk_fwd, dim3(grid), dim3(512), LDS_BYTES, stream, a);
#endif
}
```

```cpp
#include <hip/hip_runtime.h>
#include <cstdio>
#include <cstdint>
#include <cmath>

constexpr int DM = 1024, BATCH = 8, SEQ = 4096, T = BATCH * SEQ;
constexpr int NG = 64, NP = 64, GCH = 16;
constexpr int HD = 64, NQH = 16, NKVH = 4, WIN = 128;
constexpr int IN_W = 4608;
constexpr int C_U = 0, C_Q = 1024, C_K = 2048, C_V = 2304, C_GS = 2560, C_GA = 3584;
constexpr int NE = 32, TOPK = 4, DFF = 1024, NA = T * TOPK;
constexpr int MAXROWS = NA + NE * 256;
constexpr int MAXMT = MAXROWS / 256;
constexpr float EPS = 1e-5f;

namespace pg8 {
#define PG8_LAS __attribute__((address_space(3)))
typedef unsigned short bf16_t;
typedef short bf16x8 __attribute__((ext_vector_type(8)));
typedef float f32x4 __attribute__((ext_vector_type(4)));
typedef unsigned u32x4 __attribute__((ext_vector_type(4)));
typedef int i32x8 __attribute__((ext_vector_type(8)));
typedef int i32x4 __attribute__((ext_vector_type(4)));
__device__ __forceinline__ i32x8 cat8(bf16x8 lo, bf16x8 hi) { return __builtin_shufflevector(__builtin_bit_cast(i32x4, lo), __builtin_bit_cast(i32x4, hi), 0, 1, 2, 3, 4, 5, 6, 7); }
constexpr int BM = 256, BK = 64, HALF = 128, HTB = HALF * BK * 2  , STAGE_BYTES = 8 * HTB, NXCD = 8, WGM = 8;

__host__ __device__ __forceinline__ int lds_byte(int r, int c) { const int st = (r >> 4) * 2 + (c >> 5), rr = r & 15, cc = c & 31, ob = rr * 64 + cc * 2; return st * 1024 + (ob ^ (((ob >> 9) & 1) << 5)); }
__host__ __device__ __forceinline__ void stage_rc(int b, int& R, int& C) { const int st = b / 1024, sb = b % 1024, swz = sb ^ (((sb >> 9) & 1) << 5); R = (st >> 1) * 16 + swz / 64; C = (st & 1) * 32 + (swz % 64) / 2; }
__host__ __device__ __forceinline__ int perm32(int rho) { const int n = rho >> 4, i = rho & 15; return 8 * (i >> 2) + 4 * n + (i & 3); }

struct Unit { int pm, pn, e, pl, rows; };
struct Gemm { const bf16_t* A; const bf16_t* Bt; const bf16_t* A2; const bf16_t* Bt2; int M, N, K, agm, scaleA, scaleB, pad0, pad1; };

struct StaticOrder {
    static constexpr bool GATHER = false, FP8 = false;
    int nM, nN, nwg, G, c;
    __host__ __device__ void init(int M, int N, int G_, int c_) { nM = M / BM; nN = N / BM; nwg = nM * nN; G = G_; c = c_; }
    __host__ __device__ bool next(int i, Unit& u) const {
        const long L = (long)i * G + c; if (L >= nwg) return false;
        int wgid = (int)L; { const int q = nwg / NXCD, r = nwg % NXCD, xcd = wgid % NXCD, off = wgid / NXCD; wgid = (xcd < r ? xcd * (q + 1) : r * (q + 1) + (xcd - r) * q) + off; }
        const int nig = WGM * nN, gid = wgid / nig, fm = gid * WGM, gsz = (nM - fm) < WGM ? (nM - fm) : WGM;
        u.pm = fm + ((wgid % nig) % gsz); u.pn = (wgid % nig) / gsz; u.e = 0; u.pl = u.pn; u.rows = BM; return true;
    }
    __device__ __forceinline__ void a_ready(const Unit&) const {}
    __device__ __forceinline__ void done(const Unit&) const {}
};

template <class Epi, class Sched, bool ALIGN_EPI = true>
__device__ __forceinline__ void gemm_phase(PG8_LAS unsigned char* lds, const Gemm g, const Sched& S, const Epi& E) {
    int tid = threadIdx.x; asm volatile("" : "+v"(tid));
    const int wid = __builtin_amdgcn_readfirstlane(tid >> 6), lane = tid & 63, wr = wid >> 2, wc = wid & 3, fr = lane & 15, fq = lane >> 4;
    constexpr bool GATHER = Sched::GATHER, FP8 = Sched::FP8;
    const int K = g.K, KB = FP8 ? K : 2 * K, nt = KB / 128;
    int RA[2], CA[2]; unsigned voffA0[2], voffA1[2], voffB[2];
#pragma unroll
    for (int i = 0; i < 2; ++i) { int R, C; stage_rc(tid * 16 + i * 8192, R, C); RA[i] = R; CA[i] = C;
        const int Rb = 2 * (R & ~31) + (Epi::PERM ? perm32(R & 31) : (R & 31));
        voffB[i] = (unsigned)(Rb * KB + C * 2);
        if (g.agm) { voffA0[i] = (unsigned)((C >> 4) * g.M * 32 + R * 32 + (C & 15) * 2); voffA1[i] = voffA0[i] + (unsigned)(HALF * 32); }
        else { voffA0[i] = (unsigned)(R * KB + C * 2); voffA1[i] = (unsigned)((R + HALF) * KB + C * 2); } }
    const size_t kstep = (size_t)(BK * 2);
    const size_t hstepB = (size_t)32 * KB;
    const size_t tstep = (size_t)BM * KB;
    const size_t kstepA = g.agm ? (size_t)4 * g.M * 32 : kstep, tstepA = g.agm ? (size_t)BM * 32 : tstep;
    const unsigned ldsw = (unsigned)wid * 1024u;
    const int aoff = lds_byte(wr * 64 + fr, FP8 ? fq * 16 : fq * 8), boff = lds_byte(wc * 32 + fr, FP8 ? fq * 16 : fq * 8);
    constexpr int KOFF = FP8 ? 16 : 1024;
#define PG8_SA(b, h) (((b) * 2 + (h)) * HTB)
#define PG8_SB(b, h) ((4 + (b) * 2 + (h)) * HTB)
#define PG8_STAGE(bufoff, gbase, voff) do { _Pragma("unroll") for (int _i = 0; _i < 2; ++_i) \
        __builtin_amdgcn_global_load_lds((const unsigned*)((const char*)(gbase) + (voff)[_i]), (PG8_LAS unsigned*)(lds + (bufoff) + ldsw + _i * 8192), 16, 0, 0); } while (0)
#define PG8_LDA(dst, b, h) do { _Pragma("unroll") for (int m = 0; m < 4; ++m) _Pragma("unroll") for (int k = 0; k < 2; ++k) dst[m][k] = *(const PG8_LAS bf16x8*)(lds + PG8_SA(b, h) + aoff + m * 2048 + k * KOFF); } while (0)
#define PG8_LDB(dst, b, h) do { _Pragma("unroll") for (int n = 0; n < 2; ++n) _Pragma("unroll") for (int k = 0; k < 2; ++k) dst[n][k] = *(const PG8_LAS bf16x8*)(lds + PG8_SB(b, h) + boff + n * 2048 + k * KOFF); } while (0)
#define PG8_MMA(ai, bj, At, Bt) do { __builtin_amdgcn_s_setprio(1); _Pragma("unroll") for (int m = 0; m < 4; ++m) _Pragma("unroll") for (int n = 0; n < 2; ++n) { \
        if constexpr (FP8) acc[ai][bj][m][n] = __builtin_amdgcn_mfma_scale_f32_16x16x128_f8f6f4(cat8(Bt[n][0], Bt[n][1]), cat8(At[m][0], At[m][1]), acc[ai][bj][m][n], 0, 0, 0, g.scaleB, 0, g.scaleA); \
        else { _Pragma("unroll") for (int k = 0; k < 2; ++k) acc[ai][bj][m][n] = __builtin_amdgcn_mfma_f32_16x16x32_bf16(Bt[n][k], At[m][k], acc[ai][bj][m][n], 0, 0, 0); } } __builtin_amdgcn_s_setprio(0); } while (0)
#define PG8_WAIT_V(n) asm volatile("s_waitcnt vmcnt(" #n ")" ::: "memory")
#define PG8_WAIT_L(n) asm volatile("s_waitcnt lgkmcnt(" #n ")" ::: "memory")
#define PG8_BAR __builtin_amdgcn_s_barrier()
#define PG8_SCHED __builtin_amdgcn_sched_barrier(0)
    Unit cur, nxt; int ui = 0;
    if (!S.next(0, cur)) return;
    f32x4 acc[2][2][4][2];
#pragma unroll
    for (int a = 0; a < 2; ++a)
#pragma unroll
        for (int b = 0; b < 2; ++b)
#pragma unroll
            for (int m = 0; m < 4; ++m)
#pragma unroll
                for (int n = 0; n < 2; ++n) acc[a][b][m][n] = (f32x4){0.f, 0.f, 0.f, 0.f};
    bf16x8 At[4][2], B0[2][2], B1[2][2];
    if constexpr (GATHER) {
#pragma unroll
        for (int i = 0; i < 2; ++i) { voffA0[i] = (unsigned)S.arow(cur, RA[i]) * (unsigned)KB + (unsigned)(CA[i] * 2); voffA1[i] = (unsigned)S.arow(cur, HALF + RA[i]) * (unsigned)KB + (unsigned)(CA[i] * 2); } }
    const char* cA = GATHER ? (const char*)g.A : (const char*)(cur.e && g.A2 ? g.A2 : g.A) + (size_t)cur.pm * tstepA; const char* cB = (const char*)(!GATHER && cur.e && g.Bt2 ? g.Bt2 : g.Bt) + (size_t)cur.pn * tstep;
    S.a_ready(cur);
    PG8_STAGE(PG8_SB(0, 0), cB, voffB); PG8_STAGE(PG8_SB(0, 1), cB + hstepB, voffB); PG8_STAGE(PG8_SA(0, 0), cA, voffA0); PG8_STAGE(PG8_SA(0, 1), cA, voffA1);
    if (wr == 1) PG8_BAR;
    PG8_WAIT_V(2); PG8_BAR;
    PG8_STAGE(PG8_SB(1, 0), cB + kstep, voffB); PG8_STAGE(PG8_SA(1, 0), cA + kstepA, voffA0); PG8_STAGE(PG8_SB(1, 1), cB + hstepB + kstep, voffB);
    PG8_WAIT_V(6); PG8_BAR;
    for (;;) {
        const bool has_next = S.next(ui + 1, nxt);
        const char* nA = GATHER ? cA : (has_next ? (const char*)(nxt.e && g.A2 ? g.A2 : g.A) + (size_t)nxt.pm * tstepA : cA); const char* nB = has_next ? (const char*)(!GATHER && nxt.e && g.Bt2 ? g.Bt2 : g.Bt) + (size_t)nxt.pn * tstep : cB;
        unsigned nvA0[2], nvA1[2];
#pragma unroll
        for (int i = 0; i < 2; ++i) { nvA0[i] = voffA0[i]; nvA1[i] = voffA1[i]; }
        if constexpr (GATHER) { if (has_next) {
#pragma unroll
            for (int i = 0; i < 2; ++i) { nvA0[i] = (unsigned)S.arow(nxt, RA[i]) * (unsigned)KB + (unsigned)(CA[i] * 2); nvA1[i] = (unsigned)S.arow(nxt, HALF + RA[i]) * (unsigned)KB + (unsigned)(CA[i] * 2); } } }
        for (int t = 0; t < nt; t += 2) {
            const bool last = (t == nt - 2);
            const char* a1 = cA + (size_t)(t + 1) * kstepA;
            const char* a2 = last ? nA : cA + (size_t)(t + 2) * kstepA; const char* b2 = last ? nB : cB + (size_t)(t + 2) * kstep;
            const char* a3 = a2 + kstepA; const char* b3 = b2 + kstep;
            if (last && has_next) S.a_ready(nxt);
            PG8_LDB(B0, 0, 0); PG8_LDB(B1, 0, 1); PG8_SCHED; PG8_LDA(At, 0, 0); PG8_STAGE(PG8_SA(1, 1), a1, voffA1);
            if constexpr (GATHER) { if (last) {
#pragma unroll
                for (int i = 0; i < 2; ++i) { voffA0[i] = nvA0[i]; voffA1[i] = nvA1[i]; } } }
            PG8_WAIT_V(8); PG8_WAIT_L(0); PG8_BAR; PG8_MMA(0, 0, At, B0); PG8_MMA(0, 1, At, B1); PG8_BAR; PG8_SCHED;
            PG8_LDA(At, 0, 1); PG8_STAGE(PG8_SB(0, 0), b2, voffB); PG8_STAGE(PG8_SB(0, 1), b2 + hstepB, voffB); PG8_STAGE(PG8_SA(0, 0), a2, voffA0);
            PG8_WAIT_V(8); PG8_WAIT_L(0); PG8_BAR; PG8_MMA(1, 0, At, B0); PG8_MMA(1, 1, At, B1); PG8_BAR; PG8_SCHED;
            PG8_LDB(B0, 1, 0); PG8_LDB(B1, 1, 1); PG8_SCHED; PG8_LDA(At, 1, 0); PG8_STAGE(PG8_SA(0, 1), a2, voffA1);
            PG8_WAIT_V(8); PG8_WAIT_L(0); PG8_BAR; PG8_MMA(0, 0, At, B0); PG8_MMA(0, 1, At, B1); PG8_BAR; PG8_SCHED;
            PG8_LDA(At, 1, 1); PG8_STAGE(PG8_SB(1, 0), b3, voffB); PG8_STAGE(PG8_SB(1, 1), b3 + hstepB, voffB); PG8_STAGE(PG8_SA(1, 0), a3, voffA0);
            PG8_WAIT_V(8); PG8_WAIT_L(0); PG8_BAR; PG8_MMA(1, 0, At, B0); PG8_MMA(1, 1, At, B1); PG8_BAR; PG8_SCHED;
        }
        if constexpr (ALIGN_EPI) { if (wr == 0) PG8_BAR; }
        E(acc, cur, wr, wc, fr, fq); S.done(cur);
        if (!has_next) break;
#pragma unroll
        for (int a = 0; a < 2; ++a)
#pragma unroll
            for (int b = 0; b < 2; ++b)
#pragma unroll
                for (int m = 0; m < 4; ++m)
#pragma unroll
                    for (int n = 0; n < 2; ++n) acc[a][b][m][n] = (f32x4){0.f, 0.f, 0.f, 0.f};
        cur = nxt; cA = nA; cB = nB; ++ui;
        if constexpr (ALIGN_EPI) { if (wr == 1) PG8_BAR; }
    }
    PG8_WAIT_V(0);
    if constexpr (!ALIGN_EPI) { if (wr == 0) PG8_BAR; }
    PG8_BAR;
#undef PG8_SA
#undef PG8_SB
#undef PG8_STAGE
#undef PG8_LDA
#undef PG8_LDB
#undef PG8_MMA
#undef PG8_WAIT_V
#undef PG8_WAIT_L
#undef PG8_BAR
#undef PG8_SCHED
}

__device__ __forceinline__ unsigned cvt_pk_bf16(float lo, float hi) { unsigned r; asm volatile("v_cvt_pk_bf16_f32 %0, %1, %2" : "=v"(r) : "v"(lo), "v"(hi)); return r; }
__device__ __forceinline__ float bf_lo(unsigned w) { return __uint_as_float(w << 16); }
__device__ __forceinline__ float bf_hi(unsigned w) { return __uint_as_float(w & 0xffff0000u); }
__device__ __forceinline__ float sigm(float x) { return __builtin_amdgcn_rcpf(1.f + __builtin_amdgcn_exp2f(-1.4426950408889634f * x)); }
__device__ __forceinline__ u32x4 pack8(const f32x4 v0, const f32x4 v1) { u32x4 w; w.x = cvt_pk_bf16(v0[0], v0[1]); w.y = cvt_pk_bf16(v0[2], v0[3]); w.z = cvt_pk_bf16(v1[0], v1[1]); w.w = cvt_pk_bf16(v1[2], v1[3]); return w; }
__device__ __forceinline__ void unpack8(const u32x4 w, f32x4& v0, f32x4& v1) { v0 = (f32x4){bf_lo(w.x), bf_hi(w.x), bf_lo(w.y), bf_hi(w.y)}; v1 = (f32x4){bf_lo(w.z), bf_hi(w.z), bf_lo(w.w), bf_hi(w.w)}; }

struct EpiProj {
    static constexpr bool PERM = true;
    bf16_t* O; const float* qg; const float* kg; int ldc; float qscale; int nostore, pad;
    __device__ __forceinline__ void operator()(f32x4 (&acc)[2][2][4][2], const Unit& u, int wr, int wc, int fr, int fq) const {
        const int row0 = u.pm * BM + wr * 64 + fr, col0 = u.pl * BM + wc * 64 + 8 * fq;
        if (u.pl >= 4 && u.pl <= 8) {
            const float* gp = (u.pl == 8 ? kg : qg) + 8 * fq; const float sc = (u.pl == 8) ? 1.f : qscale;
            f32x4 gv[2][2];
#pragma unroll
            for (int bj = 0; bj < 2; ++bj)
#pragma unroll
                for (int n = 0; n < 2; ++n) gv[bj][n] = *(const f32x4*)(gp + 32 * bj + 4 * n) * sc;
#pragma unroll
            for (int ai = 0; ai < 2; ++ai)
#pragma unroll
                for (int m = 0; m < 4; ++m) { float ss = 0.f;
#pragma unroll
                    for (int bj = 0; bj < 2; ++bj)
#pragma unroll
                        for (int n = 0; n < 2; ++n) { const f32x4 v = acc[ai][bj][m][n]; ss += (v[0] * v[0] + v[1] * v[1]) + (v[2] * v[2] + v[3] * v[3]); }
                    ss += __shfl_xor(ss, 16); ss += __shfl_xor(ss, 32);
                    const float rs = rsqrtf(ss * (1.f / 64.f) + 1e-5f);
#pragma unroll
                    for (int bj = 0; bj < 2; ++bj)
#pragma unroll
                        for (int n = 0; n < 2; ++n) acc[ai][bj][m][n] = acc[ai][bj][m][n] * rs * gv[bj][n]; }
        }
#pragma unroll
        for (int ai = 0; ai < 2; ++ai)
#pragma unroll
            for (int m = 0; m < 4; ++m) { bf16_t* rowp = O + (size_t)(row0 + ai * HALF + m * 16) * ldc + col0;
#pragma unroll
                for (int bj = 0; bj < 2; ++bj) { const u32x4 w = pack8(acc[ai][bj][m][0], acc[ai][bj][m][1]); if (!nostore) *(u32x4*)(rowp + bj * 32) = w; else asm volatile("" :: "v"(w)); } }
    }
};
struct EpiGlu {
    static constexpr bool PERM = true;
    bf16_t* O; int ldc, pad;
    __device__ __forceinline__ void operator()(f32x4 (&acc)[2][2][4][2], const Unit& u, int wr, int wc, int fr, int fq) const {
        const int row0 = u.pm * BM + wr * 64 + fr, col0 = u.pl * HALF + wc * 32 + 8 * fq;
#pragma unroll
        for (int ai = 0; ai < 2; ++ai)
#pragma unroll
            for (int m = 0; m < 4; ++m) { bf16_t* rowp = O + (size_t)(row0 + ai * HALF + m * 16) * ldc + col0;
                f32x4 o0, o1;
#pragma unroll
                for (int j = 0; j < 4; ++j) { o0[j] = acc[ai][0][m][0][j] * sigm(acc[ai][1][m][0][j]); o1[j] = acc[ai][0][m][1][j] * sigm(acc[ai][1][m][1][j]); }
                *(u32x4*)rowp = pack8(o0, o1); }
    }
};
struct EpiGate {
    static constexpr bool PERM = true;
    bf16_t* O; const bf16_t* G; int ldc, ldg, gcol0, gcol1;
    __device__ __forceinline__ void operator()(f32x4 (&acc)[2][2][4][2], const Unit& u, int wr, int wc, int fr, int fq) const {
        const int row0 = u.pm * BM + wr * 64 + fr, col0 = u.pl * BM + wc * 64 + 8 * fq; const bool add = u.e != 0; const int gcol = add ? gcol1 : gcol0;
#pragma unroll
        for (int ai = 0; ai < 2; ++ai) {
            u32x4 gw[4][2], ow[4][2];
#pragma unroll
            for (int m = 0; m < 4; ++m)
#pragma unroll
                for (int bj = 0; bj < 2; ++bj) { const size_t r = (size_t)(row0 + ai * HALF + m * 16);
                    gw[m][bj] = *(const u32x4*)(G + r * ldg + gcol + col0 + bj * 32);
                    if (add) ow[m][bj] = __builtin_nontemporal_load((const u32x4*)(O + r * ldc + col0 + bj * 32)); else ow[m][bj] = (u32x4){0u, 0u, 0u, 0u}; }
#pragma unroll
            for (int m = 0; m < 4; ++m)
#pragma unroll
                for (int bj = 0; bj < 2; ++bj) { const size_t r = (size_t)(row0 + ai * HALF + m * 16);
                    f32x4 g0, g1; unpack8(gw[m][bj], g0, g1);
                    f32x4 o0, o1, p0, p1; unpack8(ow[m][bj], p0, p1);
#pragma unroll
                    for (int j = 0; j < 4; ++j) { o0[j] = sigm(g0[j]) * acc[ai][bj][m][0][j] + p0[j]; o1[j] = sigm(g1[j]) * acc[ai][bj][m][1][j] + p1[j]; }
                    *(u32x4*)(O + r * ldc + col0 + bj * 32) = pack8(o0, o1); } }
    }
};
struct EpiResid {
    static constexpr bool PERM = false;
    const float* base; float* out; int ldc, pad;
    __device__ __forceinline__ void operator()(f32x4 (&acc)[2][2][4][2], const Unit& u, int wr, int wc, int fr, int fq) const {
        const int row0 = u.pm * BM + wr * 64 + fr, col0 = u.pl * BM + wc * 64 + 4 * fq;
#pragma unroll
        for (int ai = 0; ai < 2; ++ai) {
            f32x4 bv[4][2][2];
#pragma unroll
            for (int m = 0; m < 4; ++m) { const size_t off = (size_t)(row0 + ai * HALF + m * 16) * ldc + col0;
#pragma unroll
                for (int bj = 0; bj < 2; ++bj)
#pragma unroll
                    for (int n = 0; n < 2; ++n) bv[m][bj][n] = *(const f32x4*)(base + off + bj * 32 + n * 16); }
#pragma unroll
            for (int m = 0; m < 4; ++m) { const size_t off = (size_t)(row0 + ai * HALF + m * 16) * ldc + col0;
#pragma unroll
                for (int bj = 0; bj < 2; ++bj)
#pragma unroll
                    for (int n = 0; n < 2; ++n) *(f32x4*)(out + off + bj * 32 + n * 16) = bv[m][bj][n] + acc[ai][bj][m][n]; } }
    }
};
struct EpiSwiglu {
    static constexpr bool PERM = true;
    unsigned char* O; const float* bias; const int* list; int ldc, dff; float limit, alpha; int lstride, pad;
    __device__ __forceinline__ void operator()(f32x4 (&acc)[2][2][4][2], const Unit& u, int wr, int wc, int fr, int fq) const {
        const int col0 = u.pl * HALF + wc * 32 + 8 * fq;
        const float* bg = bias + (size_t)u.e * 2 * dff + col0; const float* bu = bg + dff;
        const f32x4 bg0 = *(const f32x4*)bg, bg1 = *(const f32x4*)(bg + 4), bu0 = *(const f32x4*)bu, bu1 = *(const f32x4*)(bu + 4);
        const int* lp = list + (size_t)u.e * lstride + u.pm * BM;
        int aidx[2][4];
#pragma unroll
        for (int ai = 0; ai < 2; ++ai)
#pragma unroll
            for (int m = 0; m < 4; ++m) { const int r = ai * HALF + wr * 64 + m * 16 + fr; aidx[ai][m] = lp[r < u.rows ? r : 0]; }
#pragma unroll
        for (int ai = 0; ai < 2; ++ai)
#pragma unroll
            for (int m = 0; m < 4; ++m) { const int r = ai * HALF + wr * 64 + m * 16 + fr;
                if (r < u.rows) { const int a = aidx[ai][m]; unsigned char* rowp = O + (size_t)a * ldc + col0;
                f32x4 o0, o1;
#pragma unroll
                for (int j = 0; j < 4; ++j) {
                    float gt = fminf(acc[ai][0][m][0][j] + bg0[j], limit), up = fminf(fmaxf(acc[ai][1][m][0][j] + bu0[j], -limit), limit);
                    o0[j] = (up + 1.f) * gt * sigm(alpha * gt);
                    gt = fminf(acc[ai][0][m][1][j] + bg1[j], limit); up = fminf(fmaxf(acc[ai][1][m][1][j] + bu1[j], -limit), limit);
                    o1[j] = (up + 1.f) * gt * sigm(alpha * gt); }
                int w0 = __builtin_amdgcn_cvt_pk_fp8_f32(o0[0], o0[1], 0, false); w0 = __builtin_amdgcn_cvt_pk_fp8_f32(o0[2], o0[3], w0, true);
                int w1 = __builtin_amdgcn_cvt_pk_fp8_f32(o1[0], o1[1], 0, false); w1 = __builtin_amdgcn_cvt_pk_fp8_f32(o1[2], o1[3], w1, true);
                *(unsigned long long*)rowp = (unsigned long long)(unsigned)w0 | ((unsigned long long)(unsigned)w1 << 32); } }
    }
};
struct EpiDown {
    static constexpr bool PERM = true;
    bf16_t* O; const float* bias; const int* list; int ldc, ncol, lstride, pad;
    __device__ __forceinline__ void operator()(f32x4 (&acc)[2][2][4][2], const Unit& u, int wr, int wc, int fr, int fq) const {
        const int col0 = u.pl * BM + wc * 64 + 8 * fq;
        const float* bp = bias + (size_t)u.e * ncol + col0;
        f32x4 bv[2][2];
#pragma unroll
        for (int bj = 0; bj < 2; ++bj) { bv[bj][0] = *(const f32x4*)(bp + bj * 32); bv[bj][1] = *(const f32x4*)(bp + bj * 32 + 4); }
        const int* lp = list + (size_t)u.e * lstride + u.pm * BM;
        int aidx[2][4];
#pragma unroll
        for (int ai = 0; ai < 2; ++ai)
#pragma unroll
            for (int m = 0; m < 4; ++m) { const int r = ai * HALF + wr * 64 + m * 16 + fr; aidx[ai][m] = lp[r < u.rows ? r : 0]; }
#pragma unroll
        for (int ai = 0; ai < 2; ++ai)
#pragma unroll
            for (int m = 0; m < 4; ++m) { const int r = ai * HALF + wr * 64 + m * 16 + fr;
                if (r < u.rows) { const int a = aidx[ai][m]; bf16_t* rowp = O + (size_t)a * ldc + col0;
#pragma unroll
                for (int bj = 0; bj < 2; ++bj) *(u32x4*)(rowp + bj * 32) = pack8(acc[ai][bj][m][0] + bv[bj][0], acc[ai][bj][m][1] + bv[bj][1]); } }
    }
};
struct GroupedOrder {
    static constexpr bool GATHER = true, FP8 = true;
    const PG8_LAS unsigned char* tile_e; const PG8_LAS int* pref; const PG8_LAS int* cnt; const int* list; int nN, G, c, nM, lstride, ashift;
    __device__ __forceinline__ bool next(int i, Unit& u) const {
        const int nwg = nM * nN; const long L = (long)i * G + c; if (L >= nwg) return false;
        int wgid = (int)L; { const int q = nwg / NXCD, r = nwg % NXCD, xcd = wgid % NXCD, off = wgid / NXCD; wgid = (xcd < r ? xcd * (q + 1) : r * (q + 1) + (xcd - r) * q) + off; }
        const int nig = WGM * nN, gid = wgid / nig, fm = gid * WGM, gsz = (nM - fm) < WGM ? (nM - fm) : WGM;
        const int mt = fm + ((wgid % nig) % gsz), pl = (wgid % nig) / gsz;
        const int e = tile_e[mt]; const int mtl = mt - pref[e]; const int left = cnt[e] - 256 * mtl;
        u.pm = mtl; u.pn = e * nN + pl; u.e = e; u.pl = pl; u.rows = left < 256 ? left : 256; return true;
    }
    __device__ __forceinline__ int arow(const Unit& u, int r) const { const int rr = r < u.rows ? r : u.rows - 1; return list[(size_t)u.e * lstride + u.pm * BM + rr] >> ashift; }
    __device__ __forceinline__ void a_ready(const Unit&) const {}
    __device__ __forceinline__ void done(const Unit&) const {}
};
struct DualOrder {
    static constexpr bool GATHER = false, FP8 = false;
    StaticOrder S; int nper;
    __device__ __forceinline__ void init(int M, int N, int G, int c) { S.init(M, N, G, c); nper = (S.nwg - c + G - 1) / G; if (nper < 0) nper = 0; }
    __device__ __forceinline__ bool next(int i, Unit& u) const { if (i >= 2 * nper) return false; const int e = i >= nper ? 1 : 0; const bool ok = S.next(i - e * nper, u); u.e = e; return ok; }
    __device__ __forceinline__ void a_ready(const Unit&) const {}
    __device__ __forceinline__ void done(const Unit&) const {}
};
}

#define GAS __attribute__((address_space(1)))
#define LAS __attribute__((address_space(3)))
typedef unsigned short bf16;
typedef unsigned v4u __attribute__((ext_vector_type(4)));
typedef float f32x4 __attribute__((ext_vector_type(4)));
typedef short bf16x8 __attribute__((ext_vector_type(8)));
typedef GAS unsigned gu32;
typedef GAS unsigned long long gu64;
#define RLX_AGENT __ATOMIC_RELAXED, __HIP_MEMORY_SCOPE_AGENT
#define LDS_WAIT() asm volatile("s_waitcnt lgkmcnt(0)" ::: "memory")
#define VM_WAIT() asm volatile("s_waitcnt vmcnt(0)" ::: "memory")
__device__ __forceinline__ unsigned long long rt() { return __builtin_amdgcn_s_memrealtime(); }
__device__ __forceinline__ unsigned f2bf(float f) { unsigned u = __builtin_bit_cast(unsigned, f); return (u + 0x7fffu + ((u >> 16) & 1u)) >> 16; }
__device__ __forceinline__ unsigned pk2(float lo, float hi) { return f2bf(lo) | (f2bf(hi) << 16); }

#define XB_TMO      128
#define XB_XCNT(j)  (256  + 64 * (j))
#define XB_XSUB(j)  (1280 + 64 * (j))
#define XB_XGEN(j)  (2304 + 64 * (j))
#define XB_TOP      3328
#define XB_TOPGEN   3392
#define XCD_BAR_WORDS 3456
#define XB_SPIN_CAP (1u << 18)

__device__ __forceinline__ unsigned xb_ld(unsigned* p)              { return __hip_atomic_load(p, __ATOMIC_RELAXED, __HIP_MEMORY_SCOPE_AGENT); }
__device__ __forceinline__ unsigned xb_add(unsigned* p, unsigned v) { return __hip_atomic_fetch_add(p, v, __ATOMIC_RELAXED, __HIP_MEMORY_SCOPE_AGENT); }
__device__ __forceinline__ unsigned xb_xcc_id() { return (unsigned)__builtin_amdgcn_s_getreg((3 << 11) | 20) & 0xFu; }
#define XB_SPIN(cond, bar) do { unsigned _sp = 0; while (cond) { __builtin_amdgcn_s_sleep(1); \
    if ((++_sp & 255u) == 0u) { if (xb_ld(&(bar)[XB_TMO])) break; if (_sp > XB_SPIN_CAP) { atomicAdd(&(bar)[XB_TMO], 1u); break; } } } } while (0)

struct XcdBarrier {
    unsigned* bar; unsigned x;
    volatile LAS unsigned* st;
};

__device__ __forceinline__ XcdBarrier xcd_barrier_post(unsigned* bar, volatile LAS unsigned* st) {
    XcdBarrier b; b.bar = bar; b.x = xb_xcc_id(); b.st = st;
    if (threadIdx.x == 0) (void)xb_add(&bar[XB_XCNT(b.x)], 1u);
    return b;
}
__device__ __forceinline__ void xcd_barrier_complete(unsigned* bar, unsigned x, unsigned& nloc, unsigned& nx) {
    const unsigned G = gridDim.x * gridDim.y * gridDim.z;
    unsigned sum, cnt, mine, sp = 0u;
    for (;;) {
        sum = 0u; cnt = 0u; mine = 0u;
#pragma unroll
        for (unsigned j = 0; j < 16; ++j) { const unsigned c = xb_ld(&bar[XB_XCNT(j)]); sum += c; cnt += (c > 0u) ? 1u : 0u; mine = (j == x) ? c : mine; }
        if (sum == G) break;
        __builtin_amdgcn_s_sleep(1);
        if ((++sp & 255u) == 0u) { if (xb_ld(&bar[XB_TMO])) break; if (sp > XB_SPIN_CAP) { atomicAdd(&bar[XB_TMO], 1u); break; } }
    }
    nloc = mine > 0u ? mine : 1u; nx = cnt > 0u ? cnt : 1u;
}

__device__ __forceinline__ void xcd_barrier(const XcdBarrier& b) {
    asm volatile("s_waitcnt vmcnt(0)" ::: "memory");
    __syncthreads();
    if (threadIdx.x == 0) {
        unsigned* bar = b.bar;
        __builtin_amdgcn_s_waitcnt(0);
        unsigned nloc = b.st[0], nx = b.st[1];
        if (nloc == 0u) { xcd_barrier_complete(bar, b.x, nloc, nx); b.st[0] = nloc; b.st[1] = nx; }
        const unsigned old = xb_add(&bar[XB_XSUB(b.x)], 1u);
        const unsigned gen = old / nloc;
        if (old + 1u == (gen + 1u) * nloc) {
            __builtin_amdgcn_fence(__ATOMIC_RELEASE, "agent");
            asm volatile("s_waitcnt vmcnt(0)" ::: "memory");
            const unsigned og = xb_add(&bar[XB_TOP], 1u);
            const unsigned tg = og / nx;
            if (og + 1u == (tg + 1u) * nx) xb_add(&bar[XB_TOPGEN], 1u);
            else XB_SPIN(xb_ld(&bar[XB_TOPGEN]) == tg, bar);
            __builtin_amdgcn_fence(__ATOMIC_ACQUIRE, "agent");
            xb_add(&bar[XB_XGEN(b.x)], 1u);
            asm volatile("s_waitcnt vmcnt(0)" ::: "memory");
        } else {
            XB_SPIN(xb_ld(&bar[XB_XGEN(b.x)]) == gen, bar);
            __builtin_amdgcn_fence(__ATOMIC_ACQUIRE, "agent");
            asm volatile("s_waitcnt vmcnt(0)" ::: "memory");
        }
    }
    __syncthreads();
}

constexpr size_t MiB = 1u << 20;
constexpr size_t WS_CTL = 0;
constexpr size_t CTL_ZERO_BYTES = 65536;
constexpr size_t WS_WIN = 1 * MiB, WS_WGLU = 10 * MiB, WS_WSSM = 14 * MiB, WS_WATT = 16 * MiB, WS_WOUT = 18 * MiB;
constexpr size_t WS_WGU = 20 * MiB, WS_WDN = 148 * MiB;
constexpr float WSCALE = 64.f; constexpr int WSCALE_E8M0 = 127 - 6;
constexpr size_t WS_ROUTE = 216 * MiB;
constexpr size_t WS_H = 224 * MiB;
constexpr size_t WS_PROJ = 288 * MiB;
constexpr size_t WS_S5OUT = 576 * MiB;
constexpr size_t WS_ATTN = 640 * MiB;
constexpr size_t WS_ACT = 704 * MiB;
constexpr size_t WS_BTAB = 976 * MiB, WS_CTAB = 980 * MiB, WS_KTAB = 984 * MiB, WS_A16 = 985 * MiB;
constexpr size_t WS_END = 986 * MiB;
static_assert(WS_PROJ + (size_t)T * IN_W * 2 <= WS_S5OUT && WS_PROJ + (size_t)NA * 1024 * 2 <= WS_S5OUT && WS_ACT + (size_t)NA * 1024 * 2 <= WS_BTAB, "ws map");
constexpr int CW_CNT = 0;
constexpr int CW_BAR = 4096;
static_assert((CW_BAR + 3 * XCD_BAR_WORDS) * 4 <= (int)CTL_ZERO_BYTES, "ctl map");
constexpr size_t RT_TOPW = 0, RT_LIST = 1 * MiB;

constexpr int LDS_BYTES = 163840;
constexpr int RING_OFF = 0;
constexpr int MISC_OFF = LDS_BYTES - 256;
constexpr int GT_OFF = 131072;

__device__ __forceinline__ float bf2f(bf16 b) { return __uint_as_float((unsigned)b << 16); }
__device__ __forceinline__ float wave_sum(float v) {
#pragma unroll
    for (int o = 1; o < 64; o <<= 1) v += __shfl_xor(v, o);
    return v;
}
__device__ __forceinline__ float wave_max(float v) {
#pragma unroll
    for (int o = 1; o < 64; o <<= 1) v = fmaxf(v, __shfl_xor(v, o));
    return v;
}
__device__ __forceinline__ float gelu_tanh(float x) { const float z = -2.3022081985f * (x + 0.044715f * x * x * x); return x * __builtin_amdgcn_rcpf(1.f + __builtin_amdgcn_exp2f(z)); }
#define WAVE_SYNC() do { __builtin_amdgcn_wave_barrier(); asm volatile("s_waitcnt lgkmcnt(0)" ::: "memory"); } while (0)

struct Args { const float* in[25]; float* out; unsigned char* ws; int ph_lo, ph_hi, bar_idx, sub; };
struct Ctx { int tid, lane, wave, vcu, G, gw, ngw; LAS unsigned char* lds; };

constexpr int TR_SCR = 64 * 65 * 4;
__device__ __forceinline__ void transpose_item(const float* W, int K, int N, bf16* WT, int mode, LAS float* scr, int item, int lane) {
    const int nblk = N / 64, kb = item / nblk, nb = item % nblk, k0 = 64 * kb, n0 = 64 * nb;
#pragma unroll 4
    for (int i = 0; i < 16; ++i) { const int kk = 4 * i + (lane >> 4), nn = 4 * (lane & 15); const f32x4 w = *(const f32x4*)(W + (size_t)(k0 + kk) * N + n0 + nn);
        LAS float* s = scr + kk * 65 + nn; s[0] = w.x; s[1] = w.y; s[2] = w.z; s[3] = w.w; }
    LDS_WAIT(); asm volatile("" ::: "memory");
    const int c = lane & 7;
#pragma unroll
    for (int j = 0; j < 8; ++j) { const int n = (lane >> 3) + 8 * j; const LAS float* s = scr + (8 * c) * 65 + n;
        v4u o; o.x = pk2(s[0 * 65], s[1 * 65]); o.y = pk2(s[2 * 65], s[3 * 65]); o.z = pk2(s[4 * 65], s[5 * 65]); o.w = pk2(s[6 * 65], s[7 * 65]);
        int r = n0 + n;
        if (mode == 1) { const int nh = N / 2, hf = (r >= nh) ? 1 : 0, np = r - hf * nh; r = 256 * (np / 128) + 64 * ((np % 128) / 32) + 32 * hf + (np % 32); }
        *(v4u*)(WT + (size_t)r * K + k0 + 8 * c) = o; }
    LDS_WAIT(); asm volatile("" ::: "memory");
}
__device__ __forceinline__ void transpose_item_fp8(const float* W, int K, int N, unsigned char* WT, int mode, float wscale, LAS float* scr, int item, int lane) {
    const int nblk = N / 64, kb = item / nblk, nb = item % nblk, k0 = 64 * kb, n0 = 64 * nb;
#pragma unroll 4
    for (int i = 0; i < 16; ++i) { const int kk = 4 * i + (lane >> 4), nn = 4 * (lane & 15); const f32x4 w = *(const f32x4*)(W + (size_t)(k0 + kk) * N + n0 + nn);
        LAS float* s = scr + kk * 65 + nn; s[0] = w.x; s[1] = w.y; s[2] = w.z; s[3] = w.w; }
    LDS_WAIT(); asm volatile("" ::: "memory");
    const int c = lane & 3;
#pragma unroll
    for (int j = 0; j < 4; ++j) { const int n = (lane >> 2) + 16 * j; const LAS float* s = scr + (16 * c) * 65 + n;
        v4u o;
#pragma unroll
        for (int q = 0; q < 4; ++q) { int w = __builtin_amdgcn_cvt_pk_fp8_f32(s[(4 * q) * 65] * wscale, s[(4 * q + 1) * 65] * wscale, 0, false); w = __builtin_amdgcn_cvt_pk_fp8_f32(s[(4 * q + 2) * 65] * wscale, s[(4 * q + 3) * 65] * wscale, w, true); o[q] = (unsigned)w; }
        int r = n0 + n;
        if (mode == 1) { const int nh = N / 2, hf = (r >= nh) ? 1 : 0, np = r - hf * nh; r = 256 * (np / 128) + 64 * ((np % 128) / 32) + 32 * hf + (np % 32); }
        *(v4u*)(WT + (size_t)r * K + k0 + 16 * c) = o; }
    LDS_WAIT(); asm volatile("" ::: "memory");
}
__device__ __forceinline__ void transpose_job_fp8(const Ctx& C, const float* W, unsigned char* WT, int K, int N, int mode, int nmat, float wscale) {
    LAS float* scr = (LAS float*)(C.lds + RING_OFF + C.wave * TR_SCR);
    const int per = (K / 64) * (N / 64); const int total = per * nmat;
    for (int it = C.gw; it < total; it += C.ngw) { const int mat = it / per, item = it % per;
        transpose_item_fp8(W + (size_t)mat * K * N, K, N, WT + (size_t)mat * K * N, mode, wscale, scr, item, C.lane); }
}
__device__ __forceinline__ void transpose_job(const Ctx& C, const float* W, bf16* WT, int K, int N, int mode, int nmat) {
    LAS float* scr = (LAS float*)(C.lds + RING_OFF + C.wave * TR_SCR);
    const int per = (K / 64) * (N / 64); const int total = per * nmat;
    for (int it = C.gw; it < total; it += C.ngw) { const int mat = it / per, item = it % per;
        transpose_item(W + (size_t)mat * K * N, K, N, WT + (size_t)mat * K * N, mode, scr, item, C.lane); }
}
__device__ __forceinline__ void rmsnorm_rows(const Ctx& C, const float* x, const float* g, bf16* out) {
    for (int m = C.gw; m < T; m += C.ngw) {
        const f32x4* xr = (const f32x4*)(x + (size_t)m * DM) + C.lane; f32x4 v[4]; float s = 0.f;
#pragma unroll
        for (int j = 0; j < 4; ++j) { v[j] = xr[64 * j]; s += (v[j].x * v[j].x + v[j].y * v[j].y) + (v[j].z * v[j].z + v[j].w * v[j].w); }
        const float rs = rsqrtf(wave_sum(s) * (1.f / DM) + EPS);
        unsigned long long* o8 = (unsigned long long*)(out + (size_t)m * DM) + C.lane;
#pragma unroll
        for (int j = 0; j < 4; ++j) { const f32x4 gg = ((const f32x4*)g)[64 * j + C.lane];
            o8[64 * j] = (unsigned long long)pk2(v[j].x * rs * gg.x, v[j].y * rs * gg.y) | ((unsigned long long)pk2(v[j].z * rs * gg.z, v[j].w * rs * gg.w) << 32); }
    }
}
__device__ __forceinline__ void router_pass(const Ctx& C, const float* x1, const float* g2, const float* w_router, const float* b_router, unsigned char* h2, float* top_w, int* list, unsigned* ctl) {
    LAS float* HN = (LAS float*)(C.lds + RING_OFF); LAS float* PART = HN + 16 * 1024; LAS unsigned* HIST = (LAS unsigned*)(PART + 8 * 2 * 16 * 32); LAS unsigned* BASE = HIST + 32; LAS unsigned* RK = BASE + 32;
    LAS unsigned char* EIDS = (LAS unsigned char*)(RK + 32);
    int tid = C.tid; asm volatile("" : "+v"(tid));
    const int lane = tid & 63, wave = C.wave, e = lane & 31, dh = lane >> 5;
    float wreg[64];
#pragma unroll
    for (int i = 0; i < 64; ++i) wreg[i] = w_router[(size_t)(128 * wave + 64 * dh + i) * NE + e];
    const float bias = b_router[e];
    if (tid < 32) HIST[tid] = 0u;
    __syncthreads();
    int nrounds = 0;
    f32x4 vn[2][4];
    if (C.vcu < T / 16) {
#pragma unroll
        for (int q = 0; q < 2; ++q) { const f32x4* xr = (const f32x4*)(x1 + (size_t)(C.vcu * 16 + 2 * wave + q) * DM) + lane;
#pragma unroll
            for (int j = 0; j < 4; ++j) vn[q][j] = xr[64 * j]; } }
    for (int grp = C.vcu; grp < T / 16; grp += C.G, ++nrounds) {
        f32x4 v[2][4];
#pragma unroll
        for (int q = 0; q < 2; ++q)
#pragma unroll
            for (int j = 0; j < 4; ++j) v[q][j] = vn[q][j];
        if (grp + C.G < T / 16) {
#pragma unroll
            for (int q = 0; q < 2; ++q) { const f32x4* xr = (const f32x4*)(x1 + (size_t)((grp + C.G) * 16 + 2 * wave + q) * DM) + lane;
#pragma unroll
                for (int j = 0; j < 4; ++j) vn[q][j] = xr[64 * j]; } }
#pragma unroll
        for (int q = 0; q < 2; ++q) { const int tl = 2 * wave + q; float s = 0.f;
#pragma unroll
            for (int j = 0; j < 4; ++j) s += (v[q][j].x * v[q][j].x + v[q][j].y * v[q][j].y) + (v[q][j].z * v[q][j].z + v[q][j].w * v[q][j].w);
            const float rs = rsqrtf(wave_sum(s) * (1.f / DM) + EPS);
            int* o4 = (int*)(h2 + (size_t)(grp * 16 + tl) * DM) + lane;
#pragma unroll
            for (int j = 0; j < 4; ++j) { const f32x4 gg = ((const f32x4*)g2)[64 * j + lane];
                const f32x4 y = (f32x4){v[q][j].x * rs * gg.x, v[q][j].y * rs * gg.y, v[q][j].z * rs * gg.z, v[q][j].w * rs * gg.w};
                *(LAS f32x4*)(HN + tl * 1024 + 256 * j + 4 * lane) = y;
                int w = __builtin_amdgcn_cvt_pk_fp8_f32(y.x, y.y, 0, false); w = __builtin_amdgcn_cvt_pk_fp8_f32(y.z, y.w, w, true); o4[64 * j] = w; } }
        __syncthreads();
        const LAS float* hb = HN + 128 * wave + 64 * dh;
#pragma unroll 1
        for (int t = 0; t < 16; t += 4) { float a0 = 0.f, a1 = 0.f, a2 = 0.f, a3 = 0.f;
#pragma unroll
            for (int i4 = 0; i4 < 16; ++i4) {
                const f32x4 h0 = *(const LAS f32x4*)(hb + (t + 0) * 1024 + 4 * i4), h1 = *(const LAS f32x4*)(hb + (t + 1) * 1024 + 4 * i4), h2v = *(const LAS f32x4*)(hb + (t + 2) * 1024 + 4 * i4), h3 = *(const LAS f32x4*)(hb + (t + 3) * 1024 + 4 * i4);
                a0 += h0.x * wreg[4 * i4] + h0.y * wreg[4 * i4 + 1] + h0.z * wreg[4 * i4 + 2] + h0.w * wreg[4 * i4 + 3];
                a1 += h1.x * wreg[4 * i4] + h1.y * wreg[4 * i4 + 1] + h1.z * wreg[4 * i4 + 2] + h1.w * wreg[4 * i4 + 3];
                a2 += h2v.x * wreg[4 * i4] + h2v.y * wreg[4 * i4 + 1] + h2v.z * wreg[4 * i4 + 2] + h2v.w * wreg[4 * i4 + 3];
                a3 += h3.x * wreg[4 * i4] + h3.y * wreg[4 * i4 + 1] + h3.z * wreg[4 * i4 + 2] + h3.w * wreg[4 * i4 + 3]; }
            LAS float* pp = PART + ((wave * 2 + dh) * 16 + t) * 32 + e; pp[0] = a0; pp[32] = a1; pp[64] = a2; pp[96] = a3; }
        __syncthreads();
#pragma unroll 1
        for (int q = 0; q < 2; ++q) { const int tl = 2 * wave + q; float acc = 0.f;
#pragma unroll
            for (int w8 = 0; w8 < 8; ++w8) acc += PART[((4 * dh * 2 + w8) * 16 + tl) * 32 + e];
            acc += __shfl_xor(acc, 32);
            float logit = acc + bias;
            float tv[4]; int ti[4];
#pragma unroll
            for (int k = 0; k < 4; ++k) { const float mx = wave_max(logit); const unsigned long long bal = __ballot(logit == mx); const int idx = (__ffsll((long long)bal) - 1) & 31;
                tv[k] = mx; ti[k] = idx; if (e == idx) logit = -INFINITY; }
            const float e1 = __expf(tv[1] - tv[0]), e2 = __expf(tv[2] - tv[0]), e3 = __expf(tv[3] - tv[0]); const float inv = 1.f / (1.f + e1 + e2 + e3);
            if (lane < 4) { const int k = lane; const int ei = k == 0 ? ti[0] : k == 1 ? ti[1] : k == 2 ? ti[2] : ti[3]; const float wv = (k == 0 ? 1.f : k == 1 ? e1 : k == 2 ? e2 : e3) * inv;
                top_w[(size_t)(grp * 16 + tl) * 4 + k] = wv; EIDS[(nrounds * 16 + tl) * 4 + k] = (unsigned char)ei;
                __hip_atomic_fetch_add(HIST + ei, 1u, __ATOMIC_RELAXED, __HIP_MEMORY_SCOPE_WORKGROUP); } }
    }
    __syncthreads();
    if (tid < 32) { BASE[tid] = atomicAdd(ctl + CW_CNT + tid, HIST[tid]); RK[tid] = 0u; }
    __syncthreads();
    for (int idx = tid; idx < nrounds * 64; idx += 512) { const int ei = EIDS[idx]; const unsigned rank = __hip_atomic_fetch_add(RK + ei, 1u, __ATOMIC_RELAXED, __HIP_MEMORY_SCOPE_WORKGROUP);
        const int r = idx >> 6, tl = (idx >> 2) & 15, k = idx & 3; list[(size_t)ei * T + BASE[ei] + rank] = ((C.vcu + r * C.G) * 16 + tl) * 4 + k; }
    __syncthreads();
}
__device__ __forceinline__ int grouped_tables(const Ctx& C, const unsigned* ctl) {
    LAS int* cnt = (LAS int*)(C.lds + GT_OFF); LAS int* pref = cnt + 32; LAS unsigned char* tile_e = (LAS unsigned char*)(pref + 36);
    if (C.tid == 0) { int run = 0;
        for (int e = 0; e < NE; ++e) { const int c = (int)__hip_atomic_load(ctl + CW_CNT + e, RLX_AGENT); cnt[e] = c; pref[e] = run; const int n = (c + 255) >> 8; for (int i = 0; i < n; ++i) tile_e[run + i] = (unsigned char)e; run += n; }
        pref[NE] = run; }
    __syncthreads();
    return pref[NE];
}
__device__ __forceinline__ void combine_pass(const Ctx& C, float* out, const bf16* ys, const float* top_w) {
    const int lane = C.lane;
    for (int tok = C.gw; tok < T; tok += C.ngw) {
        f32x4* o = (f32x4*)(out + (size_t)tok * DM);
        f32x4 acc[4];
#pragma unroll
        for (int j = 0; j < 4; ++j) acc[j] = o[64 * j + lane];
        const f32x4 wv4 = *(const f32x4*)(top_w + (size_t)tok * 4);
#pragma unroll
        for (int k = 0; k < 4; ++k) { const float wv = wv4[k]; const unsigned long long* y8 = (const unsigned long long*)(ys + ((size_t)tok * 4 + k) * DM);
#pragma unroll
            for (int j = 0; j < 4; ++j) { const unsigned long long q = y8[64 * j + lane]; const unsigned lo = (unsigned)q, hi = (unsigned)(q >> 32);
                acc[j].x += wv * __uint_as_float(lo << 16); acc[j].y += wv * __uint_as_float(lo & 0xffff0000u); acc[j].z += wv * __uint_as_float(hi << 16); acc[j].w += wv * __uint_as_float(hi & 0xffff0000u); } }
#pragma unroll
        for (int j = 0; j < 4; ++j) o[64 * j + lane] = acc[j];
    }
}

namespace att {
using bf16x8 = __attribute__((ext_vector_type(8))) short;
using s16x4 = __attribute__((ext_vector_type(4))) short;
using f32x16 = __attribute__((ext_vector_type(16))) float;
using u32x4 = __attribute__((ext_vector_type(4))) unsigned;
typedef float f32x2_t __attribute__((ext_vector_type(2))); typedef __bf16 bf16x2_t __attribute__((ext_vector_type(2)));
constexpr float LOG2E = 1.4426950408889634f, QSCALE = 0.125f * LOG2E;
constexpr int SLOTB = 8192, NSLOT = 4;
constexpr int L_K = 0, L_V = NSLOT * SLOTB, L_WS = 2 * NSLOT * SLOTB, L_OST = L_WS + 8 * 256, L_BYTES = L_OST + 8 * 4096;
__device__ __forceinline__ int crow(int r, int hi) { return (r & 3) + 8 * (r >> 2) + 4 * hi; }
__device__ __forceinline__ void glds16(const void* gsrc, unsigned lds_dst) { unsigned keep;
    asm volatile("s_mov_b32 %0, m0\n\ts_mov_b32 m0, %2\n\ts_nop 0\n\tglobal_load_lds_dwordx4 %1, off\n\ts_mov_b32 m0, %0" : "=&s"(keep) : "v"(gsrc), "s"(lds_dst) : "memory"); }
__device__ __forceinline__ unsigned cvtpk_s(float lo, float hi) { f32x2_t v = {lo, hi}; bf16x2_t b = __builtin_convertvector(v, bf16x2_t); return __builtin_bit_cast(unsigned, b); }
typedef __attribute__((address_space(3))) const char* lds_cptr;
__device__ __forceinline__ void qkt_half(f32x16& p, lds_cptr kb, const bf16x8* qr) {
    const f32x16 z = f32x16{};
#pragma unroll
    for (int d0 = 0; d0 < 4; ++d0) {
        const bf16x8 b0 = *(const __attribute__((address_space(3))) bf16x8*)(kb + d0 * 2048);
        p = __builtin_amdgcn_mfma_f32_32x32x16_bf16(b0, qr[d0], d0 == 0 ? z : p, 0, 0, 0); }
}
__device__ __forceinline__ void pv_half(f32x16* o, int vb, bf16x8 pa0, bf16x8 pa1) {
#pragma unroll
    for (int d0 = 0; d0 < 2; ++d0) { s16x4 lo[2], hi[2];
#pragma unroll
        for (int ks = 0; ks < 2; ++ks) {
            asm volatile("ds_read_b64_tr_b16 %0,%1 offset:%c2" : "=&v"(lo[ks]) : "v"(vb), "i"(d0 * 4096 + ks * 1024) : "memory");
            asm volatile("ds_read_b64_tr_b16 %0,%1 offset:%c2" : "=&v"(hi[ks]) : "v"(vb), "i"(d0 * 4096 + ks * 1024 + 512) : "memory"); }
        asm volatile("s_waitcnt lgkmcnt(0)" ::: "memory"); __builtin_amdgcn_sched_barrier(0);
#define ATT_PK(k) (bf16x8){lo[k][0], lo[k][1], lo[k][2], lo[k][3], hi[k][0], hi[k][1], hi[k][2], hi[k][3]}
        o[d0] = __builtin_amdgcn_mfma_f32_32x32x16_bf16(pa0, ATT_PK(0), o[d0], 0, 0, 0);
        o[d0] = __builtin_amdgcn_mfma_f32_32x32x16_bf16(pa1, ATT_PK(1), o[d0], 0, 0, 0);
#undef ATT_PK
    }
}
__device__ __forceinline__ void dma_tile(const bf16* proj, int b, int kvh, int ti, unsigned lds0, int wid, int lane) {
    const unsigned slot = (unsigned)((ti + 2) & 3) * SLOTB;
    int kr = 64 * ti + lane; kr = kr < 0 ? 0 : kr;
    int vr = 64 * ti + 16 * (wid & 3) + (lane >> 2); vr = vr < 0 ? 0 : vr;
    const bf16* ksrc = proj + (size_t)(b * SEQ + kr) * IN_W + C_K + kvh * 64 + wid * 8;
    const bf16* vsrc = proj + (size_t)(b * SEQ + vr) * IN_W + C_V + kvh * 64 + (wid >> 2) * 32 + (lane & 3) * 8;
    glds16(ksrc, (unsigned)__builtin_amdgcn_readfirstlane(lds0 + L_K + slot + wid * 1024));
    glds16(vsrc, (unsigned)__builtin_amdgcn_readfirstlane(lds0 + L_V + slot + wid * 1024));
}
#define ATT_WAIT_BAR() asm volatile("s_waitcnt vmcnt(0) lgkmcnt(0)\n\ts_barrier" ::: "memory")
__device__ __forceinline__ void attn_run(int b, int kvh, int qb0, int nqb, const bf16* proj, const float* sinks, bf16* O, LAS unsigned char* shm) {
    const int tid = threadIdx.x, lane = tid & 63, r32 = lane & 31, hi = lane >> 5; const int wid = __builtin_amdgcn_readfirstlane(tid >> 6);
    const int h = kvh * 4 + (wid & 3), sub = wid >> 2;
    const unsigned lds0 = (unsigned)(uintptr_t)shm;
    LAS float* wsf = (LAS float*)(shm + L_WS) + wid * 64;
    const lds_cptr shm3 = (lds_cptr)shm;
    const int vb0 = (int)(lds0 + L_V) + ((lane >> 4) & 1) * 32 + (lane & 3) * 8 + (4 * hi + ((lane & 15) >> 2)) * 64;
    const float slope2 = exp2f(-0.5f * (float)(h + 1)) * LOG2E, sink2 = sinks[h] * LOG2E;
    dma_tile(proj, b, kvh, qb0 - 2, lds0, wid, lane); dma_tile(proj, b, kvh, qb0 - 1, lds0, wid, lane); dma_tile(proj, b, kvh, qb0, lds0, wid, lane);
    const bf16* Qw = proj + (size_t)(b * SEQ + qb0 * 64 + 32 * sub + r32) * IN_W + C_Q + h * 64 + hi * 8;
    bf16x8 qn[4];
#pragma unroll
    for (int d0 = 0; d0 < 4; ++d0) qn[d0] = *(const bf16x8*)(Qw + d0 * 16);
    for (int qi = 0; qi < nqb; ++qi) {
        const int qb = qb0 + qi, tq0 = qb * 64 + 32 * sub;
        bf16x8 qr[4];
#pragma unroll
        for (int d0 = 0; d0 < 4; ++d0) qr[d0] = qn[d0];
        ATT_WAIT_BAR();
        if (qi + 1 < nqb) dma_tile(proj, b, kvh, qb + 1, lds0, wid, lane);
        f32x16 p[5];
#pragma unroll
        for (int i = 0; i < 5; ++i) { const int g = i + sub; qkt_half(p[i], shm3 + L_K + ((qb + (g >> 1)) & 3) * SLOTB + (g & 1) * 512 + hi * 1024 + r32 * 16, qr); }
        if (qi + 1 < nqb) {
#pragma unroll
            for (int d0 = 0; d0 < 4; ++d0) qn[d0] = *(const bf16x8*)(Qw + (size_t)(64 * (qi + 1)) * IN_W + d0 * 16); }
        float dbase = (float)(128 + r32 - 4 * hi); asm volatile("" : "+v"(dbase));
        const float dmax = (float)(tq0 + r32);
        float mx = -INFINITY;
#pragma unroll
        for (int i = 0; i < 5; ++i)
#pragma unroll
            for (int r = 0; r < 16; ++r) { const float d = dbase - (float)(32 * i + (r & 3) + 8 * (r >> 2));
                float v = p[i][r] - slope2 * d;
                if (i == 0) v = (d < 128.f) ? v : -INFINITY;
                if (i == 4) v = (d >= 0.f) ? v : -INFINITY;
                if (qb < 2) v = (d <= dmax) ? v : -INFINITY;
                p[i][r] = v; mx = fmaxf(mx, v); }
        { auto rr = __builtin_amdgcn_permlane32_swap(__float_as_uint(mx), __float_as_uint(mx), false, false); mx = fmaxf(__uint_as_float(rr[0]), __uint_as_float(rr[1])); }
        mx = fmaxf(mx, sink2);
        float ls = 0.f;
        f32x16 o[2]; o[0] = f32x16{}; o[1] = f32x16{};
#pragma unroll
        for (int i = 0; i < 5; ++i) { const int g = i + sub;
#pragma unroll
            for (int r = 0; r < 16; ++r) { const float e = __builtin_amdgcn_exp2f(p[i][r] - mx); p[i][r] = e; ls += e; }
            u32x4 pw0, pw1;
#define ATT_PKW(P, B) cvtpk_s(P[B], P[B + 1])
            pw0 = (u32x4){ATT_PKW(p[i], 0), ATT_PKW(p[i], 2), ATT_PKW(p[i], 4), ATT_PKW(p[i], 6)}; pw1 = (u32x4){ATT_PKW(p[i], 8), ATT_PKW(p[i], 10), ATT_PKW(p[i], 12), ATT_PKW(p[i], 14)};
#undef ATT_PKW
            __builtin_amdgcn_sched_barrier(0);
            pv_half(o, vb0 + ((qb + (g >> 1)) & 3) * SLOTB + (g & 1) * 2048, __builtin_bit_cast(bf16x8, pw0), __builtin_bit_cast(bf16x8, pw1));
        }
        { auto rr = __builtin_amdgcn_permlane32_swap(__float_as_uint(ls), __float_as_uint(ls), false, false); ls = __uint_as_float(rr[0]) + __uint_as_float(rr[1]); }
        ls += __builtin_amdgcn_exp2f(sink2 - mx);
        if (hi == 0) wsf[32 + r32] = ls;
        asm volatile("s_waitcnt lgkmcnt(0)" ::: "memory");
        float rli[16];
#pragma unroll
        for (int r = 0; r < 16; ++r) rli[r] = __builtin_amdgcn_rcpf(wsf[32 + crow(r, hi)]);
        bf16* Ow = O + (size_t)(b * SEQ + tq0) * 1024 + h * 64;
        { LAS bf16* stg = (LAS bf16*)(shm + L_OST) + wid * 2048;
#pragma unroll
            for (int r = 0; r < 16; ++r) { const int orow = crow(r, hi);
#pragma unroll
                for (int d0 = 0; d0 < 2; ++d0) stg[orow * 64 + d0 * 32 + r32] = (bf16)f2bf(o[d0][r] * rli[r]); }
            asm volatile("s_waitcnt lgkmcnt(0)" ::: "memory");
#pragma unroll
            for (int i = 0; i < 4; ++i) { const int row = i * 8 + (lane >> 3), ch = lane & 7; const u32x4 v = *(const LAS u32x4*)(stg + row * 64 + ch * 8); *(u32x4*)(Ow + (size_t)row * 1024 + ch * 8) = v; } }
    }
    ATT_WAIT_BAR();
}
#undef ATT_WAIT_BAR
}

namespace s5 {
using bf16x8 = __attribute__((ext_vector_type(8))) short;
using f32x16 = __attribute__((ext_vector_type(16))) float;
struct cf { float re, im; };
__device__ __forceinline__ cf cmul(cf a, cf b) { return cf{a.re * b.re - a.im * b.im, a.re * b.im + a.im * b.re}; }
__device__ __forceinline__ cf cfma(cf a, cf b, cf c) { return cf{c.re + a.re * b.re - a.im * b.im, c.im + a.re * b.im + a.im * b.re}; }
__device__ __forceinline__ int crow(int r, int hi) { return (r & 3) + 8 * (r >> 2) + 4 * hi; }
__device__ __forceinline__ bf16x8 ldg16(const bf16* ubase, unsigned lane_off) { return *(const bf16x8*)((const char*)ubase + lane_off); }
constexpr size_t BT_G = 128 * 256, KT_G = 16 * 16 * 16, CT_G = 256 * 128;
constexpr int IMG_STRIDE = 136;
constexpr int L_IMG = 0, L_T = 8 * 32 * IMG_STRIDE * 2, L_BYTES = L_T + 8 * 2 * 2 * 32 * 4;

__device__ __forceinline__ void build_tables(int g, int part, const float* a_re, const float* a_im, const float* log_dt, const float* b_re, const float* b_im, const float* c_re, const float* c_im, const float* d_skip,
                                             bf16* Btab, bf16* Ktab, bf16* Ctab, float* A16tab, LAS unsigned char* scr, int tid) {
    LAS double* LA = (LAS double*)scr; LAS double* TH = LA + 64;
    LAS float* bbr = (LAS float*)(scr + 1024); LAS float* bbi = bbr + 1024;
    LAS float* pwr = bbi + 1024; LAS float* pwi = pwr + 17 * 64;
    if (tid < 64) { const int i = g * NP + tid;
        const double dt = exp((double)log_dt[g]), are = a_re[i], aim = a_im[i];
        const double la = are * dt, th = aim * dt, mag = exp(la), abr = mag * cos(th), abi = mag * sin(th), den = are * are + aim * aim, em1 = abr - 1.0;
        const double qre = (em1 * are + abi * aim) / den, qim = (abi * are - em1 * aim) / den;
        LA[tid] = la; TH[tid] = th;
        for (int h = 0; h < GCH; ++h) { const double br = b_re[i * GCH + h], bi = b_im[i * GCH + h]; bbr[tid * 16 + h] = (float)(qre * br - qim * bi); bbi[tid * 16 + h] = (float)(qre * bi + qim * br); } }
    __syncthreads();
    for (int e = tid; e < 17 * 64; e += 512) { const int n = e >> 6, p = e & 63; const double m = exp((double)n * LA[p]), t = (double)n * TH[p]; pwr[e] = (float)(m * cos(t)); pwi[e] = (float)(m * sin(t)); }
    __syncthreads();
    if (part == 0 && tid < 64) { A16tab[(g * 64 + tid) * 2] = pwr[16 * 64 + tid]; A16tab[(g * 64 + tid) * 2 + 1] = pwi[16 * 64 + tid]; }
    for (int e = tid; e < 32 * 256; e += 512) { const int pl = e >> 8, k = e & 255, j = k >> 4, hp = k & 15, pp = 32 * part + pl, p = pp & 63;
        const float wr = pwr[(15 - j) * 64 + p], wi = pwi[(15 - j) * 64 + p], br = bbr[p * 16 + hp], bi = bbi[p * 16 + hp];
        const float v = (pp < 64) ? (wr * br - wi * bi) : (wr * bi + wi * br);
        Btab[(size_t)g * BT_G + (size_t)pp * 256 + k] = (bf16)f2bf(v); }
    for (int e = tid; e < 64 * 128; e += 512) { const int nl = e >> 7, pp = e & 127, n = 64 * part + nl, i = n >> 4, h = n & 15, p = pp & 63;
        const float cr = c_re[(size_t)(g * 16 + h) * NP + p], ci = c_im[(size_t)(g * 16 + h) * NP + p], wr = pwr[(i + 1) * 64 + p], wi = pwi[(i + 1) * 64 + p];
        const float v = (pp < 64) ? (cr * wr - ci * wi) : -(cr * wi + ci * wr);
        Ctab[(size_t)g * CT_G + (size_t)n * 128 + pp] = (bf16)f2bf(v); }
    for (int e = tid; e < 4 * 256; e += 512) { const int d = 4 * part + (e >> 8), h = (e >> 4) & 15, hp = e & 15; float acc = 0.f;
        for (int p = 0; p < 64; ++p) { const float cr = c_re[(size_t)(g * 16 + h) * NP + p], ci = c_im[(size_t)(g * 16 + h) * NP + p], wr = pwr[d * 64 + p], wi = pwi[d * 64 + p], br = bbr[p * 16 + hp], bi = bbi[p * 16 + hp];
            const float tr = wr * br - wi * bi, ti = wr * bi + wi * br; acc += cr * tr - ci * ti; }
        if (d == 0 && h == hp) acc += d_skip[g * 16 + h];
        Ktab[(size_t)g * KT_G + (size_t)(d * 16 + h) * 16 + hp] = (bf16)f2bf(acc); }
    __syncthreads();
}

__device__ __forceinline__ void scan_local(f32x16& re, f32x16& im, const cf p1, const cf p4, const int hi, cf (&em)[4], cf& T) {
#pragma unroll
    for (int q = 0; q < 4; ++q)
#pragma unroll
        for (int k = 1; k < 4; ++k) { const int r = 4 * q + k; const cf v = cfma(p1, cf{re[r - 1], im[r - 1]}, cf{re[r], im[r]}); re[r] = v.re; im[r] = v.im; }
    cf E = cf{0.f, 0.f};
#pragma unroll
    for (int q = 0; q < 4; ++q) {
        auto sr = __builtin_amdgcn_permlane32_swap(__float_as_uint(re[4 * q + 3]), __float_as_uint(re[4 * q + 3]), false, false);
        auto si = __builtin_amdgcn_permlane32_swap(__float_as_uint(im[4 * q + 3]), __float_as_uint(im[4 * q + 3]), false, false);
        const cf elo = cf{__uint_as_float(sr[0]), __uint_as_float(si[0])}, ehi = cf{__uint_as_float(sr[1]), __uint_as_float(si[1])};
        const cf Elo = E; E = cfma(p4, E, elo); const cf Ehi = E; E = cfma(p4, E, ehi);
        em[q] = hi ? Ehi : Elo; }
    T = E;
}
__device__ __forceinline__ void scan_finish(f32x16& re, f32x16& im, const cf p1, const cf p2, const cf p3, const cf p4, const cf g2, const int hi, const cf (&em)[4], const cf X) {
    cf cur = hi ? p4 : cf{1.f, 0.f};
#pragma unroll
    for (int q = 0; q < 4; ++q) { const cf carry = cfma(cur, X, em[q]); cur = cmul(cur, g2);
        cf v;
        v = cfma(p1, carry, cf{re[4 * q + 0], im[4 * q + 0]}); re[4 * q + 0] = v.re; im[4 * q + 0] = v.im;
        v = cfma(p2, carry, cf{re[4 * q + 1], im[4 * q + 1]}); re[4 * q + 1] = v.re; im[4 * q + 1] = v.im;
        v = cfma(p3, carry, cf{re[4 * q + 2], im[4 * q + 2]}); re[4 * q + 2] = v.re; im[4 * q + 2] = v.im;
        v = cfma(p4, carry, cf{re[4 * q + 3], im[4 * q + 3]}); re[4 * q + 3] = v.re; im[4 * q + 3] = v.im; }
}

__device__ __forceinline__ void glds16(const void* gsrc, unsigned lds_dst) { unsigned keep;
    asm volatile("s_mov_b32 %0, m0\n\ts_mov_b32 m0, %2\n\ts_nop 0\n\tglobal_load_lds_dwordx4 %1, off\n\ts_mov_b32 m0, %0" : "=&s"(keep) : "v"(gsrc), "s"(lds_dst) : "memory"); }
constexpr int L_TAB = 0, L_TABK = 65536, L_IMG2 = 73728, L_T2 = L_IMG2 + 8 * 32 * IMG_STRIDE * 2, L_BYTES2 = L_T2 + 4096;

__device__ __forceinline__ void s5_unit(int b, int g, const bf16* proj, const bf16* Btab, const bf16* Ktab, const bf16* Ctab, const float* A16tab, bf16* out, LAS unsigned char* shm) {
    int tid = threadIdx.x; asm volatile("" : "+v"(tid));
    const int lane = tid & 63, col = lane & 31, hi = lane >> 5; const int wid = __builtin_amdgcn_readfirstlane(tid >> 6);
    const unsigned lds0 = (unsigned)(uintptr_t)shm;
    { const char* src = (const char*)(Btab + (size_t)g * BT_G);
#pragma unroll
      for (int i = 0; i < 8; ++i) { const int p = wid * 8 + i, row = 2 * p + (lane >> 5), c = (lane & 31) ^ (row & 31);
          glds16(src + row * 512 + c * 16, (unsigned)__builtin_amdgcn_readfirstlane(lds0 + L_TAB + p * 1024)); } }
    const bf16* ub = proj + (size_t)(b * SEQ + 512 * wid) * IN_W + C_U + 16 * g;
    const unsigned uoff = (unsigned)((16 * col * IN_W + 8 * hi) * 2);
    bf16x8 ua[16];
#pragma unroll
    for (int j = 0; j < 16; ++j) ua[j] = ldg16(ub + (size_t)j * IN_W, uoff);
    asm volatile("s_waitcnt vmcnt(0)" ::: "memory"); __syncthreads();
    const LAS unsigned char* tb = shm + L_TAB; const unsigned a0 = (unsigned)(col * 512) | (unsigned)(((hi * 16) ^ (col * 16)));
    f32x16 zt[4];
#pragma unroll
    for (int nt = 0; nt < 4; ++nt) zt[nt] = f32x16{};
#pragma unroll
    for (int j = 0; j < 16; ++j) { const bf16x8 uj = ua[j]; const unsigned aj = a0 ^ (unsigned)(j * 32);
#pragma unroll
        for (int nt = 0; nt < 4; ++nt) { const bf16x8 bfr = *(const LAS bf16x8*)(tb + aj + nt * 16384); zt[nt] = __builtin_amdgcn_mfma_f32_32x32x16_bf16(uj, bfr, zt[nt], 0, 0, 0); } }
    LAS float* Tb = (LAS float*)(shm + L_T2);
    LAS bf16* img = (LAS bf16*)(shm + L_IMG2) + wid * 32 * IMG_STRIDE;
    {
        cf P1[2], P2[2], P3[2], P4[2], G2[2], EM[2][4], TT[2];
#pragma unroll
        for (int s = 0; s < 2; ++s) { const float2 a = ((const float2*)A16tab)[g * 64 + 32 * s + col]; P1[s] = cf{a.x, a.y}; P2[s] = cmul(P1[s], P1[s]); P3[s] = cmul(P2[s], P1[s]); P4[s] = cmul(P2[s], P2[s]); G2[s] = cmul(P4[s], P4[s]); }
        scan_local(zt[0], zt[2], P1[0], P4[0], hi, EM[0], TT[0]);
        scan_local(zt[1], zt[3], P1[1], P4[1], hi, EM[1], TT[1]);
        if (hi == 0) {
#pragma unroll
            for (int s = 0; s < 2; ++s) { Tb[((wid * 2 + s) * 2 + 0) * 32 + col] = TT[s].re; Tb[((wid * 2 + s) * 2 + 1) * 32 + col] = TT[s].im; } }
        asm volatile("s_waitcnt lgkmcnt(0)" ::: "memory"); __syncthreads();
        { const char* src = (const char*)(Ctab + (size_t)g * CT_G);
#pragma unroll
          for (int i = 0; i < 8; ++i) { const int p = wid * 8 + i, row = 4 * p + (lane >> 4), c = (lane & 15) ^ (row & 15);
              glds16(src + row * 256 + c * 16, (unsigned)__builtin_amdgcn_readfirstlane(lds0 + L_TAB + p * 1024)); }
          glds16((const char*)(Ktab + (size_t)g * KT_G) + wid * 1024 + lane * 16, (unsigned)__builtin_amdgcn_readfirstlane(lds0 + L_TABK + wid * 1024)); }
#pragma unroll
        for (int j = 0; j < 16; ++j) ua[j] = ldg16(ub + (size_t)j * IN_W, uoff);
#pragma unroll
        for (int s = 0; s < 2; ++s) {
            const cf g4 = cmul(G2[s], G2[s]), g8 = cmul(g4, g4);
            cf X = cf{0.f, 0.f};
            for (int v = 0; v < wid; ++v) X = cfma(g8, X, cf{Tb[((v * 2 + s) * 2 + 0) * 32 + col], Tb[((v * 2 + s) * 2 + 1) * 32 + col]});
            scan_finish(zt[s], zt[2 + s], P1[s], P2[s], P3[s], P4[s], G2[s], hi, EM[s], X);
            if (hi == 0) { img[32 * s + col] = (bf16)f2bf(X.re); img[64 + 32 * s + col] = (bf16)f2bf(X.im); }
#pragma unroll
            for (int r = 0; r < 16; ++r) { const int row = crow(r, hi) + 1;
                if (row < 32) { img[row * IMG_STRIDE + 32 * s + col] = (bf16)f2bf(zt[s][r]); img[row * IMG_STRIDE + 64 + 32 * s + col] = (bf16)f2bf(zt[2 + s][r]); } }
        }
    }
    asm volatile("s_waitcnt vmcnt(0) lgkmcnt(0)" ::: "memory"); __syncthreads();
    bf16x8 sa[8];
#pragma unroll
    for (int ks = 0; ks < 8; ++ks) sa[ks] = *(const LAS bf16x8*)(img + col * IMG_STRIDE + 16 * ks + 8 * hi);
    asm volatile("s_waitcnt lgkmcnt(0)" ::: "memory"); __builtin_amdgcn_wave_barrier();
    const int ih = col >> 4, h = col & 15;
    const LAS unsigned char* kb = shm + L_TABK + ih * 512 + h * 32 + hi * 16;
    const unsigned c0 = (unsigned)(col * 256) | (unsigned)((hi * 16) ^ ((col & 15) * 16));
    LAS bf16* stg = img;
    bf16* og = out + ((size_t)g * T + (size_t)(b * SEQ + 512 * wid)) * 16;
#pragma unroll
    for (int ps = 0; ps < 2; ++ps) {
        f32x16 acc[4];
#pragma unroll
        for (int n = 0; n < 4; ++n) acc[n] = f32x16{};
#pragma unroll
        for (int j = 0; j < 8 * ps + 8; ++j) { const bf16x8 uj = ua[j];
#pragma unroll
            for (int n = 0; n < 4; ++n) { const int nt = 4 * ps + n;
                if (j <= 2 * nt + 1) {
                    bf16x8 kf;
                    if (j == 2 * nt + 1) { kf = *(const LAS bf16x8*)(shm + L_TABK + h * 32 + hi * 16); if (ih == 0) kf = bf16x8{}; }
                    else kf = *(const LAS bf16x8*)(kb + (2 * nt - j) * 512);
                    acc[n] = __builtin_amdgcn_mfma_f32_32x32x16_bf16(uj, kf, acc[n], 0, 0, 0); } } }
#pragma unroll
        for (int ks = 0; ks < 8; ++ks) { const unsigned ck = c0 ^ (unsigned)(ks * 32);
#pragma unroll
            for (int n = 0; n < 4; ++n) { const bf16x8 cfr = *(const LAS bf16x8*)(tb + ck + (4 * ps + n) * 8192); acc[n] = __builtin_amdgcn_mfma_f32_32x32x16_bf16(sa[ks], cfr, acc[n], 0, 0, 0); } }
#pragma unroll
        for (int n = 0; n < 4; ++n)
#pragma unroll
            for (int r = 0; r < 16; ++r) stg[(crow(r, hi) * 8 + 2 * n + ih) * 16 + h] = (bf16)f2bf(gelu_tanh(acc[n][r]));
        asm volatile("s_waitcnt lgkmcnt(0)" ::: "memory"); __builtin_amdgcn_wave_barrier();
#pragma unroll
        for (int q = 0; q < 8; ++q) { const int pc = q * 64 + lane, chunk = pc >> 4, il = (pc >> 1) & 7, hf = pc & 1;
            const v4u v = *(const LAS v4u*)(stg + (chunk * 8 + il) * 16 + hf * 8);
            *(v4u*)(og + (size_t)(16 * chunk + 8 * ps + il) * 16 + hf * 8) = v; }
        asm volatile("s_waitcnt lgkmcnt(0)" ::: "memory"); __builtin_amdgcn_wave_barrier();
    }
    __syncthreads();
}
}

constexpr int NPH = 10;
__global__ void __launch_bounds__(512, 2) mk_fwd(Args args) {
    extern __shared__ __attribute__((aligned(16))) unsigned char lds_raw[];
    Ctx C; C.lds = (LAS unsigned char*)lds_raw; C.tid = threadIdx.x; C.lane = C.tid & 63; C.wave = __builtin_amdgcn_readfirstlane(C.tid >> 6);
    C.G = gridDim.x; { const int bx = blockIdx.x; C.vcu = (C.G % 8 == 0) ? (bx % 8) * (C.G / 8) + bx / 8 : bx; }
    C.gw = C.vcu * 8 + C.wave; C.ngw = C.G * 8;
    volatile LAS unsigned* MISC = (volatile LAS unsigned*)(C.lds + MISC_OFF);
    if (C.tid < 64) MISC[C.tid] = 0u;
    __syncthreads();
    unsigned char* ws = args.ws; unsigned* ctl = (unsigned*)(ws + WS_CTL);
    const int lo = args.ph_lo, hi = args.ph_hi;
    XcdBarrier bar; bar.bar = ctl + CW_BAR + args.bar_idx * XCD_BAR_WORDS; bar.x = 0; bar.st = nullptr;
    if (hi - lo > 1) bar = xcd_barrier_post(ctl + CW_BAR + args.bar_idx * XCD_BAR_WORDS, MISC + 8);
#define IN(k) (lo <= (k) && (k) < hi)
#define SEAM(k) do { if (IN(k) && IN((k) + 1)) xcd_barrier(bar); } while (0)
    const float* x = args.in[0]; float* out = args.out;
    bf16* WIN = (bf16*)(ws + WS_WIN); bf16* WGLU = (bf16*)(ws + WS_WGLU); bf16* WSSM = (bf16*)(ws + WS_WSSM); bf16* WATT = (bf16*)(ws + WS_WATT); bf16* WOUT = (bf16*)(ws + WS_WOUT);
    bf16* WGU = (bf16*)(ws + WS_WGU); bf16* WDN = (bf16*)(ws + WS_WDN); bf16* BTAB = (bf16*)(ws + WS_BTAB); bf16* CTAB = (bf16*)(ws + WS_CTAB); bf16* KTAB = (bf16*)(ws + WS_KTAB); float* A16TAB = (float*)(ws + WS_A16);
    bf16* H = (bf16*)(ws + WS_H); bf16* PROJ = (bf16*)(ws + WS_PROJ); bf16* S5OUT = (bf16*)(ws + WS_S5OUT); bf16* ATTN = (bf16*)(ws + WS_ATTN);
    bf16* GLU = H; bf16* MIXED = S5OUT; bf16* H2 = ATTN; bf16* YS = PROJ; bf16* ACT = (bf16*)(ws + WS_ACT);
    float* top_w = (float*)(ws + WS_ROUTE + RT_TOPW); int* list = (int*)(ws + WS_ROUTE + RT_LIST);
    LAS unsigned char* ring = C.lds + RING_OFF;

    if (IN(0)) {
        for (int blk = C.vcu; blk < NG * 4; blk += C.G) s5::build_tables(blk >> 2, blk & 3, args.in[3], args.in[4], args.in[5], args.in[6], args.in[7], args.in[8], args.in[9], args.in[10], BTAB, KTAB, CTAB, A16TAB, ring, C.tid);
        transpose_job(C, args.in[2], WIN, DM, IN_W, 0, 1);
        transpose_job(C, args.in[11], WGLU, 1024, 2048, 1, 1);
        transpose_job(C, args.in[12], WSSM, 1024, 1024, 0, 1);
        transpose_job(C, args.in[16], WATT, 1024, 1024, 0, 1);
        transpose_job(C, args.in[17], WOUT, 1024, 1024, 0, 1);
        transpose_job_fp8(C, args.in[21], (unsigned char*)WGU, 1024, 2048, 1, NE, WSCALE);
        transpose_job_fp8(C, args.in[23], (unsigned char*)WDN, 1024, 1024, 0, NE, WSCALE);
        rmsnorm_rows(C, x, args.in[1], H);
        __syncthreads();
    }
    SEAM(0);
    if (IN(1)) { pg8::Gemm g{}; g.A = H; g.Bt = WIN; g.M = T; g.N = IN_W; g.K = DM; pg8::StaticOrder S; S.init(T, IN_W, C.G, (int)blockIdx.x);
        pg8::EpiProj e{}; e.O = PROJ; e.ldc = IN_W; e.qg = args.in[13]; e.kg = args.in[14]; e.qscale = att::QSCALE; e.nostore = (args.sub >> 2) & 1; pg8::gemm_phase<pg8::EpiProj, pg8::StaticOrder>(ring, g, S, e); }
    SEAM(1);
    if (IN(2)) {
        if (args.sub & 1) for (int uu = C.vcu; uu < BATCH * NG / 2; uu += C.G) for (int i = 0; i < 2; ++i) { const int unit = 2 * uu + i; s5::s5_unit(unit & 7, unit >> 3, PROJ, BTAB, KTAB, CTAB, A16TAB, S5OUT, ring); }
        if (args.sub & 2) for (int run = C.vcu; run < BATCH * NKVH * 8; run += C.G) att::attn_run(run >> 5, (run >> 3) & 3, (run & 7) * 8, 8, PROJ, args.in[15], ATTN, ring);
        __syncthreads();
    }
    SEAM(2);
    if (IN(3)) { pg8::Gemm g{}; g.A = S5OUT; g.Bt = WGLU; g.M = T; g.N = 2048; g.K = 1024; g.agm = 1; pg8::StaticOrder S; S.init(T, 2048, C.G, (int)blockIdx.x);
        pg8::EpiGlu e{}; e.O = GLU; e.ldc = 1024; pg8::gemm_phase<pg8::EpiGlu, pg8::StaticOrder>(ring, g, S, e); }
    SEAM(3);
    if (IN(4)) { pg8::Gemm g{}; g.A = GLU; g.Bt = WSSM; g.A2 = ATTN; g.Bt2 = WATT; g.M = T; g.N = 1024; g.K = 1024; pg8::DualOrder S; S.init(T, 1024, C.G, (int)blockIdx.x);
        pg8::EpiGate e{}; e.O = MIXED; e.ldc = 1024; e.G = PROJ; e.ldg = IN_W; e.gcol0 = C_GS; e.gcol1 = C_GA; pg8::gemm_phase<pg8::EpiGate, pg8::DualOrder>(ring, g, S, e); }
    SEAM(4);
    if (IN(5)) { pg8::Gemm g{}; g.A = MIXED; g.Bt = WOUT; g.M = T; g.N = 1024; g.K = 1024; pg8::StaticOrder S; S.init(T, 1024, C.G, (int)blockIdx.x);
        pg8::EpiResid e{}; e.base = x; e.out = out; e.ldc = 1024; pg8::gemm_phase<pg8::EpiResid, pg8::StaticOrder>(ring, g, S, e); }
    SEAM(5);
    if (IN(6)) { router_pass(C, out, args.in[18], args.in[19], args.in[20], (unsigned char*)H2, top_w, list, ctl); }
    SEAM(6);
    if (IN(7)) { const int nM = grouped_tables(C, ctl);
        pg8::Gemm g{}; g.A = H2; g.Bt = WGU; g.M = NA; g.N = 2048; g.K = 1024; g.scaleA = 0x7f7f7f7f; g.scaleB = WSCALE_E8M0 * 0x01010101;
        pg8::GroupedOrder S; S.cnt = (const LAS int*)(C.lds + GT_OFF); S.pref = S.cnt + 32; S.tile_e = (const LAS unsigned char*)(S.pref + 36); S.list = list; S.nN = 8; S.G = C.G; S.c = (int)blockIdx.x; S.nM = nM; S.lstride = T; S.ashift = 2;
        pg8::EpiSwiglu e{}; e.O = (unsigned char*)ACT; e.ldc = 1024; e.bias = args.in[22]; e.dff = DFF; e.limit = 7.0f; e.alpha = 1.702f; e.list = list; e.lstride = T;
        pg8::gemm_phase<pg8::EpiSwiglu, pg8::GroupedOrder>(ring, g, S, e); }
    SEAM(7);
    if (IN(8)) { const int nM = grouped_tables(C, ctl);
        pg8::Gemm g{}; g.A = ACT; g.Bt = WDN; g.M = NA; g.N = 1024; g.K = 1024; g.scaleA = 0x7f7f7f7f; g.scaleB = WSCALE_E8M0 * 0x01010101;
        pg8::GroupedOrder S; S.cnt = (const LAS int*)(C.lds + GT_OFF); S.pref = S.cnt + 32; S.tile_e = (const LAS unsigned char*)(S.pref + 36); S.list = list; S.nN = 4; S.G = C.G; S.c = (int)blockIdx.x; S.nM = nM; S.lstride = T; S.ashift = 0;
        pg8::EpiDown e{}; e.O = YS; e.ldc = 1024; e.bias = args.in[24]; e.ncol = 1024; e.list = list; e.lstride = T;
        pg8::gemm_phase<pg8::EpiDown, pg8::GroupedOrder>(ring, g, S, e); }
    SEAM(8);
    if (IN(9)) { combine_pass(C, out, YS, top_w); }
#undef IN
#undef SEAM
}

extern "C" void kernel_launch(void* const* d_in, const int* in_sizes, int n_in, void* d_out, int out_size, void* d_ws, size_t ws_size, hipStream_t stream) {
    static int grid = 0;
    if (grid == 0) {
        if (n_in != 25 || in_sizes[0] != T * DM || out_size != T * DM || ws_size < WS_END) { fprintf(stderr, "kernel_launch: unexpected shapes / workspace (n_in %d, ws %zu)\n", n_in, ws_size); grid = -1; return; }
        int dev = 0, cus = 0, per_cu = 0;
        if (hipGetDevice(&dev) != hipSuccess || hipDeviceGetAttribute(&cus, hipDeviceAttributeMultiprocessorCount, dev) != hipSuccess) { grid = -1; return; }
        if (hipFuncSetAttribute((const void*)mk_fwd, hipFuncAttributeMaxDynamicSharedMemorySize, LDS_BYTES) != hipSuccess) { fprintf(stderr, "kernel_launch: hipFuncSetAttribute failed\n"); grid = -1; return; }
        if (hipOccupancyMaxActiveBlocksPerMultiprocessor(&per_cu, (const void*)mk_fwd, 512, LDS_BYTES) != hipSuccess || per_cu < 1) { fprintf(stderr, "kernel_launch: occupancy query says %d workgroups per CU\n", per_cu); grid = -1; (void)hipGetLastError(); return; }
        grid = cus;
    }
    if (grid < 0) return;
    if (hipMemsetAsync((char*)d_ws + WS_CTL, 0, CTL_ZERO_BYTES, stream) != hipSuccess) return;
    Args a{};
    for (int i = 0; i < 25; ++i) a.in[i] = (const float*)d_in[i];
    a.out = (float*)d_out; a.ws = (unsigned char*)d_ws;
#ifdef MK_RANGES
    { const int rg[] = MK_RANGES; int nb = 0; for (unsigned i = 0; i + 2 < sizeof(rg) / sizeof(int); i += 3) { a.ph_lo = rg[i]; a.ph_hi = rg[i + 1]; a.sub = rg[i + 2]; a.bar_idx = (rg[i + 1] - rg[i] > 1) ? nb++ : 0;
        hipLaunchKernelGGL(mk_fwd, dim3(grid), dim3(512), LDS_BYTES, stream, a); } }
#else
    a.ph_lo = 0; a.ph_hi = NPH; a.bar_idx = 0; a.sub = 3; hipLaunchKernelGGL(mk_fwd, dim3(grid), dim3(512), LDS_BYTES, stream, a);
#endif
}
```

```cpp
#include <hip/hip_runtime.h>
#include <cstdio>
#include <cstdint>
#include <cmath>

constexpr int DM = 1024, BATCH = 8, SEQ = 4096, T = BATCH * SEQ;
constexpr int NG = 64, NP = 64, GCH = 16;
constexpr int HD = 64, NQH = 16, NKVH = 4, WIN = 128;
constexpr int IN_W = 4608;
constexpr int C_U = 0, C_Q = 1024, C_K = 2048, C_V = 2304, C_GS = 2560, C_GA = 3584;
constexpr int NE = 32, TOPK = 4, DFF = 1024, NA = T * TOPK;
constexpr int MAXROWS = NA + NE * 256;
constexpr int MAXMT = MAXROWS / 256;
constexpr float EPS = 1e-5f;

namespace pg8 {
#define PG8_LAS __attribute__((address_space(3)))
typedef unsigned short bf16_t;
typedef short bf16x8 __attribute__((ext_vector_type(8)));
typedef float f32x4 __attribute__((ext_vector_type(4)));
typedef unsigned u32x4 __attribute__((ext_vector_type(4)));
typedef int i32x8 __attribute__((ext_vector_type(8)));
typedef int i32x4 __attribute__((ext_vector_type(4)));
__device__ __forceinline__ i32x8 cat8(bf16x8 lo, bf16x8 hi) { return __builtin_shufflevector(__builtin_bit_cast(i32x4, lo), __builtin_bit_cast(i32x4, hi), 0, 1, 2, 3, 4, 5, 6, 7); }
constexpr int BM = 256, BK = 64, HALF = 128, HTB = HALF * BK * 2  , STAGE_BYTES = 8 * HTB, NXCD = 8, WGM = 8;

__host__ __device__ __forceinline__ int lds_byte(int r, int c) { const int st = (r >> 4) * 2 + (c >> 5), rr = r & 15, cc = c & 31, ob = rr * 64 + cc * 2; return st * 1024 + (ob ^ (((ob >> 9) & 1) << 5)); }
__host__ __device__ __forceinline__ void stage_rc(int b, int& R, int& C) { const int st = b / 1024, sb = b % 1024, swz = sb ^ (((sb >> 9) & 1) << 5); R = (st >> 1) * 16 + swz / 64; C = (st & 1) * 32 + (swz % 64) / 2; }
__host__ __device__ __forceinline__ int perm32(int rho) { const int n = rho >> 4, i = rho & 15; return 8 * (i >> 2) + 4 * n + (i & 3); }

struct Unit { int pm, pn, e, pl, rows; };
struct Gemm { const bf16_t* A; const bf16_t* Bt; const bf16_t* A2; const bf16_t* Bt2; int M, N, K, agm, scaleA, scaleB, pad0, pad1; };

struct StaticOrder {
    static constexpr bool GATHER = false, FP8 = false;
    static constexpr PG8_LAS int* lbuf = nullptr;
    int nM, nN, nwg, G, c;
    __host__ __device__ void init(int M, int N, int G_, int c_) { nM = M / BM; nN = N / BM; nwg = nM * nN; G = G_; c = c_; }
    __host__ __device__ bool next(int i, Unit& u) const {
        const long L = (long)i * G + c; if (L >= nwg) return false;
        int wgid = (int)L; { const int q = nwg / NXCD, r = nwg % NXCD, xcd = wgid % NXCD, off = wgid / NXCD; wgid = (xcd < r ? xcd * (q + 1) : r * (q + 1) + (xcd - r) * q) + off; }
        const int nig = WGM * nN, gid = wgid / nig, fm = gid * WGM, gsz = (nM - fm) < WGM ? (nM - fm) : WGM;
        u.pm = fm + ((wgid % nig) % gsz); u.pn = (wgid % nig) / gsz; u.e = 0; u.pl = u.pn; u.rows = BM; return true;
    }
    __device__ __forceinline__ void a_ready(const Unit&) const {}
    __device__ __forceinline__ void done(const Unit&) const {}
};

template <class Epi, class Sched, bool ALIGN_EPI = true>
__device__ __forceinline__ void gemm_phase(PG8_LAS unsigned char* lds, const Gemm g, const Sched& S, const Epi& E) {
    int tid = threadIdx.x; asm volatile("" : "+v"(tid));
    const int wid = __builtin_amdgcn_readfirstlane(tid >> 6), lane = tid & 63, wr = wid >> 2, wc = wid & 3, fr = lane & 15, fq = lane >> 4;
    constexpr bool GATHER = Sched::GATHER, FP8 = Sched::FP8;
    const int K = g.K, KB = FP8 ? K : 2 * K, nt = KB / 128;
    int RA[2], CA[2]; unsigned voffA0[2], voffA1[2], voffB[2];
#pragma unroll
    for (int i = 0; i < 2; ++i) { int R, C; stage_rc(tid * 16 + i * 8192, R, C); RA[i] = R; CA[i] = C;
        const int Rb = 2 * (R & ~31) + (Epi::PERM ? perm32(R & 31) : (R & 31));
        voffB[i] = (unsigned)(Rb * KB + C * 2);
        if (g.agm) { voffA0[i] = (unsigned)((C >> 4) * g.M * 32 + R * 32 + (C & 15) * 2); voffA1[i] = voffA0[i] + (unsigned)(HALF * 32); }
        else { voffA0[i] = (unsigned)(R * KB + C * 2); voffA1[i] = (unsigned)((R + HALF) * KB + C * 2); } }
    const size_t kstep = (size_t)(BK * 2);
    const size_t hstepB = (size_t)32 * KB;
    const size_t tstep = (size_t)BM * KB;
    const size_t kstepA = g.agm ? (size_t)4 * g.M * 32 : kstep, tstepA = g.agm ? (size_t)BM * 32 : tstep;
    const unsigned ldsw = (unsigned)wid * 1024u;
    const int aoff = lds_byte(wr * 64 + fr, FP8 ? fq * 16 : fq * 8), boff = lds_byte(wc * 32 + fr, FP8 ? fq * 16 : fq * 8);
    constexpr int KOFF = FP8 ? 16 : 1024;
#define PG8_SA(b, h) (((b) * 2 + (h)) * HTB)
#define PG8_SB(b, h) ((4 + (b) * 2 + (h)) * HTB)
#define PG8_STAGE(bufoff, gbase, voff) do { _Pragma("unroll") for (int _i = 0; _i < 2; ++_i) \
        __builtin_amdgcn_global_load_lds((const unsigned*)((const char*)(gbase) + (voff)[_i]), (PG8_LAS unsigned*)(lds + (bufoff) + ldsw + _i * 8192), 16, 0, 0); } while (0)
#define PG8_LDA(dst, b, h) do { _Pragma("unroll") for (int m = 0; m < 4; ++m) _Pragma("unroll") for (int k = 0; k < 2; ++k) dst[m][k] = *(const PG8_LAS bf16x8*)(lds + PG8_SA(b, h) + aoff + m * 2048 + k * KOFF); } while (0)
#define PG8_LDB(dst, b, h) do { _Pragma("unroll") for (int n = 0; n < 2; ++n) _Pragma("unroll") for (int k = 0; k < 2; ++k) dst[n][k] = *(const PG8_LAS bf16x8*)(lds + PG8_SB(b, h) + boff + n * 2048 + k * KOFF); } while (0)
#define PG8_MMA(ai, bj, At, Bt) do { __builtin_amdgcn_s_setprio(1); _Pragma("unroll") for (int m = 0; m < 4; ++m) _Pragma("unroll") for (int n = 0; n < 2; ++n) { \
        if constexpr (FP8) acc[ai][bj][m][n] = __builtin_amdgcn_mfma_scale_f32_16x16x128_f8f6f4(cat8(Bt[n][0], Bt[n][1]), cat8(At[m][0], At[m][1]), acc[ai][bj][m][n], 0, 0, 0, g.scaleB, 0, g.scaleA); \
        else { _Pragma("unroll") for (int k = 0; k < 2; ++k) acc[ai][bj][m][n] = __builtin_amdgcn_mfma_f32_16x16x32_bf16(Bt[n][k], At[m][k], acc[ai][bj][m][n], 0, 0, 0); } } __builtin_amdgcn_s_setprio(0); } while (0)
#define PG8_WAIT_V(n) asm volatile("s_waitcnt vmcnt(" #n ")" ::: "memory")
#define PG8_WAIT_L(n) asm volatile("s_waitcnt lgkmcnt(" #n ")" ::: "memory")
#define PG8_BAR __builtin_amdgcn_s_barrier()
#define PG8_SCHED __builtin_amdgcn_sched_barrier(0)
    Unit cur, nxt; int ui = 0;
    if (!S.next(0, cur)) return;
    f32x4 acc[2][2][4][2];
#pragma unroll
    for (int a = 0; a < 2; ++a)
#pragma unroll
        for (int b = 0; b < 2; ++b)
#pragma unroll
            for (int m = 0; m < 4; ++m)
#pragma unroll
                for (int n = 0; n < 2; ++n) acc[a][b][m][n] = (f32x4){0.f, 0.f, 0.f, 0.f};
    bf16x8 At[4][2], B0[2][2], B1[2][2];
    PG8_LAS int* const lring = S.lbuf;
    if constexpr (GATHER) {
        if (tid < BM) lring[tid] = S.list_entry(cur, tid);
        asm volatile("s_waitcnt vmcnt(0) lgkmcnt(0)" ::: "memory"); PG8_BAR; asm volatile("" ::: "memory");
#pragma unroll
        for (int i = 0; i < 2; ++i) { const int r0 = RA[i] < cur.rows ? RA[i] : cur.rows - 1, r1 = HALF + RA[i] < cur.rows ? HALF + RA[i] : cur.rows - 1;
            voffA0[i] = (unsigned)(lring[r0] >> S.ashift) * (unsigned)KB + (unsigned)(CA[i] * 2); voffA1[i] = (unsigned)(lring[r1] >> S.ashift) * (unsigned)KB + (unsigned)(CA[i] * 2); } }
    const char* cA = GATHER ? (const char*)g.A : (const char*)(cur.e && g.A2 ? g.A2 : g.A) + (size_t)cur.pm * tstepA; const char* cB = (const char*)(!GATHER && cur.e && g.Bt2 ? g.Bt2 : g.Bt) + (size_t)cur.pn * tstep;
    S.a_ready(cur);
    PG8_STAGE(PG8_SB(0, 0), cB, voffB); PG8_STAGE(PG8_SB(0, 1), cB + hstepB, voffB); PG8_STAGE(PG8_SA(0, 0), cA, voffA0); PG8_STAGE(PG8_SA(0, 1), cA, voffA1);
    if (wr == 1) PG8_BAR;
    PG8_WAIT_V(2); PG8_BAR;
    PG8_STAGE(PG8_SB(1, 0), cB + kstep, voffB); PG8_STAGE(PG8_SA(1, 0), cA + kstepA, voffA0); PG8_STAGE(PG8_SB(1, 1), cB + hstepB + kstep, voffB);
    PG8_WAIT_V(6); PG8_BAR;
    for (;;) {
        const bool has_next = S.next(ui + 1, nxt);
        const char* nA = GATHER ? cA : (has_next ? (const char*)(nxt.e && g.A2 ? g.A2 : g.A) + (size_t)nxt.pm * tstepA : cA); const char* nB = has_next ? (const char*)(!GATHER && nxt.e && g.Bt2 ? g.Bt2 : g.Bt) + (size_t)nxt.pn * tstep : cB;
        const int slot_cur = (ui % 3) * BM, slot_nxt = ((ui + 1) % 3) * BM;
        if constexpr (GATHER) { if (has_next && wid < 4)
            __builtin_amdgcn_global_load_lds((const unsigned*)(S.list_ptr(nxt) + wid * 64 + lane), (PG8_LAS unsigned*)(lring + slot_nxt + wid * 64), 4, 0, 0); }
        for (int t = 0; t < nt; t += 2) {
            const bool last = (t == nt - 2);
            const char* a1 = cA + (size_t)(t + 1) * kstepA;
            const char* a2 = last ? nA : cA + (size_t)(t + 2) * kstepA; const char* b2 = last ? nB : cB + (size_t)(t + 2) * kstep;
            const char* a3 = a2 + kstepA; const char* b3 = b2 + kstep;
            if (last && has_next) S.a_ready(nxt);
            PG8_LDB(B0, 0, 0); PG8_LDB(B1, 0, 1); PG8_SCHED; PG8_LDA(At, 0, 0); PG8_STAGE(PG8_SA(1, 1), a1, voffA1);
            if constexpr (GATHER) { if (last && has_next) {
#pragma unroll
                for (int i = 0; i < 2; ++i) { const int r0 = RA[i] < nxt.rows ? RA[i] : nxt.rows - 1, r1 = HALF + RA[i] < nxt.rows ? HALF + RA[i] : nxt.rows - 1;
                    voffA0[i] = (unsigned)(lring[slot_nxt + r0] >> S.ashift) * (unsigned)KB + (unsigned)(CA[i] * 2); voffA1[i] = (unsigned)(lring[slot_nxt + r1] >> S.ashift) * (unsigned)KB + (unsigned)(CA[i] * 2); } } }
            PG8_WAIT_V(8); PG8_WAIT_L(0); PG8_BAR; PG8_MMA(0, 0, At, B0); PG8_MMA(0, 1, At, B1); PG8_BAR; PG8_SCHED;
            PG8_LDA(At, 0, 1); PG8_STAGE(PG8_SB(0, 0), b2, voffB); PG8_STAGE(PG8_SB(0, 1), b2 + hstepB, voffB); PG8_STAGE(PG8_SA(0, 0), a2, voffA0);
            PG8_WAIT_V(8); PG8_WAIT_L(0); PG8_BAR; PG8_MMA(1, 0, At, B0); PG8_MMA(1, 1, At, B1); PG8_BAR; PG8_SCHED;
            PG8_LDB(B0, 1, 0); PG8_LDB(B1, 1, 1); PG8_SCHED; PG8_LDA(At, 1, 0); PG8_STAGE(PG8_SA(0, 1), a2, voffA1);
            PG8_WAIT_V(8); PG8_WAIT_L(0); PG8_BAR; PG8_MMA(0, 0, At, B0); PG8_MMA(0, 1, At, B1); PG8_BAR; PG8_SCHED;
            PG8_LDA(At, 1, 1); PG8_STAGE(PG8_SB(1, 0), b3, voffB); PG8_STAGE(PG8_SB(1, 1), b3 + hstepB, voffB); PG8_STAGE(PG8_SA(1, 0), a3, voffA0);
            PG8_WAIT_V(8); PG8_WAIT_L(0); PG8_BAR; PG8_MMA(1, 0, At, B0); PG8_MMA(1, 1, At, B1); PG8_BAR; PG8_SCHED;
        }
        if constexpr (ALIGN_EPI) { if (wr == 0) PG8_BAR; }
        E(acc, cur, wr, wc, fr, fq, lring + slot_cur); S.done(cur);
        if (!has_next) break;
#pragma unroll
        for (int a = 0; a < 2; ++a)
#pragma unroll
            for (int b = 0; b < 2; ++b)
#pragma unroll
                for (int m = 0; m < 4; ++m)
#pragma unroll
                    for (int n = 0; n < 2; ++n) acc[a][b][m][n] = (f32x4){0.f, 0.f, 0.f, 0.f};
        cur = nxt; cA = nA; cB = nB; ++ui;
        if constexpr (ALIGN_EPI) { if (wr == 1) PG8_BAR; }
    }
    PG8_WAIT_V(0);
    if constexpr (!ALIGN_EPI) { if (wr == 0) PG8_BAR; }
    PG8_BAR;
#undef PG8_SA
#undef PG8_SB
#undef PG8_STAGE
#undef PG8_LDA
#undef PG8_LDB
#undef PG8_MMA
#undef PG8_WAIT_V
#undef PG8_WAIT_L
#undef PG8_BAR
#undef PG8_SCHED
}

__device__ __forceinline__ unsigned cvt_pk_bf16(float lo, float hi) { unsigned r; asm volatile("v_cvt_pk_bf16_f32 %0, %1, %2" : "=v"(r) : "v"(lo), "v"(hi)); return r; }
__device__ __forceinline__ float bf_lo(unsigned w) { return __uint_as_float(w << 16); }
__device__ __forceinline__ float bf_hi(unsigned w) { return __uint_as_float(w & 0xffff0000u); }
__device__ __forceinline__ float sigm(float x) { return __builtin_amdgcn_rcpf(1.f + __builtin_amdgcn_exp2f(-1.4426950408889634f * x)); }
__device__ __forceinline__ f32x4 sigm4(f32x4 x) { f32x4 t = x * -1.4426950408889634f, s;
#pragma unroll
    for (int j = 0; j < 4; ++j) s[j] = __builtin_amdgcn_exp2f(t[j]);
    s = s + 1.f;
#pragma unroll
    for (int j = 0; j < 4; ++j) s[j] = __builtin_amdgcn_rcpf(s[j]);
    return s; }
__device__ __forceinline__ u32x4 pack8(const f32x4 v0, const f32x4 v1) { u32x4 w; w.x = cvt_pk_bf16(v0[0], v0[1]); w.y = cvt_pk_bf16(v0[2], v0[3]); w.z = cvt_pk_bf16(v1[0], v1[1]); w.w = cvt_pk_bf16(v1[2], v1[3]); return w; }
__device__ __forceinline__ void unpack8(const u32x4 w, f32x4& v0, f32x4& v1) { v0 = (f32x4){bf_lo(w.x), bf_hi(w.x), bf_lo(w.y), bf_hi(w.y)}; v1 = (f32x4){bf_lo(w.z), bf_hi(w.z), bf_lo(w.w), bf_hi(w.w)}; }

struct EpiProj {
    static constexpr bool PERM = true;
    bf16_t* O; const float* qg; const float* kg; bf16_t* U; int ldc; float qscale; int nostore, urows;
    __device__ __forceinline__ void operator()(f32x4 (&acc)[2][2][4][2], const Unit& u, int wr, int wc, int fr, int fq, const PG8_LAS int* lrow) const {
        const int row0 = u.pm * BM + wr * 64 + fr, col0 = u.pl * BM + wc * 64 + 8 * fq;
        if (u.pl >= 4 && u.pl <= 8) {
            const float* gp = (u.pl == 8 ? kg : qg) + 8 * fq; const float sc = (u.pl == 8) ? 1.f : qscale;
            f32x4 gv[2][2];
#pragma unroll
            for (int bj = 0; bj < 2; ++bj)
#pragma unroll
                for (int n = 0; n < 2; ++n) gv[bj][n] = *(const f32x4*)(gp + 32 * bj + 4 * n) * sc;
#pragma unroll
            for (int ai = 0; ai < 2; ++ai)
#pragma unroll
                for (int m = 0; m < 4; ++m) { float ss = 0.f;
#pragma unroll
                    for (int bj = 0; bj < 2; ++bj)
#pragma unroll
                        for (int n = 0; n < 2; ++n) { const f32x4 v = acc[ai][bj][m][n]; ss += (v[0] * v[0] + v[1] * v[1]) + (v[2] * v[2] + v[3] * v[3]); }
                    ss += __shfl_xor(ss, 16); ss += __shfl_xor(ss, 32);
                    const float rs = rsqrtf(ss * (1.f / 64.f) + 1e-5f);
#pragma unroll
                    for (int bj = 0; bj < 2; ++bj)
#pragma unroll
                        for (int n = 0; n < 2; ++n) acc[ai][bj][m][n] = acc[ai][bj][m][n] * rs * gv[bj][n]; }
        }
#pragma unroll
        for (int ai = 0; ai < 2; ++ai)
#pragma unroll
            for (int m = 0; m < 4; ++m) { bf16_t* rowp = O + (size_t)(row0 + ai * HALF + m * 16) * ldc + col0;
#pragma unroll
                for (int bj = 0; bj < 2; ++bj) { const u32x4 w = pack8(acc[ai][bj][m][0], acc[ai][bj][m][1]);
                    if (u.pl < 4) { const int c = col0 + bj * 32; *(u32x4*)(U + ((size_t)(c >> 4) * urows + (size_t)(row0 + ai * HALF + m * 16)) * 16 + (c & 15)) = w; }
                    else if (!nostore) *(u32x4*)(rowp + bj * 32) = w; else asm volatile("" :: "v"(w)); } }
    }
};
struct EpiGlu {
    static constexpr bool PERM = true;
    bf16_t* O; int ldc, pad;
    __device__ __forceinline__ void operator()(f32x4 (&acc)[2][2][4][2], const Unit& u, int wr, int wc, int fr, int fq, const PG8_LAS int* lrow) const {
        const int row0 = u.pm * BM + wr * 64 + fr, col0 = u.pl * HALF + wc * 32 + 8 * fq;
#pragma unroll
        for (int ai = 0; ai < 2; ++ai)
#pragma unroll
            for (int m = 0; m < 4; ++m) { bf16_t* rowp = O + (size_t)(row0 + ai * HALF + m * 16) * ldc + col0;
                const f32x4 o0 = acc[ai][0][m][0] * sigm4(acc[ai][1][m][0]), o1 = acc[ai][0][m][1] * sigm4(acc[ai][1][m][1]);
                *(u32x4*)rowp = pack8(o0, o1); }
    }
};
struct EpiGate {
    static constexpr bool PERM = true;
    bf16_t* O; const bf16_t* G; int ldc, ldg, gcol0, gcol1;
    __device__ __forceinline__ void operator()(f32x4 (&acc)[2][2][4][2], const Unit& u, int wr, int wc, int fr, int fq, const PG8_LAS int* lrow) const {
        const int row0 = u.pm * BM + wr * 64 + fr, col0 = u.pl * BM + wc * 64 + 8 * fq; const bool add = u.e != 0; const int gcol = add ? gcol1 : gcol0;
#pragma unroll
        for (int ai = 0; ai < 2; ++ai) {
            u32x4 gw[4][2], ow[4][2];
#pragma unroll
            for (int m = 0; m < 4; ++m)
#pragma unroll
                for (int bj = 0; bj < 2; ++bj) { const size_t r = (size_t)(row0 + ai * HALF + m * 16);
                    gw[m][bj] = *(const u32x4*)(G + r * ldg + gcol + col0 + bj * 32);
                    if (add) ow[m][bj] = __builtin_nontemporal_load((const u32x4*)(O + r * ldc + col0 + bj * 32)); else ow[m][bj] = (u32x4){0u, 0u, 0u, 0u}; }
#pragma unroll
            for (int m = 0; m < 4; ++m)
#pragma unroll
                for (int bj = 0; bj < 2; ++bj) { const size_t r = (size_t)(row0 + ai * HALF + m * 16);
                    f32x4 g0, g1; unpack8(gw[m][bj], g0, g1);
                    f32x4 p0, p1; unpack8(ow[m][bj], p0, p1);
                    const f32x4 o0 = sigm4(g0) * acc[ai][bj][m][0] + p0, o1 = sigm4(g1) * acc[ai][bj][m][1] + p1;
                    *(u32x4*)(O + r * ldc + col0 + bj * 32) = pack8(o0, o1); } }
    }
};
struct EpiResid {
    static constexpr bool PERM = false;
    const float* base; float* out; int ldc, pad;
    __device__ __forceinline__ void operator()(f32x4 (&acc)[2][2][4][2], const Unit& u, int wr, int wc, int fr, int fq, const PG8_LAS int* lrow) const {
        const int row0 = u.pm * BM + wr * 64 + fr, col0 = u.pl * BM + wc * 64 + 4 * fq;
#pragma unroll
        for (int ai = 0; ai < 2; ++ai) {
            f32x4 bv[4][2][2];
#pragma unroll
            for (int m = 0; m < 4; ++m) { const size_t off = (size_t)(row0 + ai * HALF + m * 16) * ldc + col0;
#pragma unroll
                for (int bj = 0; bj < 2; ++bj)
#pragma unroll
                    for (int n = 0; n < 2; ++n) bv[m][bj][n] = *(const f32x4*)(base + off + bj * 32 + n * 16); }
#pragma unroll
            for (int m = 0; m < 4; ++m) { const size_t off = (size_t)(row0 + ai * HALF + m * 16) * ldc + col0;
#pragma unroll
                for (int bj = 0; bj < 2; ++bj)
#pragma unroll
                    for (int n = 0; n < 2; ++n) *(f32x4*)(out + off + bj * 32 + n * 16) = bv[m][bj][n] + acc[ai][bj][m][n]; } }
    }
};
struct EpiSwiglu {
    static constexpr bool PERM = true;
    unsigned char* O; const float* bias; const int* list; int ldc, dff; float limit, alpha; int lstride, skip;
    __device__ __forceinline__ void operator()(f32x4 (&acc)[2][2][4][2], const Unit& u, int wr, int wc, int fr, int fq, const PG8_LAS int* lrow) const {
        if (skip) { for (int ai = 0; ai < 2; ++ai) for (int m = 0; m < 4; ++m) asm volatile("" :: "v"(acc[ai][0][m][0]), "v"(acc[ai][0][m][1]), "v"(acc[ai][1][m][0]), "v"(acc[ai][1][m][1])); return; }
        const int col0 = u.pl * HALF + wc * 32 + 8 * fq;
        const float* bg = bias + (size_t)u.e * 2 * dff + col0; const float* bu = bg + dff;
        const f32x4 bg0 = *(const f32x4*)bg, bg1 = *(const f32x4*)(bg + 4), bu0 = *(const f32x4*)bu, bu1 = *(const f32x4*)(bu + 4);
        const float nal2 = -1.4426950408889634f * alpha;
        int aidx[2][4];
#pragma unroll
        for (int ai = 0; ai < 2; ++ai)
#pragma unroll
            for (int m = 0; m < 4; ++m) { const int r = ai * HALF + wr * 64 + m * 16 + fr; aidx[ai][m] = lrow[r < u.rows ? r : 0]; }
#pragma unroll
        for (int ai = 0; ai < 2; ++ai)
#pragma unroll
            for (int m = 0; m < 4; ++m) { const int r = ai * HALF + wr * 64 + m * 16 + fr;
                if (r < u.rows) { const int a = aidx[ai][m]; unsigned char* rowp = O + (size_t)a * ldc + col0;
                const f32x4 gt0 = __builtin_elementwise_min(acc[ai][0][m][0] + bg0, (f32x4){limit, limit, limit, limit}), gt1 = __builtin_elementwise_min(acc[ai][0][m][1] + bg1, (f32x4){limit, limit, limit, limit});
                f32x4 up0 = acc[ai][1][m][0] + bu0, up1 = acc[ai][1][m][1] + bu1, s0, s1;
                const f32x4 a0 = gt0 * nal2, a1 = gt1 * nal2;
#pragma unroll
                for (int j = 0; j < 4; ++j) { up0[j] = __builtin_amdgcn_fmed3f(up0[j], -limit, limit); up1[j] = __builtin_amdgcn_fmed3f(up1[j], -limit, limit);
                    s0[j] = __builtin_amdgcn_exp2f(a0[j]); s1[j] = __builtin_amdgcn_exp2f(a1[j]); }
                s0 = s0 + 1.f; s1 = s1 + 1.f;
#pragma unroll
                for (int j = 0; j < 4; ++j) { s0[j] = __builtin_amdgcn_rcpf(s0[j]); s1[j] = __builtin_amdgcn_rcpf(s1[j]); }
                const f32x4 o0 = (up0 * gt0 + gt0) * s0, o1 = (up1 * gt1 + gt1) * s1;
                int w0 = __builtin_amdgcn_cvt_pk_fp8_f32(o0[0], o0[1], 0, false); w0 = __builtin_amdgcn_cvt_pk_fp8_f32(o0[2], o0[3], w0, true);
                int w1 = __builtin_amdgcn_cvt_pk_fp8_f32(o1[0], o1[1], 0, false); w1 = __builtin_amdgcn_cvt_pk_fp8_f32(o1[2], o1[3], w1, true);
                *(unsigned long long*)rowp = (unsigned long long)(unsigned)w0 | ((unsigned long long)(unsigned)w1 << 32); } }
    }
};
struct EpiDown {
    static constexpr bool PERM = true;
    bf16_t* O; const float* bias; const int* list; int ldc, ncol, lstride, pad;
    __device__ __forceinline__ void operator()(f32x4 (&acc)[2][2][4][2], const Unit& u, int wr, int wc, int fr, int fq, const PG8_LAS int* lrow) const {
        const int col0 = u.pl * BM + wc * 64 + 8 * fq;
        const float* bp = bias + (size_t)u.e * ncol + col0;
        f32x4 bv[2][2];
#pragma unroll
        for (int bj = 0; bj < 2; ++bj) { bv[bj][0] = *(const f32x4*)(bp + bj * 32); bv[bj][1] = *(const f32x4*)(bp + bj * 32 + 4); }
        int aidx[2][4];
#pragma unroll
        for (int ai = 0; ai < 2; ++ai)
#pragma unroll
            for (int m = 0; m < 4; ++m) { const int r = ai * HALF + wr * 64 + m * 16 + fr; aidx[ai][m] = lrow[r < u.rows ? r : 0]; }
#pragma unroll
        for (int ai = 0; ai < 2; ++ai)
#pragma unroll
            for (int m = 0; m < 4; ++m) { const int r = ai * HALF + wr * 64 + m * 16 + fr;
                if (r < u.rows) { const int a = aidx[ai][m]; bf16_t* rowp = O + (size_t)a * ldc + col0;
#pragma unroll
                for (int bj = 0; bj < 2; ++bj) *(u32x4*)(rowp + bj * 32) = pack8(acc[ai][bj][m][0] + bv[bj][0], acc[ai][bj][m][1] + bv[bj][1]); } }
    }
};
struct GroupedOrder {
    static constexpr bool GATHER = true, FP8 = true;
    const PG8_LAS unsigned char* tile_e; const PG8_LAS int* pref; const PG8_LAS int* cnt; PG8_LAS int* lbuf; const int* list; int nN, G, c, nM, lstride, ashift;
    __device__ __forceinline__ bool next(int i, Unit& u) const {
        const int nwg = nM * nN; const long L = (long)i * G + c; if (L >= nwg) return false;
        int wgid = (int)L; { const int q = nwg / NXCD, r = nwg % NXCD, xcd = wgid % NXCD, off = wgid / NXCD; wgid = (xcd < r ? xcd * (q + 1) : r * (q + 1) + (xcd - r) * q) + off; }
        const int nig = WGM * nN, gid = wgid / nig, fm = gid * WGM, gsz = (nM - fm) < WGM ? (nM - fm) : WGM;
        const int mt = fm + ((wgid % nig) % gsz), pl = (wgid % nig) / gsz;
        const int e = tile_e[mt]; const int mtl = mt - pref[e]; const int left = cnt[e] - 256 * mtl;
        u.pm = mtl; u.pn = e * nN + pl; u.e = e; u.pl = pl; u.rows = left < 256 ? left : 256; return true;
    }
    __device__ __forceinline__ const int* list_ptr(const Unit& u) const { return list + (size_t)u.e * lstride + u.pm * BM; }
    __device__ __forceinline__ int list_entry(const Unit& u, int r) const { return list_ptr(u)[r < u.rows ? r : u.rows - 1]; }
    __device__ __forceinline__ void a_ready(const Unit&) const {}
    __device__ __forceinline__ void done(const Unit&) const {}
};
struct DualOrder {
    static constexpr bool GATHER = false, FP8 = false;
    static constexpr PG8_LAS int* lbuf = nullptr;
    StaticOrder S; int nper;
    __device__ __forceinline__ void init(int M, int N, int G, int c) { S.init(M, N, G, c); nper = (S.nwg - c + G - 1) / G; if (nper < 0) nper = 0; }
    __device__ __forceinline__ bool next(int i, Unit& u) const { if (i >= 2 * nper) return false; const int e = i >= nper ? 1 : 0; const bool ok = S.next(i - e * nper, u); u.e = e; return ok; }
    __device__ __forceinline__ void a_ready(const Unit&) const {}
    __device__ __forceinline__ void done(const Unit&) const {}
};
}

#define GAS __attribute__((address_space(1)))
#define LAS __attribute__((address_space(3)))
typedef unsigned short bf16;
typedef unsigned v4u __attribute__((ext_vector_type(4)));
typedef float f32x4 __attribute__((ext_vector_type(4)));
typedef short bf16x8 __attribute__((ext_vector_type(8)));
typedef GAS unsigned gu32;
typedef GAS unsigned long long gu64;
#define RLX_AGENT __ATOMIC_RELAXED, __HIP_MEMORY_SCOPE_AGENT
#define LDS_WAIT() asm volatile("s_waitcnt lgkmcnt(0)" ::: "memory")
#define VM_WAIT() asm volatile("s_waitcnt vmcnt(0)" ::: "memory")
__device__ __forceinline__ unsigned long long rt() { return __builtin_amdgcn_s_memrealtime(); }
__device__ __forceinline__ unsigned f2bf(float f) { unsigned u = __builtin_bit_cast(unsigned, f); return (u + 0x7fffu + ((u >> 16) & 1u)) >> 16; }
__device__ __forceinline__ unsigned pk2(float lo, float hi) { return f2bf(lo) | (f2bf(hi) << 16); }

#define XB_TMO      128
#define XB_XCNT(j)  (256  + 64 * (j))
#define XB_XSUB(j)  (1280 + 64 * (j))
#define XB_XGEN(j)  (2304 + 64 * (j))
#define XB_TOP      3328
#define XB_TOPGEN   3392
#define XCD_BAR_WORDS 3456
#define XB_SPIN_CAP (1u << 18)

__device__ __forceinline__ unsigned xb_ld(unsigned* p)              { return __hip_atomic_load(p, __ATOMIC_RELAXED, __HIP_MEMORY_SCOPE_AGENT); }
__device__ __forceinline__ unsigned xb_add(unsigned* p, unsigned v) { return __hip_atomic_fetch_add(p, v, __ATOMIC_RELAXED, __HIP_MEMORY_SCOPE_AGENT); }
__device__ __forceinline__ unsigned xb_xcc_id() { return (unsigned)__builtin_amdgcn_s_getreg((3 << 11) | 20) & 0xFu; }
#define XB_SPIN(cond, bar) do { unsigned _sp = 0; while (cond) { __builtin_amdgcn_s_sleep(1); \
    if ((++_sp & 255u) == 0u) { if (xb_ld(&(bar)[XB_TMO])) break; if (_sp > XB_SPIN_CAP) { atomicAdd(&(bar)[XB_TMO], 1u); break; } } } } while (0)

struct XcdBarrier {
    unsigned* bar; unsigned x;
    volatile LAS unsigned* st;
};

__device__ __forceinline__ XcdBarrier xcd_barrier_post(unsigned* bar, volatile LAS unsigned* st) {
    XcdBarrier b; b.bar = bar; b.x = xb_xcc_id(); b.st = st;
    if (threadIdx.x == 0) (void)xb_add(&bar[XB_XCNT(b.x)], 1u);
    return b;
}
__device__ __forceinline__ void xcd_barrier_complete(unsigned* bar, unsigned x, unsigned& nloc, unsigned& nx) {
    const unsigned G = gridDim.x * gridDim.y * gridDim.z;
    unsigned sum, cnt, mine, sp = 0u;
    for (;;) {
        sum = 0u; cnt = 0u; mine = 0u;
#pragma unroll
        for (unsigned j = 0; j < 16; ++j) { const unsigned c = xb_ld(&bar[XB_XCNT(j)]); sum += c; cnt += (c > 0u) ? 1u : 0u; mine = (j == x) ? c : mine; }
        if (sum == G) break;
        __builtin_amdgcn_s_sleep(1);
        if ((++sp & 255u) == 0u) { if (xb_ld(&bar[XB_TMO])) break; if (sp > XB_SPIN_CAP) { atomicAdd(&bar[XB_TMO], 1u); break; } }
    }
    nloc = mine > 0u ? mine : 1u; nx = cnt > 0u ? cnt : 1u;
}

__device__ __forceinline__ void xcd_barrier(const XcdBarrier& b) {
    asm volatile("s_waitcnt vmcnt(0)" ::: "memory");
    __syncthreads();
    if (threadIdx.x == 0) {
        unsigned* bar = b.bar;
        __builtin_amdgcn_s_waitcnt(0);
        unsigned nloc = b.st[0], nx = b.st[1];
        if (nloc == 0u) { xcd_barrier_complete(bar, b.x, nloc, nx); b.st[0] = nloc; b.st[1] = nx; }
        const unsigned old = xb_add(&bar[XB_XSUB(b.x)], 1u);
        const unsigned gen = old / nloc;
        if (old + 1u == (gen + 1u) * nloc) {
            __builtin_amdgcn_fence(__ATOMIC_RELEASE, "agent");
            asm volatile("s_waitcnt vmcnt(0)" ::: "memory");
            const unsigned og = xb_add(&bar[XB_TOP], 1u);
            const unsigned tg = og / nx;
            if (og + 1u == (tg + 1u) * nx) xb_add(&bar[XB_TOPGEN], 1u);
            else XB_SPIN(xb_ld(&bar[XB_TOPGEN]) == tg, bar);
            __builtin_amdgcn_fence(__ATOMIC_ACQUIRE, "agent");
            xb_add(&bar[XB_XGEN(b.x)], 1u);
            asm volatile("s_waitcnt vmcnt(0)" ::: "memory");
        } else {
            XB_SPIN(xb_ld(&bar[XB_XGEN(b.x)]) == gen, bar);
            __builtin_amdgcn_fence(__ATOMIC_ACQUIRE, "agent");
            asm volatile("s_waitcnt vmcnt(0)" ::: "memory");
        }
    }
    __syncthreads();
}

constexpr size_t MiB = 1u << 20;
constexpr size_t WS_CTL = 0;
constexpr size_t CTL_ZERO_BYTES = 65536;
constexpr size_t WS_WIN = 1 * MiB, WS_WGLU = 10 * MiB, WS_WSSM = 14 * MiB, WS_WATT = 16 * MiB, WS_WOUT = 18 * MiB;
constexpr size_t WS_WGU = 20 * MiB, WS_WDN = 148 * MiB;
constexpr float WSCALE = 64.f; constexpr int WSCALE_E8M0 = 127 - 6;
constexpr size_t WS_ROUTE = 216 * MiB;
constexpr size_t WS_H = 224 * MiB;
constexpr size_t WS_PROJ = 288 * MiB;
constexpr size_t WS_S5OUT = 576 * MiB;
constexpr size_t WS_ATTN = 640 * MiB;
constexpr size_t WS_ACT = 704 * MiB;
constexpr size_t WS_BTAB = 976 * MiB, WS_CTAB = 980 * MiB, WS_KTAB = 984 * MiB, WS_A16 = 985 * MiB;
constexpr size_t WS_END = 986 * MiB;
static_assert(WS_PROJ + (size_t)T * IN_W * 2 <= WS_S5OUT && WS_PROJ + (size_t)NA * 1024 * 2 <= WS_S5OUT && WS_ACT + (size_t)NA * 1024 * 2 <= WS_BTAB, "ws map");
constexpr int CW_CNT = 0;
constexpr int CW_BAR = 4096;
static_assert((CW_BAR + 3 * XCD_BAR_WORDS) * 4 <= (int)CTL_ZERO_BYTES, "ctl map");
constexpr size_t RT_TOPW = 0, RT_LIST = 1 * MiB;

constexpr int LDS_BYTES = 163840;
constexpr int RING_OFF = 0;
constexpr int MISC_OFF = LDS_BYTES - 256;
constexpr int GT_OFF = 131072;

__device__ __forceinline__ float bf2f(bf16 b) { return __uint_as_float((unsigned)b << 16); }
__device__ __forceinline__ float wave_sum(float v) {
#pragma unroll
    for (int o = 1; o < 64; o <<= 1) v += __shfl_xor(v, o);
    return v;
}
__device__ __forceinline__ float wave_max(float v) {
#pragma unroll
    for (int o = 1; o < 64; o <<= 1) v = fmaxf(v, __shfl_xor(v, o));
    return v;
}
__device__ __forceinline__ float gelu_tanh(float x) { const float z = -2.3022081985f * (x + 0.044715f * x * x * x); return x * __builtin_amdgcn_rcpf(1.f + __builtin_amdgcn_exp2f(z)); }
#define WAVE_SYNC() do { __builtin_amdgcn_wave_barrier(); asm volatile("s_waitcnt lgkmcnt(0)" ::: "memory"); } while (0)

struct Args { const float* in[25]; float* out; unsigned char* ws; int ph_lo, ph_hi, bar_idx, sub; };
struct Ctx { int tid, lane, wave, vcu, G, gw, ngw; LAS unsigned char* lds; };

constexpr int TR_SCR = 64 * 65 * 4;
__device__ __forceinline__ void transpose_item(const float* W, int K, int N, bf16* WT, int mode, LAS float* scr, int item, int lane) {
    const int nblk = N / 64, kb = item / nblk, nb = item % nblk, k0 = 64 * kb, n0 = 64 * nb;
#pragma unroll 4
    for (int i = 0; i < 16; ++i) { const int kk = 4 * i + (lane >> 4), nn = 4 * (lane & 15); const f32x4 w = *(const f32x4*)(W + (size_t)(k0 + kk) * N + n0 + nn);
        LAS float* s = scr + kk * 65 + nn; s[0] = w.x; s[1] = w.y; s[2] = w.z; s[3] = w.w; }
    LDS_WAIT(); asm volatile("" ::: "memory");
    const int c = lane & 7;
#pragma unroll
    for (int j = 0; j < 8; ++j) { const int n = (lane >> 3) + 8 * j; const LAS float* s = scr + (8 * c) * 65 + n;
        v4u o; o.x = pk2(s[0 * 65], s[1 * 65]); o.y = pk2(s[2 * 65], s[3 * 65]); o.z = pk2(s[4 * 65], s[5 * 65]); o.w = pk2(s[6 * 65], s[7 * 65]);
        int r = n0 + n;
        if (mode == 1) { const int nh = N / 2, hf = (r >= nh) ? 1 : 0, np = r - hf * nh; r = 256 * (np / 128) + 64 * ((np % 128) / 32) + 32 * hf + (np % 32); }
        *(v4u*)(WT + (size_t)r * K + k0 + 8 * c) = o; }
    LDS_WAIT(); asm volatile("" ::: "memory");
}
__device__ __forceinline__ void transpose_item_fp8(const float* W, int K, int N, unsigned char* WT, int mode, float wscale, LAS float* scr, int item, int lane) {
    const int nblk = N / 64, kb = item / nblk, nb = item % nblk, k0 = 64 * kb, n0 = 64 * nb;
#pragma unroll 4
    for (int i = 0; i < 16; ++i) { const int kk = 4 * i + (lane >> 4), nn = 4 * (lane & 15); const f32x4 w = *(const f32x4*)(W + (size_t)(k0 + kk) * N + n0 + nn);
        LAS float* s = scr + kk * 65 + nn; s[0] = w.x; s[1] = w.y; s[2] = w.z; s[3] = w.w; }
    LDS_WAIT(); asm volatile("" ::: "memory");
    const int c = lane & 3;
#pragma unroll
    for (int j = 0; j < 4; ++j) { const int n = (lane >> 2) + 16 * j; const LAS float* s = scr + (16 * c) * 65 + n;
        v4u o;
#pragma unroll
        for (int q = 0; q < 4; ++q) { int w = __builtin_amdgcn_cvt_pk_fp8_f32(s[(4 * q) * 65] * wscale, s[(4 * q + 1) * 65] * wscale, 0, false); w = __builtin_amdgcn_cvt_pk_fp8_f32(s[(4 * q + 2) * 65] * wscale, s[(4 * q + 3) * 65] * wscale, w, true); o[q] = (unsigned)w; }
        int r = n0 + n;
        if (mode == 1) { const int nh = N / 2, hf = (r >= nh) ? 1 : 0, np = r - hf * nh; r = 256 * (np / 128) + 64 * ((np % 128) / 32) + 32 * hf + (np % 32); }
        *(v4u*)(WT + (size_t)r * K + k0 + 16 * c) = o; }
    LDS_WAIT(); asm volatile("" ::: "memory");
}
__device__ __forceinline__ void transpose_job_fp8(const Ctx& C, const float* W, unsigned char* WT, int K, int N, int mode, int nmat, float wscale) {
    LAS float* scr = (LAS float*)(C.lds + RING_OFF + C.wave * TR_SCR);
    const int per = (K / 64) * (N / 64); const int total = per * nmat;
    for (int it = C.gw; it < total; it += C.ngw) { const int mat = it / per, item = it % per;
        transpose_item_fp8(W + (size_t)mat * K * N, K, N, WT + (size_t)mat * K * N, mode, wscale, scr, item, C.lane); }
}
__device__ __forceinline__ void transpose_job(const Ctx& C, const float* W, bf16* WT, int K, int N, int mode, int nmat) {
    LAS float* scr = (LAS float*)(C.lds + RING_OFF + C.wave * TR_SCR);
    const int per = (K / 64) * (N / 64); const int total = per * nmat;
    for (int it = C.gw; it < total; it += C.ngw) { const int mat = it / per, item = it % per;
        transpose_item(W + (size_t)mat * K * N, K, N, WT + (size_t)mat * K * N, mode, scr, item, C.lane); }
}
__device__ __forceinline__ void rmsnorm_rows(const Ctx& C, const float* x, const float* g, bf16* out) {
    for (int m = C.gw; m < T; m += C.ngw) {
        const f32x4* xr = (const f32x4*)(x + (size_t)m * DM) + C.lane; f32x4 v[4]; float s = 0.f;
#pragma unroll
        for (int j = 0; j < 4; ++j) { v[j] = xr[64 * j]; s += (v[j].x * v[j].x + v[j].y * v[j].y) + (v[j].z * v[j].z + v[j].w * v[j].w); }
        const float rs = rsqrtf(wave_sum(s) * (1.f / DM) + EPS);
        unsigned long long* o8 = (unsigned long long*)(out + (size_t)m * DM) + C.lane;
#pragma unroll
        for (int j = 0; j < 4; ++j) { const f32x4 gg = ((const f32x4*)g)[64 * j + C.lane];
            o8[64 * j] = (unsigned long long)pk2(v[j].x * rs * gg.x, v[j].y * rs * gg.y) | ((unsigned long long)pk2(v[j].z * rs * gg.z, v[j].w * rs * gg.w) << 32); }
    }
}
__device__ __forceinline__ void router_pass(const Ctx& C, const float* x1, const float* g2, const float* w_router, const float* b_router, unsigned char* h2, float* top_w, int* list, unsigned* ctl) {
    LAS float* HN = (LAS float*)(C.lds + RING_OFF); LAS float* PART = HN + 16 * 1024; LAS unsigned* HIST = (LAS unsigned*)(PART + 8 * 2 * 16 * 32); LAS unsigned* BASE = HIST + 32; LAS unsigned* RK = BASE + 32;
    LAS unsigned char* EIDS = (LAS unsigned char*)(RK + 32);
    int tid = C.tid; asm volatile("" : "+v"(tid));
    const int lane = tid & 63, wave = C.wave, e = lane & 31, dh = lane >> 5;
    float wreg[64];
#pragma unroll
    for (int i = 0; i < 64; ++i) wreg[i] = w_router[(size_t)(128 * wave + 64 * dh + i) * NE + e];
    const float bias = b_router[e];
    if (tid < 32) HIST[tid] = 0u;
    __syncthreads();
    int nrounds = 0;
    f32x4 vn[2][4];
    if (C.vcu < T / 16) {
#pragma unroll
        for (int q = 0; q < 2; ++q) { const f32x4* xr = (const f32x4*)(x1 + (size_t)(C.vcu * 16 + 2 * wave + q) * DM) + lane;
#pragma unroll
            for (int j = 0; j < 4; ++j) vn[q][j] = xr[64 * j]; } }
    for (int grp = C.vcu; grp < T / 16; grp += C.G, ++nrounds) {
        f32x4 v[2][4];
#pragma unroll
        for (int q = 0; q < 2; ++q)
#pragma unroll
            for (int j = 0; j < 4; ++j) v[q][j] = vn[q][j];
        if (grp + C.G < T / 16) {
#pragma unroll
            for (int q = 0; q < 2; ++q) { const f32x4* xr = (const f32x4*)(x1 + (size_t)((grp + C.G) * 16 + 2 * wave + q) * DM) + lane;
#pragma unroll
                for (int j = 0; j < 4; ++j) vn[q][j] = xr[64 * j]; } }
#pragma unroll
        for (int q = 0; q < 2; ++q) { const int tl = 2 * wave + q; float s = 0.f;
#pragma unroll
            for (int j = 0; j < 4; ++j) s += (v[q][j].x * v[q][j].x + v[q][j].y * v[q][j].y) + (v[q][j].z * v[q][j].z + v[q][j].w * v[q][j].w);
            const float rs = rsqrtf(wave_sum(s) * (1.f / DM) + EPS);
            int* o4 = (int*)(h2 + (size_t)(grp * 16 + tl) * DM) + lane;
#pragma unroll
            for (int j = 0; j < 4; ++j) { const f32x4 gg = ((const f32x4*)g2)[64 * j + lane];
                const f32x4 y = (f32x4){v[q][j].x * rs * gg.x, v[q][j].y * rs * gg.y, v[q][j].z * rs * gg.z, v[q][j].w * rs * gg.w};
                *(LAS f32x4*)(HN + tl * 1024 + 256 * j + 4 * lane) = y;
                int w = __builtin_amdgcn_cvt_pk_fp8_f32(y.x, y.y, 0, false); w = __builtin_amdgcn_cvt_pk_fp8_f32(y.z, y.w, w, true); o4[64 * j] = w; } }
        __syncthreads();
        const LAS float* hb = HN + 128 * wave + 64 * dh;
#pragma unroll 1
        for (int t = 0; t < 16; t += 4) { float a0 = 0.f, a1 = 0.f, a2 = 0.f, a3 = 0.f;
#pragma unroll
            for (int i4 = 0; i4 < 16; ++i4) {
                const f32x4 h0 = *(const LAS f32x4*)(hb + (t + 0) * 1024 + 4 * i4), h1 = *(const LAS f32x4*)(hb + (t + 1) * 1024 + 4 * i4), h2v = *(const LAS f32x4*)(hb + (t + 2) * 1024 + 4 * i4), h3 = *(const LAS f32x4*)(hb + (t + 3) * 1024 + 4 * i4);
                a0 += h0.x * wreg[4 * i4] + h0.y * wreg[4 * i4 + 1] + h0.z * wreg[4 * i4 + 2] + h0.w * wreg[4 * i4 + 3];
                a1 += h1.x * wreg[4 * i4] + h1.y * wreg[4 * i4 + 1] + h1.z * wreg[4 * i4 + 2] + h1.w * wreg[4 * i4 + 3];
                a2 += h2v.x * wreg[4 * i4] + h2v.y * wreg[4 * i4 + 1] + h2v.z * wreg[4 * i4 + 2] + h2v.w * wreg[4 * i4 + 3];
                a3 += h3.x * wreg[4 * i4] + h3.y * wreg[4 * i4 + 1] + h3.z * wreg[4 * i4 + 2] + h3.w * wreg[4 * i4 + 3]; }
            LAS float* pp = PART + ((wave * 2 + dh) * 16 + t) * 32 + e; pp[0] = a0; pp[32] = a1; pp[64] = a2; pp[96] = a3; }
        __syncthreads();
#pragma unroll 1
        for (int q = 0; q < 2; ++q) { const int tl = 2 * wave + q; float acc = 0.f;
#pragma unroll
            for (int w8 = 0; w8 < 8; ++w8) acc += PART[((4 * dh * 2 + w8) * 16 + tl) * 32 + e];
            acc += __shfl_xor(acc, 32);
            float logit = acc + bias;
            float tv[4]; int ti[4];
#pragma unroll
            for (int k = 0; k < 4; ++k) { const float mx = wave_max(logit); const unsigned long long bal = __ballot(logit == mx); const int idx = (__ffsll((long long)bal) - 1) & 31;
                tv[k] = mx; ti[k] = idx; if (e == idx) logit = -INFINITY; }
            const float e1 = __expf(tv[1] - tv[0]), e2 = __expf(tv[2] - tv[0]), e3 = __expf(tv[3] - tv[0]); const float inv = 1.f / (1.f + e1 + e2 + e3);
            if (lane < 4) { const int k = lane; const int ei = k == 0 ? ti[0] : k == 1 ? ti[1] : k == 2 ? ti[2] : ti[3]; const float wv = (k == 0 ? 1.f : k == 1 ? e1 : k == 2 ? e2 : e3) * inv;
                top_w[(size_t)(grp * 16 + tl) * 4 + k] = wv; EIDS[(nrounds * 16 + tl) * 4 + k] = (unsigned char)ei;
                __hip_atomic_fetch_add(HIST + ei, 1u, __ATOMIC_RELAXED, __HIP_MEMORY_SCOPE_WORKGROUP); } }
    }
    __syncthreads();
    if (tid < 32) { BASE[tid] = atomicAdd(ctl + CW_CNT + tid, HIST[tid]); RK[tid] = 0u; }
    __syncthreads();
    for (int idx = tid; idx < nrounds * 64; idx += 512) { const int ei = EIDS[idx]; const unsigned rank = __hip_atomic_fetch_add(RK + ei, 1u, __ATOMIC_RELAXED, __HIP_MEMORY_SCOPE_WORKGROUP);
        const int r = idx >> 6, tl = (idx >> 2) & 15, k = idx & 3; list[(size_t)ei * T + BASE[ei] + rank] = ((C.vcu + r * C.G) * 16 + tl) * 4 + k; }
    __syncthreads();
}
__device__ __forceinline__ int grouped_tables(const Ctx& C, const unsigned* ctl) {
    LAS int* cnt = (LAS int*)(C.lds + GT_OFF); LAS int* pref = cnt + 32; LAS unsigned char* tile_e = (LAS unsigned char*)(pref + 36);
    if (C.wave == 0) {
        const int e = C.lane & 31; const int c = (int)__hip_atomic_load(ctl + CW_CNT + e, RLX_AGENT); const int n = (c + 255) >> 8;
        int incl = n;
#pragma unroll
        for (int o = 1; o < 32; o <<= 1) { const int t = __shfl_up(incl, o, 32); if (e >= o) incl += t; }
        const int start = incl - n;
        if (C.lane < 32) { cnt[e] = c; pref[e] = start; if (e == 31) pref[32] = incl; for (int i = 0; i < n; ++i) tile_e[start + i] = (unsigned char)e; }
    }
    __syncthreads();
    return pref[NE];
}
__device__ __forceinline__ void combine_pass(const Ctx& C, float* out, const bf16* ys, const float* top_w) {
    const int lane = C.lane;
    for (int tok = C.gw; tok < T; tok += C.ngw) {
        f32x4* o = (f32x4*)(out + (size_t)tok * DM);
        f32x4 acc[4];
#pragma unroll
        for (int j = 0; j < 4; ++j) acc[j] = o[64 * j + lane];
        const f32x4 wv4 = *(const f32x4*)(top_w + (size_t)tok * 4);
#pragma unroll
        for (int k = 0; k < 4; ++k) { const float wv = wv4[k]; const unsigned long long* y8 = (const unsigned long long*)(ys + ((size_t)tok * 4 + k) * DM);
#pragma unroll
            for (int j = 0; j < 4; ++j) { const unsigned long long q = y8[64 * j + lane]; const unsigned lo = (unsigned)q, hi = (unsigned)(q >> 32);
                acc[j].x += wv * __uint_as_float(lo << 16); acc[j].y += wv * __uint_as_float(lo & 0xffff0000u); acc[j].z += wv * __uint_as_float(hi << 16); acc[j].w += wv * __uint_as_float(hi & 0xffff0000u); } }
#pragma unroll
        for (int j = 0; j < 4; ++j) o[64 * j + lane] = acc[j];
    }
}

namespace att {
using bf16x8 = __attribute__((ext_vector_type(8))) short;
using s16x4 = __attribute__((ext_vector_type(4))) short;
using f32x16 = __attribute__((ext_vector_type(16))) float;
using u32x4 = __attribute__((ext_vector_type(4))) unsigned;
typedef float f32x2_t __attribute__((ext_vector_type(2))); typedef __bf16 bf16x2_t __attribute__((ext_vector_type(2)));
constexpr float LOG2E = 1.4426950408889634f, QSCALE = 0.125f * LOG2E;
constexpr int SLOTB = 8192, NSLOT = 4;
constexpr int L_K = 0, L_V = NSLOT * SLOTB, L_WS = 2 * NSLOT * SLOTB, L_OST = L_WS + 8 * 256, L_BYTES = L_OST + 8 * 4096;
__device__ __forceinline__ int crow(int r, int hi) { return (r & 3) + 8 * (r >> 2) + 4 * hi; }
__device__ __forceinline__ void glds16(const void* gsrc, unsigned lds_dst) { unsigned keep;
    asm volatile("s_mov_b32 %0, m0\n\ts_mov_b32 m0, %2\n\ts_nop 0\n\tglobal_load_lds_dwordx4 %1, off\n\ts_mov_b32 m0, %0" : "=&s"(keep) : "v"(gsrc), "s"(lds_dst) : "memory"); }
__device__ __forceinline__ unsigned cvtpk_s(float lo, float hi) { f32x2_t v = {lo, hi}; bf16x2_t b = __builtin_convertvector(v, bf16x2_t); return __builtin_bit_cast(unsigned, b); }
typedef __attribute__((address_space(3))) const char* lds_cptr;
__device__ __forceinline__ void qkt_half(f32x16& p, lds_cptr kb, const bf16x8* qr) {
    const f32x16 z = f32x16{};
#pragma unroll
    for (int d0 = 0; d0 < 4; ++d0) {
        const bf16x8 b0 = *(const __attribute__((address_space(3))) bf16x8*)(kb + d0 * 2048);
        p = __builtin_amdgcn_mfma_f32_32x32x16_bf16(b0, qr[d0], d0 == 0 ? z : p, 0, 0, 0); }
}
__device__ __forceinline__ void pv_half(f32x16* o, int vb, bf16x8 pa0, bf16x8 pa1) {
#pragma unroll
    for (int d0 = 0; d0 < 2; ++d0) { s16x4 lo[2], hi[2];
#pragma unroll
        for (int ks = 0; ks < 2; ++ks) {
            asm volatile("ds_read_b64_tr_b16 %0,%1 offset:%c2" : "=&v"(lo[ks]) : "v"(vb), "i"(d0 * 4096 + ks * 1024) : "memory");
            asm volatile("ds_read_b64_tr_b16 %0,%1 offset:%c2" : "=&v"(hi[ks]) : "v"(vb), "i"(d0 * 4096 + ks * 1024 + 512) : "memory"); }
        asm volatile("s_waitcnt lgkmcnt(0)" ::: "memory"); __builtin_amdgcn_sched_barrier(0);
#define ATT_PK(k) (bf16x8){lo[k][0], lo[k][1], lo[k][2], lo[k][3], hi[k][0], hi[k][1], hi[k][2], hi[k][3]}
        o[d0] = __builtin_amdgcn_mfma_f32_32x32x16_bf16(pa0, ATT_PK(0), o[d0], 0, 0, 0);
        o[d0] = __builtin_amdgcn_mfma_f32_32x32x16_bf16(pa1, ATT_PK(1), o[d0], 0, 0, 0);
#undef ATT_PK
    }
}
__device__ __forceinline__ void dma_tile(const bf16* proj, int b, int kvh, int ti, unsigned lds0, int wid, int lane) {
    const unsigned slot = (unsigned)((ti + 2) & 3) * SLOTB;
    int kr = 64 * ti + lane; kr = kr < 0 ? 0 : kr;
    int vr = 64 * ti + 16 * (wid & 3) + (lane >> 2); vr = vr < 0 ? 0 : vr;
    const bf16* ksrc = proj + (size_t)(b * SEQ + kr) * IN_W + C_K + kvh * 64 + wid * 8;
    const bf16* vsrc = proj + (size_t)(b * SEQ + vr) * IN_W + C_V + kvh * 64 + (wid >> 2) * 32 + (lane & 3) * 8;
    glds16(ksrc, (unsigned)__builtin_amdgcn_readfirstlane(lds0 + L_K + slot + wid * 1024));
    glds16(vsrc, (unsigned)__builtin_amdgcn_readfirstlane(lds0 + L_V + slot + wid * 1024));
}
#define ATT_WAIT_BAR() asm volatile("s_waitcnt vmcnt(0) lgkmcnt(0)\n\ts_barrier" ::: "memory")
__device__ __forceinline__ void attn_run(int b, int kvh, int qb0, int nqb, const bf16* proj, const float* sinks, bf16* O, LAS unsigned char* shm) {
    const int tid = threadIdx.x, lane = tid & 63, r32 = lane & 31, hi = lane >> 5; const int wid = __builtin_amdgcn_readfirstlane(tid >> 6);
    const int h = kvh * 4 + (wid & 3), sub = wid >> 2;
    const unsigned lds0 = (unsigned)(uintptr_t)shm;
    LAS float* wsf = (LAS float*)(shm + L_WS) + wid * 64;
    const lds_cptr shm3 = (lds_cptr)shm;
    const int vb0 = (int)(lds0 + L_V) + ((lane >> 4) & 1) * 32 + (lane & 3) * 8 + (4 * hi + ((lane & 15) >> 2)) * 64;
    const float slope2 = exp2f(-0.5f * (float)(h + 1)) * LOG2E, sink2 = sinks[h] * LOG2E;
    dma_tile(proj, b, kvh, qb0 - 2, lds0, wid, lane); dma_tile(proj, b, kvh, qb0 - 1, lds0, wid, lane); dma_tile(proj, b, kvh, qb0, lds0, wid, lane);
    const bf16* Qw = proj + (size_t)(b * SEQ + qb0 * 64 + 32 * sub + r32) * IN_W + C_Q + h * 64 + hi * 8;
    bf16x8 qn[4];
#pragma unroll
    for (int d0 = 0; d0 < 4; ++d0) qn[d0] = *(const bf16x8*)(Qw + d0 * 16);
    for (int qi = 0; qi < nqb; ++qi) {
        const int qb = qb0 + qi, tq0 = qb * 64 + 32 * sub;
        bf16x8 qr[4];
#pragma unroll
        for (int d0 = 0; d0 < 4; ++d0) qr[d0] = qn[d0];
        ATT_WAIT_BAR();
        if (qi + 1 < nqb) dma_tile(proj, b, kvh, qb + 1, lds0, wid, lane);
        f32x16 p[5];
#pragma unroll
        for (int i = 0; i < 5; ++i) { const int g = i + sub; qkt_half(p[i], shm3 + L_K + ((qb + (g >> 1)) & 3) * SLOTB + (g & 1) * 512 + hi * 1024 + r32 * 16, qr); }
        if (qi + 1 < nqb) {
#pragma unroll
            for (int d0 = 0; d0 < 4; ++d0) qn[d0] = *(const bf16x8*)(Qw + (size_t)(64 * (qi + 1)) * IN_W + d0 * 16); }
        float dbase = (float)(128 + r32 - 4 * hi); asm volatile("" : "+v"(dbase));
        const float dmax = (float)(tq0 + r32);
        float mx = -INFINITY;
#pragma unroll
        for (int i = 0; i < 5; ++i)
#pragma unroll
            for (int r = 0; r < 16; ++r) { const float d = dbase - (float)(32 * i + (r & 3) + 8 * (r >> 2));
                float v = p[i][r] - slope2 * d;
                if (i == 0) v = (d < 128.f) ? v : -INFINITY;
                if (i == 4) v = (d >= 0.f) ? v : -INFINITY;
                if (qb < 2) v = (d <= dmax) ? v : -INFINITY;
                p[i][r] = v; mx = fmaxf(mx, v); }
        { auto rr = __builtin_amdgcn_permlane32_swap(__float_as_uint(mx), __float_as_uint(mx), false, false); mx = fmaxf(__uint_as_float(rr[0]), __uint_as_float(rr[1])); }
        mx = fmaxf(mx, sink2);
        float ls = 0.f;
        f32x16 o[2]; o[0] = f32x16{}; o[1] = f32x16{};
#pragma unroll
        for (int i = 0; i < 5; ++i) { const int g = i + sub;
#pragma unroll
            for (int r = 0; r < 16; ++r) { const float e = __builtin_amdgcn_exp2f(p[i][r] - mx); p[i][r] = e; ls += e; }
            u32x4 pw0, pw1;
#define ATT_PKW(P, B) cvtpk_s(P[B], P[B + 1])
            pw0 = (u32x4){ATT_PKW(p[i], 0), ATT_PKW(p[i], 2), ATT_PKW(p[i], 4), ATT_PKW(p[i], 6)}; pw1 = (u32x4){ATT_PKW(p[i], 8), ATT_PKW(p[i], 10), ATT_PKW(p[i], 12), ATT_PKW(p[i], 14)};
#undef ATT_PKW
            __builtin_amdgcn_sched_barrier(0);
            pv_half(o, vb0 + ((qb + (g >> 1)) & 3) * SLOTB + (g & 1) * 2048, __builtin_bit_cast(bf16x8, pw0), __builtin_bit_cast(bf16x8, pw1));
        }
        { auto rr = __builtin_amdgcn_permlane32_swap(__float_as_uint(ls), __float_as_uint(ls), false, false); ls = __uint_as_float(rr[0]) + __uint_as_float(rr[1]); }
        ls += __builtin_amdgcn_exp2f(sink2 - mx);
        if (hi == 0) wsf[32 + r32] = ls;
        asm volatile("s_waitcnt lgkmcnt(0)" ::: "memory");
        float rli[16];
#pragma unroll
        for (int r = 0; r < 16; ++r) rli[r] = __builtin_amdgcn_rcpf(wsf[32 + crow(r, hi)]);
        bf16* Ow = O + (size_t)(b * SEQ + tq0) * 1024 + h * 64;
        { LAS bf16* stg = (LAS bf16*)(shm + L_OST) + wid * 2048;
#pragma unroll
            for (int r = 0; r < 16; ++r) { const int orow = crow(r, hi);
#pragma unroll
                for (int d0 = 0; d0 < 2; ++d0) stg[orow * 64 + d0 * 32 + r32] = (bf16)f2bf(o[d0][r] * rli[r]); }
            asm volatile("s_waitcnt lgkmcnt(0)" ::: "memory");
#pragma unroll
            for (int i = 0; i < 4; ++i) { const int row = i * 8 + (lane >> 3), ch = lane & 7; const u32x4 v = *(const LAS u32x4*)(stg + row * 64 + ch * 8); *(u32x4*)(Ow + (size_t)row * 1024 + ch * 8) = v; } }
    }
    ATT_WAIT_BAR();
}
#undef ATT_WAIT_BAR
}

namespace s5 {
using bf16x8 = __attribute__((ext_vector_type(8))) short;
using f32x16 = __attribute__((ext_vector_type(16))) float;
struct cf { float re, im; };
__device__ __forceinline__ cf cmul(cf a, cf b) { return cf{a.re * b.re - a.im * b.im, a.re * b.im + a.im * b.re}; }
__device__ __forceinline__ cf cfma(cf a, cf b, cf c) { return cf{c.re + a.re * b.re - a.im * b.im, c.im + a.re * b.im + a.im * b.re}; }
__device__ __forceinline__ int crow(int r, int hi) { return (r & 3) + 8 * (r >> 2) + 4 * hi; }
__device__ __forceinline__ bf16x8 ldg16(const bf16* ubase, unsigned lane_off) { return *(const bf16x8*)((const char*)ubase + lane_off); }
constexpr size_t BT_G = 128 * 256, KT_G = 16 * 16 * 16, CT_G = 256 * 128;
constexpr int IMG_STRIDE = 136;
constexpr int L_IMG = 0, L_T = 8 * 32 * IMG_STRIDE * 2, L_BYTES = L_T + 8 * 2 * 2 * 32 * 4;

__device__ __forceinline__ void build_tables(int g, int part, const float* a_re, const float* a_im, const float* log_dt, const float* b_re, const float* b_im, const float* c_re, const float* c_im, const float* d_skip,
                                             bf16* Btab, bf16* Ktab, bf16* Ctab, float* A16tab, LAS unsigned char* scr, int tid) {
    LAS double* LA = (LAS double*)scr; LAS double* TH = LA + 64;
    LAS float* bbr = (LAS float*)(scr + 1024); LAS float* bbi = bbr + 1024;
    LAS float* pwr = bbi + 1024; LAS float* pwi = pwr + 17 * 64;
    LAS float* ccr = pwi + 17 * 64; LAS float* cci = ccr + 1024;
    for (int e = tid; e < 1024; e += 512) { ccr[e] = c_re[(size_t)g * 1024 + e]; cci[e] = c_im[(size_t)g * 1024 + e]; }
    if (tid < 64) { const int i = g * NP + tid;
        const double dt = exp((double)log_dt[g]), are = a_re[i], aim = a_im[i];
        const double la = are * dt, th = aim * dt, mag = exp(la), abr = mag * cos(th), abi = mag * sin(th), den = are * are + aim * aim, em1 = abr - 1.0;
        const double qre = (em1 * are + abi * aim) / den, qim = (abi * are - em1 * aim) / den;
        LA[tid] = la; TH[tid] = th;
        for (int h = 0; h < GCH; ++h) { const double br = b_re[i * GCH + h], bi = b_im[i * GCH + h]; bbr[tid * 16 + h] = (float)(qre * br - qim * bi); bbi[tid * 16 + h] = (float)(qre * bi + qim * br); } }
    __syncthreads();
    for (int e = tid; e < 17 * 64; e += 512) { const int n = e >> 6, p = e & 63; const double m = exp((double)n * LA[p]), t = (double)n * TH[p]; pwr[e] = (float)(m * cos(t)); pwi[e] = (float)(m * sin(t)); }
    __syncthreads();
    if (part == 0 && tid < 64) { A16tab[(g * 64 + tid) * 2] = pwr[16 * 64 + tid]; A16tab[(g * 64 + tid) * 2 + 1] = pwi[16 * 64 + tid]; }
    for (int e = tid; e < 32 * 256; e += 512) { const int pl = e >> 8, k = e & 255, j = k >> 4, hp = k & 15, pp = 32 * part + pl, p = pp & 63;
        const float wr = pwr[(15 - j) * 64 + p], wi = pwi[(15 - j) * 64 + p], br = bbr[p * 16 + hp], bi = bbi[p * 16 + hp];
        const float v = (pp < 64) ? (wr * br - wi * bi) : (wr * bi + wi * br);
        Btab[(size_t)g * BT_G + (size_t)pp * 256 + k] = (bf16)f2bf(v); }
    for (int e = tid; e < 64 * 128; e += 512) { const int nl = e >> 7, pp = e & 127, n = 64 * part + nl, i = n >> 4, h = n & 15, p = pp & 63;
        const float cr = ccr[h * NP + p], ci = cci[h * NP + p], wr = pwr[(i + 1) * 64 + p], wi = pwi[(i + 1) * 64 + p];
        const float v = (pp < 64) ? (cr * wr - ci * wi) : -(cr * wi + ci * wr);
        Ctab[(size_t)g * CT_G + (size_t)n * 128 + pp] = (bf16)f2bf(v); }
    for (int e = tid; e < 4 * 256; e += 512) { const int d = 4 * part + (e >> 8), h = (e >> 4) & 15, hp = e & 15; float acc = 0.f;
#pragma unroll 8
        for (int p = 0; p < 64; ++p) { const float cr = ccr[h * NP + p], ci = cci[h * NP + p], wr = pwr[d * 64 + p], wi = pwi[d * 64 + p], br = bbr[p * 16 + hp], bi = bbi[p * 16 + hp];
            const float tr = wr * br - wi * bi, ti = wr * bi + wi * br; acc += cr * tr - ci * ti; }
        if (d == 0 && h == hp) acc += d_skip[g * 16 + h];
        Ktab[(size_t)g * KT_G + (size_t)(d * 16 + h) * 16 + hp] = (bf16)f2bf(acc); }
    __syncthreads();
}

__device__ __forceinline__ void scan_local(f32x16& re, f32x16& im, const cf p1, const cf p4, const int hi, cf (&em)[4], cf& T) {
#pragma unroll
    for (int q = 0; q < 4; ++q)
#pragma unroll
        for (int k = 1; k < 4; ++k) { const int r = 4 * q + k; const cf v = cfma(p1, cf{re[r - 1], im[r - 1]}, cf{re[r], im[r]}); re[r] = v.re; im[r] = v.im; }
    cf E = cf{0.f, 0.f};
#pragma unroll
    for (int q = 0; q < 4; ++q) {
        auto sr = __builtin_amdgcn_permlane32_swap(__float_as_uint(re[4 * q + 3]), __float_as_uint(re[4 * q + 3]), false, false);
        auto si = __builtin_amdgcn_permlane32_swap(__float_as_uint(im[4 * q + 3]), __float_as_uint(im[4 * q + 3]), false, false);
        const cf elo = cf{__uint_as_float(sr[0]), __uint_as_float(si[0])}, ehi = cf{__uint_as_float(sr[1]), __uint_as_float(si[1])};
        const cf Elo = E; E = cfma(p4, E, elo); const cf Ehi = E; E = cfma(p4, E, ehi);
        em[q] = hi ? Ehi : Elo; }
    T = E;
}
__device__ __forceinline__ void scan_finish(f32x16& re, f32x16& im, const cf p1, const cf p2, const cf p3, const cf p4, const cf g2, const int hi, const cf (&em)[4], const cf X) {
    cf cur = hi ? p4 : cf{1.f, 0.f};
#pragma unroll
    for (int q = 0; q < 4; ++q) { const cf carry = cfma(cur, X, em[q]); cur = cmul(cur, g2);
        cf v;
        v = cfma(p1, carry, cf{re[4 * q + 0], im[4 * q + 0]}); re[4 * q + 0] = v.re; im[4 * q + 0] = v.im;
        v = cfma(p2, carry, cf{re[4 * q + 1], im[4 * q + 1]}); re[4 * q + 1] = v.re; im[4 * q + 1] = v.im;
        v = cfma(p3, carry, cf{re[4 * q + 2], im[4 * q + 2]}); re[4 * q + 2] = v.re; im[4 * q + 2] = v.im;
        v = cfma(p4, carry, cf{re[4 * q + 3], im[4 * q + 3]}); re[4 * q + 3] = v.re; im[4 * q + 3] = v.im; }
}

__device__ __forceinline__ void glds16(const void* gsrc, unsigned lds_dst) { unsigned keep;
    asm volatile("s_mov_b32 %0, m0\n\ts_mov_b32 m0, %2\n\ts_nop 0\n\tglobal_load_lds_dwordx4 %1, off\n\ts_mov_b32 m0, %0" : "=&s"(keep) : "v"(gsrc), "s"(lds_dst) : "memory"); }
constexpr int L_TAB = 0, L_TABK = 65536, L_IMG2 = 73728, L_T2 = L_IMG2 + 8 * 32 * IMG_STRIDE * 2, L_BYTES2 = L_T2 + 4096;

__device__ __forceinline__ void s5_unit(int b, int g, const bf16* proj, const bf16* Btab, const bf16* Ktab, const bf16* Ctab, const float* A16tab, bf16* out, LAS unsigned char* shm) {
    int tid = threadIdx.x; asm volatile("" : "+v"(tid));
    const int lane = tid & 63, col = lane & 31, hi = lane >> 5; const int wid = __builtin_amdgcn_readfirstlane(tid >> 6);
    const unsigned lds0 = (unsigned)(uintptr_t)shm;
    { const char* src = (const char*)(Btab + (size_t)g * BT_G);
#pragma unroll
      for (int i = 0; i < 8; ++i) { const int p = wid * 8 + i, row = 2 * p + (lane >> 5), c = (lane & 31) ^ (row & 31);
          glds16(src + row * 512 + c * 16, (unsigned)__builtin_amdgcn_readfirstlane(lds0 + L_TAB + p * 1024)); } }
    const bf16* ub = proj + ((size_t)g * T + (size_t)(b * SEQ + 512 * wid)) * 16;
    const unsigned uoff = (unsigned)(col * 512 + hi * 16);
    bf16x8 ua[16];
#pragma unroll
    for (int j = 0; j < 16; ++j) ua[j] = ldg16(ub + (size_t)j * 16, uoff);
    asm volatile("s_waitcnt vmcnt(0)" ::: "memory"); __syncthreads();
    const LAS unsigned char* tb = shm + L_TAB; const unsigned a0 = (unsigned)(col * 512) | (unsigned)(((hi * 16) ^ (col * 16)));
    f32x16 zt[4];
#pragma unroll
    for (int nt = 0; nt < 4; ++nt) zt[nt] = f32x16{};
#pragma unroll
    for (int j = 0; j < 16; ++j) { const bf16x8 uj = ua[j]; const unsigned aj = a0 ^ (unsigned)(j * 32);
#pragma unroll
        for (int nt = 0; nt < 4; ++nt) { const bf16x8 bfr = *(const LAS bf16x8*)(tb + aj + nt * 16384); zt[nt] = __builtin_amdgcn_mfma_f32_32x32x16_bf16(uj, bfr, zt[nt], 0, 0, 0); } }
    LAS float* Tb = (LAS float*)(shm + L_T2);
    LAS bf16* img = (LAS bf16*)(shm + L_IMG2) + wid * 32 * IMG_STRIDE;
    {
        cf P1[2], P2[2], P3[2], P4[2], G2[2], EM[2][4], TT[2];
#pragma unroll
        for (int s = 0; s < 2; ++s) { const float2 a = ((const float2*)A16tab)[g * 64 + 32 * s + col]; P1[s] = cf{a.x, a.y}; P2[s] = cmul(P1[s], P1[s]); P3[s] = cmul(P2[s], P1[s]); P4[s] = cmul(P2[s], P2[s]); G2[s] = cmul(P4[s], P4[s]); }
        scan_local(zt[0], zt[2], P1[0], P4[0], hi, EM[0], TT[0]);
        scan_local(zt[1], zt[3], P1[1], P4[1], hi, EM[1], TT[1]);
        if (hi == 0) {
#pragma unroll
            for (int s = 0; s < 2; ++s) { Tb[((wid * 2 + s) * 2 + 0) * 32 + col] = TT[s].re; Tb[((wid * 2 + s) * 2 + 1) * 32 + col] = TT[s].im; } }
        asm volatile("s_waitcnt lgkmcnt(0)" ::: "memory"); __syncthreads();
        { const char* src = (const char*)(Ctab + (size_t)g * CT_G);
#pragma unroll
          for (int i = 0; i < 8; ++i) { const int p = wid * 8 + i, row = 4 * p + (lane >> 4), c = (lane & 15) ^ (row & 15);
              glds16(src + row * 256 + c * 16, (unsigned)__builtin_amdgcn_readfirstlane(lds0 + L_TAB + p * 1024)); }
          glds16((const char*)(Ktab + (size_t)g * KT_G) + wid * 1024 + lane * 16, (unsigned)__builtin_amdgcn_readfirstlane(lds0 + L_TABK + wid * 1024)); }
#pragma unroll
        for (int j = 0; j < 16; ++j) ua[j] = ldg16(ub + (size_t)j * 16, uoff);
#pragma unroll
        for (int s = 0; s < 2; ++s) {
            const cf g4 = cmul(G2[s], G2[s]), g8 = cmul(g4, g4);
            cf X = cf{0.f, 0.f};
            for (int v = 0; v < wid; ++v) X = cfma(g8, X, cf{Tb[((v * 2 + s) * 2 + 0) * 32 + col], Tb[((v * 2 + s) * 2 + 1) * 32 + col]});
            scan_finish(zt[s], zt[2 + s], P1[s], P2[s], P3[s], P4[s], G2[s], hi, EM[s], X);
            if (hi == 0) { img[32 * s + col] = (bf16)f2bf(X.re); img[64 + 32 * s + col] = (bf16)f2bf(X.im); }
#pragma unroll
            for (int r = 0; r < 16; ++r) { const int row = crow(r, hi) + 1;
                if (row < 32) { img[row * IMG_STRIDE + 32 * s + col] = (bf16)f2bf(zt[s][r]); img[row * IMG_STRIDE + 64 + 32 * s + col] = (bf16)f2bf(zt[2 + s][r]); } }
        }
    }
    asm volatile("s_waitcnt vmcnt(0) lgkmcnt(0)" ::: "memory"); __syncthreads();
    bf16x8 sa[8];
#pragma unroll
    for (int ks = 0; ks < 8; ++ks) sa[ks] = *(const LAS bf16x8*)(img + col * IMG_STRIDE + 16 * ks + 8 * hi);
    asm volatile("s_waitcnt lgkmcnt(0)" ::: "memory"); __builtin_amdgcn_wave_barrier();
    const int ih = col >> 4, h = col & 15;
    const LAS unsigned char* kb = shm + L_TABK + ih * 512 + h * 32 + hi * 16;
    const unsigned c0 = (unsigned)(col * 256) | (unsigned)((hi * 16) ^ ((col & 15) * 16));
    LAS bf16* stg = img;
    bf16* og = out + ((size_t)g * T + (size_t)(b * SEQ + 512 * wid)) * 16;
#pragma unroll
    for (int ps = 0; ps < 2; ++ps) {
        f32x16 acc[4];
#pragma unroll
        for (int n = 0; n < 4; ++n) acc[n] = f32x16{};
#pragma unroll
        for (int j = 0; j < 8 * ps + 8; ++j) { const bf16x8 uj = ua[j];
#pragma unroll
            for (int n = 0; n < 4; ++n) { const int nt = 4 * ps + n;
                if (j <= 2 * nt + 1) {
                    bf16x8 kf;
                    if (j == 2 * nt + 1) { kf = *(const LAS bf16x8*)(shm + L_TABK + h * 32 + hi * 16); if (ih == 0) kf = bf16x8{}; }
                    else kf = *(const LAS bf16x8*)(kb + (2 * nt - j) * 512);
                    acc[n] = __builtin_amdgcn_mfma_f32_32x32x16_bf16(uj, kf, acc[n], 0, 0, 0); } } }
#pragma unroll
        for (int ks = 0; ks < 8; ++ks) { const unsigned ck = c0 ^ (unsigned)(ks * 32);
#pragma unroll
            for (int n = 0; n < 4; ++n) { const bf16x8 cfr = *(const LAS bf16x8*)(tb + ck + (4 * ps + n) * 8192); acc[n] = __builtin_amdgcn_mfma_f32_32x32x16_bf16(sa[ks], cfr, acc[n], 0, 0, 0); } }
#pragma unroll
        for (int n = 0; n < 4; ++n)
#pragma unroll
            for (int r = 0; r < 16; ++r) stg[(crow(r, hi) * 8 + 2 * n + ih) * 16 + h] = (bf16)f2bf(gelu_tanh(acc[n][r]));
        asm volatile("s_waitcnt lgkmcnt(0)" ::: "memory"); __builtin_amdgcn_wave_barrier();
#pragma unroll
        for (int q = 0; q < 8; ++q) { const int pc = q * 64 + lane, chunk = pc >> 4, il = (pc >> 1) & 7, hf = pc & 1;
            const v4u v = *(const LAS v4u*)(stg + (chunk * 8 + il) * 16 + hf * 8);
            *(v4u*)(og + (size_t)(16 * chunk + 8 * ps + il) * 16 + hf * 8) = v; }
        asm volatile("s_waitcnt lgkmcnt(0)" ::: "memory"); __builtin_amdgcn_wave_barrier();
    }
    __syncthreads();
}
}

constexpr int NPH = 10;
__global__ void __launch_bounds__(512, 2) mk_fwd(Args args) {
    extern __shared__ __attribute__((aligned(16))) unsigned char lds_raw[];
    Ctx C; C.lds = (LAS unsigned char*)lds_raw; C.tid = threadIdx.x; C.lane = C.tid & 63; C.wave = __builtin_amdgcn_readfirstlane(C.tid >> 6);
    C.G = gridDim.x; { const int bx = blockIdx.x; C.vcu = (C.G % 8 == 0) ? (bx % 8) * (C.G / 8) + bx / 8 : bx; }
    C.gw = C.vcu * 8 + C.wave; C.ngw = C.G * 8;
    volatile LAS unsigned* MISC = (volatile LAS unsigned*)(C.lds + MISC_OFF);
    if (C.tid < 64) MISC[C.tid] = 0u;
    __syncthreads();
    unsigned char* ws = args.ws; unsigned* ctl = (unsigned*)(ws + WS_CTL);
    const int lo = args.ph_lo, hi = args.ph_hi;
    XcdBarrier bar; bar.bar = ctl + CW_BAR + args.bar_idx * XCD_BAR_WORDS; bar.x = 0; bar.st = nullptr;
    if (hi - lo > 1) bar = xcd_barrier_post(ctl + CW_BAR + args.bar_idx * XCD_BAR_WORDS, MISC + 8);
#define IN(k) (lo <= (k) && (k) < hi)
#define SEAM(k) do { if (IN(k) && IN((k) + 1)) { xcd_barrier(bar); if (args.sub & 8) xcd_barrier(bar); } } while (0)
    const float* x = args.in[0]; float* out = args.out;
    bf16* WIN = (bf16*)(ws + WS_WIN); bf16* WGLU = (bf16*)(ws + WS_WGLU); bf16* WSSM = (bf16*)(ws + WS_WSSM); bf16* WATT = (bf16*)(ws + WS_WATT); bf16* WOUT = (bf16*)(ws + WS_WOUT);
    bf16* WGU = (bf16*)(ws + WS_WGU); bf16* WDN = (bf16*)(ws + WS_WDN); bf16* BTAB = (bf16*)(ws + WS_BTAB); bf16* CTAB = (bf16*)(ws + WS_CTAB); bf16* KTAB = (bf16*)(ws + WS_KTAB); float* A16TAB = (float*)(ws + WS_A16);
    bf16* H = (bf16*)(ws + WS_H); bf16* PROJ = (bf16*)(ws + WS_PROJ); bf16* S5OUT = (bf16*)(ws + WS_S5OUT); bf16* ATTN = (bf16*)(ws + WS_ATTN);
    bf16* GLU = H; bf16* MIXED = S5OUT; bf16* H2 = ATTN; bf16* YS = PROJ; bf16* ACT = (bf16*)(ws + WS_ACT);
    bf16* UGM = (bf16*)(ws + WS_ACT);
    float* top_w = (float*)(ws + WS_ROUTE + RT_TOPW); int* list = (int*)(ws + WS_ROUTE + RT_LIST);
    LAS unsigned char* ring = C.lds + RING_OFF;

    if (IN(0)) {
        for (int blk = C.vcu; blk < NG * 4; blk += C.G) s5::build_tables(blk >> 2, blk & 3, args.in[3], args.in[4], args.in[5], args.in[6], args.in[7], args.in[8], args.in[9], args.in[10], BTAB, KTAB, CTAB, A16TAB, ring, C.tid);
        transpose_job(C, args.in[2], WIN, DM, IN_W, 0, 1);
        transpose_job(C, args.in[11], WGLU, 1024, 2048, 1, 1);
        transpose_job(C, args.in[12], WSSM, 1024, 1024, 0, 1);
        transpose_job(C, args.in[16], WATT, 1024, 1024, 0, 1);
        transpose_job(C, args.in[17], WOUT, 1024, 1024, 0, 1);
        transpose_job_fp8(C, args.in[21], (unsigned char*)WGU, 1024, 2048, 1, NE, WSCALE);
        transpose_job_fp8(C, args.in[23], (unsigned char*)WDN, 1024, 1024, 0, NE, WSCALE);
        rmsnorm_rows(C, x, args.in[1], H);
        __syncthreads();
    }
    SEAM(0);
    if (IN(1)) { pg8::Gemm g{}; g.A = H; g.Bt = WIN; g.M = T; g.N = IN_W; g.K = DM; pg8::StaticOrder S; S.init(T, IN_W, C.G, (int)blockIdx.x);
        pg8::EpiProj e{}; e.O = PROJ; e.ldc = IN_W; e.qg = args.in[13]; e.kg = args.in[14]; e.qscale = att::QSCALE; e.nostore = (args.sub >> 2) & 1; e.U = UGM; e.urows = T; pg8::gemm_phase<pg8::EpiProj, pg8::StaticOrder>(ring, g, S, e); }
    SEAM(1);
    if (IN(2)) {
        if (args.sub & 1) for (int uu = C.vcu; uu < BATCH * NG / 2; uu += C.G) for (int i = 0; i < 2; ++i) { const int unit = 2 * uu + i; s5::s5_unit(unit & 7, unit >> 3, UGM, BTAB, KTAB, CTAB, A16TAB, S5OUT, ring); }
        if (args.sub & 2) for (int run = C.vcu; run < BATCH * NKVH * 8; run += C.G) att::attn_run(run >> 5, (run >> 3) & 3, (run & 7) * 8, 8, PROJ, args.in[15], ATTN, ring);
        __syncthreads();
    }
    SEAM(2);
    if (IN(3)) { pg8::Gemm g{}; g.A = S5OUT; g.Bt = WGLU; g.M = T; g.N = 2048; g.K = 1024; g.agm = 1; pg8::StaticOrder S; S.init(T, 2048, C.G, (int)blockIdx.x);
        pg8::EpiGlu e{}; e.O = GLU; e.ldc = 1024; pg8::gemm_phase<pg8::EpiGlu, pg8::StaticOrder>(ring, g, S, e); }
    SEAM(3);
    if (IN(4)) { pg8::Gemm g{}; g.A = GLU; g.Bt = WSSM; g.A2 = ATTN; g.Bt2 = WATT; g.M = T; g.N = 1024; g.K = 1024; pg8::DualOrder S; S.init(T, 1024, C.G, (int)blockIdx.x);
        pg8::EpiGate e{}; e.O = MIXED; e.ldc = 1024; e.G = PROJ; e.ldg = IN_W; e.gcol0 = C_GS; e.gcol1 = C_GA; pg8::gemm_phase<pg8::EpiGate, pg8::DualOrder>(ring, g, S, e); }
    SEAM(4);
    if (IN(5)) { pg8::Gemm g{}; g.A = MIXED; g.Bt = WOUT; g.M = T; g.N = 1024; g.K = 1024; pg8::StaticOrder S; S.init(T, 1024, C.G, (int)blockIdx.x);
        pg8::EpiResid e{}; e.base = x; e.out = out; e.ldc = 1024; pg8::gemm_phase<pg8::EpiResid, pg8::StaticOrder>(ring, g, S, e); }
    SEAM(5);
    if (IN(6)) { router_pass(C, out, args.in[18], args.in[19], args.in[20], (unsigned char*)H2, top_w, list, ctl); }
    SEAM(6);
    if (IN(7)) { const int nM = grouped_tables(C, ctl);
        pg8::Gemm g{}; g.A = H2; g.Bt = WGU; g.M = NA; g.N = 2048; g.K = 1024; g.scaleA = 0x7f7f7f7f; g.scaleB = WSCALE_E8M0 * 0x01010101;
        pg8::GroupedOrder S; S.cnt = (const LAS int*)(C.lds + GT_OFF); S.pref = S.cnt + 32; S.tile_e = (const LAS unsigned char*)(S.pref + 36); S.lbuf = (LAS int*)(C.lds + GT_OFF + 2048); S.list = list; S.nN = 8; S.G = C.G; S.c = (int)blockIdx.x; S.nM = nM; S.lstride = T; S.ashift = 2;
        pg8::EpiSwiglu e{}; e.O = (unsigned char*)ACT; e.ldc = 1024; e.bias = args.in[22]; e.dff = DFF; e.limit = 7.0f; e.alpha = 1.702f; e.list = list; e.lstride = T; e.skip = (args.sub >> 4) & 1;
        pg8::gemm_phase<pg8::EpiSwiglu, pg8::GroupedOrder>(ring, g, S, e); }
    SEAM(7);
    if (IN(8)) { const int nM = grouped_tables(C, ctl);
        pg8::Gemm g{}; g.A = ACT; g.Bt = WDN; g.M = NA; g.N = 1024; g.K = 1024; g.scaleA = 0x7f7f7f7f; g.scaleB = WSCALE_E8M0 * 0x01010101;
        pg8::GroupedOrder S; S.cnt = (const LAS int*)(C.lds + GT_OFF); S.pref = S.cnt + 32; S.tile_e = (const LAS unsigned char*)(S.pref + 36); S.lbuf = (LAS int*)(C.lds + GT_OFF + 2048); S.list = list; S.nN = 4; S.G = C.G; S.c = (int)blockIdx.x; S.nM = nM; S.lstride = T; S.ashift = 0;
        pg8::EpiDown e{}; e.O = YS; e.ldc = 1024; e.bias = args.in[24]; e.ncol = 1024; e.list = list; e.lstride = T;
        pg8::gemm_phase<pg8::EpiDown, pg8::GroupedOrder>(ring, g, S, e); }
    SEAM(8);
    if (IN(9)) { combine_pass(C, out, YS, top_w); }
#undef IN
#undef SEAM
}

extern "C" void kernel_launch(void* const* d_in, const int* in_sizes, int n_in, void* d_out, int out_size, void* d_ws, size_t ws_size, hipStream_t stream) {
    static int grid = 0;
    if (grid == 0) {
        if (n_in != 25 || in_sizes[0] != T * DM || out_size != T * DM || ws_size < WS_END) { fprintf(stderr, "kernel_launch: unexpected shapes / workspace (n_in %d, ws %zu)\n", n_in, ws_size); grid = -1; return; }
        int dev = 0, cus = 0, per_cu = 0;
        if (hipGetDevice(&dev) != hipSuccess || hipDeviceGetAttribute(&cus, hipDeviceAttributeMultiprocessorCount, dev) != hipSuccess) { grid = -1; return; }
        if (hipFuncSetAttribute((const void*)mk_fwd, hipFuncAttributeMaxDynamicSharedMemorySize, LDS_BYTES) != hipSuccess) { fprintf(stderr, "kernel_launch: hipFuncSetAttribute failed\n"); grid = -1; return; }
        if (hipOccupancyMaxActiveBlocksPerMultiprocessor(&per_cu, (const void*)mk_fwd, 512, LDS_BYTES) != hipSuccess || per_cu < 1) { fprintf(stderr, "kernel_launch: occupancy query says %d workgroups per CU\n", per_cu); grid = -1; (void)hipGetLastError(); return; }
        grid = cus;
    }
    if (grid < 0) return;
    if (hipMemsetAsync((char*)d_ws + WS_CTL, 0, CTL_ZERO_BYTES, stream) != hipSuccess) return;
    Args a{};
    for (int i = 0; i < 25; ++i) a.in[i] = (const float*)d_in[i];
    a.out = (float*)d_out; a.ws = (unsigned char*)d_ws;
#ifdef MK_RANGES
    { const int rg[] = MK_RANGES; int nb = 0; for (unsigned i = 0; i + 2 < sizeof(rg) / sizeof(int); i += 3) { a.ph_lo = rg[i]; a.ph_hi = rg[i + 1]; a.sub = rg[i + 2]; a.bar_idx = (rg[i + 1] - rg[i] > 1) ? nb++ : 0;
        hipLaunchKernelGGL(mk_fwd, dim3(grid), dim3(512), LDS_BYTES, stream, a); } }
#else
    a.ph_lo = 0; a.ph_hi = NPH; a.bar_idx = 0; a.sub = 3; hipLaunchKernelGGL(mk_fwd, dim3(grid), dim3(512), LDS_BYTES, stream, a);
#endif
}
```

```cpp
#include <hip/hip_runtime.h>
#include <cstdio>
#include <cstdint>
#include <cmath>

constexpr int DM = 1024, BATCH = 8, SEQ = 4096, T = BATCH * SEQ;
constexpr int NG = 64, NP = 64, GCH = 16;
constexpr int HD = 64, NQH = 16, NKVH = 4, WIN = 128;
constexpr int IN_W = 4608;
constexpr int C_U = 0, C_Q = 1024, C_K = 2048, C_V = 2304, C_GS = 2560, C_GA = 3584;
constexpr int NE = 32, TOPK = 4, DFF = 1024, NA = T * TOPK;
constexpr int MAXROWS = NA + NE * 256;
constexpr int MAXMT = MAXROWS / 256;
constexpr float EPS = 1e-5f;

namespace pg8 {
#define PG8_LAS __attribute__((address_space(3)))
typedef unsigned short bf16_t;
typedef short bf16x8 __attribute__((ext_vector_type(8)));
typedef float f32x4 __attribute__((ext_vector_type(4)));
typedef unsigned u32x4 __attribute__((ext_vector_type(4)));
typedef int i32x8 __attribute__((ext_vector_type(8)));
typedef int i32x4 __attribute__((ext_vector_type(4)));
__device__ __forceinline__ i32x8 cat8(bf16x8 lo, bf16x8 hi) { return __builtin_shufflevector(__builtin_bit_cast(i32x4, lo), __builtin_bit_cast(i32x4, hi), 0, 1, 2, 3, 4, 5, 6, 7); }
constexpr int BM = 256, BK = 64, HALF = 128, HTB = HALF * BK * 2  , STAGE_BYTES = 8 * HTB, NXCD = 8, WGM = 8;

__host__ __device__ __forceinline__ int lds_byte(int r, int c) { const int st = (r >> 4) * 2 + (c >> 5), rr = r & 15, cc = c & 31, ob = rr * 64 + cc * 2; return st * 1024 + (ob ^ (((ob >> 9) & 1) << 5)); }
__host__ __device__ __forceinline__ void stage_rc(int b, int& R, int& C) { const int st = b / 1024, sb = b % 1024, swz = sb ^ (((sb >> 9) & 1) << 5); R = (st >> 1) * 16 + swz / 64; C = (st & 1) * 32 + (swz % 64) / 2; }
__host__ __device__ __forceinline__ int perm32(int rho) { const int n = rho >> 4, i = rho & 15; return 8 * (i >> 2) + 4 * n + (i & 3); }

struct Unit { int pm, pn, e, pl, rows, srow; };
struct Gemm { const bf16_t* A; const bf16_t* Bt; const bf16_t* A2; const bf16_t* Bt2; int M, N, K, agm, scaleA, scaleB, pad0, pad1; };

struct StaticOrder {
    static constexpr bool GATHER = false, FP8 = false, LINROWS = false;
    static constexpr PG8_LAS int* lbuf = nullptr;
    int nM, nN, nwg, G, c;
    __host__ __device__ void init(int M, int N, int G_, int c_) { nM = M / BM; nN = N / BM; nwg = nM * nN; G = G_; c = c_; }
    __host__ __device__ bool next(int i, Unit& u) const {
        const long L = (long)i * G + c; if (L >= nwg) return false;
        int wgid = (int)L; { const int q = nwg / NXCD, r = nwg % NXCD, xcd = wgid % NXCD, off = wgid / NXCD; wgid = (xcd < r ? xcd * (q + 1) : r * (q + 1) + (xcd - r) * q) + off; }
        const int nig = WGM * nN, gid = wgid / nig, fm = gid * WGM, gsz = (nM - fm) < WGM ? (nM - fm) : WGM;
        u.pm = fm + ((wgid % nig) % gsz); u.pn = (wgid % nig) / gsz; u.e = 0; u.pl = u.pn; u.rows = BM; u.srow = u.pm * BM; return true;
    }
    __device__ __forceinline__ void a_ready(const Unit&) const {}
    __device__ __forceinline__ void done(const Unit&) const {}
};

template <class Epi, class Sched, bool ALIGN_EPI = true>
__device__ __forceinline__ void gemm_phase(PG8_LAS unsigned char* lds, const Gemm g, const Sched& S, const Epi& E) {
    int tid = threadIdx.x; asm volatile("" : "+v"(tid));
    const int wid = __builtin_amdgcn_readfirstlane(tid >> 6), lane = tid & 63, wr = wid >> 2, wc = wid & 3, fr = lane & 15, fq = lane >> 4;
    constexpr bool GATHER = Sched::GATHER, FP8 = Sched::FP8;
    const int K = g.K, KB = FP8 ? K : 2 * K, nt = KB / 128;
    int RA[2], CA[2]; unsigned voffA0[2], voffA1[2], voffB[2];
#pragma unroll
    for (int i = 0; i < 2; ++i) { int R, C; stage_rc(tid * 16 + i * 8192, R, C); RA[i] = R; CA[i] = C;
        const int Rb = 2 * (R & ~31) + (Epi::PERM ? perm32(R & 31) : (R & 31));
        voffB[i] = (unsigned)(Rb * KB + C * 2);
        if (g.agm) { voffA0[i] = (unsigned)((C >> 4) * g.M * 32 + R * 32 + (C & 15) * 2); voffA1[i] = voffA0[i] + (unsigned)(HALF * 32); }
        else { voffA0[i] = (unsigned)(R * KB + C * 2); voffA1[i] = (unsigned)((R + HALF) * KB + C * 2); } }
    const size_t kstep = (size_t)(BK * 2);
    const size_t hstepB = (size_t)32 * KB;
    const size_t tstep = (size_t)BM * KB;
    const size_t kstepA = g.agm ? (size_t)4 * g.M * 32 : kstep, tstepA = g.agm ? (size_t)BM * 32 : tstep;
    const unsigned ldsw = (unsigned)wid * 1024u;
    const int aoff = lds_byte(wr * 64 + fr, FP8 ? fq * 16 : fq * 8), boff = lds_byte(wc * 32 + fr, FP8 ? fq * 16 : fq * 8);
    constexpr int KOFF = FP8 ? 16 : 1024;
#define PG8_SA(b, h) (((b) * 2 + (h)) * HTB)
#define PG8_SB(b, h) ((4 + (b) * 2 + (h)) * HTB)
#define PG8_STAGE(bufoff, gbase, voff) do { _Pragma("unroll") for (int _i = 0; _i < 2; ++_i) \
        __builtin_amdgcn_global_load_lds((const unsigned*)((const char*)(gbase) + (voff)[_i]), (PG8_LAS unsigned*)(lds + (bufoff) + ldsw + _i * 8192), 16, 0, 0); } while (0)
#define PG8_LDA(dst, b, h) do { _Pragma("unroll") for (int m = 0; m < 4; ++m) _Pragma("unroll") for (int k = 0; k < 2; ++k) dst[m][k] = *(const PG8_LAS bf16x8*)(lds + PG8_SA(b, h) + aoff + m * 2048 + k * KOFF); } while (0)
#define PG8_LDB(dst, b, h) do { _Pragma("unroll") for (int n = 0; n < 2; ++n) _Pragma("unroll") for (int k = 0; k < 2; ++k) dst[n][k] = *(const PG8_LAS bf16x8*)(lds + PG8_SB(b, h) + boff + n * 2048 + k * KOFF); } while (0)
#define PG8_MMA(ai, bj, At, Bt) do { __builtin_amdgcn_s_setprio(1); _Pragma("unroll") for (int m = 0; m < 4; ++m) _Pragma("unroll") for (int n = 0; n < 2; ++n) { \
        if constexpr (FP8) acc[ai][bj][m][n] = __builtin_amdgcn_mfma_scale_f32_16x16x128_f8f6f4(cat8(Bt[n][0], Bt[n][1]), cat8(At[m][0], At[m][1]), acc[ai][bj][m][n], 0, 0, 0, g.scaleB, 0, g.scaleA); \
        else { _Pragma("unroll") for (int k = 0; k < 2; ++k) acc[ai][bj][m][n] = __builtin_amdgcn_mfma_f32_16x16x32_bf16(Bt[n][k], At[m][k], acc[ai][bj][m][n], 0, 0, 0); } } __builtin_amdgcn_s_setprio(0); } while (0)
#define PG8_WAIT_V(n) asm volatile("s_waitcnt vmcnt(" #n ")" ::: "memory")
#define PG8_WAIT_L(n) asm volatile("s_waitcnt lgkmcnt(" #n ")" ::: "memory")
#define PG8_BAR __builtin_amdgcn_s_barrier()
#define PG8_SCHED __builtin_amdgcn_sched_barrier(0)
    Unit cur, nxt; int ui = 0;
    if (!S.next(0, cur)) return;
    f32x4 acc[2][2][4][2];
#pragma unroll
    for (int a = 0; a < 2; ++a)
#pragma unroll
        for (int b = 0; b < 2; ++b)
#pragma unroll
            for (int m = 0; m < 4; ++m)
#pragma unroll
                for (int n = 0; n < 2; ++n) acc[a][b][m][n] = (f32x4){0.f, 0.f, 0.f, 0.f};
    bf16x8 At[4][2], B0[2][2], B1[2][2];
    PG8_LAS int* const lring = S.lbuf;
    if constexpr (Epi::BIAS_LDS) { if (tid < BM) S.lbuf[3 * BM + tid] = __builtin_bit_cast(int, *E.bias_elem(cur, tid));
        asm volatile("s_waitcnt vmcnt(0) lgkmcnt(0)" ::: "memory"); PG8_BAR; asm volatile("" ::: "memory"); }
    constexpr bool LINROWS = Sched::LINROWS;
    if constexpr (GATHER && LINROWS) {
#pragma unroll
        for (int i = 0; i < 2; ++i) { voffA0[i] = (unsigned)(cur.srow + RA[i]) * (unsigned)KB + (unsigned)(CA[i] * 2); voffA1[i] = (unsigned)(cur.srow + HALF + RA[i]) * (unsigned)KB + (unsigned)(CA[i] * 2); } }
    if constexpr (GATHER && !LINROWS) {
        if (tid < BM) lring[tid] = S.list_entry(cur, tid);
        asm volatile("s_waitcnt vmcnt(0) lgkmcnt(0)" ::: "memory"); PG8_BAR; asm volatile("" ::: "memory");
#pragma unroll
        for (int i = 0; i < 2; ++i) { const int r0 = RA[i] < cur.rows ? RA[i] : cur.rows - 1, r1 = HALF + RA[i] < cur.rows ? HALF + RA[i] : cur.rows - 1;
            voffA0[i] = (unsigned)(lring[r0] >> S.ashift) * (unsigned)KB + (unsigned)(CA[i] * 2); voffA1[i] = (unsigned)(lring[r1] >> S.ashift) * (unsigned)KB + (unsigned)(CA[i] * 2); } }
    const char* cA = GATHER ? (const char*)g.A : (const char*)(cur.e && g.A2 ? g.A2 : g.A) + (size_t)cur.pm * tstepA; const char* cB = (const char*)(!GATHER && cur.e && g.Bt2 ? g.Bt2 : g.Bt) + (size_t)cur.pn * tstep;
    S.a_ready(cur);
    PG8_STAGE(PG8_SB(0, 0), cB, voffB); PG8_STAGE(PG8_SB(0, 1), cB + hstepB, voffB); PG8_STAGE(PG8_SA(0, 0), cA, voffA0); PG8_STAGE(PG8_SA(0, 1), cA, voffA1);
    if (wr == 1) PG8_BAR;
    PG8_WAIT_V(2); PG8_BAR;
    PG8_STAGE(PG8_SB(1, 0), cB + kstep, voffB); PG8_STAGE(PG8_SA(1, 0), cA + kstepA, voffA0); PG8_STAGE(PG8_SB(1, 1), cB + hstepB + kstep, voffB);
    PG8_WAIT_V(6); PG8_BAR;
    for (;;) {
        const bool has_next = S.next(ui + 1, nxt);
        const char* nA = GATHER ? cA : (has_next ? (const char*)(nxt.e && g.A2 ? g.A2 : g.A) + (size_t)nxt.pm * tstepA : cA); const char* nB = has_next ? (const char*)(!GATHER && nxt.e && g.Bt2 ? g.Bt2 : g.Bt) + (size_t)nxt.pn * tstep : cB;
        const int slot_cur = (ui % 3) * BM, slot_nxt = ((ui + 1) % 3) * BM;
        if constexpr (Epi::BIAS_LDS) { if (has_next && wid >= 4)
            __builtin_amdgcn_global_load_lds((const unsigned*)E.bias_elem(nxt, (wid - 4) * 64 + lane), (PG8_LAS unsigned*)(lring + 3 * BM + slot_nxt + (wid - 4) * 64), 4, 0, 0); }
        if constexpr (GATHER && !LINROWS) { if (has_next && wid < 4)
            __builtin_amdgcn_global_load_lds((const unsigned*)(S.list_ptr(nxt) + wid * 64 + lane), (PG8_LAS unsigned*)(lring + slot_nxt + wid * 64), 4, 0, 0); }
        for (int t = 0; t < nt; t += 2) {
            const bool last = (t == nt - 2);
            const char* a1 = cA + (size_t)(t + 1) * kstepA;
            const char* a2 = last ? nA : cA + (size_t)(t + 2) * kstepA; const char* b2 = last ? nB : cB + (size_t)(t + 2) * kstep;
            const char* a3 = a2 + kstepA; const char* b3 = b2 + kstep;
            if (last && has_next) S.a_ready(nxt);
            PG8_LDB(B0, 0, 0); PG8_LDB(B1, 0, 1); PG8_SCHED; PG8_LDA(At, 0, 0); PG8_STAGE(PG8_SA(1, 1), a1, voffA1);
            if constexpr (GATHER && LINROWS) { if (last && has_next) {
#pragma unroll
                for (int i = 0; i < 2; ++i) { voffA0[i] = (unsigned)(nxt.srow + RA[i]) * (unsigned)KB + (unsigned)(CA[i] * 2); voffA1[i] = (unsigned)(nxt.srow + HALF + RA[i]) * (unsigned)KB + (unsigned)(CA[i] * 2); } } }
            if constexpr (GATHER && !LINROWS) { if (last && has_next) {
#pragma unroll
                for (int i = 0; i < 2; ++i) { const int r0 = RA[i] < nxt.rows ? RA[i] : nxt.rows - 1, r1 = HALF + RA[i] < nxt.rows ? HALF + RA[i] : nxt.rows - 1;
                    voffA0[i] = (unsigned)(lring[slot_nxt + r0] >> S.ashift) * (unsigned)KB + (unsigned)(CA[i] * 2); voffA1[i] = (unsigned)(lring[slot_nxt + r1] >> S.ashift) * (unsigned)KB + (unsigned)(CA[i] * 2); } } }
            PG8_WAIT_V(8); PG8_WAIT_L(0); PG8_BAR; PG8_MMA(0, 0, At, B0); PG8_MMA(0, 1, At, B1); PG8_BAR; PG8_SCHED;
            PG8_LDA(At, 0, 1); PG8_STAGE(PG8_SB(0, 0), b2, voffB); PG8_STAGE(PG8_SB(0, 1), b2 + hstepB, voffB); PG8_STAGE(PG8_SA(0, 0), a2, voffA0);
            PG8_WAIT_V(8); PG8_WAIT_L(0); PG8_BAR; PG8_MMA(1, 0, At, B0); PG8_MMA(1, 1, At, B1); PG8_BAR; PG8_SCHED;
            PG8_LDB(B0, 1, 0); PG8_LDB(B1, 1, 1); PG8_SCHED; PG8_LDA(At, 1, 0); PG8_STAGE(PG8_SA(0, 1), a2, voffA1);
            PG8_WAIT_V(8); PG8_WAIT_L(0); PG8_BAR; PG8_MMA(0, 0, At, B0); PG8_MMA(0, 1, At, B1); PG8_BAR; PG8_SCHED;
            PG8_LDA(At, 1, 1); PG8_STAGE(PG8_SB(1, 0), b3, voffB); PG8_STAGE(PG8_SB(1, 1), b3 + hstepB, voffB); PG8_STAGE(PG8_SA(1, 0), a3, voffA0);
            PG8_WAIT_V(8); PG8_WAIT_L(0); PG8_BAR; PG8_MMA(1, 0, At, B0); PG8_MMA(1, 1, At, B1); PG8_BAR; PG8_SCHED;
        }
        if constexpr (ALIGN_EPI) { if (wr == 0) PG8_BAR; }
        E(acc, cur, wr, wc, fr, fq, lring + slot_cur); S.done(cur);
        if (!has_next) break;
#pragma unroll
        for (int a = 0; a < 2; ++a)
#pragma unroll
            for (int b = 0; b < 2; ++b)
#pragma unroll
                for (int m = 0; m < 4; ++m)
#pragma unroll
                    for (int n = 0; n < 2; ++n) acc[a][b][m][n] = (f32x4){0.f, 0.f, 0.f, 0.f};
        cur = nxt; cA = nA; cB = nB; ++ui;
        if constexpr (ALIGN_EPI) { if (wr == 1) PG8_BAR; }
    }
    PG8_WAIT_V(0);
    if constexpr (!ALIGN_EPI) { if (wr == 0) PG8_BAR; }
    PG8_BAR;
#undef PG8_SA
#undef PG8_SB
#undef PG8_STAGE
#undef PG8_LDA
#undef PG8_LDB
#undef PG8_MMA
#undef PG8_WAIT_V
#undef PG8_WAIT_L
#undef PG8_BAR
#undef PG8_SCHED
}

__device__ __forceinline__ unsigned cvt_pk_bf16(float lo, float hi) { unsigned r; asm volatile("v_cvt_pk_bf16_f32 %0, %1, %2" : "=v"(r) : "v"(lo), "v"(hi)); return r; }
__device__ __forceinline__ float bf_lo(unsigned w) { return __uint_as_float(w << 16); }
__device__ __forceinline__ float bf_hi(unsigned w) { return __uint_as_float(w & 0xffff0000u); }
__device__ __forceinline__ float sigm(float x) { return __builtin_amdgcn_rcpf(1.f + __builtin_amdgcn_exp2f(-1.4426950408889634f * x)); }
__device__ __forceinline__ f32x4 sigm4(f32x4 x) { f32x4 t = x * -1.4426950408889634f, s;
#pragma unroll
    for (int j = 0; j < 4; ++j) s[j] = __builtin_amdgcn_exp2f(t[j]);
    s = s + 1.f;
#pragma unroll
    for (int j = 0; j < 4; ++j) s[j] = __builtin_amdgcn_rcpf(s[j]);
    return s; }
__device__ __forceinline__ u32x4 pack8(const f32x4 v0, const f32x4 v1) { u32x4 w; w.x = cvt_pk_bf16(v0[0], v0[1]); w.y = cvt_pk_bf16(v0[2], v0[3]); w.z = cvt_pk_bf16(v1[0], v1[1]); w.w = cvt_pk_bf16(v1[2], v1[3]); return w; }
__device__ __forceinline__ void unpack8(const u32x4 w, f32x4& v0, f32x4& v1) { v0 = (f32x4){bf_lo(w.x), bf_hi(w.x), bf_lo(w.y), bf_hi(w.y)}; v1 = (f32x4){bf_lo(w.z), bf_hi(w.z), bf_lo(w.w), bf_hi(w.w)}; }

struct EpiProj {
    static constexpr bool PERM = true, BIAS_LDS = false;
    bf16_t* O; const float* qg; const float* kg; bf16_t* U; int ldc; float qscale; int nostore, urows;
    __device__ __forceinline__ void operator()(f32x4 (&acc)[2][2][4][2], const Unit& u, int wr, int wc, int fr, int fq, const PG8_LAS int* lrow) const {
        const int row0 = u.pm * BM + wr * 64 + fr, col0 = u.pl * BM + wc * 64 + 8 * fq;
        if (u.pl >= 4 && u.pl <= 8) {
            const float* gp = (u.pl == 8 ? kg : qg) + 8 * fq; const float sc = (u.pl == 8) ? 1.f : qscale;
            f32x4 gv[2][2];
#pragma unroll
            for (int bj = 0; bj < 2; ++bj)
#pragma unroll
                for (int n = 0; n < 2; ++n) gv[bj][n] = *(const f32x4*)(gp + 32 * bj + 4 * n) * sc;
#pragma unroll
            for (int ai = 0; ai < 2; ++ai)
#pragma unroll
                for (int m = 0; m < 4; ++m) { float ss = 0.f;
#pragma unroll
                    for (int bj = 0; bj < 2; ++bj)
#pragma unroll
                        for (int n = 0; n < 2; ++n) { const f32x4 v = acc[ai][bj][m][n]; ss += (v[0] * v[0] + v[1] * v[1]) + (v[2] * v[2] + v[3] * v[3]); }
                    ss += __shfl_xor(ss, 16); ss += __shfl_xor(ss, 32);
                    const float rs = rsqrtf(ss * (1.f / 64.f) + 1e-5f);
#pragma unroll
                    for (int bj = 0; bj < 2; ++bj)
#pragma unroll
                        for (int n = 0; n < 2; ++n) acc[ai][bj][m][n] = acc[ai][bj][m][n] * rs * gv[bj][n]; }
        }
#pragma unroll
        for (int ai = 0; ai < 2; ++ai)
#pragma unroll
            for (int m = 0; m < 4; ++m) { bf16_t* rowp = O + (size_t)(row0 + ai * HALF + m * 16) * ldc + col0;
#pragma unroll
                for (int bj = 0; bj < 2; ++bj) { const u32x4 w = pack8(acc[ai][bj][m][0], acc[ai][bj][m][1]);
                    if (u.pl < 4) { const int c = col0 + bj * 32; *(u32x4*)(U + ((size_t)(c >> 4) * urows + (size_t)(row0 + ai * HALF + m * 16)) * 16 + (c & 15)) = w; }
                    else if (!nostore) *(u32x4*)(rowp + bj * 32) = w; else asm volatile("" :: "v"(w)); } }
    }
};
struct EpiGlu {
    static constexpr bool PERM = true, BIAS_LDS = false;
    bf16_t* O; int ldc, pad;
    __device__ __forceinline__ void operator()(f32x4 (&acc)[2][2][4][2], const Unit& u, int wr, int wc, int fr, int fq, const PG8_LAS int* lrow) const {
        const int row0 = u.pm * BM + wr * 64 + fr, col0 = u.pl * HALF + wc * 32 + 8 * fq;
#pragma unroll
        for (int ai = 0; ai < 2; ++ai)
#pragma unroll
            for (int m = 0; m < 4; ++m) { bf16_t* rowp = O + (size_t)(row0 + ai * HALF + m * 16) * ldc + col0;
                const f32x4 o0 = acc[ai][0][m][0] * sigm4(acc[ai][1][m][0]), o1 = acc[ai][0][m][1] * sigm4(acc[ai][1][m][1]);
                *(u32x4*)rowp = pack8(o0, o1); }
    }
};
struct EpiGate {
    static constexpr bool PERM = true, BIAS_LDS = false;
    bf16_t* O; const bf16_t* G; int ldc, ldg, gcol0, gcol1;
    __device__ __forceinline__ void operator()(f32x4 (&acc)[2][2][4][2], const Unit& u, int wr, int wc, int fr, int fq, const PG8_LAS int* lrow) const {
        const int row0 = u.pm * BM + wr * 64 + fr, col0 = u.pl * BM + wc * 64 + 8 * fq; const bool add = u.e != 0; const int gcol = add ? gcol1 : gcol0;
#pragma unroll
        for (int ai = 0; ai < 2; ++ai) {
            u32x4 gw[4][2], ow[4][2];
#pragma unroll
            for (int m = 0; m < 4; ++m)
#pragma unroll
                for (int bj = 0; bj < 2; ++bj) { const size_t r = (size_t)(row0 + ai * HALF + m * 16);
                    gw[m][bj] = *(const u32x4*)(G + r * ldg + gcol + col0 + bj * 32);
                    if (add) ow[m][bj] = __builtin_nontemporal_load((const u32x4*)(O + r * ldc + col0 + bj * 32)); else ow[m][bj] = (u32x4){0u, 0u, 0u, 0u}; }
#pragma unroll
            for (int m = 0; m < 4; ++m)
#pragma unroll
                for (int bj = 0; bj < 2; ++bj) { const size_t r = (size_t)(row0 + ai * HALF + m * 16);
                    f32x4 g0, g1; unpack8(gw[m][bj], g0, g1);
                    f32x4 p0, p1; unpack8(ow[m][bj], p0, p1);
                    const f32x4 o0 = sigm4(g0) * acc[ai][bj][m][0] + p0, o1 = sigm4(g1) * acc[ai][bj][m][1] + p1;
                    *(u32x4*)(O + r * ldc + col0 + bj * 32) = pack8(o0, o1); } }
    }
};
struct EpiResid {
    static constexpr bool PERM = false, BIAS_LDS = false;
    const float* base; float* out; int ldc, pad;
    __device__ __forceinline__ void operator()(f32x4 (&acc)[2][2][4][2], const Unit& u, int wr, int wc, int fr, int fq, const PG8_LAS int* lrow) const {
        const int row0 = u.pm * BM + wr * 64 + fr, col0 = u.pl * BM + wc * 64 + 4 * fq;
#pragma unroll
        for (int ai = 0; ai < 2; ++ai) {
            f32x4 bv[4][2][2];
#pragma unroll
            for (int m = 0; m < 4; ++m) { const size_t off = (size_t)(row0 + ai * HALF + m * 16) * ldc + col0;
#pragma unroll
                for (int bj = 0; bj < 2; ++bj)
#pragma unroll
                    for (int n = 0; n < 2; ++n) bv[m][bj][n] = *(const f32x4*)(base + off + bj * 32 + n * 16); }
#pragma unroll
            for (int m = 0; m < 4; ++m) { const size_t off = (size_t)(row0 + ai * HALF + m * 16) * ldc + col0;
#pragma unroll
                for (int bj = 0; bj < 2; ++bj)
#pragma unroll
                    for (int n = 0; n < 2; ++n) *(f32x4*)(out + off + bj * 32 + n * 16) = bv[m][bj][n] + acc[ai][bj][m][n]; } }
    }
};
struct EpiSwiglu {
    static constexpr bool PERM = true, BIAS_LDS = true;
    __device__ __forceinline__ const float* bias_elem(const Unit& u, int i) const { return bias + (size_t)u.e * 2 * dff + u.pl * HALF + (i < HALF ? i : dff + i - HALF); }
    unsigned char* O; const float* bias; int ldc, dff; float limit, alpha; int skip, pad;
    __device__ __forceinline__ void operator()(f32x4 (&acc)[2][2][4][2], const Unit& u, int wr, int wc, int fr, int fq, const PG8_LAS int* lrow) const {
        if (skip) { for (int ai = 0; ai < 2; ++ai) for (int m = 0; m < 4; ++m) asm volatile("" :: "v"(acc[ai][0][m][0]), "v"(acc[ai][0][m][1]), "v"(acc[ai][1][m][0]), "v"(acc[ai][1][m][1])); return; }
        asm volatile("" : "+v"(fr));
        const int col0 = u.pl * HALF + wc * 32 + 8 * fq;
        const PG8_LAS float* bg = (const PG8_LAS float*)(lrow + 3 * BM) + wc * 32 + 8 * fq; const PG8_LAS float* bu = bg + HALF;
        const f32x4 bg0 = *(const PG8_LAS f32x4*)bg, bg1 = *(const PG8_LAS f32x4*)(bg + 4), bu0 = *(const PG8_LAS f32x4*)bu, bu1 = *(const PG8_LAS f32x4*)(bu + 4);
        const float nal2 = -1.4426950408889634f * alpha;
#pragma unroll
        for (int ai = 0; ai < 2; ++ai)
#pragma unroll
            for (int m = 0; m < 4; ++m) { const int r = ai * HALF + wr * 64 + m * 16 + fr; unsigned char* rowp = O + (size_t)(u.srow + r) * ldc + col0;
                const f32x4 gt0 = __builtin_elementwise_min(acc[ai][0][m][0] + bg0, (f32x4){limit, limit, limit, limit}), gt1 = __builtin_elementwise_min(acc[ai][0][m][1] + bg1, (f32x4){limit, limit, limit, limit});
                f32x4 up0 = acc[ai][1][m][0] + bu0, up1 = acc[ai][1][m][1] + bu1, s0, s1;
                const f32x4 a0 = gt0 * nal2, a1 = gt1 * nal2;
#pragma unroll
                for (int j = 0; j < 4; ++j) { up0[j] = __builtin_amdgcn_fmed3f(up0[j], -limit, limit); up1[j] = __builtin_amdgcn_fmed3f(up1[j], -limit, limit);
                    s0[j] = __builtin_amdgcn_exp2f(a0[j]); s1[j] = __builtin_amdgcn_exp2f(a1[j]); }
                s0 = s0 + 1.f; s1 = s1 + 1.f;
#pragma unroll
                for (int j = 0; j < 4; ++j) { s0[j] = __builtin_amdgcn_rcpf(s0[j]); s1[j] = __builtin_amdgcn_rcpf(s1[j]); }
                const f32x4 o0 = (up0 * gt0 + gt0) * s0, o1 = (up1 * gt1 + gt1) * s1;
                int w0 = __builtin_amdgcn_cvt_pk_fp8_f32(o0[0], o0[1], 0, false); w0 = __builtin_amdgcn_cvt_pk_fp8_f32(o0[2], o0[3], w0, true);
                int w1 = __builtin_amdgcn_cvt_pk_fp8_f32(o1[0], o1[1], 0, false); w1 = __builtin_amdgcn_cvt_pk_fp8_f32(o1[2], o1[3], w1, true);
                *(unsigned long long*)rowp = (unsigned long long)(unsigned)w0 | ((unsigned long long)(unsigned)w1 << 32); }
    }
};
struct EpiDown {
    static constexpr bool PERM = true, BIAS_LDS = true;
    __device__ __forceinline__ const float* bias_elem(const Unit& u, int i) const { return bias + (size_t)u.e * ncol + u.pl * BM + i; }
    bf16_t* O; const float* bias; int ldc, ncol, skip, pad;
    __device__ __forceinline__ void operator()(f32x4 (&acc)[2][2][4][2], const Unit& u, int wr, int wc, int fr, int fq, const PG8_LAS int* lrow) const {
        if (skip) { for (int ai = 0; ai < 2; ++ai) for (int m = 0; m < 4; ++m) asm volatile("" :: "v"(acc[ai][0][m][0]), "v"(acc[ai][0][m][1]), "v"(acc[ai][1][m][0]), "v"(acc[ai][1][m][1])); return; }
        asm volatile("" : "+v"(fr));
        const int col0 = u.pl * BM + wc * 64 + 8 * fq;
        const PG8_LAS float* bp = (const PG8_LAS float*)(lrow + 3 * BM) + wc * 64 + 8 * fq;
        f32x4 bv[2][2];
#pragma unroll
        for (int bj = 0; bj < 2; ++bj) { bv[bj][0] = *(const PG8_LAS f32x4*)(bp + bj * 32); bv[bj][1] = *(const PG8_LAS f32x4*)(bp + bj * 32 + 4); }
#pragma unroll
        for (int ai = 0; ai < 2; ++ai)
#pragma unroll
            for (int m = 0; m < 4; ++m) { bf16_t* rowp = O + (size_t)(u.srow + ai * HALF + wr * 64 + m * 16 + fr) * ldc + col0;
#pragma unroll
                for (int bj = 0; bj < 2; ++bj) *(u32x4*)(rowp + bj * 32) = pack8(acc[ai][bj][m][0] + bv[bj][0], acc[ai][bj][m][1] + bv[bj][1]); }
    }
};
template <bool GATH> struct GroupedOrderT {
    static constexpr bool GATHER = true, FP8 = true, LINROWS = !GATH;
    const PG8_LAS unsigned char* tile_e; const PG8_LAS int* pref; const PG8_LAS int* cnt; PG8_LAS int* lbuf; const int* list; int nN, G, c, nM, lstride, ashift;
    __device__ __forceinline__ bool next(int i, Unit& u) const {
        const int nwg = nM * nN; const long L = (long)i * G + c; if (L >= nwg) return false;
        int wgid = (int)L; { const int q = nwg / NXCD, r = nwg % NXCD, xcd = wgid % NXCD, off = wgid / NXCD; wgid = (xcd < r ? xcd * (q + 1) : r * (q + 1) + (xcd - r) * q) + off; }
        const int nig = WGM * nN, gid = wgid / nig, fm = gid * WGM, gsz = (nM - fm) < WGM ? (nM - fm) : WGM;
        const int mt = fm + ((wgid % nig) % gsz), pl = (wgid % nig) / gsz;
        const int e = tile_e[mt]; const int mtl = mt - pref[e]; const int left = cnt[e] - 256 * mtl;
        u.pm = mtl; u.pn = e * nN + pl; u.e = e; u.pl = pl; u.rows = left < 256 ? left : 256; u.srow = mt * BM; return true;
    }
    __device__ __forceinline__ const int* list_ptr(const Unit& u) const { return list + (size_t)u.e * lstride + u.pm * BM; }
    __device__ __forceinline__ int list_entry(const Unit& u, int r) const { return list_ptr(u)[r < u.rows ? r : u.rows - 1]; }
    __device__ __forceinline__ void a_ready(const Unit&) const {}
    __device__ __forceinline__ void done(const Unit&) const {}
};
struct DualOrder {
    static constexpr bool GATHER = false, FP8 = false, LINROWS = false;
    static constexpr PG8_LAS int* lbuf = nullptr;
    StaticOrder S; int nper;
    __device__ __forceinline__ void init(int M, int N, int G, int c) { S.init(M, N, G, c); nper = (S.nwg - c + G - 1) / G; if (nper < 0) nper = 0; }
    __device__ __forceinline__ bool next(int i, Unit& u) const { if (i >= 2 * nper) return false; const int e = i >= nper ? 1 : 0; const bool ok = S.next(i - e * nper, u); u.e = e; return ok; }
    __device__ __forceinline__ void a_ready(const Unit&) const {}
    __device__ __forceinline__ void done(const Unit&) const {}
};
}

#define GAS __attribute__((address_space(1)))
#define LAS __attribute__((address_space(3)))
typedef unsigned short bf16;
typedef unsigned v4u __attribute__((ext_vector_type(4)));
typedef float f32x4 __attribute__((ext_vector_type(4)));
typedef short bf16x8 __attribute__((ext_vector_type(8)));
typedef GAS unsigned gu32;
typedef GAS unsigned long long gu64;
#define RLX_AGENT __ATOMIC_RELAXED, __HIP_MEMORY_SCOPE_AGENT
#define LDS_WAIT() asm volatile("s_waitcnt lgkmcnt(0)" ::: "memory")
#define VM_WAIT() asm volatile("s_waitcnt vmcnt(0)" ::: "memory")
__device__ __forceinline__ unsigned long long rt() { return __builtin_amdgcn_s_memrealtime(); }
__device__ __forceinline__ unsigned f2bf(float f) { unsigned u = __builtin_bit_cast(unsigned, f); return (u + 0x7fffu + ((u >> 16) & 1u)) >> 16; }
__device__ __forceinline__ unsigned pk2(float lo, float hi) { return f2bf(lo) | (f2bf(hi) << 16); }

#define XB_TMO      128
#define XB_XCNT(j)  (256  + 64 * (j))
#define XB_XSUB(j)  (1280 + 64 * (j))
#define XB_XGEN(j)  (2304 + 64 * (j))
#define XB_TOP      3328
#define XB_TOPGEN   3392
#define XCD_BAR_WORDS 3456
#define XB_SPIN_CAP (1u << 18)

__device__ __forceinline__ unsigned xb_ld(unsigned* p)              { return __hip_atomic_load(p, __ATOMIC_RELAXED, __HIP_MEMORY_SCOPE_AGENT); }
__device__ __forceinline__ unsigned xb_add(unsigned* p, unsigned v) { return __hip_atomic_fetch_add(p, v, __ATOMIC_RELAXED, __HIP_MEMORY_SCOPE_AGENT); }
__device__ __forceinline__ unsigned xb_xcc_id() { return (unsigned)__builtin_amdgcn_s_getreg((3 << 11) | 20) & 0xFu; }
#define XB_SPIN(cond, bar) do { unsigned _sp = 0; while (cond) { __builtin_amdgcn_s_sleep(1); \
    if ((++_sp & 255u) == 0u) { if (xb_ld(&(bar)[XB_TMO])) break; if (_sp > XB_SPIN_CAP) { atomicAdd(&(bar)[XB_TMO], 1u); break; } } } } while (0)

struct XcdBarrier {
    unsigned* bar; unsigned x;
    volatile LAS unsigned* st;
};

__device__ __forceinline__ XcdBarrier xcd_barrier_post(unsigned* bar, volatile LAS unsigned* st) {
    XcdBarrier b; b.bar = bar; b.x = xb_xcc_id(); b.st = st;
    if (threadIdx.x == 0) (void)xb_add(&bar[XB_XCNT(b.x)], 1u);
    return b;
}
__device__ __forceinline__ void xcd_barrier_complete(unsigned* bar, unsigned x, unsigned& nloc, unsigned& nx) {
    const unsigned G = gridDim.x * gridDim.y * gridDim.z;
    unsigned sum, cnt, mine, sp = 0u;
    for (;;) {
        sum = 0u; cnt = 0u; mine = 0u;
#pragma unroll
        for (unsigned j = 0; j < 16; ++j) { const unsigned c = xb_ld(&bar[XB_XCNT(j)]); sum += c; cnt += (c > 0u) ? 1u : 0u; mine = (j == x) ? c : mine; }
        if (sum == G) break;
        __builtin_amdgcn_s_sleep(1);
        if ((++sp & 255u) == 0u) { if (xb_ld(&bar[XB_TMO])) break; if (sp > XB_SPIN_CAP) { atomicAdd(&bar[XB_TMO], 1u); break; } }
    }
    nloc = mine > 0u ? mine : 1u; nx = cnt > 0u ? cnt : 1u;
}

__device__ __forceinline__ void xcd_barrier(const XcdBarrier& b) {
    asm volatile("s_waitcnt vmcnt(0)" ::: "memory");
    __syncthreads();
    if (threadIdx.x == 0) {
        unsigned* bar = b.bar;
        __builtin_amdgcn_s_waitcnt(0);
        unsigned nloc = b.st[0], nx = b.st[1];
        if (nloc == 0u) { xcd_barrier_complete(bar, b.x, nloc, nx); b.st[0] = nloc; b.st[1] = nx; }
        const unsigned old = xb_add(&bar[XB_XSUB(b.x)], 1u);
        const unsigned gen = old / nloc;
        if (old + 1u == (gen + 1u) * nloc) {
            __builtin_amdgcn_fence(__ATOMIC_RELEASE, "agent");
            asm volatile("s_waitcnt vmcnt(0)" ::: "memory");
            const unsigned og = xb_add(&bar[XB_TOP], 1u);
            const unsigned tg = og / nx;
            if (og + 1u == (tg + 1u) * nx) xb_add(&bar[XB_TOPGEN], 1u);
            else XB_SPIN(xb_ld(&bar[XB_TOPGEN]) == tg, bar);
            __builtin_amdgcn_fence(__ATOMIC_ACQUIRE, "agent");
            xb_add(&bar[XB_XGEN(b.x)], 1u);
            asm volatile("s_waitcnt vmcnt(0)" ::: "memory");
        } else {
            XB_SPIN(xb_ld(&bar[XB_XGEN(b.x)]) == gen, bar);
            __builtin_amdgcn_fence(__ATOMIC_ACQUIRE, "agent");
            asm volatile("s_waitcnt vmcnt(0)" ::: "memory");
        }
    }
    __syncthreads();
}

constexpr size_t MiB = 1u << 20;
constexpr size_t WS_CTL = 0;
constexpr size_t CTL_ZERO_BYTES = 65536;
constexpr size_t WS_WIN = 1 * MiB, WS_WGLU = 10 * MiB, WS_WSSM = 14 * MiB, WS_WATT = 16 * MiB, WS_WOUT = 18 * MiB;
constexpr size_t WS_WGU = 20 * MiB, WS_WDN = 148 * MiB;
constexpr float WSCALE = 64.f; constexpr int WSCALE_E8M0 = 127 - 6;
constexpr size_t WS_ROUTE = 216 * MiB;
constexpr size_t WS_H = 224 * MiB;
constexpr size_t WS_PROJ = 288 * MiB;
constexpr size_t WS_S5OUT = 576 * MiB;
constexpr size_t WS_ATTN = 640 * MiB;
constexpr size_t WS_ACT = 704 * MiB;
constexpr size_t WS_BTAB = 976 * MiB, WS_CTAB = 980 * MiB, WS_KTAB = 984 * MiB, WS_A16 = 985 * MiB;
constexpr size_t WS_END = 986 * MiB;
static_assert(WS_PROJ + (size_t)T * IN_W * 2 <= WS_S5OUT && WS_PROJ + (size_t)MAXROWS * 1024 * 2 <= WS_S5OUT && WS_ACT + (size_t)MAXROWS * 1024 <= WS_BTAB, "ws map");
constexpr int CW_CNT = 0;
constexpr int CW_BAR = 4096;
static_assert((CW_BAR + 3 * XCD_BAR_WORDS) * 4 <= (int)CTL_ZERO_BYTES, "ctl map");
constexpr size_t RT_TOPW = 0, RT_LIST = 1 * MiB, RT_APOS = 5 * MiB;

constexpr int LDS_BYTES = 163840;
constexpr int RING_OFF = 0;
constexpr int MISC_OFF = LDS_BYTES - 256;
constexpr int GT_OFF = 131072;

__device__ __forceinline__ float bf2f(bf16 b) { return __uint_as_float((unsigned)b << 16); }
__device__ __forceinline__ float wave_sum(float v) {
#pragma unroll
    for (int o = 1; o < 64; o <<= 1) v += __shfl_xor(v, o);
    return v;
}
__device__ __forceinline__ float wave_max(float v) {
#pragma unroll
    for (int o = 1; o < 64; o <<= 1) v = fmaxf(v, __shfl_xor(v, o));
    return v;
}
__device__ __forceinline__ float gelu_tanh(float x) { const float z = -2.3022081985f * (x + 0.044715f * x * x * x); return x * __builtin_amdgcn_rcpf(1.f + __builtin_amdgcn_exp2f(z)); }
#define WAVE_SYNC() do { __builtin_amdgcn_wave_barrier(); asm volatile("s_waitcnt lgkmcnt(0)" ::: "memory"); } while (0)

struct Args { const float* in[25]; float* out; unsigned char* ws; int ph_lo, ph_hi, bar_idx, sub; };
struct Ctx { int tid, lane, wave, vcu, G, gw, ngw; LAS unsigned char* lds; };

constexpr int TR_SCR = 64 * 65 * 4;
__device__ __forceinline__ void transpose_item(const float* W, int K, int N, bf16* WT, int mode, LAS float* scr, int item, int lane) {
    const int nblk = N / 64, kb = item / nblk, nb = item % nblk, k0 = 64 * kb, n0 = 64 * nb;
#pragma unroll 4
    for (int i = 0; i < 16; ++i) { const int kk = 4 * i + (lane >> 4), nn = 4 * (lane & 15); const f32x4 w = *(const f32x4*)(W + (size_t)(k0 + kk) * N + n0 + nn);
        LAS float* s = scr + kk * 65 + nn; s[0] = w.x; s[1] = w.y; s[2] = w.z; s[3] = w.w; }
    LDS_WAIT(); asm volatile("" ::: "memory");
    const int c = lane & 7;
#pragma unroll
    for (int j = 0; j < 8; ++j) { const int n = (lane >> 3) + 8 * j; const LAS float* s = scr + (8 * c) * 65 + n;
        v4u o; o.x = pk2(s[0 * 65], s[1 * 65]); o.y = pk2(s[2 * 65], s[3 * 65]); o.z = pk2(s[4 * 65], s[5 * 65]); o.w = pk2(s[6 * 65], s[7 * 65]);
        int r = n0 + n;
        if (mode == 1) { const int nh = N / 2, hf = (r >= nh) ? 1 : 0, np = r - hf * nh; r = 256 * (np / 128) + 64 * ((np % 128) / 32) + 32 * hf + (np % 32); }
        *(v4u*)(WT + (size_t)r * K + k0 + 8 * c) = o; }
    LDS_WAIT(); asm volatile("" ::: "memory");
}
__device__ __forceinline__ void transpose_item_fp8(const float* W, int K, int N, unsigned char* WT, int mode, float wscale, LAS float* scr, int item, int lane) {
    const int nblk = N / 64, kb = item / nblk, nb = item % nblk, k0 = 64 * kb, n0 = 64 * nb;
#pragma unroll 4
    for (int i = 0; i < 16; ++i) { const int kk = 4 * i + (lane >> 4), nn = 4 * (lane & 15); const f32x4 w = *(const f32x4*)(W + (size_t)(k0 + kk) * N + n0 + nn);
        LAS float* s = scr + kk * 65 + nn; s[0] = w.x; s[1] = w.y; s[2] = w.z; s[3] = w.w; }
    LDS_WAIT(); asm volatile("" ::: "memory");
    const int c = lane & 3;
#pragma unroll
    for (int j = 0; j < 4; ++j) { const int n = (lane >> 2) + 16 * j; const LAS float* s = scr + (16 * c) * 65 + n;
        v4u o;
#pragma unroll
        for (int q = 0; q < 4; ++q) { int w = __builtin_amdgcn_cvt_pk_fp8_f32(s[(4 * q) * 65] * wscale, s[(4 * q + 1) * 65] * wscale, 0, false); w = __builtin_amdgcn_cvt_pk_fp8_f32(s[(4 * q + 2) * 65] * wscale, s[(4 * q + 3) * 65] * wscale, w, true); o[q] = (unsigned)w; }
        int r = n0 + n;
        if (mode == 1) { const int nh = N / 2, hf = (r >= nh) ? 1 : 0, np = r - hf * nh; r = 256 * (np / 128) + 64 * ((np % 128) / 32) + 32 * hf + (np % 32); }
        *(v4u*)(WT + (size_t)r * K + k0 + 16 * c) = o; }
    LDS_WAIT(); asm volatile("" ::: "memory");
}
__device__ __forceinline__ void transpose_job_fp8(const Ctx& C, const float* W, unsigned char* WT, int K, int N, int mode, int nmat, float wscale) {
    LAS float* scr = (LAS float*)(C.lds + RING_OFF + C.wave * TR_SCR);
    const int per = (K / 64) * (N / 64); const int total = per * nmat;
    for (int it = C.gw; it < total; it += C.ngw) { const int mat = it / per, item = it % per;
        transpose_item_fp8(W + (size_t)mat * K * N, K, N, WT + (size_t)mat * K * N, mode, wscale, scr, item, C.lane); }
}
__device__ __forceinline__ void transpose_job(const Ctx& C, const float* W, bf16* WT, int K, int N, int mode, int nmat) {
    LAS float* scr = (LAS float*)(C.lds + RING_OFF + C.wave * TR_SCR);
    const int per = (K / 64) * (N / 64); const int total = per * nmat;
    for (int it = C.gw; it < total; it += C.ngw) { const int mat = it / per, item = it % per;
        transpose_item(W + (size_t)mat * K * N, K, N, WT + (size_t)mat * K * N, mode, scr, item, C.lane); }
}
__device__ __forceinline__ void rmsnorm_rows(const Ctx& C, const float* x, const float* g, bf16* out) {
    for (int m = C.gw; m < T; m += C.ngw) {
        const f32x4* xr = (const f32x4*)(x + (size_t)m * DM) + C.lane; f32x4 v[4]; float s = 0.f;
#pragma unroll
        for (int j = 0; j < 4; ++j) { v[j] = xr[64 * j]; s += (v[j].x * v[j].x + v[j].y * v[j].y) + (v[j].z * v[j].z + v[j].w * v[j].w); }
        const float rs = rsqrtf(wave_sum(s) * (1.f / DM) + EPS);
        unsigned long long* o8 = (unsigned long long*)(out + (size_t)m * DM) + C.lane;
#pragma unroll
        for (int j = 0; j < 4; ++j) { const f32x4 gg = ((const f32x4*)g)[64 * j + C.lane];
            o8[64 * j] = (unsigned long long)pk2(v[j].x * rs * gg.x, v[j].y * rs * gg.y) | ((unsigned long long)pk2(v[j].z * rs * gg.z, v[j].w * rs * gg.w) << 32); }
    }
}
__device__ __forceinline__ void router_pass(const Ctx& C, const float* x1, const float* g2, const float* w_router, const float* b_router, unsigned char* h2, float* top_w, int* list, int* apos, unsigned* ctl) {
    LAS float* HN = (LAS float*)(C.lds + RING_OFF); LAS float* PART = HN + 16 * 1024; LAS unsigned* HIST = (LAS unsigned*)(PART + 8 * 2 * 16 * 32); LAS unsigned* BASE = HIST + 32; LAS unsigned* RK = BASE + 32;
    LAS unsigned char* EIDS = (LAS unsigned char*)(RK + 32);
    int tid = C.tid; asm volatile("" : "+v"(tid));
    const int lane = tid & 63, wave = C.wave, e = lane & 31, dh = lane >> 5;
    float wreg[64];
#pragma unroll
    for (int i = 0; i < 64; ++i) wreg[i] = w_router[(size_t)(128 * wave + 64 * dh + i) * NE + e];
    const float bias = b_router[e];
    if (tid < 32) HIST[tid] = 0u;
    __syncthreads();
    int nrounds = 0;
    f32x4 vn[2][4];
    if (C.vcu < T / 16) {
#pragma unroll
        for (int q = 0; q < 2; ++q) { const f32x4* xr = (const f32x4*)(x1 + (size_t)(C.vcu * 16 + 2 * wave + q) * DM) + lane;
#pragma unroll
            for (int j = 0; j < 4; ++j) vn[q][j] = xr[64 * j]; } }
    for (int grp = C.vcu; grp < T / 16; grp += C.G, ++nrounds) {
        f32x4 v[2][4];
#pragma unroll
        for (int q = 0; q < 2; ++q)
#pragma unroll
            for (int j = 0; j < 4; ++j) v[q][j] = vn[q][j];
        if (grp + C.G < T / 16) {
#pragma unroll
            for (int q = 0; q < 2; ++q) { const f32x4* xr = (const f32x4*)(x1 + (size_t)((grp + C.G) * 16 + 2 * wave + q) * DM) + lane;
#pragma unroll
                for (int j = 0; j < 4; ++j) vn[q][j] = xr[64 * j]; } }
#pragma unroll
        for (int q = 0; q < 2; ++q) { const int tl = 2 * wave + q; float s = 0.f;
#pragma unroll
            for (int j = 0; j < 4; ++j) s += (v[q][j].x * v[q][j].x + v[q][j].y * v[q][j].y) + (v[q][j].z * v[q][j].z + v[q][j].w * v[q][j].w);
            const float rs = rsqrtf(wave_sum(s) * (1.f / DM) + EPS);
            int* o4 = (int*)(h2 + (size_t)(grp * 16 + tl) * DM) + lane;
#pragma unroll
            for (int j = 0; j < 4; ++j) { const f32x4 gg = ((const f32x4*)g2)[64 * j + lane];
                const f32x4 y = (f32x4){v[q][j].x * rs * gg.x, v[q][j].y * rs * gg.y, v[q][j].z * rs * gg.z, v[q][j].w * rs * gg.w};
                *(LAS f32x4*)(HN + tl * 1024 + 256 * j + 4 * lane) = y;
                int w = __builtin_amdgcn_cvt_pk_fp8_f32(y.x, y.y, 0, false); w = __builtin_amdgcn_cvt_pk_fp8_f32(y.z, y.w, w, true); o4[64 * j] = w; } }
        __syncthreads();
        const LAS float* hb = HN + 128 * wave + 64 * dh;
#pragma unroll 1
        for (int t = 0; t < 16; t += 4) { float a0 = 0.f, a1 = 0.f, a2 = 0.f, a3 = 0.f;
#pragma unroll
            for (int i4 = 0; i4 < 16; ++i4) {
                const f32x4 h0 = *(const LAS f32x4*)(hb + (t + 0) * 1024 + 4 * i4), h1 = *(const LAS f32x4*)(hb + (t + 1) * 1024 + 4 * i4), h2v = *(const LAS f32x4*)(hb + (t + 2) * 1024 + 4 * i4), h3 = *(const LAS f32x4*)(hb + (t + 3) * 1024 + 4 * i4);
                a0 += h0.x * wreg[4 * i4] + h0.y * wreg[4 * i4 + 1] + h0.z * wreg[4 * i4 + 2] + h0.w * wreg[4 * i4 + 3];
                a1 += h1.x * wreg[4 * i4] + h1.y * wreg[4 * i4 + 1] + h1.z * wreg[4 * i4 + 2] + h1.w * wreg[4 * i4 + 3];
                a2 += h2v.x * wreg[4 * i4] + h2v.y * wreg[4 * i4 + 1] + h2v.z * wreg[4 * i4 + 2] + h2v.w * wreg[4 * i4 + 3];
                a3 += h3.x * wreg[4 * i4] + h3.y * wreg[4 * i4 + 1] + h3.z * wreg[4 * i4 + 2] + h3.w * wreg[4 * i4 + 3]; }
            LAS float* pp = PART + ((wave * 2 + dh) * 16 + t) * 32 + e; pp[0] = a0; pp[32] = a1; pp[64] = a2; pp[96] = a3; }
        __syncthreads();
#pragma unroll 1
        for (int q = 0; q < 2; ++q) { const int tl = 2 * wave + q; float acc = 0.f;
#pragma unroll
            for (int w8 = 0; w8 < 8; ++w8) acc += PART[((4 * dh * 2 + w8) * 16 + tl) * 32 + e];
            acc += __shfl_xor(acc, 32);
            float logit = acc + bias;
            float tv[4]; int ti[4];
#pragma unroll
            for (int k = 0; k < 4; ++k) { const float mx = wave_max(logit); const unsigned long long bal = __ballot(logit == mx); const int idx = (__ffsll((long long)bal) - 1) & 31;
                tv[k] = mx; ti[k] = idx; if (e == idx) logit = -INFINITY; }
            const float e1 = __expf(tv[1] - tv[0]), e2 = __expf(tv[2] - tv[0]), e3 = __expf(tv[3] - tv[0]); const float inv = 1.f / (1.f + e1 + e2 + e3);
            if (lane < 4) { const int k = lane; const int ei = k == 0 ? ti[0] : k == 1 ? ti[1] : k == 2 ? ti[2] : ti[3]; const float wv = (k == 0 ? 1.f : k == 1 ? e1 : k == 2 ? e2 : e3) * inv;
                top_w[(size_t)(grp * 16 + tl) * 4 + k] = wv; EIDS[(nrounds * 16 + tl) * 4 + k] = (unsigned char)ei;
                __hip_atomic_fetch_add(HIST + ei, 1u, __ATOMIC_RELAXED, __HIP_MEMORY_SCOPE_WORKGROUP); } }
    }
    __syncthreads();
    if (tid < 32) { BASE[tid] = atomicAdd(ctl + CW_CNT + tid, HIST[tid]); RK[tid] = 0u; }
    __syncthreads();
    for (int idx = tid; idx < nrounds * 64; idx += 512) { const int ei = EIDS[idx]; const unsigned rank = __hip_atomic_fetch_add(RK + ei, 1u, __ATOMIC_RELAXED, __HIP_MEMORY_SCOPE_WORKGROUP);
        const int r = idx >> 6, tl = (idx >> 2) & 15, k = idx & 3, a = ((C.vcu + r * C.G) * 16 + tl) * 4 + k; const int slot = (int)(BASE[ei] + rank); list[(size_t)ei * T + slot] = a; apos[a] = (ei << 20) | slot; }
    __syncthreads();
}
__device__ __forceinline__ int grouped_tables(const Ctx& C, const unsigned* ctl) {
    LAS int* cnt = (LAS int*)(C.lds + GT_OFF); LAS int* pref = cnt + 32; LAS unsigned char* tile_e = (LAS unsigned char*)(pref + 36);
    if (C.wave == 0) {
        const int e = C.lane & 31; const int c = (int)__hip_atomic_load(ctl + CW_CNT + e, RLX_AGENT); const int n = (c + 255) >> 8;
        int incl = n;
#pragma unroll
        for (int o = 1; o < 32; o <<= 1) { const int t = __shfl_up(incl, o, 32); if (e >= o) incl += t; }
        const int start = incl - n;
        if (C.lane < 32) { cnt[e] = c; pref[e] = start; if (e == 31) pref[32] = incl; for (int i = 0; i < n; ++i) tile_e[start + i] = (unsigned char)e; }
    }
    __syncthreads();
    return pref[NE];
}
__device__ __forceinline__ void combine_pass(const Ctx& C, float* out, const bf16* ys, const float* top_w, const int* apos) {
    const LAS int* pref = (const LAS int*)(C.lds + GT_OFF) + 32;
    const int lane = C.lane;
    for (int tok = C.gw; tok < T; tok += C.ngw) {
        f32x4* o = (f32x4*)(out + (size_t)tok * DM);
        f32x4 acc[4];
#pragma unroll
        for (int j = 0; j < 4; ++j) acc[j] = o[64 * j + lane];
        const f32x4 wv4 = *(const f32x4*)(top_w + (size_t)tok * 4);
        const int4 ap = *(const int4*)(apos + (size_t)tok * 4);
#pragma unroll
        for (int k = 0; k < 4; ++k) { const float wv = wv4[k]; const int p = k == 0 ? ap.x : k == 1 ? ap.y : k == 2 ? ap.z : ap.w; const int srow = pref[p >> 20] * 256 + (p & 0xFFFFF);
            const unsigned long long* y8 = (const unsigned long long*)(ys + (size_t)srow * DM);
#pragma unroll
            for (int j = 0; j < 4; ++j) { const unsigned long long q = y8[64 * j + lane]; const unsigned lo = (unsigned)q, hi = (unsigned)(q >> 32);
                acc[j].x += wv * __uint_as_float(lo << 16); acc[j].y += wv * __uint_as_float(lo & 0xffff0000u); acc[j].z += wv * __uint_as_float(hi << 16); acc[j].w += wv * __uint_as_float(hi & 0xffff0000u); } }
#pragma unroll
        for (int j = 0; j < 4; ++j) o[64 * j + lane] = acc[j];
    }
}

namespace att {
using bf16x8 = __attribute__((ext_vector_type(8))) short;
using s16x4 = __attribute__((ext_vector_type(4))) short;
using f32x16 = __attribute__((ext_vector_type(16))) float;
using u32x4 = __attribute__((ext_vector_type(4))) unsigned;
typedef float f32x2_t __attribute__((ext_vector_type(2))); typedef __bf16 bf16x2_t __attribute__((ext_vector_type(2)));
constexpr float LOG2E = 1.4426950408889634f, QSCALE = 0.125f * LOG2E;
constexpr int SLOTB = 8192, NSLOT = 4;
constexpr int L_K = 0, L_V = NSLOT * SLOTB, L_WS = 2 * NSLOT * SLOTB, L_OST = L_WS + 8 * 256, L_BYTES = L_OST + 8 * 4096;
__device__ __forceinline__ int crow(int r, int hi) { return (r & 3) + 8 * (r >> 2) + 4 * hi; }
__device__ __forceinline__ void glds16(const void* gsrc, unsigned lds_dst) { unsigned keep;
    asm volatile("s_mov_b32 %0, m0\n\ts_mov_b32 m0, %2\n\ts_nop 0\n\tglobal_load_lds_dwordx4 %1, off\n\ts_mov_b32 m0, %0" : "=&s"(keep) : "v"(gsrc), "s"(lds_dst) : "memory"); }
__device__ __forceinline__ unsigned cvtpk_s(float lo, float hi) { f32x2_t v = {lo, hi}; bf16x2_t b = __builtin_convertvector(v, bf16x2_t); return __builtin_bit_cast(unsigned, b); }
typedef __attribute__((address_space(3))) const char* lds_cptr;
__device__ __forceinline__ void qkt_half(f32x16& p, lds_cptr kb, const bf16x8* qr) {
    const f32x16 z = f32x16{};
#pragma unroll
    for (int d0 = 0; d0 < 4; ++d0) {
        const bf16x8 b0 = *(const __attribute__((address_space(3))) bf16x8*)(kb + d0 * 2048);
        p = __builtin_amdgcn_mfma_f32_32x32x16_bf16(b0, qr[d0], d0 == 0 ? z : p, 0, 0, 0); }
}
__device__ __forceinline__ void pv_half(f32x16* o, int vb, bf16x8 pa0, bf16x8 pa1) {
#pragma unroll
    for (int d0 = 0; d0 < 2; ++d0) { s16x4 lo[2], hi[2];
#pragma unroll
        for (int ks = 0; ks < 2; ++ks) {
            asm volatile("ds_read_b64_tr_b16 %0,%1 offset:%c2" : "=&v"(lo[ks]) : "v"(vb), "i"(d0 * 4096 + ks * 1024) : "memory");
            asm volatile("ds_read_b64_tr_b16 %0,%1 offset:%c2" : "=&v"(hi[ks]) : "v"(vb), "i"(d0 * 4096 + ks * 1024 + 512) : "memory"); }
        asm volatile("s_waitcnt lgkmcnt(0)" ::: "memory"); __builtin_amdgcn_sched_barrier(0);
#define ATT_PK(k) (bf16x8){lo[k][0], lo[k][1], lo[k][2], lo[k][3], hi[k][0], hi[k][1], hi[k][2], hi[k][3]}
        o[d0] = __builtin_amdgcn_mfma_f32_32x32x16_bf16(pa0, ATT_PK(0), o[d0], 0, 0, 0);
        o[d0] = __builtin_amdgcn_mfma_f32_32x32x16_bf16(pa1, ATT_PK(1), o[d0], 0, 0, 0);
#undef ATT_PK
    }
}
__device__ __forceinline__ void dma_tile(const bf16* proj, int b, int kvh, int ti, unsigned lds0, int wid, int lane) {
    const unsigned slot = (unsigned)((ti + 2) & 3) * SLOTB;
    int kr = 64 * ti + lane; kr = kr < 0 ? 0 : kr;
    int vr = 64 * ti + 16 * (wid & 3) + (lane >> 2); vr = vr < 0 ? 0 : vr;
    const bf16* ksrc = proj + (size_t)(b * SEQ + kr) * IN_W + C_K + kvh * 64 + wid * 8;
    const bf16* vsrc = proj + (size_t)(b * SEQ + vr) * IN_W + C_V + kvh * 64 + (wid >> 2) * 32 + (lane & 3) * 8;
    glds16(ksrc, (unsigned)__builtin_amdgcn_readfirstlane(lds0 + L_K + slot + wid * 1024));
    glds16(vsrc, (unsigned)__builtin_amdgcn_readfirstlane(lds0 + L_V + slot + wid * 1024));
}
#define ATT_WAIT_BAR() asm volatile("s_waitcnt vmcnt(0) lgkmcnt(0)\n\ts_barrier" ::: "memory")
__device__ __forceinline__ void attn_run(int b, int kvh, int qb0, int nqb, const bf16* proj, const float* sinks, bf16* O, LAS unsigned char* shm) {
    const int tid = threadIdx.x, lane = tid & 63, r32 = lane & 31, hi = lane >> 5; const int wid = __builtin_amdgcn_readfirstlane(tid >> 6);
    const int h = kvh * 4 + (wid & 3), sub = wid >> 2;
    const unsigned lds0 = (unsigned)(uintptr_t)shm;
    LAS float* wsf = (LAS float*)(shm + L_WS) + wid * 64;
    const lds_cptr shm3 = (lds_cptr)shm;
    const int vb0 = (int)(lds0 + L_V) + ((lane >> 4) & 1) * 32 + (lane & 3) * 8 + (4 * hi + ((lane & 15) >> 2)) * 64;
    const float slope2 = exp2f(-0.5f * (float)(h + 1)) * LOG2E, sink2 = sinks[h] * LOG2E;
    dma_tile(proj, b, kvh, qb0 - 2, lds0, wid, lane); dma_tile(proj, b, kvh, qb0 - 1, lds0, wid, lane); dma_tile(proj, b, kvh, qb0, lds0, wid, lane);
    const bf16* Qw = proj + (size_t)(b * SEQ + qb0 * 64 + 32 * sub + r32) * IN_W + C_Q + h * 64 + hi * 8;
    bf16x8 qn[4];
#pragma unroll
    for (int d0 = 0; d0 < 4; ++d0) qn[d0] = *(const bf16x8*)(Qw + d0 * 16);
    for (int qi = 0; qi < nqb; ++qi) {
        const int qb = qb0 + qi, tq0 = qb * 64 + 32 * sub;
        bf16x8 qr[4];
#pragma unroll
        for (int d0 = 0; d0 < 4; ++d0) qr[d0] = qn[d0];
        ATT_WAIT_BAR();
        if (qi + 1 < nqb) dma_tile(proj, b, kvh, qb + 1, lds0, wid, lane);
        f32x16 p[5];
#pragma unroll
        for (int i = 0; i < 5; ++i) { const int g = i + sub; qkt_half(p[i], shm3 + L_K + ((qb + (g >> 1)) & 3) * SLOTB + (g & 1) * 512 + hi * 1024 + r32 * 16, qr); }
        if (qi + 1 < nqb) {
#pragma unroll
            for (int d0 = 0; d0 < 4; ++d0) qn[d0] = *(const bf16x8*)(Qw + (size_t)(64 * (qi + 1)) * IN_W + d0 * 16); }
        float dbase = (float)(128 + r32 - 4 * hi); asm volatile("" : "+v"(dbase));
        const float dmax = (float)(tq0 + r32);
        float mx = -INFINITY;
#pragma unroll
        for (int i = 0; i < 5; ++i)
#pragma unroll
            for (int r = 0; r < 16; ++r) { const float d = dbase - (float)(32 * i + (r & 3) + 8 * (r >> 2));
                float v = p[i][r] - slope2 * d;
                if (i == 0) v = (d < 128.f) ? v : -INFINITY;
                if (i == 4) v = (d >= 0.f) ? v : -INFINITY;
                if (qb < 2) v = (d <= dmax) ? v : -INFINITY;
                p[i][r] = v; mx = fmaxf(mx, v); }
        { auto rr = __builtin_amdgcn_permlane32_swap(__float_as_uint(mx), __float_as_uint(mx), false, false); mx = fmaxf(__uint_as_float(rr[0]), __uint_as_float(rr[1])); }
        mx = fmaxf(mx, sink2);
        float ls = 0.f;
        f32x16 o[2]; o[0] = f32x16{}; o[1] = f32x16{};
#pragma unroll
        for (int i = 0; i < 5; ++i) { const int g = i + sub;
#pragma unroll
            for (int r = 0; r < 16; ++r) { const float e = __builtin_amdgcn_exp2f(p[i][r] - mx); p[i][r] = e; ls += e; }
            u32x4 pw0, pw1;
#define ATT_PKW(P, B) cvtpk_s(P[B], P[B + 1])
            pw0 = (u32x4){ATT_PKW(p[i], 0), ATT_PKW(p[i], 2), ATT_PKW(p[i], 4), ATT_PKW(p[i], 6)}; pw1 = (u32x4){ATT_PKW(p[i], 8), ATT_PKW(p[i], 10), ATT_PKW(p[i], 12), ATT_PKW(p[i], 14)};
#undef ATT_PKW
            __builtin_amdgcn_sched_barrier(0);
            pv_half(o, vb0 + ((qb + (g >> 1)) & 3) * SLOTB + (g & 1) * 2048, __builtin_bit_cast(bf16x8, pw0), __builtin_bit_cast(bf16x8, pw1));
        }
        { auto rr = __builtin_amdgcn_permlane32_swap(__float_as_uint(ls), __float_as_uint(ls), false, false); ls = __uint_as_float(rr[0]) + __uint_as_float(rr[1]); }
        ls += __builtin_amdgcn_exp2f(sink2 - mx);
        if (hi == 0) wsf[32 + r32] = ls;
        asm volatile("s_waitcnt lgkmcnt(0)" ::: "memory");
        float rli[16];
#pragma unroll
        for (int r = 0; r < 16; ++r) rli[r] = __builtin_amdgcn_rcpf(wsf[32 + crow(r, hi)]);
        bf16* Ow = O + (size_t)(b * SEQ + tq0) * 1024 + h * 64;
        { LAS bf16* stg = (LAS bf16*)(shm + L_OST) + wid * 2048;
#pragma unroll
            for (int r = 0; r < 16; ++r) { const int orow = crow(r, hi);
#pragma unroll
                for (int d0 = 0; d0 < 2; ++d0) stg[orow * 64 + d0 * 32 + r32] = (bf16)f2bf(o[d0][r] * rli[r]); }
            asm volatile("s_waitcnt lgkmcnt(0)" ::: "memory");
#pragma unroll
            for (int i = 0; i < 4; ++i) { const int row = i * 8 + (lane >> 3), ch = lane & 7; const u32x4 v = *(const LAS u32x4*)(stg + row * 64 + ch * 8); *(u32x4*)(Ow + (size_t)row * 1024 + ch * 8) = v; } }
    }
    ATT_WAIT_BAR();
}
#undef ATT_WAIT_BAR
}

namespace s5 {
using bf16x8 = __attribute__((ext_vector_type(8))) short;
using f32x16 = __attribute__((ext_vector_type(16))) float;
struct cf { float re, im; };
__device__ __forceinline__ cf cmul(cf a, cf b) { return cf{a.re * b.re - a.im * b.im, a.re * b.im + a.im * b.re}; }
__device__ __forceinline__ cf cfma(cf a, cf b, cf c) { return cf{c.re + a.re * b.re - a.im * b.im, c.im + a.re * b.im + a.im * b.re}; }
__device__ __forceinline__ int crow(int r, int hi) { return (r & 3) + 8 * (r >> 2) + 4 * hi; }
__device__ __forceinline__ bf16x8 ldg16(const bf16* ubase, unsigned lane_off) { return *(const bf16x8*)((const char*)ubase + lane_off); }
constexpr size_t BT_G = 128 * 256, KT_G = 16 * 16 * 16, CT_G = 256 * 128;
constexpr int IMG_STRIDE = 136;
constexpr int L_IMG = 0, L_T = 8 * 32 * IMG_STRIDE * 2, L_BYTES = L_T + 8 * 2 * 2 * 32 * 4;

__device__ __forceinline__ void build_tables(int g, int part, const float* a_re, const float* a_im, const float* log_dt, const float* b_re, const float* b_im, const float* c_re, const float* c_im, const float* d_skip,
                                             bf16* Btab, bf16* Ktab, bf16* Ctab, float* A16tab, LAS unsigned char* scr, int tid) {
    LAS double* LA = (LAS double*)scr; LAS double* TH = LA + 64;
    LAS float* bbr = (LAS float*)(scr + 1024); LAS float* bbi = bbr + 1024;
    LAS float* pwr = bbi + 1024; LAS float* pwi = pwr + 17 * 64;
    LAS float* ccr = pwi + 17 * 64; LAS float* cci = ccr + 1024;
    for (int e = tid; e < 1024; e += 512) { ccr[e] = c_re[(size_t)g * 1024 + e]; cci[e] = c_im[(size_t)g * 1024 + e]; }
    if (tid < 64) { const int i = g * NP + tid;
        const double dt = exp((double)log_dt[g]), are = a_re[i], aim = a_im[i];
        const double la = are * dt, th = aim * dt, mag = exp(la), abr = mag * cos(th), abi = mag * sin(th), den = are * are + aim * aim, em1 = abr - 1.0;
        const double qre = (em1 * are + abi * aim) / den, qim = (abi * are - em1 * aim) / den;
        LA[tid] = la; TH[tid] = th;
        for (int h = 0; h < GCH; ++h) { const double br = b_re[i * GCH + h], bi = b_im[i * GCH + h]; bbr[tid * 16 + h] = (float)(qre * br - qim * bi); bbi[tid * 16 + h] = (float)(qre * bi + qim * br); } }
    __syncthreads();
    for (int e = tid; e < 17 * 64; e += 512) { const int n = e >> 6, p = e & 63; const double m = exp((double)n * LA[p]), t = (double)n * TH[p]; pwr[e] = (float)(m * cos(t)); pwi[e] = (float)(m * sin(t)); }
    __syncthreads();
    if (part == 0 && tid < 64) { A16tab[(g * 64 + tid) * 2] = pwr[16 * 64 + tid]; A16tab[(g * 64 + tid) * 2 + 1] = pwi[16 * 64 + tid]; }
    for (int e = tid; e < 32 * 256; e += 512) { const int pl = e >> 8, k = e & 255, j = k >> 4, hp = k & 15, pp = 32 * part + pl, p = pp & 63;
        const float wr = pwr[(15 - j) * 64 + p], wi = pwi[(15 - j) * 64 + p], br = bbr[p * 16 + hp], bi = bbi[p * 16 + hp];
        const float v = (pp < 64) ? (wr * br - wi * bi) : (wr * bi + wi * br);
        Btab[(size_t)g * BT_G + (size_t)pp * 256 + k] = (bf16)f2bf(v); }
    for (int e = tid; e < 64 * 128; e += 512) { const int nl = e >> 7, pp = e & 127, n = 64 * part + nl, i = n >> 4, h = n & 15, p = pp & 63;
        const float cr = ccr[h * NP + p], ci = cci[h * NP + p], wr = pwr[(i + 1) * 64 + p], wi = pwi[(i + 1) * 64 + p];
        const float v = (pp < 64) ? (cr * wr - ci * wi) : -(cr * wi + ci * wr);
        Ctab[(size_t)g * CT_G + (size_t)n * 128 + pp] = (bf16)f2bf(v); }
    for (int e = tid; e < 4 * 256; e += 512) { const int d = 4 * part + (e >> 8), h = (e >> 4) & 15, hp = e & 15; float acc = 0.f;
#pragma unroll 8
        for (int p = 0; p < 64; ++p) { const float cr = ccr[h * NP + p], ci = cci[h * NP + p], wr = pwr[d * 64 + p], wi = pwi[d * 64 + p], br = bbr[p * 16 + hp], bi = bbi[p * 16 + hp];
            const float tr = wr * br - wi * bi, ti = wr * bi + wi * br; acc += cr * tr - ci * ti; }
        if (d == 0 && h == hp) acc += d_skip[g * 16 + h];
        Ktab[(size_t)g * KT_G + (size_t)(d * 16 + h) * 16 + hp] = (bf16)f2bf(acc); }
    __syncthreads();
}

__device__ __forceinline__ void scan_local(f32x16& re, f32x16& im, const cf p1, const cf p4, const int hi, cf (&em)[4], cf& T) {
#pragma unroll
    for (int q = 0; q < 4; ++q)
#pragma unroll
        for (int k = 1; k < 4; ++k) { const int r = 4 * q + k; const cf v = cfma(p1, cf{re[r - 1], im[r - 1]}, cf{re[r], im[r]}); re[r] = v.re; im[r] = v.im; }
    cf E = cf{0.f, 0.f};
#pragma unroll
    for (int q = 0; q < 4; ++q) {
        auto sr = __builtin_amdgcn_permlane32_swap(__float_as_uint(re[4 * q + 3]), __float_as_uint(re[4 * q + 3]), false, false);
        auto si = __builtin_amdgcn_permlane32_swap(__float_as_uint(im[4 * q + 3]), __float_as_uint(im[4 * q + 3]), false, false);
        const cf elo = cf{__uint_as_float(sr[0]), __uint_as_float(si[0])}, ehi = cf{__uint_as_float(sr[1]), __uint_as_float(si[1])};
        const cf Elo = E; E = cfma(p4, E, elo); const cf Ehi = E; E = cfma(p4, E, ehi);
        em[q] = hi ? Ehi : Elo; }
    T = E;
}
__device__ __forceinline__ void scan_finish(f32x16& re, f32x16& im, const cf p1, const cf p2, const cf p3, const cf p4, const cf g2, const int hi, const cf (&em)[4], const cf X) {
    cf cur = hi ? p4 : cf{1.f, 0.f};
#pragma unroll
    for (int q = 0; q < 4; ++q) { const cf carry = cfma(cur, X, em[q]); cur = cmul(cur, g2);
        cf v;
        v = cfma(p1, carry, cf{re[4 * q + 0], im[4 * q + 0]}); re[4 * q + 0] = v.re; im[4 * q + 0] = v.im;
        v = cfma(p2, carry, cf{re[4 * q + 1], im[4 * q + 1]}); re[4 * q + 1] = v.re; im[4 * q + 1] = v.im;
        v = cfma(p3, carry, cf{re[4 * q + 2], im[4 * q + 2]}); re[4 * q + 2] = v.re; im[4 * q + 2] = v.im;
        v = cfma(p4, carry, cf{re[4 * q + 3], im[4 * q + 3]}); re[4 * q + 3] = v.re; im[4 * q + 3] = v.im; }
}

__device__ __forceinline__ void glds16(const void* gsrc, unsigned lds_dst) { unsigned keep;
    asm volatile("s_mov_b32 %0, m0\n\ts_mov_b32 m0, %2\n\ts_nop 0\n\tglobal_load_lds_dwordx4 %1, off\n\ts_mov_b32 m0, %0" : "=&s"(keep) : "v"(gsrc), "s"(lds_dst) : "memory"); }
constexpr int L_TAB = 0, L_TABK = 65536, L_IMG2 = 73728, L_T2 = L_IMG2 + 8 * 32 * IMG_STRIDE * 2, L_BYTES2 = L_T2 + 4096;

__device__ __forceinline__ void s5_unit(int b, int g, const bf16* proj, const bf16* Btab, const bf16* Ktab, const bf16* Ctab, const float* A16tab, bf16* out, LAS unsigned char* shm) {
    int tid = threadIdx.x; asm volatile("" : "+v"(tid));
    const int lane = tid & 63, col = lane & 31, hi = lane >> 5; const int wid = __builtin_amdgcn_readfirstlane(tid >> 6);
    const unsigned lds0 = (unsigned)(uintptr_t)shm;
    { const char* src = (const char*)(Btab + (size_t)g * BT_G);
#pragma unroll
      for (int i = 0; i < 8; ++i) { const int p = wid * 8 + i, row = 2 * p + (lane >> 5), c = (lane & 31) ^ (row & 31);
          glds16(src + row * 512 + c * 16, (unsigned)__builtin_amdgcn_readfirstlane(lds0 + L_TAB + p * 1024)); } }
    const bf16* ub = proj + ((size_t)g * T + (size_t)(b * SEQ + 512 * wid)) * 16;
    const unsigned uoff = (unsigned)(col * 512 + hi * 16);
    bf16x8 ua[16];
#pragma unroll
    for (int j = 0; j < 16; ++j) ua[j] = ldg16(ub + (size_t)j * 16, uoff);
    asm volatile("s_waitcnt vmcnt(0)" ::: "memory"); __syncthreads();
    const LAS unsigned char* tb = shm + L_TAB; const unsigned a0 = (unsigned)(col * 512) | (unsigned)(((hi * 16) ^ (col * 16)));
    f32x16 zt[4];
#pragma unroll
    for (int nt = 0; nt < 4; ++nt) zt[nt] = f32x16{};
#pragma unroll
    for (int j = 0; j < 16; ++j) { const bf16x8 uj = ua[j]; const unsigned aj = a0 ^ (unsigned)(j * 32);
#pragma unroll
        for (int nt = 0; nt < 4; ++nt) { const bf16x8 bfr = *(const LAS bf16x8*)(tb + aj + nt * 16384); zt[nt] = __builtin_amdgcn_mfma_f32_32x32x16_bf16(uj, bfr, zt[nt], 0, 0, 0); } }
    LAS float* Tb = (LAS float*)(shm + L_T2);
    LAS bf16* img = (LAS bf16*)(shm + L_IMG2) + wid * 32 * IMG_STRIDE;
    {
        cf P1[2], P2[2], P3[2], P4[2], G2[2], EM[2][4], TT[2];
#pragma unroll
        for (int s = 0; s < 2; ++s) { const float2 a = ((const float2*)A16tab)[g * 64 + 32 * s + col]; P1[s] = cf{a.x, a.y}; P2[s] = cmul(P1[s], P1[s]); P3[s] = cmul(P2[s], P1[s]); P4[s] = cmul(P2[s], P2[s]); G2[s] = cmul(P4[s], P4[s]); }
        scan_local(zt[0], zt[2], P1[0], P4[0], hi, EM[0], TT[0]);
        scan_local(zt[1], zt[3], P1[1], P4[1], hi, EM[1], TT[1]);
        if (hi == 0) {
#pragma unroll
            for (int s = 0; s < 2; ++s) { Tb[((wid * 2 + s) * 2 + 0) * 32 + col] = TT[s].re; Tb[((wid * 2 + s) * 2 + 1) * 32 + col] = TT[s].im; } }
        asm volatile("s_waitcnt lgkmcnt(0)" ::: "memory"); __syncthreads();
        { const char* src = (const char*)(Ctab + (size_t)g * CT_G);
#pragma unroll
          for (int i = 0; i < 8; ++i) { const int p = wid * 8 + i, row = 4 * p + (lane >> 4), c = (lane & 15) ^ (row & 15);
              glds16(src + row * 256 + c * 16, (unsigned)__builtin_amdgcn_readfirstlane(lds0 + L_TAB + p * 1024)); }
          glds16((const char*)(Ktab + (size_t)g * KT_G) + wid * 1024 + lane * 16, (unsigned)__builtin_amdgcn_readfirstlane(lds0 + L_TABK + wid * 1024)); }
#pragma unroll
        for (int j = 0; j < 16; ++j) ua[j] = ldg16(ub + (size_t)j * 16, uoff);
#pragma unroll
        for (int s = 0; s < 2; ++s) {
            const cf g4 = cmul(G2[s], G2[s]), g8 = cmul(g4, g4);
            cf X = cf{0.f, 0.f};
            for (int v = 0; v < wid; ++v) X = cfma(g8, X, cf{Tb[((v * 2 + s) * 2 + 0) * 32 + col], Tb[((v * 2 + s) * 2 + 1) * 32 + col]});
            scan_finish(zt[s], zt[2 + s], P1[s], P2[s], P3[s], P4[s], G2[s], hi, EM[s], X);
            if (hi == 0) { img[32 * s + col] = (bf16)f2bf(X.re); img[64 + 32 * s + col] = (bf16)f2bf(X.im); }
#pragma unroll
            for (int r = 0; r < 16; ++r) { const int row = crow(r, hi) + 1;
                if (row < 32) { img[row * IMG_STRIDE + 32 * s + col] = (bf16)f2bf(zt[s][r]); img[row * IMG_STRIDE + 64 + 32 * s + col] = (bf16)f2bf(zt[2 + s][r]); } }
        }
    }
    asm volatile("s_waitcnt vmcnt(0) lgkmcnt(0)" ::: "memory"); __syncthreads();
    bf16x8 sa[8];
#pragma unroll
    for (int ks = 0; ks < 8; ++ks) sa[ks] = *(const LAS bf16x8*)(img + col * IMG_STRIDE + 16 * ks + 8 * hi);
    asm volatile("s_waitcnt lgkmcnt(0)" ::: "memory"); __builtin_amdgcn_wave_barrier();
    const int ih = col >> 4, h = col & 15;
    const LAS unsigned char* kb = shm + L_TABK + ih * 512 + h * 32 + hi * 16;
    const unsigned c0 = (unsigned)(col * 256) | (unsigned)((hi * 16) ^ ((col & 15) * 16));
    LAS bf16* stg = img;
    bf16* og = out + ((size_t)g * T + (size_t)(b * SEQ + 512 * wid)) * 16;
#pragma unroll
    for (int ps = 0; ps < 2; ++ps) {
        f32x16 acc[4];
#pragma unroll
        for (int n = 0; n < 4; ++n) acc[n] = f32x16{};
#pragma unroll
        for (int j = 0; j < 8 * ps + 8; ++j) { const bf16x8 uj = ua[j];
#pragma unroll
            for (int n = 0; n < 4; ++n) { const int nt = 4 * ps + n;
                if (j <= 2 * nt + 1) {
                    bf16x8 kf;
                    if (j == 2 * nt + 1) { kf = *(const LAS bf16x8*)(shm + L_TABK + h * 32 + hi * 16); if (ih == 0) kf = bf16x8{}; }
                    else kf = *(const LAS bf16x8*)(kb + (2 * nt - j) * 512);
                    acc[n] = __builtin_amdgcn_mfma_f32_32x32x16_bf16(uj, kf, acc[n], 0, 0, 0); } } }
#pragma unroll
        for (int ks = 0; ks < 8; ++ks) { const unsigned ck = c0 ^ (unsigned)(ks * 32);
#pragma unroll
            for (int n = 0; n < 4; ++n) { const bf16x8 cfr = *(const LAS bf16x8*)(tb + ck + (4 * ps + n) * 8192); acc[n] = __builtin_amdgcn_mfma_f32_32x32x16_bf16(sa[ks], cfr, acc[n], 0, 0, 0); } }
#pragma unroll
        for (int n = 0; n < 4; ++n)
#pragma unroll
            for (int r = 0; r < 16; ++r) stg[(crow(r, hi) * 8 + 2 * n + ih) * 16 + h] = (bf16)f2bf(gelu_tanh(acc[n][r]));
        asm volatile("s_waitcnt lgkmcnt(0)" ::: "memory"); __builtin_amdgcn_wave_barrier();
#pragma unroll
        for (int q = 0; q < 8; ++q) { const int pc = q * 64 + lane, chunk = pc >> 4, il = (pc >> 1) & 7, hf = pc & 1;
            const v4u v = *(const LAS v4u*)(stg + (chunk * 8 + il) * 16 + hf * 8);
            *(v4u*)(og + (size_t)(16 * chunk + 8 * ps + il) * 16 + hf * 8) = v; }
        asm volatile("s_waitcnt lgkmcnt(0)" ::: "memory"); __builtin_amdgcn_wave_barrier();
    }
    __syncthreads();
}
}

constexpr int NPH = 10;
__global__ void __launch_bounds__(512, 2) mk_fwd(Args args) {
    extern __shared__ __attribute__((aligned(16))) unsigned char lds_raw[];
    Ctx C; C.lds = (LAS unsigned char*)lds_raw; C.tid = threadIdx.x; C.lane = C.tid & 63; C.wave = __builtin_amdgcn_readfirstlane(C.tid >> 6);
    C.G = gridDim.x; { const int bx = blockIdx.x; C.vcu = (C.G % 8 == 0) ? (bx % 8) * (C.G / 8) + bx / 8 : bx; }
    C.gw = C.vcu * 8 + C.wave; C.ngw = C.G * 8;
    volatile LAS unsigned* MISC = (volatile LAS unsigned*)(C.lds + MISC_OFF);
    if (C.tid < 64) MISC[C.tid] = 0u;
    __syncthreads();
    unsigned char* ws = args.ws; unsigned* ctl = (unsigned*)(ws + WS_CTL);
    const int lo = args.ph_lo, hi = args.ph_hi;
    XcdBarrier bar; bar.bar = ctl + CW_BAR + args.bar_idx * XCD_BAR_WORDS; bar.x = 0; bar.st = nullptr;
    if (hi - lo > 1) bar = xcd_barrier_post(ctl + CW_BAR + args.bar_idx * XCD_BAR_WORDS, MISC + 8);
#define IN(k) (lo <= (k) && (k) < hi)
#define SEAM(k) do { if (IN(k) && IN((k) + 1)) { xcd_barrier(bar); if (args.sub & 8) xcd_barrier(bar); } } while (0)
    const float* x = args.in[0]; float* out = args.out;
    bf16* WIN = (bf16*)(ws + WS_WIN); bf16* WGLU = (bf16*)(ws + WS_WGLU); bf16* WSSM = (bf16*)(ws + WS_WSSM); bf16* WATT = (bf16*)(ws + WS_WATT); bf16* WOUT = (bf16*)(ws + WS_WOUT);
    bf16* WGU = (bf16*)(ws + WS_WGU); bf16* WDN = (bf16*)(ws + WS_WDN); bf16* BTAB = (bf16*)(ws + WS_BTAB); bf16* CTAB = (bf16*)(ws + WS_CTAB); bf16* KTAB = (bf16*)(ws + WS_KTAB); float* A16TAB = (float*)(ws + WS_A16);
    bf16* H = (bf16*)(ws + WS_H); bf16* PROJ = (bf16*)(ws + WS_PROJ); bf16* S5OUT = (bf16*)(ws + WS_S5OUT); bf16* ATTN = (bf16*)(ws + WS_ATTN);
    bf16* GLU = H; bf16* MIXED = S5OUT; bf16* H2 = ATTN; bf16* YS = PROJ; bf16* ACT = (bf16*)(ws + WS_ACT);
    bf16* UGM = (bf16*)(ws + WS_ACT);
    float* top_w = (float*)(ws + WS_ROUTE + RT_TOPW); int* list = (int*)(ws + WS_ROUTE + RT_LIST); int* apos = (int*)(ws + WS_ROUTE + RT_APOS);
    LAS unsigned char* ring = C.lds + RING_OFF;

    if (IN(0)) {
        for (int blk = C.vcu; blk < NG * 4; blk += C.G) s5::build_tables(blk >> 2, blk & 3, args.in[3], args.in[4], args.in[5], args.in[6], args.in[7], args.in[8], args.in[9], args.in[10], BTAB, KTAB, CTAB, A16TAB, ring, C.tid);
        transpose_job(C, args.in[2], WIN, DM, IN_W, 0, 1);
        transpose_job(C, args.in[11], WGLU, 1024, 2048, 1, 1);
        transpose_job(C, args.in[12], WSSM, 1024, 1024, 0, 1);
        transpose_job(C, args.in[16], WATT, 1024, 1024, 0, 1);
        transpose_job(C, args.in[17], WOUT, 1024, 1024, 0, 1);
        transpose_job_fp8(C, args.in[21], (unsigned char*)WGU, 1024, 2048, 1, NE, WSCALE);
        transpose_job_fp8(C, args.in[23], (unsigned char*)WDN, 1024, 1024, 0, NE, WSCALE);
        rmsnorm_rows(C, x, args.in[1], H);
        __syncthreads();
    }
    SEAM(0);
    if (IN(1)) { pg8::Gemm g{}; g.A = H; g.Bt = WIN; g.M = T; g.N = IN_W; g.K = DM; pg8::StaticOrder S; S.init(T, IN_W, C.G, (int)blockIdx.x);
        pg8::EpiProj e{}; e.O = PROJ; e.ldc = IN_W; e.qg = args.in[13]; e.kg = args.in[14]; e.qscale = att::QSCALE; e.nostore = (args.sub >> 2) & 1; e.U = UGM; e.urows = T; pg8::gemm_phase<pg8::EpiProj, pg8::StaticOrder>(ring, g, S, e); }
    SEAM(1);
    if (IN(2)) {
        if (args.sub & 1) for (int uu = C.vcu; uu < BATCH * NG / 2; uu += C.G) for (int i = 0; i < 2; ++i) { const int unit = 2 * uu + i; s5::s5_unit(unit & 7, unit >> 3, UGM, BTAB, KTAB, CTAB, A16TAB, S5OUT, ring); }
        if (args.sub & 2) for (int run = C.vcu; run < BATCH * NKVH * 8; run += C.G) att::attn_run(run >> 5, (run >> 3) & 3, (run & 7) * 8, 8, PROJ, args.in[15], ATTN, ring);
        __syncthreads();
    }
    SEAM(2);
    if (IN(3)) { pg8::Gemm g{}; g.A = S5OUT; g.Bt = WGLU; g.M = T; g.N = 2048; g.K = 1024; g.agm = 1; pg8::StaticOrder S; S.init(T, 2048, C.G, (int)blockIdx.x);
        pg8::EpiGlu e{}; e.O = GLU; e.ldc = 1024; pg8::gemm_phase<pg8::EpiGlu, pg8::StaticOrder>(ring, g, S, e); }
    SEAM(3);
    if (IN(4)) { pg8::Gemm g{}; g.A = GLU; g.Bt = WSSM; g.A2 = ATTN; g.Bt2 = WATT; g.M = T; g.N = 1024; g.K = 1024; pg8::DualOrder S; S.init(T, 1024, C.G, (int)blockIdx.x);
        pg8::EpiGate e{}; e.O = MIXED; e.ldc = 1024; e.G = PROJ; e.ldg = IN_W; e.gcol0 = C_GS; e.gcol1 = C_GA; pg8::gemm_phase<pg8::EpiGate, pg8::DualOrder>(ring, g, S, e); }
    SEAM(4);
    if (IN(5)) { pg8::Gemm g{}; g.A = MIXED; g.Bt = WOUT; g.M = T; g.N = 1024; g.K = 1024; pg8::StaticOrder S; S.init(T, 1024, C.G, (int)blockIdx.x);
        pg8::EpiResid e{}; e.base = x; e.out = out; e.ldc = 1024; pg8::gemm_phase<pg8::EpiResid, pg8::StaticOrder>(ring, g, S, e); }
    SEAM(5);
    if (IN(6)) { router_pass(C, out, args.in[18], args.in[19], args.in[20], (unsigned char*)H2, top_w, list, apos, ctl); }
    SEAM(6);
    if (IN(7)) { const int nM = grouped_tables(C, ctl);
        pg8::Gemm g{}; g.A = H2; g.Bt = WGU; g.M = NA; g.N = 2048; g.K = 1024; g.scaleA = 0x7f7f7f7f; g.scaleB = WSCALE_E8M0 * 0x01010101;
        pg8::GroupedOrderT<true> S; S.cnt = (const LAS int*)(C.lds + GT_OFF); S.pref = S.cnt + 32; S.tile_e = (const LAS unsigned char*)(S.pref + 36); S.lbuf = (LAS int*)(C.lds + GT_OFF + 2048); S.list = list; S.nN = 8; S.G = C.G; S.c = (int)blockIdx.x; S.nM = nM; S.lstride = T; S.ashift = 2;
        pg8::EpiSwiglu e{}; e.O = (unsigned char*)ACT; e.ldc = 1024; e.bias = args.in[22]; e.dff = DFF; e.limit = 7.0f; e.alpha = 1.702f; e.skip = (args.sub >> 4) & 1;
        pg8::gemm_phase<pg8::EpiSwiglu, pg8::GroupedOrderT<true>>(ring, g, S, e); }
    SEAM(7);
    if (IN(8)) { const int nM = grouped_tables(C, ctl);
        pg8::Gemm g{}; g.A = ACT; g.Bt = WDN; g.M = NA; g.N = 1024; g.K = 1024; g.scaleA = 0x7f7f7f7f; g.scaleB = WSCALE_E8M0 * 0x01010101;
        pg8::GroupedOrderT<false> S; S.cnt = (const LAS int*)(C.lds + GT_OFF); S.pref = S.cnt + 32; S.tile_e = (const LAS unsigned char*)(S.pref + 36); S.lbuf = (LAS int*)(C.lds + GT_OFF + 2048); S.list = list; S.nN = 4; S.G = C.G; S.c = (int)blockIdx.x; S.nM = nM; S.lstride = T; S.ashift = 0;
        pg8::EpiDown e{}; e.O = YS; e.ldc = 1024; e.bias = args.in[24]; e.ncol = 1024; e.skip = (args.sub >> 4) & 1;
        pg8::gemm_phase<pg8::EpiDown, pg8::GroupedOrderT<false>>(ring, g, S, e); }
    SEAM(8);
    if (IN(9)) { (void)grouped_tables(C, ctl); combine_pass(C, out, YS, top_w, apos); }
#undef IN
#undef SEAM
}

extern "C" void kernel_launch(void* const* d_in, const int* in_sizes, int n_in, void* d_out, int out_size, void* d_ws, size_t ws_size, hipStream_t stream) {
    static int grid = 0;
    if (grid == 0) {
        if (n_in != 25 || in_sizes[0] != T * DM || out_size != T * DM || ws_size < WS_END) { fprintf(stderr, "kernel_launch: unexpected shapes / workspace (n_in %d, ws %zu)\n", n_in, ws_size); grid = -1; return; }
        int dev = 0, cus = 0, per_cu = 0;
        if (hipGetDevice(&dev) != hipSuccess || hipDeviceGetAttribute(&cus, hipDeviceAttributeMultiprocessorCount, dev) != hipSuccess) { grid = -1; return; }
        if (hipFuncSetAttribute((const void*)mk_fwd, hipFuncAttributeMaxDynamicSharedMemorySize, LDS_BYTES) != hipSuccess) { fprintf(stderr, "kernel_launch: hipFuncSetAttribute failed\n"); grid = -1; return; }
        if (hipOccupancyMaxActiveBlocksPerMultiprocessor(&per_cu, (const void*)mk_fwd, 512, LDS_BYTES) != hipSuccess || per_cu < 1) { fprintf(stderr, "kernel_launch: occupancy query says %d workgroups per CU\n", per_cu); grid = -1; (void)hipGetLastError(); return; }
        grid = cus;
    }
    if (grid < 0) return;
    if (hipMemsetAsync((char*)d_ws + WS_CTL, 0, CTL_ZERO_BYTES, stream) != hipSuccess) return;
    Args a{};
    for (int i = 0; i < 25; ++i) a.in[i] = (const float*)d_in[i];
    a.out = (float*)d_out; a.ws = (unsigned char*)d_ws;
#ifdef MK_RANGES
    { const int rg[] = MK_RANGES; int nb = 0; for (unsigned i = 0; i + 2 < sizeof(rg) / sizeof(int); i += 3) { a.ph_lo = rg[i]; a.ph_hi = rg[i + 1]; a.sub = rg[i + 2]; a.bar_idx = (rg[i + 1] - rg[i] > 1) ? nb++ : 0;
        hipLaunchKernelGGL(mk_fwd, dim3(grid), dim3(512), LDS_BYTES, stream, a); } }
#else
    a.ph_lo = 0; a.ph_hi = NPH; a.bar_idx = 0; a.sub = 3; hipLaunchKernelGGL(mk_fwd, dim3(grid), dim3(512), LDS_BYTES, stream, a);
#endif
}
```

```cpp
#include <hip/hip_runtime.h>
#include <cstdio>
#include <cstdint>
#include <cmath>

constexpr int DM = 1024, BATCH = 8, SEQ = 4096, T = BATCH * SEQ;
constexpr int NG = 64, NP = 64, GCH = 16;
constexpr int HD = 64, NQH = 16, NKVH = 4, WIN = 128;
constexpr int IN_W = 4608;
constexpr int C_U = 0, C_Q = 1024, C_K = 2048, C_V = 2304, C_GS = 2560, C_GA = 3584;
constexpr int NE = 32, TOPK = 4, DFF = 1024, NA = T * TOPK;
constexpr int MAXROWS = NA + NE * 256;
constexpr int MAXMT = MAXROWS / 256;
constexpr float EPS = 1e-5f;

namespace pg8 {
#define PG8_LAS __attribute__((address_space(3)))
typedef unsigned short bf16_t;
typedef short bf16x8 __attribute__((ext_vector_type(8)));
typedef float f32x4 __attribute__((ext_vector_type(4)));
typedef unsigned u32x4 __attribute__((ext_vector_type(4)));
typedef int i32x8 __attribute__((ext_vector_type(8)));
typedef int i32x4 __attribute__((ext_vector_type(4)));
__device__ __forceinline__ i32x8 cat8(bf16x8 lo, bf16x8 hi) { return __builtin_shufflevector(__builtin_bit_cast(i32x4, lo), __builtin_bit_cast(i32x4, hi), 0, 1, 2, 3, 4, 5, 6, 7); }
constexpr int BM = 256, BK = 64, HALF = 128, HTB = HALF * BK * 2  , STAGE_BYTES = 8 * HTB, NXCD = 8, WGM = 8;

__host__ __device__ __forceinline__ int lds_byte(int r, int c) { const int st = (r >> 4) * 2 + (c >> 5), rr = r & 15, cc = c & 31, ob = rr * 64 + cc * 2; return st * 1024 + (ob ^ (((ob >> 9) & 1) << 5)); }
__host__ __device__ __forceinline__ void stage_rc(int b, int& R, int& C) { const int st = b / 1024, sb = b % 1024, swz = sb ^ (((sb >> 9) & 1) << 5); R = (st >> 1) * 16 + swz / 64; C = (st & 1) * 32 + (swz % 64) / 2; }
__host__ __device__ __forceinline__ int perm32(int rho) { const int n = rho >> 4, i = rho & 15; return 8 * (i >> 2) + 4 * n + (i & 3); }

struct Unit { int pm, pn, e, pl, rows, srow; };
struct Gemm { const bf16_t* A; const bf16_t* Bt; const bf16_t* A2; const bf16_t* Bt2; int M, N, K, agm, scaleA, scaleB, pad0, pad1; };

struct StaticOrder {
    static constexpr bool GATHER = false, FP8 = false, LINROWS = false;
    static constexpr PG8_LAS int* lbuf = nullptr;
    int nM, nN, nwg, G, c;
    __host__ __device__ void init(int M, int N, int G_, int c_) { nM = M / BM; nN = N / BM; nwg = nM * nN; G = G_; c = c_; }
    __host__ __device__ bool next(int i, Unit& u) const {
        const long L = (long)i * G + c; if (L >= nwg) return false;
        int wgid = (int)L; { const int q = nwg / NXCD, r = nwg % NXCD, xcd = wgid % NXCD, off = wgid / NXCD; wgid = (xcd < r ? xcd * (q + 1) : r * (q + 1) + (xcd - r) * q) + off; }
        const int nig = WGM * nN, gid = wgid / nig, fm = gid * WGM, gsz = (nM - fm) < WGM ? (nM - fm) : WGM;
        u.pm = fm + ((wgid % nig) % gsz); u.pn = (wgid % nig) / gsz; u.e = 0; u.pl = u.pn; u.rows = BM; u.srow = u.pm * BM; return true;
    }
    __device__ __forceinline__ void a_ready(const Unit&) const {}
    __device__ __forceinline__ void done(const Unit&) const {}
};

template <class Epi, class Sched, bool ALIGN_EPI = true>
__device__ __forceinline__ void gemm_phase(PG8_LAS unsigned char* lds, const Gemm g, const Sched& S, const Epi& E) {
    int tid = threadIdx.x; asm volatile("" : "+v"(tid));
    const int wid = __builtin_amdgcn_readfirstlane(tid >> 6), lane = tid & 63, wr = wid >> 2, wc = wid & 3, fr = lane & 15, fq = lane >> 4;
    constexpr bool GATHER = Sched::GATHER, FP8 = Sched::FP8;
    const int K = g.K, KB = FP8 ? K : 2 * K, nt = KB / 128;
    int RA[2], CA[2]; unsigned voffA0[2], voffA1[2], voffB[2];
#pragma unroll
    for (int i = 0; i < 2; ++i) { int R, C; stage_rc(tid * 16 + i * 8192, R, C); RA[i] = R; CA[i] = C;
        const int Rb = 2 * (R & ~31) + (Epi::PERM ? perm32(R & 31) : (R & 31));
        voffB[i] = (unsigned)(Rb * KB + C * 2);
        if (g.agm) { voffA0[i] = (unsigned)((C >> 4) * g.M * 32 + R * 32 + (C & 15) * 2); voffA1[i] = voffA0[i] + (unsigned)(HALF * 32); }
        else { voffA0[i] = (unsigned)(R * KB + C * 2); voffA1[i] = (unsigned)((R + HALF) * KB + C * 2); } }
    const size_t kstep = (size_t)(BK * 2);
    const size_t hstepB = (size_t)32 * KB;
    const size_t tstep = (size_t)BM * KB;
    const size_t kstepA = g.agm ? (size_t)4 * g.M * 32 : kstep, tstepA = g.agm ? (size_t)BM * 32 : tstep;
    const unsigned ldsw = (unsigned)wid * 1024u;
    const int aoff = lds_byte(wr * 64 + fr, FP8 ? fq * 16 : fq * 8), boff = lds_byte(wc * 32 + fr, FP8 ? fq * 16 : fq * 8);
    constexpr int KOFF = FP8 ? 16 : 1024;
#define PG8_SA(b, h) (((b) * 2 + (h)) * HTB)
#define PG8_SB(b, h) ((4 + (b) * 2 + (h)) * HTB)
#define PG8_STAGE(bufoff, gbase, voff) do { _Pragma("unroll") for (int _i = 0; _i < 2; ++_i) \
        __builtin_amdgcn_global_load_lds((const unsigned*)((const char*)(gbase) + (voff)[_i]), (PG8_LAS unsigned*)(lds + (bufoff) + ldsw + _i * 8192), 16, 0, 0); } while (0)
#define PG8_LDA(dst, b, h) do { _Pragma("unroll") for (int m = 0; m < 4; ++m) _Pragma("unroll") for (int k = 0; k < 2; ++k) dst[m][k] = *(const PG8_LAS bf16x8*)(lds + PG8_SA(b, h) + aoff + m * 2048 + k * KOFF); } while (0)
#define PG8_LDB(dst, b, h) do { _Pragma("unroll") for (int n = 0; n < 2; ++n) _Pragma("unroll") for (int k = 0; k < 2; ++k) dst[n][k] = *(const PG8_LAS bf16x8*)(lds + PG8_SB(b, h) + boff + n * 2048 + k * KOFF); } while (0)
#define PG8_MMA(ai, bj, At, Bt) do { __builtin_amdgcn_s_setprio(1); _Pragma("unroll") for (int m = 0; m < 4; ++m) _Pragma("unroll") for (int n = 0; n < 2; ++n) { \
        if constexpr (FP8) acc[ai][bj][m][n] = __builtin_amdgcn_mfma_scale_f32_16x16x128_f8f6f4(cat8(Bt[n][0], Bt[n][1]), cat8(At[m][0], At[m][1]), acc[ai][bj][m][n], 0, 0, 0, g.scaleB, 0, g.scaleA); \
        else { _Pragma("unroll") for (int k = 0; k < 2; ++k) acc[ai][bj][m][n] = __builtin_amdgcn_mfma_f32_16x16x32_bf16(Bt[n][k], At[m][k], acc[ai][bj][m][n], 0, 0, 0); } } __builtin_amdgcn_s_setprio(0); } while (0)
#define PG8_WAIT_V(n) asm volatile("s_waitcnt vmcnt(" #n ")" ::: "memory")
#define PG8_WAIT_L(n) asm volatile("s_waitcnt lgkmcnt(" #n ")" ::: "memory")
#define PG8_BAR __builtin_amdgcn_s_barrier()
#define PG8_SCHED __builtin_amdgcn_sched_barrier(0)
    Unit cur, nxt; int ui = 0;
    if (!S.next(0, cur)) return;
    f32x4 acc[2][2][4][2];
#pragma unroll
    for (int a = 0; a < 2; ++a)
#pragma unroll
        for (int b = 0; b < 2; ++b)
#pragma unroll
            for (int m = 0; m < 4; ++m)
#pragma unroll
                for (int n = 0; n < 2; ++n) acc[a][b][m][n] = (f32x4){0.f, 0.f, 0.f, 0.f};
    bf16x8 At[4][2], B0[2][2], B1[2][2];
    PG8_LAS int* const lring = S.lbuf;
    if constexpr (Epi::BIAS_LDS) { if (tid < BM) S.lbuf[3 * BM + tid] = __builtin_bit_cast(int, *E.bias_elem(cur, tid));
        asm volatile("s_waitcnt vmcnt(0) lgkmcnt(0)" ::: "memory"); PG8_BAR; asm volatile("" ::: "memory"); }
    constexpr bool LINROWS = Sched::LINROWS;
    if constexpr (GATHER && LINROWS) {
#pragma unroll
        for (int i = 0; i < 2; ++i) { voffA0[i] = (unsigned)(cur.srow + RA[i]) * (unsigned)KB + (unsigned)(CA[i] * 2); voffA1[i] = (unsigned)(cur.srow + HALF + RA[i]) * (unsigned)KB + (unsigned)(CA[i] * 2); } }
    if constexpr (GATHER && !LINROWS) {
        if (tid < BM) lring[tid] = S.list_entry(cur, tid);
        asm volatile("s_waitcnt vmcnt(0) lgkmcnt(0)" ::: "memory"); PG8_BAR; asm volatile("" ::: "memory");
#pragma unroll
        for (int i = 0; i < 2; ++i) { const int r0 = RA[i] < cur.rows ? RA[i] : cur.rows - 1, r1 = HALF + RA[i] < cur.rows ? HALF + RA[i] : cur.rows - 1;
            voffA0[i] = (unsigned)(lring[r0] >> S.ashift) * (unsigned)KB + (unsigned)(CA[i] * 2); voffA1[i] = (unsigned)(lring[r1] >> S.ashift) * (unsigned)KB + (unsigned)(CA[i] * 2); } }
    const char* cA = GATHER ? (const char*)g.A : (const char*)(cur.e && g.A2 ? g.A2 : g.A) + (size_t)cur.pm * tstepA; const char* cB = (const char*)(!GATHER && cur.e && g.Bt2 ? g.Bt2 : g.Bt) + (size_t)cur.pn * tstep;
    S.a_ready(cur);
    PG8_STAGE(PG8_SB(0, 0), cB, voffB); PG8_STAGE(PG8_SB(0, 1), cB + hstepB, voffB); PG8_STAGE(PG8_SA(0, 0), cA, voffA0); PG8_STAGE(PG8_SA(0, 1), cA, voffA1);
    if (wr == 1) PG8_BAR;
    PG8_WAIT_V(2); PG8_BAR;
    PG8_STAGE(PG8_SB(1, 0), cB + kstep, voffB); PG8_STAGE(PG8_SA(1, 0), cA + kstepA, voffA0); PG8_STAGE(PG8_SB(1, 1), cB + hstepB + kstep, voffB);
    PG8_WAIT_V(6); PG8_BAR;
    for (;;) {
        const bool has_next = S.next(ui + 1, nxt);
        const char* nA = GATHER ? cA : (has_next ? (const char*)(nxt.e && g.A2 ? g.A2 : g.A) + (size_t)nxt.pm * tstepA : cA); const char* nB = has_next ? (const char*)(!GATHER && nxt.e && g.Bt2 ? g.Bt2 : g.Bt) + (size_t)nxt.pn * tstep : cB;
        const int slot_cur = (ui % 3) * BM, slot_nxt = ((ui + 1) % 3) * BM;
        if constexpr (Epi::BIAS_LDS) { if (has_next && wid >= 4)
            __builtin_amdgcn_global_load_lds((const unsigned*)E.bias_elem(nxt, (wid - 4) * 64 + lane), (PG8_LAS unsigned*)(lring + 3 * BM + slot_nxt + (wid - 4) * 64), 4, 0, 0); }
        if constexpr (GATHER && !LINROWS) { if (has_next && wid < 4)
            __builtin_amdgcn_global_load_lds((const unsigned*)(S.list_ptr(nxt) + wid * 64 + lane), (PG8_LAS unsigned*)(lring + slot_nxt + wid * 64), 4, 0, 0); }
        for (int t = 0; t < nt; t += 2) {
            const bool last = (t == nt - 2);
            const char* a1 = cA + (size_t)(t + 1) * kstepA;
            const char* a2 = last ? nA : cA + (size_t)(t + 2) * kstepA; const char* b2 = last ? nB : cB + (size_t)(t + 2) * kstep;
            const char* a3 = a2 + kstepA; const char* b3 = b2 + kstep;
            if (last && has_next) S.a_ready(nxt);
            PG8_LDB(B0, 0, 0); PG8_LDB(B1, 0, 1); PG8_SCHED; PG8_LDA(At, 0, 0); PG8_STAGE(PG8_SA(1, 1), a1, voffA1);
            if constexpr (GATHER && LINROWS) { if (last && has_next) {
#pragma unroll
                for (int i = 0; i < 2; ++i) { voffA0[i] = (unsigned)(nxt.srow + RA[i]) * (unsigned)KB + (unsigned)(CA[i] * 2); voffA1[i] = (unsigned)(nxt.srow + HALF + RA[i]) * (unsigned)KB + (unsigned)(CA[i] * 2); } } }
            if constexpr (GATHER && !LINROWS) { if (last && has_next) {
#pragma unroll
                for (int i = 0; i < 2; ++i) { const int r0 = RA[i] < nxt.rows ? RA[i] : nxt.rows - 1, r1 = HALF + RA[i] < nxt.rows ? HALF + RA[i] : nxt.rows - 1;
                    voffA0[i] = (unsigned)(lring[slot_nxt + r0] >> S.ashift) * (unsigned)KB + (unsigned)(CA[i] * 2); voffA1[i] = (unsigned)(lring[slot_nxt + r1] >> S.ashift) * (unsigned)KB + (unsigned)(CA[i] * 2); } } }
            PG8_WAIT_V(8); PG8_WAIT_L(0); PG8_BAR; PG8_MMA(0, 0, At, B0); PG8_MMA(0, 1, At, B1); PG8_BAR; PG8_SCHED;
            PG8_LDA(At, 0, 1); PG8_STAGE(PG8_SB(0, 0), b2, voffB); PG8_STAGE(PG8_SB(0, 1), b2 + hstepB, voffB); PG8_STAGE(PG8_SA(0, 0), a2, voffA0);
            PG8_WAIT_V(8); PG8_WAIT_L(0); PG8_BAR; PG8_MMA(1, 0, At, B0); PG8_MMA(1, 1, At, B1); PG8_BAR; PG8_SCHED;
            PG8_LDB(B0, 1, 0); PG8_LDB(B1, 1, 1); PG8_SCHED; PG8_LDA(At, 1, 0); PG8_STAGE(PG8_SA(0, 1), a2, voffA1);
            PG8_WAIT_V(8); PG8_WAIT_L(0); PG8_BAR; PG8_MMA(0, 0, At, B0); PG8_MMA(0, 1, At, B1); PG8_BAR; PG8_SCHED;
            PG8_LDA(At, 1, 1); PG8_STAGE(PG8_SB(1, 0), b3, voffB); PG8_STAGE(PG8_SB(1, 1), b3 + hstepB, voffB); PG8_STAGE(PG8_SA(1, 0), a3, voffA0);
            PG8_WAIT_V(8); PG8_WAIT_L(0); PG8_BAR; PG8_MMA(1, 0, At, B0); PG8_MMA(1, 1, At, B1); PG8_BAR; PG8_SCHED;
        }
        if constexpr (ALIGN_EPI) { if (wr == 0) PG8_BAR; }
        E(acc, cur, wr, wc, fr, fq, lring + slot_cur); S.done(cur);
        if (!has_next) break;
#pragma unroll
        for (int a = 0; a < 2; ++a)
#pragma unroll
            for (int b = 0; b < 2; ++b)
#pragma unroll
                for (int m = 0; m < 4; ++m)
#pragma unroll
                    for (int n = 0; n < 2; ++n) acc[a][b][m][n] = (f32x4){0.f, 0.f, 0.f, 0.f};
        cur = nxt; cA = nA; cB = nB; ++ui;
        if constexpr (ALIGN_EPI) { if (wr == 1) PG8_BAR; }
    }
    PG8_WAIT_V(0);
    if constexpr (!ALIGN_EPI) { if (wr == 0) PG8_BAR; }
    PG8_BAR;
#undef PG8_SA
#undef PG8_SB
#undef PG8_STAGE
#undef PG8_LDA
#undef PG8_LDB
#undef PG8_MMA
#undef PG8_WAIT_V
#undef PG8_WAIT_L
#undef PG8_BAR
#undef PG8_SCHED
}

__device__ __forceinline__ unsigned cvt_pk_bf16(float lo, float hi) { unsigned r; asm volatile("v_cvt_pk_bf16_f32 %0, %1, %2" : "=v"(r) : "v"(lo), "v"(hi)); return r; }
__device__ __forceinline__ float bf_lo(unsigned w) { return __uint_as_float(w << 16); }
__device__ __forceinline__ float bf_hi(unsigned w) { return __uint_as_float(w & 0xffff0000u); }
__device__ __forceinline__ float sigm(float x) { return __builtin_amdgcn_rcpf(1.f + __builtin_amdgcn_exp2f(-1.4426950408889634f * x)); }
__device__ __forceinline__ f32x4 sigm4(f32x4 x) { f32x4 t = x * -1.4426950408889634f, s;
#pragma unroll
    for (int j = 0; j < 4; ++j) s[j] = __builtin_amdgcn_exp2f(t[j]);
    s = s + 1.f;
#pragma unroll
    for (int j = 0; j < 4; ++j) s[j] = __builtin_amdgcn_rcpf(s[j]);
    return s; }
__device__ __forceinline__ u32x4 pack8(const f32x4 v0, const f32x4 v1) { u32x4 w; w.x = cvt_pk_bf16(v0[0], v0[1]); w.y = cvt_pk_bf16(v0[2], v0[3]); w.z = cvt_pk_bf16(v1[0], v1[1]); w.w = cvt_pk_bf16(v1[2], v1[3]); return w; }
__device__ __forceinline__ void unpack8(const u32x4 w, f32x4& v0, f32x4& v1) { v0 = (f32x4){bf_lo(w.x), bf_hi(w.x), bf_lo(w.y), bf_hi(w.y)}; v1 = (f32x4){bf_lo(w.z), bf_hi(w.z), bf_lo(w.w), bf_hi(w.w)}; }

struct EpiProj {
    static constexpr bool PERM = true, BIAS_LDS = false;
    bf16_t* O; const float* qg; const float* kg; bf16_t* U; int ldc; float qscale; int nostore, urows;
    __device__ __forceinline__ void operator()(f32x4 (&acc)[2][2][4][2], const Unit& u, int wr, int wc, int fr, int fq, const PG8_LAS int* lrow) const {
        const int row0 = u.pm * BM + wr * 64 + fr, col0 = u.pl * BM + wc * 64 + 8 * fq;
        if (u.pl >= 4 && u.pl <= 8) {
            const float* gp = (u.pl == 8 ? kg : qg) + 8 * fq; const float sc = (u.pl == 8) ? 1.f : qscale;
            f32x4 gv[2][2];
#pragma unroll
            for (int bj = 0; bj < 2; ++bj)
#pragma unroll
                for (int n = 0; n < 2; ++n) gv[bj][n] = *(const f32x4*)(gp + 32 * bj + 4 * n) * sc;
#pragma unroll
            for (int ai = 0; ai < 2; ++ai)
#pragma unroll
                for (int m = 0; m < 4; ++m) { float ss = 0.f;
#pragma unroll
                    for (int bj = 0; bj < 2; ++bj)
#pragma unroll
                        for (int n = 0; n < 2; ++n) { const f32x4 v = acc[ai][bj][m][n]; ss += (v[0] * v[0] + v[1] * v[1]) + (v[2] * v[2] + v[3] * v[3]); }
                    ss += __shfl_xor(ss, 16); ss += __shfl_xor(ss, 32);
                    const float rs = rsqrtf(ss * (1.f / 64.f) + 1e-5f);
#pragma unroll
                    for (int bj = 0; bj < 2; ++bj)
#pragma unroll
                        for (int n = 0; n < 2; ++n) acc[ai][bj][m][n] = acc[ai][bj][m][n] * rs * gv[bj][n]; }
        }
#pragma unroll
        for (int ai = 0; ai < 2; ++ai)
#pragma unroll
            for (int m = 0; m < 4; ++m) { bf16_t* rowp = O + (size_t)(row0 + ai * HALF + m * 16) * ldc + col0;
#pragma unroll
                for (int bj = 0; bj < 2; ++bj) { const u32x4 w = pack8(acc[ai][bj][m][0], acc[ai][bj][m][1]);
                    if (u.pl < 4) { const int c = col0 + bj * 32; *(u32x4*)(U + ((size_t)(c >> 4) * urows + (size_t)(row0 + ai * HALF + m * 16)) * 16 + (c & 15)) = w; }
                    else if (!nostore) *(u32x4*)(rowp + bj * 32) = w; else asm volatile("" :: "v"(w)); } }
    }
};
struct EpiGlu {
    static constexpr bool PERM = true, BIAS_LDS = false;
    bf16_t* O; int ldc, pad;
    __device__ __forceinline__ void operator()(f32x4 (&acc)[2][2][4][2], const Unit& u, int wr, int wc, int fr, int fq, const PG8_LAS int* lrow) const {
        const int row0 = u.pm * BM + wr * 64 + fr, col0 = u.pl * HALF + wc * 32 + 8 * fq;
#pragma unroll
        for (int ai = 0; ai < 2; ++ai)
#pragma unroll
            for (int m = 0; m < 4; ++m) { bf16_t* rowp = O + (size_t)(row0 + ai * HALF + m * 16) * ldc + col0;
                const f32x4 o0 = acc[ai][0][m][0] * sigm4(acc[ai][1][m][0]), o1 = acc[ai][0][m][1] * sigm4(acc[ai][1][m][1]);
                *(u32x4*)rowp = pack8(o0, o1); }
    }
};
struct EpiGate {
    static constexpr bool PERM = true, BIAS_LDS = false;
    bf16_t* O; const bf16_t* G; int ldc, ldg, gcol0, gcol1;
    __device__ __forceinline__ void operator()(f32x4 (&acc)[2][2][4][2], const Unit& u, int wr, int wc, int fr, int fq, const PG8_LAS int* lrow) const {
        const int row0 = u.pm * BM + wr * 64 + fr, col0 = u.pl * BM + wc * 64 + 8 * fq; const bool add = u.e != 0; const int gcol = add ? gcol1 : gcol0;
#pragma unroll
        for (int ai = 0; ai < 2; ++ai) {
            u32x4 gw[4][2], ow[4][2];
#pragma unroll
            for (int m = 0; m < 4; ++m)
#pragma unroll
                for (int bj = 0; bj < 2; ++bj) { const size_t r = (size_t)(row0 + ai * HALF + m * 16);
                    gw[m][bj] = *(const u32x4*)(G + r * ldg + gcol + col0 + bj * 32);
                    if (add) ow[m][bj] = __builtin_nontemporal_load((const u32x4*)(O + r * ldc + col0 + bj * 32)); else ow[m][bj] = (u32x4){0u, 0u, 0u, 0u}; }
#pragma unroll
            for (int m = 0; m < 4; ++m)
#pragma unroll
                for (int bj = 0; bj < 2; ++bj) { const size_t r = (size_t)(row0 + ai * HALF + m * 16);
                    f32x4 g0, g1; unpack8(gw[m][bj], g0, g1);
                    f32x4 p0, p1; unpack8(ow[m][bj], p0, p1);
                    const f32x4 o0 = sigm4(g0) * acc[ai][bj][m][0] + p0, o1 = sigm4(g1) * acc[ai][bj][m][1] + p1;
                    *(u32x4*)(O + r * ldc + col0 + bj * 32) = pack8(o0, o1); } }
    }
};
struct EpiResid {
    static constexpr bool PERM = false, BIAS_LDS = false;
    const float* base; float* out; int ldc, pad;
    __device__ __forceinline__ void operator()(f32x4 (&acc)[2][2][4][2], const Unit& u, int wr, int wc, int fr, int fq, const PG8_LAS int* lrow) const {
        const int row0 = u.pm * BM + wr * 64 + fr, col0 = u.pl * BM + wc * 64 + 4 * fq;
#pragma unroll
        for (int ai = 0; ai < 2; ++ai) {
            f32x4 bv[4][2][2];
#pragma unroll
            for (int m = 0; m < 4; ++m) { const size_t off = (size_t)(row0 + ai * HALF + m * 16) * ldc + col0;
#pragma unroll
                for (int bj = 0; bj < 2; ++bj)
#pragma unroll
                    for (int n = 0; n < 2; ++n) bv[m][bj][n] = *(const f32x4*)(base + off + bj * 32 + n * 16); }
#pragma unroll
            for (int m = 0; m < 4; ++m) { const size_t off = (size_t)(row0 + ai * HALF + m * 16) * ldc + col0;
#pragma unroll
                for (int bj = 0; bj < 2; ++bj)
#pragma unroll
                    for (int n = 0; n < 2; ++n) *(f32x4*)(out + off + bj * 32 + n * 16) = bv[m][bj][n] + acc[ai][bj][m][n]; } }
    }
};
struct EpiSwiglu {
    static constexpr bool PERM = true, BIAS_LDS = true;
    __device__ __forceinline__ const float* bias_elem(const Unit& u, int i) const { return bias + (size_t)u.e * 2 * dff + u.pl * HALF + (i < HALF ? i : dff + i - HALF); }
    unsigned char* O; const float* bias; int ldc, dff; float limit, alpha; int skip, pad;
    __device__ __forceinline__ void operator()(f32x4 (&acc)[2][2][4][2], const Unit& u, int wr, int wc, int fr, int fq, const PG8_LAS int* lrow) const {
        if (skip) { for (int ai = 0; ai < 2; ++ai) for (int m = 0; m < 4; ++m) asm volatile("" :: "v"(acc[ai][0][m][0]), "v"(acc[ai][0][m][1]), "v"(acc[ai][1][m][0]), "v"(acc[ai][1][m][1])); return; }
        asm volatile("" : "+v"(fr));
        const int col0 = u.pl * HALF + wc * 32 + 8 * fq;
        const PG8_LAS float* bg = (const PG8_LAS float*)(lrow + 3 * BM) + wc * 32 + 8 * fq; const PG8_LAS float* bu = bg + HALF;
        const f32x4 bg0 = *(const PG8_LAS f32x4*)bg, bg1 = *(const PG8_LAS f32x4*)(bg + 4), bu0 = *(const PG8_LAS f32x4*)bu, bu1 = *(const PG8_LAS f32x4*)(bu + 4);
        const float nal2 = -1.4426950408889634f * alpha;
#pragma unroll
        for (int ai = 0; ai < 2; ++ai)
#pragma unroll
            for (int m = 0; m < 4; ++m) { const int r = ai * HALF + wr * 64 + m * 16 + fr; unsigned char* rowp = O + (size_t)(u.srow + r) * ldc + col0;
                const f32x4 gt0 = __builtin_elementwise_min(acc[ai][0][m][0] + bg0, (f32x4){limit, limit, limit, limit}), gt1 = __builtin_elementwise_min(acc[ai][0][m][1] + bg1, (f32x4){limit, limit, limit, limit});
                f32x4 up0 = acc[ai][1][m][0] + bu0, up1 = acc[ai][1][m][1] + bu1, s0, s1;
                const f32x4 a0 = gt0 * nal2, a1 = gt1 * nal2;
#pragma unroll
                for (int j = 0; j < 4; ++j) { up0[j] = __builtin_amdgcn_fmed3f(up0[j], -limit, limit); up1[j] = __builtin_amdgcn_fmed3f(up1[j], -limit, limit);
                    s0[j] = __builtin_amdgcn_exp2f(a0[j]); s1[j] = __builtin_amdgcn_exp2f(a1[j]); }
                s0 = s0 + 1.f; s1 = s1 + 1.f;
#pragma unroll
                for (int j = 0; j < 4; ++j) { s0[j] = __builtin_amdgcn_rcpf(s0[j]); s1[j] = __builtin_amdgcn_rcpf(s1[j]); }
                const f32x4 o0 = (up0 * gt0 + gt0) * s0, o1 = (up1 * gt1 + gt1) * s1;
                int w0 = __builtin_amdgcn_cvt_pk_fp8_f32(o0[0], o0[1], 0, false); w0 = __builtin_amdgcn_cvt_pk_fp8_f32(o0[2], o0[3], w0, true);
                int w1 = __builtin_amdgcn_cvt_pk_fp8_f32(o1[0], o1[1], 0, false); w1 = __builtin_amdgcn_cvt_pk_fp8_f32(o1[2], o1[3], w1, true);
                *(unsigned long long*)rowp = (unsigned long long)(unsigned)w0 | ((unsigned long long)(unsigned)w1 << 32); }
    }
};
struct EpiDown {
    static constexpr bool PERM = true, BIAS_LDS = true;
    __device__ __forceinline__ const float* bias_elem(const Unit& u, int i) const { return bias + (size_t)u.e * ncol + u.pl * BM + i; }
    bf16_t* O; const float* bias; int ldc, ncol, skip, pad;
    __device__ __forceinline__ void operator()(f32x4 (&acc)[2][2][4][2], const Unit& u, int wr, int wc, int fr, int fq, const PG8_LAS int* lrow) const {
        if (skip) { for (int ai = 0; ai < 2; ++ai) for (int m = 0; m < 4; ++m) asm volatile("" :: "v"(acc[ai][0][m][0]), "v"(acc[ai][0][m][1]), "v"(acc[ai][1][m][0]), "v"(acc[ai][1][m][1])); return; }
        asm volatile("" : "+v"(fr));
        const int col0 = u.pl * BM + wc * 64 + 8 * fq;
        const PG8_LAS float* bp = (const PG8_LAS float*)(lrow + 3 * BM) + wc * 64 + 8 * fq;
        f32x4 bv[2][2];
#pragma unroll
        for (int bj = 0; bj < 2; ++bj) { bv[bj][0] = *(const PG8_LAS f32x4*)(bp + bj * 32); bv[bj][1] = *(const PG8_LAS f32x4*)(bp + bj * 32 + 4); }
#pragma unroll
        for (int ai = 0; ai < 2; ++ai)
#pragma unroll
            for (int m = 0; m < 4; ++m) { unsigned char* rowp = (unsigned char*)O + (size_t)(u.srow + ai * HALF + wr * 64 + m * 16 + fr) * ldc + col0;
#pragma unroll
                for (int bj = 0; bj < 2; ++bj) { const f32x4 o0 = acc[ai][bj][m][0] + bv[bj][0], o1 = acc[ai][bj][m][1] + bv[bj][1];
                    int w0 = __builtin_amdgcn_cvt_pk_fp8_f32(o0[0], o0[1], 0, false); w0 = __builtin_amdgcn_cvt_pk_fp8_f32(o0[2], o0[3], w0, true);
                    int w1 = __builtin_amdgcn_cvt_pk_fp8_f32(o1[0], o1[1], 0, false); w1 = __builtin_amdgcn_cvt_pk_fp8_f32(o1[2], o1[3], w1, true);
                    *(unsigned long long*)(rowp + bj * 32) = (unsigned long long)(unsigned)w0 | ((unsigned long long)(unsigned)w1 << 32); } }
    }
};
template <bool GATH> struct GroupedOrderT {
    static constexpr bool GATHER = true, FP8 = true, LINROWS = !GATH;
    const PG8_LAS unsigned char* tile_e; const PG8_LAS int* pref; const PG8_LAS int* cnt; PG8_LAS int* lbuf; const int* list; int nN, G, c, nM, lstride, ashift;
    __device__ __forceinline__ bool next(int i, Unit& u) const {
        const int nwg = nM * nN; const long L = (long)i * G + c; if (L >= nwg) return false;
        int wgid = (int)L; { const int q = nwg / NXCD, r = nwg % NXCD, xcd = wgid % NXCD, off = wgid / NXCD; wgid = (xcd < r ? xcd * (q + 1) : r * (q + 1) + (xcd - r) * q) + off; }
        const int nig = WGM * nN, gid = wgid / nig, fm = gid * WGM, gsz = (nM - fm) < WGM ? (nM - fm) : WGM;
        const int mt = fm + ((wgid % nig) % gsz), pl = (wgid % nig) / gsz;
        const int e = tile_e[mt]; const int mtl = mt - pref[e]; const int left = cnt[e] - 256 * mtl;
        u.pm = mtl; u.pn = e * nN + pl; u.e = e; u.pl = pl; u.rows = left < 256 ? left : 256; u.srow = mt * BM; return true;
    }
    __device__ __forceinline__ const int* list_ptr(const Unit& u) const { return list + (size_t)u.e * lstride + u.pm * BM; }
    __device__ __forceinline__ int list_entry(const Unit& u, int r) const { return list_ptr(u)[r < u.rows ? r : u.rows - 1]; }
    __device__ __forceinline__ void a_ready(const Unit&) const {}
    __device__ __forceinline__ void done(const Unit&) const {}
};
struct DualOrder {
    static constexpr bool GATHER = false, FP8 = false, LINROWS = false;
    static constexpr PG8_LAS int* lbuf = nullptr;
    StaticOrder S; int nper;
    __device__ __forceinline__ void init(int M, int N, int G, int c) { S.init(M, N, G, c); nper = (S.nwg - c + G - 1) / G; if (nper < 0) nper = 0; }
    __device__ __forceinline__ bool next(int i, Unit& u) const { if (i >= 2 * nper) return false; const int e = i >= nper ? 1 : 0; const bool ok = S.next(i - e * nper, u); u.e = e; return ok; }
    __device__ __forceinline__ void a_ready(const Unit&) const {}
    __device__ __forceinline__ void done(const Unit&) const {}
};
}

#define GAS __attribute__((address_space(1)))
#define LAS __attribute__((address_space(3)))
typedef unsigned short bf16;
typedef unsigned v4u __attribute__((ext_vector_type(4)));
typedef float f32x4 __attribute__((ext_vector_type(4)));
typedef short bf16x8 __attribute__((ext_vector_type(8)));
typedef GAS unsigned gu32;
typedef GAS unsigned long long gu64;
#define RLX_AGENT __ATOMIC_RELAXED, __HIP_MEMORY_SCOPE_AGENT
#define LDS_WAIT() asm volatile("s_waitcnt lgkmcnt(0)" ::: "memory")
#define VM_WAIT() asm volatile("s_waitcnt vmcnt(0)" ::: "memory")
__device__ __forceinline__ unsigned long long rt() { return __builtin_amdgcn_s_memrealtime(); }
__device__ __forceinline__ unsigned f2bf(float f) { unsigned u = __builtin_bit_cast(unsigned, f); return (u + 0x7fffu + ((u >> 16) & 1u)) >> 16; }
__device__ __forceinline__ unsigned pk2(float lo, float hi) { return f2bf(lo) | (f2bf(hi) << 16); }

#define XB_TMO      128
#define XB_XCNT(j)  (256  + 64 * (j))
#define XB_XSUB(j)  (1280 + 64 * (j))
#define XB_XGEN(j)  (2304 + 64 * (j))
#define XB_TOP      3328
#define XB_TOPGEN   3392
#define XCD_BAR_WORDS 3456
#define XB_SPIN_CAP (1u << 18)

__device__ __forceinline__ unsigned xb_ld(unsigned* p)              { return __hip_atomic_load(p, __ATOMIC_RELAXED, __HIP_MEMORY_SCOPE_AGENT); }
__device__ __forceinline__ unsigned xb_add(unsigned* p, unsigned v) { return __hip_atomic_fetch_add(p, v, __ATOMIC_RELAXED, __HIP_MEMORY_SCOPE_AGENT); }
__device__ __forceinline__ unsigned xb_xcc_id() { return (unsigned)__builtin_amdgcn_s_getreg((3 << 11) | 20) & 0xFu; }
#define XB_SPIN(cond, bar) do { unsigned _sp = 0; while (cond) { __builtin_amdgcn_s_sleep(1); \
    if ((++_sp & 255u) == 0u) { if (xb_ld(&(bar)[XB_TMO])) break; if (_sp > XB_SPIN_CAP) { atomicAdd(&(bar)[XB_TMO], 1u); break; } } } } while (0)

struct XcdBarrier {
    unsigned* bar; unsigned x;
    volatile LAS unsigned* st;
};

__device__ __forceinline__ XcdBarrier xcd_barrier_post(unsigned* bar, volatile LAS unsigned* st) {
    XcdBarrier b; b.bar = bar; b.x = xb_xcc_id(); b.st = st;
    if (threadIdx.x == 0) (void)xb_add(&bar[XB_XCNT(b.x)], 1u);
    return b;
}
__device__ __forceinline__ void xcd_barrier_complete(unsigned* bar, unsigned x, unsigned& nloc, unsigned& nx) {
    const unsigned G = gridDim.x * gridDim.y * gridDim.z;
    unsigned sum, cnt, mine, sp = 0u;
    for (;;) {
        sum = 0u; cnt = 0u; mine = 0u;
#pragma unroll
        for (unsigned j = 0; j < 16; ++j) { const unsigned c = xb_ld(&bar[XB_XCNT(j)]); sum += c; cnt += (c > 0u) ? 1u : 0u; mine = (j == x) ? c : mine; }
        if (sum == G) break;
        __builtin_amdgcn_s_sleep(1);
        if ((++sp & 255u) == 0u) { if (xb_ld(&bar[XB_TMO])) break; if (sp > XB_SPIN_CAP) { atomicAdd(&bar[XB_TMO], 1u); break; } }
    }
    nloc = mine > 0u ? mine : 1u; nx = cnt > 0u ? cnt : 1u;
}

__device__ __forceinline__ void xcd_barrier(const XcdBarrier& b) {
    asm volatile("s_waitcnt vmcnt(0)" ::: "memory");
    __syncthreads();
    if (threadIdx.x == 0) {
        unsigned* bar = b.bar;
        __builtin_amdgcn_s_waitcnt(0);
        unsigned nloc = b.st[0], nx = b.st[1];
        if (nloc == 0u) { xcd_barrier_complete(bar, b.x, nloc, nx); b.st[0] = nloc; b.st[1] = nx; }
        const unsigned old = xb_add(&bar[XB_XSUB(b.x)], 1u);
        const unsigned gen = old / nloc;
        if (old + 1u == (gen + 1u) * nloc) {
            __builtin_amdgcn_fence(__ATOMIC_RELEASE, "agent");
            asm volatile("s_waitcnt vmcnt(0)" ::: "memory");
            const unsigned og = xb_add(&bar[XB_TOP], 1u);
            const unsigned tg = og / nx;
            if (og + 1u == (tg + 1u) * nx) xb_add(&bar[XB_TOPGEN], 1u);
            else XB_SPIN(xb_ld(&bar[XB_TOPGEN]) == tg, bar);
            __builtin_amdgcn_fence(__ATOMIC_ACQUIRE, "agent");
            xb_add(&bar[XB_XGEN(b.x)], 1u);
            asm volatile("s_waitcnt vmcnt(0)" ::: "memory");
        } else {
            XB_SPIN(xb_ld(&bar[XB_XGEN(b.x)]) == gen, bar);
            __builtin_amdgcn_fence(__ATOMIC_ACQUIRE, "agent");
            asm volatile("s_waitcnt vmcnt(0)" ::: "memory");
        }
    }
    __syncthreads();
}

constexpr size_t MiB = 1u << 20;
constexpr size_t WS_CTL = 0;
constexpr size_t CTL_ZERO_BYTES = 65536;
constexpr size_t WS_WIN = 1 * MiB, WS_WGLU = 10 * MiB, WS_WSSM = 14 * MiB, WS_WATT = 16 * MiB, WS_WOUT = 18 * MiB;
constexpr size_t WS_WGU = 20 * MiB, WS_WDN = 148 * MiB;
constexpr float WSCALE = 64.f; constexpr int WSCALE_E8M0 = 127 - 6;
constexpr size_t WS_ROUTE = 216 * MiB;
constexpr size_t WS_H = 224 * MiB;
constexpr size_t WS_PROJ = 288 * MiB;
constexpr size_t WS_S5OUT = 576 * MiB;
constexpr size_t WS_ATTN = 640 * MiB;
constexpr size_t WS_ACT = 704 * MiB;
constexpr size_t WS_BTAB = 976 * MiB, WS_CTAB = 980 * MiB, WS_KTAB = 984 * MiB, WS_A16 = 985 * MiB;
constexpr size_t WS_END = 986 * MiB;
static_assert(WS_PROJ + (size_t)T * IN_W * 2 <= WS_S5OUT && WS_PROJ + (size_t)MAXROWS * 1024 * 2 <= WS_S5OUT && WS_ACT + (size_t)MAXROWS * 1024 <= WS_BTAB, "ws map");
constexpr int CW_CNT = 0;
constexpr int CW_BAR = 4096;
static_assert((CW_BAR + 3 * XCD_BAR_WORDS) * 4 <= (int)CTL_ZERO_BYTES, "ctl map");
constexpr size_t RT_TOPW = 0, RT_LIST = 1 * MiB, RT_APOS = 5 * MiB;

constexpr int LDS_BYTES = 163840;
constexpr int RING_OFF = 0;
constexpr int MISC_OFF = LDS_BYTES - 256;
constexpr int GT_OFF = 131072;

__device__ __forceinline__ float bf2f(bf16 b) { return __uint_as_float((unsigned)b << 16); }
__device__ __forceinline__ float wave_sum(float v) {
#pragma unroll
    for (int o = 1; o < 64; o <<= 1) v += __shfl_xor(v, o);
    return v;
}
__device__ __forceinline__ float wave_max(float v) {
#pragma unroll
    for (int o = 1; o < 64; o <<= 1) v = fmaxf(v, __shfl_xor(v, o));
    return v;
}
__device__ __forceinline__ float gelu_tanh(float x) { const float z = -2.3022081985f * (x + 0.044715f * x * x * x); return x * __builtin_amdgcn_rcpf(1.f + __builtin_amdgcn_exp2f(z)); }
#define WAVE_SYNC() do { __builtin_amdgcn_wave_barrier(); asm volatile("s_waitcnt lgkmcnt(0)" ::: "memory"); } while (0)

struct Args { const float* in[25]; float* out; unsigned char* ws; int ph_lo, ph_hi, bar_idx, sub; };
struct Ctx { int tid, lane, wave, vcu, G, gw, ngw; LAS unsigned char* lds; };

constexpr int TR_SCR = 64 * 65 * 4;
__device__ __forceinline__ void transpose_item(const float* W, int K, int N, bf16* WT, int mode, LAS float* scr, int item, int lane) {
    const int nblk = N / 64, kb = item / nblk, nb = item % nblk, k0 = 64 * kb, n0 = 64 * nb;
#pragma unroll 4
    for (int i = 0; i < 16; ++i) { const int kk = 4 * i + (lane >> 4), nn = 4 * (lane & 15); const f32x4 w = *(const f32x4*)(W + (size_t)(k0 + kk) * N + n0 + nn);
        LAS float* s = scr + kk * 65 + nn; s[0] = w.x; s[1] = w.y; s[2] = w.z; s[3] = w.w; }
    LDS_WAIT(); asm volatile("" ::: "memory");
    const int c = lane & 7;
#pragma unroll
    for (int j = 0; j < 8; ++j) { const int n = (lane >> 3) + 8 * j; const LAS float* s = scr + (8 * c) * 65 + n;
        v4u o; o.x = pk2(s[0 * 65], s[1 * 65]); o.y = pk2(s[2 * 65], s[3 * 65]); o.z = pk2(s[4 * 65], s[5 * 65]); o.w = pk2(s[6 * 65], s[7 * 65]);
        int r = n0 + n;
        if (mode == 1) { const int nh = N / 2, hf = (r >= nh) ? 1 : 0, np = r - hf * nh; r = 256 * (np / 128) + 64 * ((np % 128) / 32) + 32 * hf + (np % 32); }
        *(v4u*)(WT + (size_t)r * K + k0 + 8 * c) = o; }
    LDS_WAIT(); asm volatile("" ::: "memory");
}
constexpr int TR8_SCR = 128 * 33 * 4;
__device__ __forceinline__ void transpose_item_fp8(const float* W, int K, int N, unsigned char* WT, int mode, float wscale, LAS float* scr, int item, int lane) {
    const int nblk = N / 32, kb = item / nblk, nb = item % nblk, k0 = 128 * kb, n0 = 32 * nb;
#pragma unroll 4
    for (int i = 0; i < 16; ++i) { const int kk = 8 * i + (lane >> 3), nn = 4 * (lane & 7); const f32x4 w = *(const f32x4*)(W + (size_t)(k0 + kk) * N + n0 + nn);
        LAS float* s = scr + kk * 33 + nn; s[0] = w.x; s[1] = w.y; s[2] = w.z; s[3] = w.w; }
    LDS_WAIT(); asm volatile("" ::: "memory");
    int rb = n0;
    if (mode == 1) { const int nh = N / 2, hf = (n0 >= nh) ? 1 : 0, np = n0 - hf * nh; rb = 256 * (np / 128) + 64 * ((np % 128) / 32) + 32 * hf; }
    const int c = lane & 7;
#pragma unroll
    for (int j = 0; j < 4; ++j) { const int n = (lane >> 3) + 8 * j; const LAS float* s = scr + (16 * c) * 33 + n;
        v4u o;
#pragma unroll
        for (int q = 0; q < 4; ++q) { int w = __builtin_amdgcn_cvt_pk_fp8_f32(s[(4 * q) * 33] * wscale, s[(4 * q + 1) * 33] * wscale, 0, false); w = __builtin_amdgcn_cvt_pk_fp8_f32(s[(4 * q + 2) * 33] * wscale, s[(4 * q + 3) * 33] * wscale, w, true); o[q] = (unsigned)w; }
        *(v4u*)(WT + (size_t)(rb + n) * K + k0 + 16 * c) = o; }
    LDS_WAIT(); asm volatile("" ::: "memory");
}
__device__ __forceinline__ void transpose_job_fp8(const Ctx& C, const float* W, unsigned char* WT, int K, int N, int mode, int nmat, float wscale) {
    LAS float* scr = (LAS float*)(C.lds + RING_OFF + C.wave * TR8_SCR);
    const int per = (K / 128) * (N / 32); const int total = per * nmat;
    for (int it = C.gw; it < total; it += C.ngw) { const int mat = it / per, item = it % per;
        transpose_item_fp8(W + (size_t)mat * K * N, K, N, WT + (size_t)mat * K * N, mode, wscale, scr, item, C.lane); }
}
__device__ __forceinline__ void transpose_job(const Ctx& C, const float* W, bf16* WT, int K, int N, int mode, int nmat) {
    LAS float* scr = (LAS float*)(C.lds + RING_OFF + C.wave * TR8_SCR);
    const int per = (K / 64) * (N / 64); const int total = per * nmat;
    for (int it = C.gw; it < total; it += C.ngw) { const int mat = it / per, item = it % per;
        transpose_item(W + (size_t)mat * K * N, K, N, WT + (size_t)mat * K * N, mode, scr, item, C.lane); }
}
__device__ __forceinline__ void rmsnorm_rows(const Ctx& C, const float* x, const float* g, bf16* out) {
    f32x4 gg[4];
#pragma unroll
    for (int j = 0; j < 4; ++j) gg[j] = ((const f32x4*)g)[64 * j + C.lane];
    f32x4 vn[4]; int m = C.gw;
    if (m < T) { const f32x4* xr = (const f32x4*)(x + (size_t)m * DM) + C.lane;
#pragma unroll
        for (int j = 0; j < 4; ++j) vn[j] = xr[64 * j]; }
    for (; m < T; m += C.ngw) {
        f32x4 v[4]; float s = 0.f;
#pragma unroll
        for (int j = 0; j < 4; ++j) { v[j] = vn[j]; s += (v[j].x * v[j].x + v[j].y * v[j].y) + (v[j].z * v[j].z + v[j].w * v[j].w); }
        if (m + C.ngw < T) { const f32x4* xr = (const f32x4*)(x + (size_t)(m + C.ngw) * DM) + C.lane;
#pragma unroll
            for (int j = 0; j < 4; ++j) vn[j] = xr[64 * j]; }
        const float rs = rsqrtf(wave_sum(s) * (1.f / DM) + EPS);
        unsigned long long* o8 = (unsigned long long*)(out + (size_t)m * DM) + C.lane;
#pragma unroll
        for (int j = 0; j < 4; ++j) o8[64 * j] = (unsigned long long)pk2(v[j].x * rs * gg[j].x, v[j].y * rs * gg[j].y) | ((unsigned long long)pk2(v[j].z * rs * gg[j].z, v[j].w * rs * gg[j].w) << 32);
    }
}
typedef short rt_bf16x8 __attribute__((ext_vector_type(8)));
typedef float rt_f32x2 __attribute__((ext_vector_type(2))); typedef __bf16 rt_bf16x2 __attribute__((ext_vector_type(2)));
__device__ __forceinline__ unsigned rt_cvtpk(float lo, float hi) { rt_f32x2 v = {lo, hi}; rt_bf16x2 b = __builtin_convertvector(v, rt_bf16x2); return __builtin_bit_cast(unsigned, b); }
__device__ __forceinline__ void rt_split8(const float (&x)[8], rt_bf16x8& hi, rt_bf16x8& lo) {
    v4u h, l;
#pragma unroll
    for (int i = 0; i < 4; ++i) { const unsigned hb = rt_cvtpk(x[2 * i], x[2 * i + 1]); h[i] = hb;
        const float r0 = x[2 * i] - __uint_as_float(hb << 16), r1 = x[2 * i + 1] - __uint_as_float(hb & 0xffff0000u); l[i] = rt_cvtpk(r0, r1); }
    hi = __builtin_bit_cast(rt_bf16x8, h); lo = __builtin_bit_cast(rt_bf16x8, l);
}
constexpr int HN_PITCH = 1032;
__device__ __forceinline__ void router_pass(const Ctx& C, const float* x1, const float* g2, const float* w_router, const float* b_router, unsigned char* h2, float* top_w, int* list, int* apos, unsigned* ctl) {
    LAS float* HN = (LAS float*)(C.lds + RING_OFF); LAS float* PART = HN + 16 * HN_PITCH; LAS float* LOG = PART + 8 * 16 * 32; LAS unsigned* HIST = (LAS unsigned*)(LOG + 16 * 32); LAS unsigned* BASE = HIST + 32; LAS unsigned* RK = BASE + 32;
    LAS unsigned char* EIDS = (LAS unsigned char*)(RK + 32);
    int tid = C.tid; asm volatile("" : "+v"(tid));
    const int lane = tid & 63, wave = C.wave, fr = lane & 15, fq = lane >> 4;
    rt_bf16x8 bhi[4][2], blo[4][2];
#pragma unroll
    for (int ks = 0; ks < 4; ++ks)
#pragma unroll
        for (int nt = 0; nt < 2; ++nt) { float x[8];
#pragma unroll
            for (int j = 0; j < 8; ++j) x[j] = w_router[(size_t)(128 * wave + 32 * ks + 8 * fq + j) * NE + 16 * nt + fr];
            rt_split8(x, bhi[ks][nt], blo[ks][nt]); }
    const float bias = b_router[tid & 31];
    if (tid < 32) HIST[tid] = 0u;
    __syncthreads();
    int nrounds = 0;
    f32x4 vn[2][4];
    if (C.vcu < T / 16) {
#pragma unroll
        for (int q = 0; q < 2; ++q) { const f32x4* xr = (const f32x4*)(x1 + (size_t)(C.vcu * 16 + 2 * wave + q) * DM) + lane;
#pragma unroll
            for (int j = 0; j < 4; ++j) vn[q][j] = xr[64 * j]; } }
    for (int grp = C.vcu; grp < T / 16; grp += C.G, ++nrounds) {
        f32x4 v[2][4];
#pragma unroll
        for (int q = 0; q < 2; ++q)
#pragma unroll
            for (int j = 0; j < 4; ++j) v[q][j] = vn[q][j];
        if (grp + C.G < T / 16) {
#pragma unroll
            for (int q = 0; q < 2; ++q) { const f32x4* xr = (const f32x4*)(x1 + (size_t)((grp + C.G) * 16 + 2 * wave + q) * DM) + lane;
#pragma unroll
                for (int j = 0; j < 4; ++j) vn[q][j] = xr[64 * j]; } }
#pragma unroll
        for (int q = 0; q < 2; ++q) { const int tl = 2 * wave + q; float s = 0.f;
#pragma unroll
            for (int j = 0; j < 4; ++j) s += (v[q][j].x * v[q][j].x + v[q][j].y * v[q][j].y) + (v[q][j].z * v[q][j].z + v[q][j].w * v[q][j].w);
            const float rs = rsqrtf(wave_sum(s) * (1.f / DM) + EPS);
            int* o4 = (int*)(h2 + (size_t)(grp * 16 + tl) * DM) + lane;
#pragma unroll
            for (int j = 0; j < 4; ++j) { const f32x4 gg = ((const f32x4*)g2)[64 * j + lane];
                const f32x4 y = (f32x4){v[q][j].x * rs * gg.x, v[q][j].y * rs * gg.y, v[q][j].z * rs * gg.z, v[q][j].w * rs * gg.w};
                *(LAS f32x4*)(HN + tl * HN_PITCH + 256 * j + 4 * lane) = y;
                int w = __builtin_amdgcn_cvt_pk_fp8_f32(y.x, y.y, 0, false); w = __builtin_amdgcn_cvt_pk_fp8_f32(y.z, y.w, w, true); o4[64 * j] = w; } }
        __syncthreads();
        { pg8::f32x4 acc0 = {0.f, 0.f, 0.f, 0.f}, acc1 = {0.f, 0.f, 0.f, 0.f};
          const LAS float* hb = HN + fr * HN_PITCH + 128 * wave + 8 * fq;
#pragma unroll
          for (int ks = 0; ks < 4; ++ks) { const f32x4 p0 = *(const LAS f32x4*)(hb + 32 * ks), p1 = *(const LAS f32x4*)(hb + 32 * ks + 4);
              const float x[8] = {p0.x, p0.y, p0.z, p0.w, p1.x, p1.y, p1.z, p1.w}; rt_bf16x8 ahi, alo; rt_split8(x, ahi, alo);
              acc0 = __builtin_amdgcn_mfma_f32_16x16x32_bf16(ahi, bhi[ks][0], acc0, 0, 0, 0); acc1 = __builtin_amdgcn_mfma_f32_16x16x32_bf16(ahi, bhi[ks][1], acc1, 0, 0, 0);
              acc0 = __builtin_amdgcn_mfma_f32_16x16x32_bf16(ahi, blo[ks][0], acc0, 0, 0, 0); acc1 = __builtin_amdgcn_mfma_f32_16x16x32_bf16(ahi, blo[ks][1], acc1, 0, 0, 0);
              acc0 = __builtin_amdgcn_mfma_f32_16x16x32_bf16(alo, bhi[ks][0], acc0, 0, 0, 0); acc1 = __builtin_amdgcn_mfma_f32_16x16x32_bf16(alo, bhi[ks][1], acc1, 0, 0, 0); }
          LAS float* pp = PART + (wave * 16 + 4 * fq) * 32 + fr;
#pragma unroll
          for (int r = 0; r < 4; ++r) { pp[r * 32] = acc0[r]; pp[r * 32 + 16] = acc1[r]; } }
        __syncthreads();
        { float a = bias;
#pragma unroll
          for (int w8 = 0; w8 < 8; ++w8) a += PART[(w8 * 16 + (tid >> 5)) * 32 + (tid & 31)];
          LOG[tid] = a; }
        __syncthreads();
        if (lane < 2) { const int tl = 2 * wave + lane; float lg[32];
#pragma unroll
            for (int i = 0; i < 8; ++i) { const f32x4 t4 = *(const LAS f32x4*)(LOG + tl * 32 + 4 * i); lg[4 * i] = t4.x; lg[4 * i + 1] = t4.y; lg[4 * i + 2] = t4.z; lg[4 * i + 3] = t4.w; }
            float tv[4]; int ti[4];
#pragma unroll
            for (int k = 0; k < 4; ++k) { float mx = lg[0]; int mi = 0;
#pragma unroll
                for (int i = 1; i < 32; ++i) { const bool gt = lg[i] > mx; mx = gt ? lg[i] : mx; mi = gt ? i : mi; }
                tv[k] = mx; ti[k] = mi;
#pragma unroll
                for (int i = 0; i < 32; ++i) lg[i] = (i == mi) ? -INFINITY : lg[i]; }
            const float e1 = __expf(tv[1] - tv[0]), e2 = __expf(tv[2] - tv[0]), e3 = __expf(tv[3] - tv[0]); const float inv = 1.f / (1.f + e1 + e2 + e3);
            *(f32x4*)(top_w + (size_t)(grp * 16 + tl) * 4) = (f32x4){inv, e1 * inv, e2 * inv, e3 * inv};
#pragma unroll
            for (int k = 0; k < 4; ++k) { EIDS[(nrounds * 16 + tl) * 4 + k] = (unsigned char)ti[k]; __hip_atomic_fetch_add(HIST + ti[k], 1u, __ATOMIC_RELAXED, __HIP_MEMORY_SCOPE_WORKGROUP); } }
    }
    __syncthreads();
    if (tid < 32) { BASE[tid] = atomicAdd(ctl + CW_CNT + tid, HIST[tid]); RK[tid] = 0u; }
    __syncthreads();
    for (int idx = tid; idx < nrounds * 64; idx += 512) { const int ei = EIDS[idx]; const unsigned rank = __hip_atomic_fetch_add(RK + ei, 1u, __ATOMIC_RELAXED, __HIP_MEMORY_SCOPE_WORKGROUP);
        const int r = idx >> 6, tl = (idx >> 2) & 15, k = idx & 3, a = ((C.vcu + r * C.G) * 16 + tl) * 4 + k; const int slot = (int)(BASE[ei] + rank); list[(size_t)ei * T + slot] = a; apos[a] = (ei << 20) | slot; }
    __syncthreads();
}
__device__ __forceinline__ int grouped_tables(const Ctx& C, const unsigned* ctl) {
    LAS int* cnt = (LAS int*)(C.lds + GT_OFF); LAS int* pref = cnt + 32; LAS unsigned char* tile_e = (LAS unsigned char*)(pref + 36);
    if (C.wave == 0) {
        const int e = C.lane & 31; const int c = (int)__hip_atomic_load(ctl + CW_CNT + e, RLX_AGENT); const int n = (c + 255) >> 8;
        int incl = n;
#pragma unroll
        for (int o = 1; o < 32; o <<= 1) { const int t = __shfl_up(incl, o, 32); if (e >= o) incl += t; }
        const int start = incl - n;
        if (C.lane < 32) { cnt[e] = c; pref[e] = start; if (e == 31) pref[32] = incl; for (int i = 0; i < n; ++i) tile_e[start + i] = (unsigned char)e; }
    }
    __syncthreads();
    return pref[NE];
}
__device__ __forceinline__ void combine_pass(const Ctx& C, float* out, const unsigned char* ys, const float* top_w, const int* apos) {
    const LAS int* pref = (const LAS int*)(C.lds + GT_OFF) + 32;
    const int lane = C.lane;
    for (int tok = C.gw; tok < T; tok += C.ngw) {
        f32x4* o = (f32x4*)(out + (size_t)tok * DM) + 4 * lane;
        f32x4 acc[4];
#pragma unroll
        for (int j = 0; j < 4; ++j) acc[j] = o[j];
        const f32x4 wv4 = *(const f32x4*)(top_w + (size_t)tok * 4);
        const int4 ap = *(const int4*)(apos + (size_t)tok * 4);
        v4u yv[4];
#pragma unroll
        for (int k = 0; k < 4; ++k) { const int p = k == 0 ? ap.x : k == 1 ? ap.y : k == 2 ? ap.z : ap.w; const int srow = pref[p >> 20] * 256 + (p & 0xFFFFF);
            yv[k] = *(const v4u*)(ys + (size_t)srow * DM + 16 * lane); }
#pragma unroll
        for (int k = 0; k < 4; ++k) { const float wv = wv4[k];
#pragma unroll
            for (int j = 0; j < 4; ++j) { const unsigned w = yv[k][j];
                const auto lo2 = __builtin_amdgcn_cvt_pk_f32_fp8((int)w, false), hi2 = __builtin_amdgcn_cvt_pk_f32_fp8((int)w, true);
                acc[j].x += wv * lo2[0]; acc[j].y += wv * lo2[1]; acc[j].z += wv * hi2[0]; acc[j].w += wv * hi2[1]; } }
#pragma unroll
        for (int j = 0; j < 4; ++j) o[j] = acc[j];
    }
}

namespace att {
using bf16x8 = __attribute__((ext_vector_type(8))) short;
using s16x4 = __attribute__((ext_vector_type(4))) short;
using f32x16 = __attribute__((ext_vector_type(16))) float;
using u32x4 = __attribute__((ext_vector_type(4))) unsigned;
typedef float f32x2_t __attribute__((ext_vector_type(2))); typedef __bf16 bf16x2_t __attribute__((ext_vector_type(2)));
constexpr float LOG2E = 1.4426950408889634f, QSCALE = 0.125f * LOG2E;
constexpr int SLOTB = 8192, NSLOT = 4;
constexpr int L_K = 0, L_V = NSLOT * SLOTB, L_WS = 2 * NSLOT * SLOTB, L_OST = L_WS + 8 * 256, L_BYTES = L_OST + 8 * 4096;
__device__ __forceinline__ int crow(int r, int hi) { return (r & 3) + 8 * (r >> 2) + 4 * hi; }
__device__ __forceinline__ void glds16(const void* gsrc, unsigned lds_dst) { unsigned keep;
    asm volatile("s_mov_b32 %0, m0\n\ts_mov_b32 m0, %2\n\ts_nop 0\n\tglobal_load_lds_dwordx4 %1, off\n\ts_mov_b32 m0, %0" : "=&s"(keep) : "v"(gsrc), "s"(lds_dst) : "memory"); }
__device__ __forceinline__ unsigned cvtpk_s(float lo, float hi) { f32x2_t v = {lo, hi}; bf16x2_t b = __builtin_convertvector(v, bf16x2_t); return __builtin_bit_cast(unsigned, b); }
typedef __attribute__((address_space(3))) const char* lds_cptr;
__device__ __forceinline__ void qkt_half(f32x16& p, lds_cptr kb, const bf16x8* qr) {
    const f32x16 z = f32x16{};
#pragma unroll
    for (int d0 = 0; d0 < 4; ++d0) {
        const bf16x8 b0 = *(const __attribute__((address_space(3))) bf16x8*)(kb + d0 * 2048);
        p = __builtin_amdgcn_mfma_f32_32x32x16_bf16(b0, qr[d0], d0 == 0 ? z : p, 0, 0, 0); }
}
__device__ __forceinline__ void pv_half(f32x16* o, int vb, bf16x8 pa0, bf16x8 pa1) {
#pragma unroll
    for (int d0 = 0; d0 < 2; ++d0) { s16x4 lo[2], hi[2];
#pragma unroll
        for (int ks = 0; ks < 2; ++ks) {
            asm volatile("ds_read_b64_tr_b16 %0,%1 offset:%c2" : "=&v"(lo[ks]) : "v"(vb), "i"(d0 * 4096 + ks * 1024) : "memory");
            asm volatile("ds_read_b64_tr_b16 %0,%1 offset:%c2" : "=&v"(hi[ks]) : "v"(vb), "i"(d0 * 4096 + ks * 1024 + 512) : "memory"); }
        asm volatile("s_waitcnt lgkmcnt(0)" ::: "memory"); __builtin_amdgcn_sched_barrier(0);
#define ATT_PK(k) (bf16x8){lo[k][0], lo[k][1], lo[k][2], lo[k][3], hi[k][0], hi[k][1], hi[k][2], hi[k][3]}
        o[d0] = __builtin_amdgcn_mfma_f32_32x32x16_bf16(pa0, ATT_PK(0), o[d0], 0, 0, 0);
        o[d0] = __builtin_amdgcn_mfma_f32_32x32x16_bf16(pa1, ATT_PK(1), o[d0], 0, 0, 0);
#undef ATT_PK
    }
}
__device__ __forceinline__ void dma_tile(const bf16* proj, int b, int kvh, int ti, unsigned lds0, int wid, int lane) {
    const unsigned slot = (unsigned)((ti + 2) & 3) * SLOTB;
    int kr = 64 * ti + lane; kr = kr < 0 ? 0 : kr;
    int vr = 64 * ti + 16 * (wid & 3) + (lane >> 2); vr = vr < 0 ? 0 : vr;
    const bf16* ksrc = proj + (size_t)(b * SEQ + kr) * IN_W + C_K + kvh * 64 + wid * 8;
    const bf16* vsrc = proj + (size_t)(b * SEQ + vr) * IN_W + C_V + kvh * 64 + (wid >> 2) * 32 + (lane & 3) * 8;
    glds16(ksrc, (unsigned)__builtin_amdgcn_readfirstlane(lds0 + L_K + slot + wid * 1024));
    glds16(vsrc, (unsigned)__builtin_amdgcn_readfirstlane(lds0 + L_V + slot + wid * 1024));
}
#define ATT_WAIT_BAR() asm volatile("s_waitcnt vmcnt(0) lgkmcnt(0)\n\ts_barrier" ::: "memory")
__device__ __forceinline__ void attn_run(int b, int kvh, int qb0, int nqb, const bf16* proj, const float* sinks, bf16* O, LAS unsigned char* shm) {
    const int tid = threadIdx.x, lane = tid & 63, r32 = lane & 31, hi = lane >> 5; const int wid = __builtin_amdgcn_readfirstlane(tid >> 6);
    const int h = kvh * 4 + (wid & 3), sub = wid >> 2;
    const unsigned lds0 = (unsigned)(uintptr_t)shm;
    LAS float* wsf = (LAS float*)(shm + L_WS) + wid * 64;
    const lds_cptr shm3 = (lds_cptr)shm;
    const int vb0 = (int)(lds0 + L_V) + ((lane >> 4) & 1) * 32 + (lane & 3) * 8 + (4 * hi + ((lane & 15) >> 2)) * 64;
    const float slope2 = exp2f(-0.5f * (float)(h + 1)) * LOG2E, sink2 = sinks[h] * LOG2E;
    dma_tile(proj, b, kvh, qb0 - 2, lds0, wid, lane); dma_tile(proj, b, kvh, qb0 - 1, lds0, wid, lane); dma_tile(proj, b, kvh, qb0, lds0, wid, lane);
    const bf16* Qw = proj + (size_t)(b * SEQ + qb0 * 64 + 32 * sub + r32) * IN_W + C_Q + h * 64 + hi * 8;
    bf16x8 qn[4];
#pragma unroll
    for (int d0 = 0; d0 < 4; ++d0) qn[d0] = *(const bf16x8*)(Qw + d0 * 16);
    for (int qi = 0; qi < nqb; ++qi) {
        const int qb = qb0 + qi, tq0 = qb * 64 + 32 * sub;
        bf16x8 qr[4];
#pragma unroll
        for (int d0 = 0; d0 < 4; ++d0) qr[d0] = qn[d0];
        ATT_WAIT_BAR();
        if (qi + 1 < nqb) dma_tile(proj, b, kvh, qb + 1, lds0, wid, lane);
        f32x16 p[5];
#pragma unroll
        for (int i = 0; i < 5; ++i) { const int g = i + sub; qkt_half(p[i], shm3 + L_K + ((qb + (g >> 1)) & 3) * SLOTB + (g & 1) * 512 + hi * 1024 + r32 * 16, qr); }
        if (qi + 1 < nqb) {
#pragma unroll
            for (int d0 = 0; d0 < 4; ++d0) qn[d0] = *(const bf16x8*)(Qw + (size_t)(64 * (qi + 1)) * IN_W + d0 * 16); }
        float dbase = (float)(128 + r32 - 4 * hi); asm volatile("" : "+v"(dbase));
        const float dmax = (float)(tq0 + r32);
        float mx = -INFINITY;
#pragma unroll
        for (int i = 0; i < 5; ++i)
#pragma unroll
            for (int r = 0; r < 16; ++r) { const float d = dbase - (float)(32 * i + (r & 3) + 8 * (r >> 2));
                float v = p[i][r] - slope2 * d;
                if (i == 0) v = (d < 128.f) ? v : -INFINITY;
                if (i == 4) v = (d >= 0.f) ? v : -INFINITY;
                if (qb < 2) v = (d <= dmax) ? v : -INFINITY;
                p[i][r] = v; mx = fmaxf(mx, v); }
        { auto rr = __builtin_amdgcn_permlane32_swap(__float_as_uint(mx), __float_as_uint(mx), false, false); mx = fmaxf(__uint_as_float(rr[0]), __uint_as_float(rr[1])); }
        mx = fmaxf(mx, sink2);
        float ls = 0.f;
        f32x16 o[2]; o[0] = f32x16{}; o[1] = f32x16{};
#pragma unroll
        for (int i = 0; i < 5; ++i) { const int g = i + sub;
#pragma unroll
            for (int r = 0; r < 16; ++r) { const float e = __builtin_amdgcn_exp2f(p[i][r] - mx); p[i][r] = e; ls += e; }
            u32x4 pw0, pw1;
#define ATT_PKW(P, B) cvtpk_s(P[B], P[B + 1])
            pw0 = (u32x4){ATT_PKW(p[i], 0), ATT_PKW(p[i], 2), ATT_PKW(p[i], 4), ATT_PKW(p[i], 6)}; pw1 = (u32x4){ATT_PKW(p[i], 8), ATT_PKW(p[i], 10), ATT_PKW(p[i], 12), ATT_PKW(p[i], 14)};
#undef ATT_PKW
            __builtin_amdgcn_sched_barrier(0);
            pv_half(o, vb0 + ((qb + (g >> 1)) & 3) * SLOTB + (g & 1) * 2048, __builtin_bit_cast(bf16x8, pw0), __builtin_bit_cast(bf16x8, pw1));
        }
        { auto rr = __builtin_amdgcn_permlane32_swap(__float_as_uint(ls), __float_as_uint(ls), false, false); ls = __uint_as_float(rr[0]) + __uint_as_float(rr[1]); }
        ls += __builtin_amdgcn_exp2f(sink2 - mx);
        if (hi == 0) wsf[32 + r32] = ls;
        asm volatile("s_waitcnt lgkmcnt(0)" ::: "memory");
        float rli[16];
#pragma unroll
        for (int r = 0; r < 16; ++r) rli[r] = __builtin_amdgcn_rcpf(wsf[32 + crow(r, hi)]);
        bf16* Ow = O + (size_t)(b * SEQ + tq0) * 1024 + h * 64;
        { LAS bf16* stg = (LAS bf16*)(shm + L_OST) + wid * 2048;
#pragma unroll
            for (int r = 0; r < 16; ++r) { const int orow = crow(r, hi);
#pragma unroll
                for (int d0 = 0; d0 < 2; ++d0) stg[orow * 64 + d0 * 32 + r32] = (bf16)f2bf(o[d0][r] * rli[r]); }
            asm volatile("s_waitcnt lgkmcnt(0)" ::: "memory");
#pragma unroll
            for (int i = 0; i < 4; ++i) { const int row = i * 8 + (lane >> 3), ch = lane & 7; const u32x4 v = *(const LAS u32x4*)(stg + row * 64 + ch * 8); *(u32x4*)(Ow + (size_t)row * 1024 + ch * 8) = v; } }
    }
    ATT_WAIT_BAR();
}
#undef ATT_WAIT_BAR
}

namespace s5 {
using bf16x8 = __attribute__((ext_vector_type(8))) short;
using f32x16 = __attribute__((ext_vector_type(16))) float;
struct cf { float re, im; };
__device__ __forceinline__ cf cmul(cf a, cf b) { return cf{a.re * b.re - a.im * b.im, a.re * b.im + a.im * b.re}; }
__device__ __forceinline__ cf cfma(cf a, cf b, cf c) { return cf{c.re + a.re * b.re - a.im * b.im, c.im + a.re * b.im + a.im * b.re}; }
__device__ __forceinline__ int crow(int r, int hi) { return (r & 3) + 8 * (r >> 2) + 4 * hi; }
__device__ __forceinline__ bf16x8 ldg16(const bf16* ubase, unsigned lane_off) { return *(const bf16x8*)((const char*)ubase + lane_off); }
constexpr size_t BT_G = 128 * 256, KT_G = 16 * 16 * 16, CT_G = 256 * 128;
constexpr int IMG_STRIDE = 136;
constexpr int L_IMG = 0, L_T = 8 * 32 * IMG_STRIDE * 2, L_BYTES = L_T + 8 * 2 * 2 * 32 * 4;

__device__ __forceinline__ void build_tables(int g, int part, const float* a_re, const float* a_im, const float* log_dt, const float* b_re, const float* b_im, const float* c_re, const float* c_im, const float* d_skip,
                                             bf16* Btab, bf16* Ktab, bf16* Ctab, float* A16tab, LAS unsigned char* scr, int tid) {
    LAS double* LA = (LAS double*)scr; LAS double* TH = LA + 64;
    LAS float* bbr = (LAS float*)(scr + 1024); LAS float* bbi = bbr + 1024;
    LAS float* pwr = bbi + 1024; LAS float* pwi = pwr + 17 * 64;
    LAS float* ccr = pwi + 17 * 64; LAS float* cci = ccr + 1024;
    for (int e = tid; e < 1024; e += 512) { ccr[e] = c_re[(size_t)g * 1024 + e]; cci[e] = c_im[(size_t)g * 1024 + e]; }
    if (tid < 64) { const int i = g * NP + tid;
        const double dt = exp((double)log_dt[g]), are = a_re[i], aim = a_im[i];
        const double la = are * dt, th = aim * dt, mag = exp(la), abr = mag * cos(th), abi = mag * sin(th), den = are * are + aim * aim, em1 = abr - 1.0;
        const double qre = (em1 * are + abi * aim) / den, qim = (abi * are - em1 * aim) / den;
        LA[tid] = la; TH[tid] = th;
        for (int h = 0; h < GCH; ++h) { const double br = b_re[i * GCH + h], bi = b_im[i * GCH + h]; bbr[tid * 16 + h] = (float)(qre * br - qim * bi); bbi[tid * 16 + h] = (float)(qre * bi + qim * br); } }
    __syncthreads();
    for (int e = tid; e < 17 * 64; e += 512) { const int n = e >> 6, p = e & 63; const double m = exp((double)n * LA[p]), t = (double)n * TH[p]; pwr[e] = (float)(m * cos(t)); pwi[e] = (float)(m * sin(t)); }
    __syncthreads();
    if (part == 0 && tid < 64) { A16tab[(g * 64 + tid) * 2] = pwr[16 * 64 + tid]; A16tab[(g * 64 + tid) * 2 + 1] = pwi[16 * 64 + tid]; }
    for (int e = tid; e < 32 * 256; e += 512) { const int pl = e >> 8, k = e & 255, j = k >> 4, hp = k & 15, pp = 32 * part + pl, p = pp & 63;
        const float wr = pwr[(15 - j) * 64 + p], wi = pwi[(15 - j) * 64 + p], br = bbr[p * 16 + hp], bi = bbi[p * 16 + hp];
        const float v = (pp < 64) ? (wr * br - wi * bi) : (wr * bi + wi * br);
        Btab[(size_t)g * BT_G + (size_t)pp * 256 + k] = (bf16)f2bf(v); }
    for (int e = tid; e < 64 * 128; e += 512) { const int nl = e >> 7, pp = e & 127, n = 64 * part + nl, i = n >> 4, h = n & 15, p = pp & 63;
        const float cr = ccr[h * NP + p], ci = cci[h * NP + p], wr = pwr[(i + 1) * 64 + p], wi = pwi[(i + 1) * 64 + p];
        const float v = (pp < 64) ? (cr * wr - ci * wi) : -(cr * wi + ci * wr);
        Ctab[(size_t)g * CT_G + (size_t)n * 128 + pp] = (bf16)f2bf(v); }
    for (int e = tid; e < 4 * 256; e += 512) { const int d = 4 * part + (e >> 8), h = (e >> 4) & 15, hp = e & 15; float acc = 0.f;
#pragma unroll 8
        for (int p = 0; p < 64; ++p) { const float cr = ccr[h * NP + p], ci = cci[h * NP + p], wr = pwr[d * 64 + p], wi = pwi[d * 64 + p], br = bbr[p * 16 + hp], bi = bbi[p * 16 + hp];
            const float tr = wr * br - wi * bi, ti = wr * bi + wi * br; acc += cr * tr - ci * ti; }
        if (d == 0 && h == hp) acc += d_skip[g * 16 + h];
        Ktab[(size_t)g * KT_G + (size_t)(d * 16 + h) * 16 + hp] = (bf16)f2bf(acc); }
    __syncthreads();
}

__device__ __forceinline__ void scan_local(f32x16& re, f32x16& im, const cf p1, const cf p4, const int hi, cf (&em)[4], cf& T) {
#pragma unroll
    for (int q = 0; q < 4; ++q)
#pragma unroll
        for (int k = 1; k < 4; ++k) { const int r = 4 * q + k; const cf v = cfma(p1, cf{re[r - 1], im[r - 1]}, cf{re[r], im[r]}); re[r] = v.re; im[r] = v.im; }
    cf E = cf{0.f, 0.f};
#pragma unroll
    for (int q = 0; q < 4; ++q) {
        auto sr = __builtin_amdgcn_permlane32_swap(__float_as_uint(re[4 * q + 3]), __float_as_uint(re[4 * q + 3]), false, false);
        auto si = __builtin_amdgcn_permlane32_swap(__float_as_uint(im[4 * q + 3]), __float_as_uint(im[4 * q + 3]), false, false);
        const cf elo = cf{__uint_as_float(sr[0]), __uint_as_float(si[0])}, ehi = cf{__uint_as_float(sr[1]), __uint_as_float(si[1])};
        const cf Elo = E; E = cfma(p4, E, elo); const cf Ehi = E; E = cfma(p4, E, ehi);
        em[q] = hi ? Ehi : Elo; }
    T = E;
}
__device__ __forceinline__ void scan_finish(f32x16& re, f32x16& im, const cf p1, const cf p2, const cf p3, const cf p4, const cf g2, const int hi, const cf (&em)[4], const cf X) {
    cf cur = hi ? p4 : cf{1.f, 0.f};
#pragma unroll
    for (int q = 0; q < 4; ++q) { const cf carry = cfma(cur, X, em[q]); cur = cmul(cur, g2);
        cf v;
        v = cfma(p1, carry, cf{re[4 * q + 0], im[4 * q + 0]}); re[4 * q + 0] = v.re; im[4 * q + 0] = v.im;
        v = cfma(p2, carry, cf{re[4 * q + 1], im[4 * q + 1]}); re[4 * q + 1] = v.re; im[4 * q + 1] = v.im;
        v = cfma(p3, carry, cf{re[4 * q + 2], im[4 * q + 2]}); re[4 * q + 2] = v.re; im[4 * q + 2] = v.im;
        v = cfma(p4, carry, cf{re[4 * q + 3], im[4 * q + 3]}); re[4 * q + 3] = v.re; im[4 * q + 3] = v.im; }
}

__device__ __forceinline__ void glds16(const void* gsrc, unsigned lds_dst) { unsigned keep;
    asm volatile("s_mov_b32 %0, m0\n\ts_mov_b32 m0, %2\n\ts_nop 0\n\tglobal_load_lds_dwordx4 %1, off\n\ts_mov_b32 m0, %0" : "=&s"(keep) : "v"(gsrc), "s"(lds_dst) : "memory"); }
constexpr int L_TAB = 0, L_TABK = 65536, L_IMG2 = 73728, L_T2 = L_IMG2 + 8 * 32 * IMG_STRIDE * 2, L_BYTES2 = L_T2 + 4096;

__device__ __forceinline__ void s5_unit(int b, int g, const bf16* proj, const bf16* Btab, const bf16* Ktab, const bf16* Ctab, const float* A16tab, bf16* out, LAS unsigned char* shm) {
    int tid = threadIdx.x; asm volatile("" : "+v"(tid));
    const int lane = tid & 63, col = lane & 31, hi = lane >> 5; const int wid = __builtin_amdgcn_readfirstlane(tid >> 6);
    const unsigned lds0 = (unsigned)(uintptr_t)shm;
    { const char* src = (const char*)(Btab + (size_t)g * BT_G);
#pragma unroll
      for (int i = 0; i < 8; ++i) { const int p = wid * 8 + i, row = 2 * p + (lane >> 5), c = (lane & 31) ^ (row & 31);
          glds16(src + row * 512 + c * 16, (unsigned)__builtin_amdgcn_readfirstlane(lds0 + L_TAB + p * 1024)); } }
    const bf16* ub = proj + ((size_t)g * T + (size_t)(b * SEQ + 512 * wid)) * 16;
    const unsigned uoff = (unsigned)(col * 512 + hi * 16);
    bf16x8 ua[16];
#pragma unroll
    for (int j = 0; j < 16; ++j) ua[j] = ldg16(ub + (size_t)j * 16, uoff);
    asm volatile("s_waitcnt vmcnt(0)" ::: "memory"); __syncthreads();
    const LAS unsigned char* tb = shm + L_TAB; const unsigned a0 = (unsigned)(col * 512) | (unsigned)(((hi * 16) ^ (col * 16)));
    f32x16 zt[4];
#pragma unroll
    for (int nt = 0; nt < 4; ++nt) zt[nt] = f32x16{};
#pragma unroll
    for (int j = 0; j < 16; ++j) { const bf16x8 uj = ua[j]; const unsigned aj = a0 ^ (unsigned)(j * 32);
#pragma unroll
        for (int nt = 0; nt < 4; ++nt) { const bf16x8 bfr = *(const LAS bf16x8*)(tb + aj + nt * 16384); zt[nt] = __builtin_amdgcn_mfma_f32_32x32x16_bf16(uj, bfr, zt[nt], 0, 0, 0); } }
    LAS float* Tb = (LAS float*)(shm + L_T2);
    LAS bf16* img = (LAS bf16*)(shm + L_IMG2) + wid * 32 * IMG_STRIDE;
    {
        cf P1[2], P2[2], P3[2], P4[2], G2[2], EM[2][4], TT[2];
#pragma unroll
        for (int s = 0; s < 2; ++s) { const float2 a = ((const float2*)A16tab)[g * 64 + 32 * s + col]; P1[s] = cf{a.x, a.y}; P2[s] = cmul(P1[s], P1[s]); P3[s] = cmul(P2[s], P1[s]); P4[s] = cmul(P2[s], P2[s]); G2[s] = cmul(P4[s], P4[s]); }
        scan_local(zt[0], zt[2], P1[0], P4[0], hi, EM[0], TT[0]);
        scan_local(zt[1], zt[3], P1[1], P4[1], hi, EM[1], TT[1]);
        if (hi == 0) {
#pragma unroll
            for (int s = 0; s < 2; ++s) { Tb[((wid * 2 + s) * 2 + 0) * 32 + col] = TT[s].re; Tb[((wid * 2 + s) * 2 + 1) * 32 + col] = TT[s].im; } }
        asm volatile("s_waitcnt lgkmcnt(0)" ::: "memory"); __syncthreads();
        { const char* src = (const char*)(Ctab + (size_t)g * CT_G);
#pragma unroll
          for (int i = 0; i < 8; ++i) { const int p = wid * 8 + i, row = 4 * p + (lane >> 4), c = (lane & 15) ^ (row & 15);
              glds16(src + row * 256 + c * 16, (unsigned)__builtin_amdgcn_readfirstlane(lds0 + L_TAB + p * 1024)); }
          glds16((const char*)(Ktab + (size_t)g * KT_G) + wid * 1024 + lane * 16, (unsigned)__builtin_amdgcn_readfirstlane(lds0 + L_TABK + wid * 1024)); }
#pragma unroll
        for (int j = 0; j < 16; ++j) ua[j] = ldg16(ub + (size_t)j * 16, uoff);
#pragma unroll
        for (int s = 0; s < 2; ++s) {
            const cf g4 = cmul(G2[s], G2[s]), g8 = cmul(g4, g4);
            cf X = cf{0.f, 0.f};
            for (int v = 0; v < wid; ++v) X = cfma(g8, X, cf{Tb[((v * 2 + s) * 2 + 0) * 32 + col], Tb[((v * 2 + s) * 2 + 1) * 32 + col]});
            scan_finish(zt[s], zt[2 + s], P1[s], P2[s], P3[s], P4[s], G2[s], hi, EM[s], X);
            if (hi == 0) { img[32 * s + col] = (bf16)f2bf(X.re); img[64 + 32 * s + col] = (bf16)f2bf(X.im); }
#pragma unroll
            for (int r = 0; r < 16; ++r) { const int row = crow(r, hi) + 1;
                if (row < 32) { img[row * IMG_STRIDE + 32 * s + col] = (bf16)f2bf(zt[s][r]); img[row * IMG_STRIDE + 64 + 32 * s + col] = (bf16)f2bf(zt[2 + s][r]); } }
        }
    }
    asm volatile("s_waitcnt vmcnt(0) lgkmcnt(0)" ::: "memory"); __syncthreads();
    bf16x8 sa[8];
#pragma unroll
    for (int ks = 0; ks < 8; ++ks) sa[ks] = *(const LAS bf16x8*)(img + col * IMG_STRIDE + 16 * ks + 8 * hi);
    asm volatile("s_waitcnt lgkmcnt(0)" ::: "memory"); __builtin_amdgcn_wave_barrier();
    const int ih = col >> 4, h = col & 15;
    const LAS unsigned char* kb = shm + L_TABK + ih * 512 + h * 32 + hi * 16;
    const unsigned c0 = (unsigned)(col * 256) | (unsigned)((hi * 16) ^ ((col & 15) * 16));
    LAS bf16* stg = img;
    bf16* og = out + ((size_t)g * T + (size_t)(b * SEQ + 512 * wid)) * 16;
#pragma unroll
    for (int ps = 0; ps < 2; ++ps) {
        f32x16 acc[4];
#pragma unroll
        for (int n = 0; n < 4; ++n) acc[n] = f32x16{};
#pragma unroll
        for (int j = 0; j < 8 * ps + 8; ++j) { const bf16x8 uj = ua[j];
#pragma unroll
            for (int n = 0; n < 4; ++n) { const int nt = 4 * ps + n;
                if (j <= 2 * nt + 1) {
                    bf16x8 kf;
                    if (j == 2 * nt + 1) { kf = *(const LAS bf16x8*)(shm + L_TABK + h * 32 + hi * 16); if (ih == 0) kf = bf16x8{}; }
                    else kf = *(const LAS bf16x8*)(kb + (2 * nt - j) * 512);
                    acc[n] = __builtin_amdgcn_mfma_f32_32x32x16_bf16(uj, kf, acc[n], 0, 0, 0); } } }
#pragma unroll
        for (int ks = 0; ks < 8; ++ks) { const unsigned ck = c0 ^ (unsigned)(ks * 32);
#pragma unroll
            for (int n = 0; n < 4; ++n) { const bf16x8 cfr = *(const LAS bf16x8*)(tb + ck + (4 * ps + n) * 8192); acc[n] = __builtin_amdgcn_mfma_f32_32x32x16_bf16(sa[ks], cfr, acc[n], 0, 0, 0); } }
#pragma unroll
        for (int n = 0; n < 4; ++n)
#pragma unroll
            for (int r = 0; r < 16; ++r) stg[(crow(r, hi) * 8 + 2 * n + ih) * 16 + h] = (bf16)f2bf(gelu_tanh(acc[n][r]));
        asm volatile("s_waitcnt lgkmcnt(0)" ::: "memory"); __builtin_amdgcn_wave_barrier();
#pragma unroll
        for (int q = 0; q < 8; ++q) { const int pc = q * 64 + lane, chunk = pc >> 4, il = (pc >> 1) & 7, hf = pc & 1;
            const v4u v = *(const LAS v4u*)(stg + (chunk * 8 + il) * 16 + hf * 8);
            *(v4u*)(og + (size_t)(16 * chunk + 8 * ps + il) * 16 + hf * 8) = v; }
        asm volatile("s_waitcnt lgkmcnt(0)" ::: "memory"); __builtin_amdgcn_wave_barrier();
    }
    __syncthreads();
}
}

constexpr int NPH = 10;
__global__ void __launch_bounds__(512, 2) mk_fwd(Args args) {
    extern __shared__ __attribute__((aligned(16))) unsigned char lds_raw[];
    Ctx C; C.lds = (LAS unsigned char*)lds_raw; C.tid = threadIdx.x; C.lane = C.tid & 63; C.wave = __builtin_amdgcn_readfirstlane(C.tid >> 6);
    C.G = gridDim.x; { const int bx = blockIdx.x; C.vcu = (C.G % 8 == 0) ? (bx % 8) * (C.G / 8) + bx / 8 : bx; }
    C.gw = C.vcu * 8 + C.wave; C.ngw = C.G * 8;
    volatile LAS unsigned* MISC = (volatile LAS unsigned*)(C.lds + MISC_OFF);
    if (C.tid < 64) MISC[C.tid] = 0u;
    __syncthreads();
    unsigned char* ws = args.ws; unsigned* ctl = (unsigned*)(ws + WS_CTL);
    const int lo = args.ph_lo, hi = args.ph_hi;
    XcdBarrier bar; bar.bar = ctl + CW_BAR + args.bar_idx * XCD_BAR_WORDS; bar.x = 0; bar.st = nullptr;
    if (hi - lo > 1) bar = xcd_barrier_post(ctl + CW_BAR + args.bar_idx * XCD_BAR_WORDS, MISC + 8);
#define IN(k) (lo <= (k) && (k) < hi)
#define SEAM(k) do { if (IN(k) && IN((k) + 1)) { xcd_barrier(bar); if (args.sub & 8) xcd_barrier(bar); } } while (0)
    const float* x = args.in[0]; float* out = args.out;
    bf16* WIN = (bf16*)(ws + WS_WIN); bf16* WGLU = (bf16*)(ws + WS_WGLU); bf16* WSSM = (bf16*)(ws + WS_WSSM); bf16* WATT = (bf16*)(ws + WS_WATT); bf16* WOUT = (bf16*)(ws + WS_WOUT);
    bf16* WGU = (bf16*)(ws + WS_WGU); bf16* WDN = (bf16*)(ws + WS_WDN); bf16* BTAB = (bf16*)(ws + WS_BTAB); bf16* CTAB = (bf16*)(ws + WS_CTAB); bf16* KTAB = (bf16*)(ws + WS_KTAB); float* A16TAB = (float*)(ws + WS_A16);
    bf16* H = (bf16*)(ws + WS_H); bf16* PROJ = (bf16*)(ws + WS_PROJ); bf16* S5OUT = (bf16*)(ws + WS_S5OUT); bf16* ATTN = (bf16*)(ws + WS_ATTN);
    bf16* GLU = H; bf16* MIXED = S5OUT; bf16* H2 = ATTN; bf16* YS = PROJ; bf16* ACT = (bf16*)(ws + WS_ACT);
    bf16* UGM = (bf16*)(ws + WS_ACT);
    float* top_w = (float*)(ws + WS_ROUTE + RT_TOPW); int* list = (int*)(ws + WS_ROUTE + RT_LIST); int* apos = (int*)(ws + WS_ROUTE + RT_APOS);
    LAS unsigned char* ring = C.lds + RING_OFF;

    if (IN(0)) {
        for (int blk = C.vcu; blk < NG * 4; blk += C.G) s5::build_tables(blk >> 2, blk & 3, args.in[3], args.in[4], args.in[5], args.in[6], args.in[7], args.in[8], args.in[9], args.in[10], BTAB, KTAB, CTAB, A16TAB, ring, C.tid);
        transpose_job(C, args.in[2], WIN, DM, IN_W, 0, 1);
        transpose_job(C, args.in[11], WGLU, 1024, 2048, 1, 1);
        transpose_job(C, args.in[12], WSSM, 1024, 1024, 0, 1);
        transpose_job(C, args.in[16], WATT, 1024, 1024, 0, 1);
        transpose_job(C, args.in[17], WOUT, 1024, 1024, 0, 1);
        transpose_job_fp8(C, args.in[21], (unsigned char*)WGU, 1024, 2048, 1, NE, WSCALE);
        transpose_job_fp8(C, args.in[23], (unsigned char*)WDN, 1024, 1024, 0, NE, WSCALE);
        rmsnorm_rows(C, x, args.in[1], H);
        __syncthreads();
    }
    SEAM(0);
    if (IN(1)) { pg8::Gemm g{}; g.A = H; g.Bt = WIN; g.M = T; g.N = IN_W; g.K = DM; pg8::StaticOrder S; S.init(T, IN_W, C.G, (int)blockIdx.x);
        pg8::EpiProj e{}; e.O = PROJ; e.ldc = IN_W; e.qg = args.in[13]; e.kg = args.in[14]; e.qscale = att::QSCALE; e.nostore = (args.sub >> 2) & 1; e.U = UGM; e.urows = T; pg8::gemm_phase<pg8::EpiProj, pg8::StaticOrder>(ring, g, S, e); }
    SEAM(1);
    if (IN(2)) {
        if (args.sub & 1) for (int uu = C.vcu; uu < BATCH * NG / 2; uu += C.G) for (int i = 0; i < 2; ++i) { const int unit = 2 * uu + i; s5::s5_unit(unit & 7, unit >> 3, UGM, BTAB, KTAB, CTAB, A16TAB, S5OUT, ring); }
        if (args.sub & 2) for (int run = C.vcu; run < BATCH * NKVH * 8; run += C.G) att::attn_run(run >> 5, (run >> 3) & 3, (run & 7) * 8, 8, PROJ, args.in[15], ATTN, ring);
        __syncthreads();
    }
    SEAM(2);
    if (IN(3)) { pg8::Gemm g{}; g.A = S5OUT; g.Bt = WGLU; g.M = T; g.N = 2048; g.K = 1024; g.agm = 1; pg8::StaticOrder S; S.init(T, 2048, C.G, (int)blockIdx.x);
        pg8::EpiGlu e{}; e.O = GLU; e.ldc = 1024; pg8::gemm_phase<pg8::EpiGlu, pg8::StaticOrder>(ring, g, S, e); }
    SEAM(3);
    if (IN(4)) { pg8::Gemm g{}; g.A = GLU; g.Bt = WSSM; g.A2 = ATTN; g.Bt2 = WATT; g.M = T; g.N = 1024; g.K = 1024; pg8::DualOrder S; S.init(T, 1024, C.G, (int)blockIdx.x);
        pg8::EpiGate e{}; e.O = MIXED; e.ldc = 1024; e.G = PROJ; e.ldg = IN_W; e.gcol0 = C_GS; e.gcol1 = C_GA; pg8::gemm_phase<pg8::EpiGate, pg8::DualOrder>(ring, g, S, e); }
    SEAM(4);
    if (IN(5)) { pg8::Gemm g{}; g.A = MIXED; g.Bt = WOUT; g.M = T; g.N = 1024; g.K = 1024; pg8::StaticOrder S; S.init(T, 1024, C.G, (int)blockIdx.x);
        pg8::EpiResid e{}; e.base = x; e.out = out; e.ldc = 1024; pg8::gemm_phase<pg8::EpiResid, pg8::StaticOrder>(ring, g, S, e); }
    SEAM(5);
    if (IN(6)) { router_pass(C, out, args.in[18], args.in[19], args.in[20], (unsigned char*)H2, top_w, list, apos, ctl); }
    SEAM(6);
    if (IN(7)) { const int nM = grouped_tables(C, ctl);
        pg8::Gemm g{}; g.A = H2; g.Bt = WGU; g.M = NA; g.N = 2048; g.K = 1024; g.scaleA = 0x7f7f7f7f; g.scaleB = WSCALE_E8M0 * 0x01010101;
        pg8::GroupedOrderT<true> S; S.cnt = (const LAS int*)(C.lds + GT_OFF); S.pref = S.cnt + 32; S.tile_e = (const LAS unsigned char*)(S.pref + 36); S.lbuf = (LAS int*)(C.lds + GT_OFF + 2048); S.list = list; S.nN = 8; S.G = C.G; S.c = (int)blockIdx.x; S.nM = nM; S.lstride = T; S.ashift = 2;
        pg8::EpiSwiglu e{}; e.O = (unsigned char*)ACT; e.ldc = 1024; e.bias = args.in[22]; e.dff = DFF; e.limit = 7.0f; e.alpha = 1.702f; e.skip = (args.sub >> 4) & 1;
        pg8::gemm_phase<pg8::EpiSwiglu, pg8::GroupedOrderT<true>>(ring, g, S, e); }
    SEAM(7);
    if (IN(8)) { const int nM = grouped_tables(C, ctl);
        pg8::Gemm g{}; g.A = ACT; g.Bt = WDN; g.M = NA; g.N = 1024; g.K = 1024; g.scaleA = 0x7f7f7f7f; g.scaleB = WSCALE_E8M0 * 0x01010101;
        pg8::GroupedOrderT<false> S; S.cnt = (const LAS int*)(C.lds + GT_OFF); S.pref = S.cnt + 32; S.tile_e = (const LAS unsigned char*)(S.pref + 36); S.lbuf = (LAS int*)(C.lds + GT_OFF + 2048); S.list = list; S.nN = 4; S.G = C.G; S.c = (int)blockIdx.x; S.nM = nM; S.lstride = T; S.ashift = 0;
        pg8::EpiDown e{}; e.O = YS; e.ldc = 1024; e.bias = args.in[24]; e.ncol = 1024; e.skip = (args.sub >> 4) & 1;
        pg8::gemm_phase<pg8::EpiDown, pg8::GroupedOrderT<false>>(ring, g, S, e); }
    SEAM(8);
    if (IN(9)) { (void)grouped_tables(C, ctl); combine_pass(C, out, (const unsigned char*)YS, top_w, apos); }
#undef IN
#undef SEAM
}

extern "C" void kernel_launch(void* const* d_in, const int* in_sizes, int n_in, void* d_out, int out_size, void* d_ws, size_t ws_size, hipStream_t stream) {
    static int grid = 0;
    if (grid == 0) {
        if (n_in != 25 || in_sizes[0] != T * DM || out_size != T * DM || ws_size < WS_END) { fprintf(stderr, "kernel_launch: unexpected shapes / workspace (n_in %d, ws %zu)\n", n_in, ws_size); grid = -1; return; }
        int dev = 0, cus = 0, per_cu = 0;
        if (hipGetDevice(&dev) != hipSuccess || hipDeviceGetAttribute(&cus, hipDeviceAttributeMultiprocessorCount, dev) != hipSuccess) { grid = -1; return; }
        if (hipFuncSetAttribute((const void*)mk_fwd, hipFuncAttributeMaxDynamicSharedMemorySize, LDS_BYTES) != hipSuccess) { fprintf(stderr, "kernel_launch: hipFuncSetAttribute failed\n"); grid = -1; return; }
        if (hipOccupancyMaxActiveBlocksPerMultiprocessor(&per_cu, (const void*)mk_fwd, 512, LDS_BYTES) != hipSuccess || per_cu < 1) { fprintf(stderr, "kernel_launch: occupancy query says %d workgroups per CU\n", per_cu); grid = -1; (void)hipGetLastError(); return; }
        grid = cus;
    }
    if (grid < 0) return;
    if (hipMemsetAsync((char*)d_ws + WS_CTL, 0, CTL_ZERO_BYTES, stream) != hipSuccess) return;
    Args a{};
    for (int i = 0; i < 25; ++i) a.in[i] = (const float*)d_in[i];
    a.out = (float*)d_out; a.ws = (unsigned char*)d_ws;
#ifdef MK_RANGES
    { const int rg[] = MK_RANGES; int nb = 0; for (unsigned i = 0; i + 2 < sizeof(rg) / sizeof(int); i += 3) { a.ph_lo = rg[i]; a.ph_hi = rg[i + 1]; a.sub = rg[i + 2]; a.bar_idx = (rg[i + 1] - rg[i] > 1) ? nb++ : 0;
        hipLaunchKernelGGL(mk_fwd, dim3(grid), dim3(512), LDS_BYTES, stream, a); } }
#else
    a.ph_lo = 0; a.ph_hi = NPH; a.bar_idx = 0; a.sub = 3; hipLaunchKernelGGL(mk_fwd, dim3(grid), dim3(512), LDS_BYTES, stream, a);
#endif
}
```

```cpp
#include <hip/hip_runtime.h>
#include <cstdio>
#include <cstdint>
#include <cmath>

constexpr int DM = 1024, BATCH = 8, SEQ = 4096, T = BATCH * SEQ;
constexpr int NG = 64, NP = 64, GCH = 16;
constexpr int HD = 64, NQH = 16, NKVH = 4, WIN = 128;
constexpr int IN_W = 4608;
constexpr int C_U = 0, C_Q = 1024, C_K = 2048, C_V = 2304, C_GS = 2560, C_GA = 3584;
constexpr int NE = 32, TOPK = 4, DFF = 1024, NA = T * TOPK;
constexpr int MAXROWS = NA + NE * 256;
constexpr int MAXMT = MAXROWS / 256;
constexpr float EPS = 1e-5f;

namespace pg8 {
#define PG8_LAS __attribute__((address_space(3)))
typedef unsigned short bf16_t;
typedef short bf16x8 __attribute__((ext_vector_type(8)));
typedef float f32x4 __attribute__((ext_vector_type(4)));
typedef unsigned u32x4 __attribute__((ext_vector_type(4)));
typedef int i32x8 __attribute__((ext_vector_type(8)));
typedef int i32x4 __attribute__((ext_vector_type(4)));
__device__ __forceinline__ i32x8 cat8(bf16x8 lo, bf16x8 hi) { return __builtin_shufflevector(__builtin_bit_cast(i32x4, lo), __builtin_bit_cast(i32x4, hi), 0, 1, 2, 3, 4, 5, 6, 7); }
constexpr int BM = 256, BK = 64, HALF = 128, HTB = HALF * BK * 2  , STAGE_BYTES = 8 * HTB, NXCD = 8, WGM = 8;

__host__ __device__ __forceinline__ int lds_byte(int r, int c) { const int st = (r >> 4) * 2 + (c >> 5), rr = r & 15, cc = c & 31, ob = rr * 64 + cc * 2; return st * 1024 + (ob ^ (((ob >> 9) & 1) << 5)); }
__host__ __device__ __forceinline__ void stage_rc(int b, int& R, int& C) { const int st = b / 1024, sb = b % 1024, swz = sb ^ (((sb >> 9) & 1) << 5); R = (st >> 1) * 16 + swz / 64; C = (st & 1) * 32 + (swz % 64) / 2; }
__host__ __device__ __forceinline__ int perm32(int rho) { const int n = rho >> 4, i = rho & 15; return 8 * (i >> 2) + 4 * n + (i & 3); }

struct Unit { int pm, pn, e, pl, rows, srow; };
struct Gemm { const bf16_t* A; const bf16_t* Bt; const bf16_t* A2; const bf16_t* Bt2; int M, N, K, agm, scaleA, scaleB, pad0, pad1; };

struct StaticOrder {
    static constexpr bool GATHER = false, FP8 = false, LINROWS = false;
    static constexpr PG8_LAS int* lbuf = nullptr;
    int nM, nN, nwg, G, c;
    __host__ __device__ void init(int M, int N, int G_, int c_) { nM = M / BM; nN = N / BM; nwg = nM * nN; G = G_; c = c_; }
    __host__ __device__ bool next(int i, Unit& u) const {
        const long L = (long)i * G + c; if (L >= nwg) return false;
        int wgid = (int)L; { const int q = nwg / NXCD, r = nwg % NXCD, xcd = wgid % NXCD, off = wgid / NXCD; wgid = (xcd < r ? xcd * (q + 1) : r * (q + 1) + (xcd - r) * q) + off; }
        const int nig = WGM * nN, gid = wgid / nig, fm = gid * WGM, gsz = (nM - fm) < WGM ? (nM - fm) : WGM;
        u.pm = fm + ((wgid % nig) % gsz); u.pn = (wgid % nig) / gsz; u.e = 0; u.pl = u.pn; u.rows = BM; u.srow = u.pm * BM; return true;
    }
    __device__ __forceinline__ void a_ready(const Unit&) const {}
    __device__ __forceinline__ void done(const Unit&) const {}
};

template <class Epi, class Sched, bool ALIGN_EPI = true>
__device__ __forceinline__ void gemm_phase(PG8_LAS unsigned char* lds, const Gemm g, const Sched& S, const Epi& E) {
    int tid = threadIdx.x; asm volatile("" : "+v"(tid));
    const int wid = __builtin_amdgcn_readfirstlane(tid >> 6), lane = tid & 63, wr = wid >> 2, wc = wid & 3, fr = lane & 15, fq = lane >> 4;
    constexpr bool GATHER = Sched::GATHER, FP8 = Sched::FP8;
    const int K = g.K, KB = FP8 ? K : 2 * K, nt = KB / 128;
    int RA[2], CA[2]; unsigned voffA0[2], voffA1[2], voffB[2];
#pragma unroll
    for (int i = 0; i < 2; ++i) { int R, C; stage_rc(tid * 16 + i * 8192, R, C); RA[i] = R; CA[i] = C;
        const int Rb = 2 * (R & ~31) + (Epi::PERM ? perm32(R & 31) : (R & 31));
        voffB[i] = (unsigned)(Rb * KB + C * 2);
        if (g.agm) { voffA0[i] = (unsigned)((C >> 4) * g.M * 32 + R * 32 + (C & 15) * 2); voffA1[i] = voffA0[i] + (unsigned)(HALF * 32); }
        else { voffA0[i] = (unsigned)(R * KB + C * 2); voffA1[i] = (unsigned)((R + HALF) * KB + C * 2); } }
    const size_t kstep = (size_t)(BK * 2);
    const size_t hstepB = (size_t)32 * KB;
    const size_t tstep = (size_t)BM * KB;
    const size_t kstepA = g.agm ? (size_t)4 * g.M * 32 : kstep, tstepA = g.agm ? (size_t)BM * 32 : tstep;
    const unsigned ldsw = (unsigned)wid * 1024u;
    const int aoff = lds_byte(wr * 64 + fr, fq * 8), boff = lds_byte(wc * 32 + fr, fq * 8);
    constexpr int KOFF = 1024;
#define PG8_SA(b, h) (((b) * 2 + (h)) * HTB)
#define PG8_SB(b, h) ((4 + (b) * 2 + (h)) * HTB)
#define PG8_STAGE(bufoff, gbase, voff) do { _Pragma("unroll") for (int _i = 0; _i < 2; ++_i) \
        __builtin_amdgcn_global_load_lds((const unsigned*)((const char*)(gbase) + (voff)[_i]), (PG8_LAS unsigned*)(lds + (bufoff) + ldsw + _i * 8192), 16, 0, 0); } while (0)
#define PG8_LDA(dst, b, h) do { _Pragma("unroll") for (int m = 0; m < 4; ++m) _Pragma("unroll") for (int k = 0; k < 2; ++k) dst[m][k] = *(const PG8_LAS bf16x8*)(lds + PG8_SA(b, h) + aoff + m * 2048 + k * KOFF); } while (0)
#define PG8_LDB(dst, b, h) do { _Pragma("unroll") for (int n = 0; n < 2; ++n) _Pragma("unroll") for (int k = 0; k < 2; ++k) dst[n][k] = *(const PG8_LAS bf16x8*)(lds + PG8_SB(b, h) + boff + n * 2048 + k * KOFF); } while (0)
#define PG8_MMA(ai, bj, At, Bt) do { __builtin_amdgcn_s_setprio(1); _Pragma("unroll") for (int m = 0; m < 4; ++m) _Pragma("unroll") for (int n = 0; n < 2; ++n) { \
        if constexpr (FP8) acc[ai][bj][m][n] = __builtin_amdgcn_mfma_scale_f32_16x16x128_f8f6f4(cat8(Bt[n][0], Bt[n][1]), cat8(At[m][0], At[m][1]), acc[ai][bj][m][n], 0, 0, 0, g.scaleB, 0, g.scaleA); \
        else { _Pragma("unroll") for (int k = 0; k < 2; ++k) acc[ai][bj][m][n] = __builtin_amdgcn_mfma_f32_16x16x32_bf16(Bt[n][k], At[m][k], acc[ai][bj][m][n], 0, 0, 0); } } __builtin_amdgcn_s_setprio(0); } while (0)
#define PG8_WAIT_V(n) asm volatile("s_waitcnt vmcnt(" #n ")" ::: "memory")
#define PG8_WAIT_L(n) asm volatile("s_waitcnt lgkmcnt(" #n ")" ::: "memory")
#define PG8_BAR __builtin_amdgcn_s_barrier()
#define PG8_SCHED __builtin_amdgcn_sched_barrier(0)
    Unit cur, nxt; int ui = 0;
    if (!S.next(0, cur)) return;
    f32x4 acc[2][2][4][2];
#pragma unroll
    for (int a = 0; a < 2; ++a)
#pragma unroll
        for (int b = 0; b < 2; ++b)
#pragma unroll
            for (int m = 0; m < 4; ++m)
#pragma unroll
                for (int n = 0; n < 2; ++n) acc[a][b][m][n] = (f32x4){0.f, 0.f, 0.f, 0.f};
    bf16x8 At[4][2], B0[2][2], B1[2][2];
    PG8_LAS int* const lring = S.lbuf;
    if constexpr (Epi::BIAS_LDS) { if (tid < BM) S.lbuf[3 * BM + tid] = __builtin_bit_cast(int, *E.bias_elem(cur, tid));
        asm volatile("s_waitcnt vmcnt(0) lgkmcnt(0)" ::: "memory"); PG8_BAR; asm volatile("" ::: "memory"); }
    constexpr bool LINROWS = Sched::LINROWS;
    if constexpr (GATHER && LINROWS) {
#pragma unroll
        for (int i = 0; i < 2; ++i) { voffA0[i] = (unsigned)(cur.srow + RA[i]) * (unsigned)KB + (unsigned)(CA[i] * 2); voffA1[i] = (unsigned)(cur.srow + HALF + RA[i]) * (unsigned)KB + (unsigned)(CA[i] * 2); } }
    if constexpr (GATHER && !LINROWS) {
        if (tid < BM) lring[tid] = S.list_entry(cur, tid);
        asm volatile("s_waitcnt vmcnt(0) lgkmcnt(0)" ::: "memory"); PG8_BAR; asm volatile("" ::: "memory");
#pragma unroll
        for (int i = 0; i < 2; ++i) { const int r0 = RA[i] < cur.rows ? RA[i] : cur.rows - 1, r1 = HALF + RA[i] < cur.rows ? HALF + RA[i] : cur.rows - 1;
            voffA0[i] = (unsigned)(lring[r0] >> S.ashift) * (unsigned)KB + (unsigned)(CA[i] * 2); voffA1[i] = (unsigned)(lring[r1] >> S.ashift) * (unsigned)KB + (unsigned)(CA[i] * 2); } }
    const char* cA = GATHER ? (const char*)g.A : (const char*)(cur.e && g.A2 ? g.A2 : g.A) + (size_t)cur.pm * tstepA; const char* cB = (const char*)(!GATHER && cur.e && g.Bt2 ? g.Bt2 : g.Bt) + (size_t)cur.pn * tstep;
    S.a_ready(cur);
    PG8_STAGE(PG8_SB(0, 0), cB, voffB); PG8_STAGE(PG8_SB(0, 1), cB + hstepB, voffB); PG8_STAGE(PG8_SA(0, 0), cA, voffA0); PG8_STAGE(PG8_SA(0, 1), cA, voffA1);
    if (wr == 1) PG8_BAR;
    PG8_WAIT_V(2); PG8_BAR;
    PG8_STAGE(PG8_SB(1, 0), cB + kstep, voffB); PG8_STAGE(PG8_SA(1, 0), cA + kstepA, voffA0); PG8_STAGE(PG8_SB(1, 1), cB + hstepB + kstep, voffB);
    PG8_WAIT_V(6); PG8_BAR;
    for (;;) {
        const bool has_next = S.next(ui + 1, nxt);
        const char* nA = GATHER ? cA : (has_next ? (const char*)(nxt.e && g.A2 ? g.A2 : g.A) + (size_t)nxt.pm * tstepA : cA); const char* nB = has_next ? (const char*)(!GATHER && nxt.e && g.Bt2 ? g.Bt2 : g.Bt) + (size_t)nxt.pn * tstep : cB;
        const int slot_cur = (ui % 3) * BM, slot_nxt = ((ui + 1) % 3) * BM;
        if constexpr (Epi::BIAS_LDS) { if (has_next && wid >= 4)
            __builtin_amdgcn_global_load_lds((const unsigned*)E.bias_elem(nxt, (wid - 4) * 64 + lane), (PG8_LAS unsigned*)(lring + 3 * BM + slot_nxt + (wid - 4) * 64), 4, 0, 0); }
        if constexpr (GATHER && !LINROWS) { if (has_next && wid < 4)
            __builtin_amdgcn_global_load_lds((const unsigned*)(S.list_ptr(nxt) + wid * 64 + lane), (PG8_LAS unsigned*)(lring + slot_nxt + wid * 64), 4, 0, 0); }
        for (int t = 0; t < nt; t += 2) {
            const bool last = (t == nt - 2);
            const char* a1 = cA + (size_t)(t + 1) * kstepA;
            const char* a2 = last ? nA : cA + (size_t)(t + 2) * kstepA; const char* b2 = last ? nB : cB + (size_t)(t + 2) * kstep;
            const char* a3 = a2 + kstepA; const char* b3 = b2 + kstep;
            if (last && has_next) S.a_ready(nxt);
            PG8_LDB(B0, 0, 0); PG8_LDB(B1, 0, 1); PG8_SCHED; PG8_LDA(At, 0, 0); PG8_STAGE(PG8_SA(1, 1), a1, voffA1);
            if constexpr (GATHER && LINROWS) { if (last && has_next) {
#pragma unroll
                for (int i = 0; i < 2; ++i) { voffA0[i] = (unsigned)(nxt.srow + RA[i]) * (unsigned)KB + (unsigned)(CA[i] * 2); voffA1[i] = (unsigned)(nxt.srow + HALF + RA[i]) * (unsigned)KB + (unsigned)(CA[i] * 2); } } }
            if constexpr (GATHER && !LINROWS) { if (last && has_next) {
#pragma unroll
                for (int i = 0; i < 2; ++i) { const int r0 = RA[i] < nxt.rows ? RA[i] : nxt.rows - 1, r1 = HALF + RA[i] < nxt.rows ? HALF + RA[i] : nxt.rows - 1;
                    voffA0[i] = (unsigned)(lring[slot_nxt + r0] >> S.ashift) * (unsigned)KB + (unsigned)(CA[i] * 2); voffA1[i] = (unsigned)(lring[slot_nxt + r1] >> S.ashift) * (unsigned)KB + (unsigned)(CA[i] * 2); } } }
            PG8_WAIT_V(8); PG8_WAIT_L(0); PG8_BAR; PG8_MMA(0, 0, At, B0); PG8_MMA(0, 1, At, B1); PG8_BAR; PG8_SCHED;
            PG8_LDA(At, 0, 1); PG8_STAGE(PG8_SB(0, 0), b2, voffB); PG8_STAGE(PG8_SB(0, 1), b2 + hstepB, voffB); PG8_STAGE(PG8_SA(0, 0), a2, voffA0);
            PG8_WAIT_V(8); PG8_WAIT_L(0); PG8_BAR; PG8_MMA(1, 0, At, B0); PG8_MMA(1, 1, At, B1); PG8_BAR; PG8_SCHED;
            PG8_LDB(B0, 1, 0); PG8_LDB(B1, 1, 1); PG8_SCHED; PG8_LDA(At, 1, 0); PG8_STAGE(PG8_SA(0, 1), a2, voffA1);
            PG8_WAIT_V(8); PG8_WAIT_L(0); PG8_BAR; PG8_MMA(0, 0, At, B0); PG8_MMA(0, 1, At, B1); PG8_BAR; PG8_SCHED;
            PG8_LDA(At, 1, 1); PG8_STAGE(PG8_SB(1, 0), b3, voffB); PG8_STAGE(PG8_SB(1, 1), b3 + hstepB, voffB); PG8_STAGE(PG8_SA(1, 0), a3, voffA0);
            PG8_WAIT_V(8); PG8_WAIT_L(0); PG8_BAR; PG8_MMA(1, 0, At, B0); PG8_MMA(1, 1, At, B1); PG8_BAR; PG8_SCHED;
        }
        if constexpr (ALIGN_EPI) { if (wr == 0) PG8_BAR; }
        E(acc, cur, wr, wc, fr, fq, lring + slot_cur); S.done(cur);
        if (!has_next) break;
#pragma unroll
        for (int a = 0; a < 2; ++a)
#pragma unroll
            for (int b = 0; b < 2; ++b)
#pragma unroll
                for (int m = 0; m < 4; ++m)
#pragma unroll
                    for (int n = 0; n < 2; ++n) acc[a][b][m][n] = (f32x4){0.f, 0.f, 0.f, 0.f};
        cur = nxt; cA = nA; cB = nB; ++ui;
        if constexpr (ALIGN_EPI) { if (wr == 1) PG8_BAR; }
    }
    PG8_WAIT_V(0);
    if constexpr (!ALIGN_EPI) { if (wr == 0) PG8_BAR; }
    PG8_BAR;
#undef PG8_SA
#undef PG8_SB
#undef PG8_STAGE
#undef PG8_LDA
#undef PG8_LDB
#undef PG8_MMA
#undef PG8_WAIT_V
#undef PG8_WAIT_L
#undef PG8_BAR
#undef PG8_SCHED
}

__device__ __forceinline__ unsigned cvt_pk_bf16(float lo, float hi) { unsigned r; asm volatile("v_cvt_pk_bf16_f32 %0, %1, %2" : "=v"(r) : "v"(lo), "v"(hi)); return r; }
__device__ __forceinline__ float bf_lo(unsigned w) { return __uint_as_float(w << 16); }
__device__ __forceinline__ float bf_hi(unsigned w) { return __uint_as_float(w & 0xffff0000u); }
__device__ __forceinline__ float sigm(float x) { return __builtin_amdgcn_rcpf(1.f + __builtin_amdgcn_exp2f(-1.4426950408889634f * x)); }
__device__ __forceinline__ f32x4 sigm4(f32x4 x) { f32x4 t = x * -1.4426950408889634f, s;
#pragma unroll
    for (int j = 0; j < 4; ++j) s[j] = __builtin_amdgcn_exp2f(t[j]);
    s = s + 1.f;
#pragma unroll
    for (int j = 0; j < 4; ++j) s[j] = __builtin_amdgcn_rcpf(s[j]);
    return s; }
__device__ __forceinline__ u32x4 pack8(const f32x4 v0, const f32x4 v1) { u32x4 w; w.x = cvt_pk_bf16(v0[0], v0[1]); w.y = cvt_pk_bf16(v0[2], v0[3]); w.z = cvt_pk_bf16(v1[0], v1[1]); w.w = cvt_pk_bf16(v1[2], v1[3]); return w; }
__device__ __forceinline__ void unpack8(const u32x4 w, f32x4& v0, f32x4& v1) { v0 = (f32x4){bf_lo(w.x), bf_hi(w.x), bf_lo(w.y), bf_hi(w.y)}; v1 = (f32x4){bf_lo(w.z), bf_hi(w.z), bf_lo(w.w), bf_hi(w.w)}; }

struct EpiProj {
    static constexpr bool PERM = true, BIAS_LDS = false;
    bf16_t* O; const float* qg; const float* kg; bf16_t* U; PG8_LAS unsigned char* stage; int ldc; float qscale; int nostore, urows, pad;
    __device__ __forceinline__ void operator()(f32x4 (&acc)[2][2][4][2], const Unit& u, int wr, int wc, int fr, int fq, const PG8_LAS int* lrow) const {
        if (nostore & 2) { for (int ai = 0; ai < 2; ++ai) for (int m = 0; m < 4; ++m) asm volatile("" :: "v"(acc[ai][0][m][0]), "v"(acc[ai][0][m][1]), "v"(acc[ai][1][m][0]), "v"(acc[ai][1][m][1])); return; }
        const int row0 = u.pm * BM + wr * 64 + fr, col0 = u.pl * BM + wc * 64 + 8 * fq;
        if (u.pl >= 4 && u.pl <= 8) {
            const float* gp = (u.pl == 8 ? kg : qg) + 8 * fq; const float sc = (u.pl == 8) ? 1.f : qscale;
            f32x4 gv[2][2];
#pragma unroll
            for (int bj = 0; bj < 2; ++bj)
#pragma unroll
                for (int n = 0; n < 2; ++n) gv[bj][n] = *(const f32x4*)(gp + 32 * bj + 4 * n) * sc;
#pragma unroll
            for (int ai = 0; ai < 2; ++ai)
#pragma unroll
                for (int m = 0; m < 4; ++m) { float ss = 0.f;
#pragma unroll
                    for (int bj = 0; bj < 2; ++bj)
#pragma unroll
                        for (int n = 0; n < 2; ++n) { const f32x4 v = acc[ai][bj][m][n]; ss += (v[0] * v[0] + v[1] * v[1]) + (v[2] * v[2] + v[3] * v[3]); }
                    ss += __shfl_xor(ss, 16); ss += __shfl_xor(ss, 32);
                    const float rs = rsqrtf(ss * (1.f / 64.f) + 1e-5f);
#pragma unroll
                    for (int bj = 0; bj < 2; ++bj)
#pragma unroll
                        for (int n = 0; n < 2; ++n) acc[ai][bj][m][n] = acc[ai][bj][m][n] * rs * gv[bj][n]; }
        }
        if (u.pl < 4) {
#pragma unroll
            for (int ai = 0; ai < 2; ++ai)
#pragma unroll
                for (int m = 0; m < 4; ++m)
#pragma unroll
                    for (int bj = 0; bj < 2; ++bj) { const u32x4 w = pack8(acc[ai][bj][m][0], acc[ai][bj][m][1]); const int c = col0 + bj * 32;
                        *(u32x4*)(U + ((size_t)(c >> 4) * urows + (size_t)(row0 + ai * HALF + m * 16)) * 16 + (c & 15)) = w; }
        } else {
            PG8_LAS unsigned char* stg = stage + (wr * 4 + wc) * 2304; const int lane = fq * 16 + fr;
            bf16_t* ob = O + (size_t)(u.pm * BM + wr * 64 + (lane >> 3)) * ldc + u.pl * BM + wc * 64 + 8 * (lane & 7);
#pragma unroll
            for (int ai = 0; ai < 2; ++ai)
#pragma unroll
                for (int m = 0; m < 4; ++m) {
#pragma unroll
                    for (int bj = 0; bj < 2; ++bj) *(PG8_LAS u32x4*)(stg + fr * 144 + bj * 64 + fq * 16) = pack8(acc[ai][bj][m][0], acc[ai][bj][m][1]);
                    asm volatile("s_waitcnt lgkmcnt(0)" ::: "memory");
                    const u32x4 r0 = *(const PG8_LAS u32x4*)(stg + (lane >> 3) * 144 + (lane & 7) * 16), r1 = *(const PG8_LAS u32x4*)(stg + ((lane >> 3) + 8) * 144 + (lane & 7) * 16);
                    asm volatile("s_waitcnt lgkmcnt(0)" ::: "memory");
                    if (!(nostore & 1)) { *(u32x4*)(ob + (size_t)(ai * HALF + m * 16) * ldc) = r0; *(u32x4*)(ob + (size_t)(ai * HALF + m * 16 + 8) * ldc) = r1; } }
        }
    }
};
struct EpiGlu {
    static constexpr bool PERM = true, BIAS_LDS = false;
    bf16_t* O; int ldc, pad;
    __device__ __forceinline__ void operator()(f32x4 (&acc)[2][2][4][2], const Unit& u, int wr, int wc, int fr, int fq, const PG8_LAS int* lrow) const {
        const int row0 = u.pm * BM + wr * 64 + fr, col0 = u.pl * HALF + wc * 32 + 8 * fq;
#pragma unroll
        for (int ai = 0; ai < 2; ++ai)
#pragma unroll
            for (int m = 0; m < 4; ++m) { bf16_t* rowp = O + (size_t)(row0 + ai * HALF + m * 16) * ldc + col0;
                const f32x4 o0 = acc[ai][0][m][0] * sigm4(acc[ai][1][m][0]), o1 = acc[ai][0][m][1] * sigm4(acc[ai][1][m][1]);
                *(u32x4*)rowp = pack8(o0, o1); }
    }
};
struct EpiGate {
    static constexpr bool PERM = true, BIAS_LDS = false;
    bf16_t* O; const bf16_t* G; PG8_LAS unsigned char* stage; int ldc, ldg, gcol0, gcol1;
    __device__ __forceinline__ void operator()(f32x4 (&acc)[2][2][4][2], const Unit& u, int wr, int wc, int fr, int fq, const PG8_LAS int* lrow) const {
        const int row0 = u.pm * BM + wr * 64 + fr, col0 = u.pl * BM + wc * 64 + 8 * fq; const bool add = u.e != 0; const int gcol = add ? gcol1 : gcol0;
        PG8_LAS unsigned char* stg = stage + (wr * 4 + wc) * 2304; const int lane = fq * 16 + fr;
        bf16_t* ob = O + (size_t)(u.pm * BM + wr * 64 + (lane >> 3)) * ldc + u.pl * BM + wc * 64 + 8 * (lane & 7);
#pragma unroll
        for (int ai = 0; ai < 2; ++ai) {
            u32x4 gw[4][2], ow[4][2];
#pragma unroll
            for (int m = 0; m < 4; ++m)
#pragma unroll
                for (int bj = 0; bj < 2; ++bj) { const size_t r = (size_t)(row0 + ai * HALF + m * 16);
                    gw[m][bj] = *(const u32x4*)(G + r * ldg + gcol + col0 + bj * 32);
                    if (add) ow[m][bj] = __builtin_nontemporal_load((const u32x4*)(O + r * ldc + col0 + bj * 32)); else ow[m][bj] = (u32x4){0u, 0u, 0u, 0u}; }
#pragma unroll
            for (int m = 0; m < 4; ++m)
#pragma unroll
                for (int bj = 0; bj < 2; ++bj) { const size_t r = (size_t)(row0 + ai * HALF + m * 16);
                    f32x4 g0, g1; unpack8(gw[m][bj], g0, g1);
                    f32x4 p0, p1; unpack8(ow[m][bj], p0, p1);
                    const f32x4 o0 = sigm4(g0) * acc[ai][bj][m][0] + p0, o1 = sigm4(g1) * acc[ai][bj][m][1] + p1;
                    *(PG8_LAS u32x4*)(stg + fr * 144 + bj * 64 + fq * 16) = pack8(o0, o1);
                    if (bj == 1) {
                        asm volatile("s_waitcnt lgkmcnt(0)" ::: "memory");
                        const u32x4 r0 = *(const PG8_LAS u32x4*)(stg + (lane >> 3) * 144 + (lane & 7) * 16), r1 = *(const PG8_LAS u32x4*)(stg + ((lane >> 3) + 8) * 144 + (lane & 7) * 16);
                        asm volatile("s_waitcnt lgkmcnt(0)" ::: "memory");
                        *(u32x4*)(ob + (size_t)(ai * HALF + m * 16) * ldc) = r0; *(u32x4*)(ob + (size_t)(ai * HALF + m * 16 + 8) * ldc) = r1; } } }
    }
};
struct EpiResid {
    static constexpr bool PERM = false, BIAS_LDS = false;
    const float* base; float* out; PG8_LAS unsigned char* stage; int ldc, pad;
    __device__ __forceinline__ void operator()(f32x4 (&acc)[2][2][4][2], const Unit& u, int wr, int wc, int fr, int fq, const PG8_LAS int* lrow) const {
        PG8_LAS unsigned char* stg = stage + (wr * 4 + wc) * 2304; const int lane = fq * 16 + fr;
        const size_t gb = (size_t)(u.pm * BM + wr * 64 + (lane >> 3)) * ldc + u.pl * BM + wc * 64 + 4 * (lane & 7);
#pragma unroll
        for (int ai = 0; ai < 2; ++ai) {
            f32x4 bv[4][2][2];
#pragma unroll
            for (int m = 0; m < 4; ++m)
#pragma unroll
                for (int bj = 0; bj < 2; ++bj) { const size_t o = gb + (size_t)(ai * HALF + m * 16) * ldc + bj * 32; bv[m][bj][0] = *(const f32x4*)(base + o); bv[m][bj][1] = *(const f32x4*)(base + o + (size_t)8 * ldc); }
#pragma unroll
            for (int m = 0; m < 4; ++m)
#pragma unroll
                for (int bj = 0; bj < 2; ++bj) { const size_t o = gb + (size_t)(ai * HALF + m * 16) * ldc + bj * 32;
#pragma unroll
                    for (int n = 0; n < 2; ++n) *(PG8_LAS f32x4*)(stg + fr * 144 + n * 64 + fq * 16) = acc[ai][bj][m][n];
                    asm volatile("s_waitcnt lgkmcnt(0)" ::: "memory");
                    const f32x4 r0 = *(const PG8_LAS f32x4*)(stg + (lane >> 3) * 144 + (lane & 7) * 16), r1 = *(const PG8_LAS f32x4*)(stg + ((lane >> 3) + 8) * 144 + (lane & 7) * 16);
                    asm volatile("s_waitcnt lgkmcnt(0)" ::: "memory");
                    *(f32x4*)(out + o) = r0 + bv[m][bj][0]; *(f32x4*)(out + o + (size_t)8 * ldc) = r1 + bv[m][bj][1]; } }
    }
};
struct EpiSwiglu {
    static constexpr bool PERM = true, BIAS_LDS = true;
    __device__ __forceinline__ const float* bias_elem(const Unit& u, int i) const { return bias + (size_t)u.e * 2 * dff + u.pl * HALF + (i < HALF ? i : dff + i - HALF); }
    unsigned char* O; const float* bias; int ldc, dff; float limit, alpha; int skip, pad;
    __device__ __forceinline__ void operator()(f32x4 (&acc)[2][2][4][2], const Unit& u, int wr, int wc, int fr, int fq, const PG8_LAS int* lrow) const {
        if (skip) { for (int ai = 0; ai < 2; ++ai) for (int m = 0; m < 4; ++m) asm volatile("" :: "v"(acc[ai][0][m][0]), "v"(acc[ai][0][m][1]), "v"(acc[ai][1][m][0]), "v"(acc[ai][1][m][1])); return; }
        asm volatile("" : "+v"(fr));
        const int col0 = u.pl * HALF + wc * 32 + 8 * fq;
        const PG8_LAS float* bg = (const PG8_LAS float*)(lrow + 3 * BM) + wc * 32 + 8 * fq; const PG8_LAS float* bu = bg + HALF;
        const f32x4 bg0 = *(const PG8_LAS f32x4*)bg, bg1 = *(const PG8_LAS f32x4*)(bg + 4), bu0 = *(const PG8_LAS f32x4*)bu, bu1 = *(const PG8_LAS f32x4*)(bu + 4);
        const float nal2 = -1.4426950408889634f * alpha;
#pragma unroll
        for (int ai = 0; ai < 2; ++ai)
#pragma unroll
            for (int m = 0; m < 4; ++m) { const int r = ai * HALF + wr * 64 + m * 16 + fr; unsigned char* rowp = O + (size_t)(u.srow + r) * ldc + col0;
                const f32x4 gt0 = __builtin_elementwise_min(acc[ai][0][m][0] + bg0, (f32x4){limit, limit, limit, limit}), gt1 = __builtin_elementwise_min(acc[ai][0][m][1] + bg1, (f32x4){limit, limit, limit, limit});
                f32x4 up0 = acc[ai][1][m][0] + bu0, up1 = acc[ai][1][m][1] + bu1, s0, s1;
                const f32x4 a0 = gt0 * nal2, a1 = gt1 * nal2;
#pragma unroll
                for (int j = 0; j < 4; ++j) { up0[j] = __builtin_amdgcn_fmed3f(up0[j], -limit, limit); up1[j] = __builtin_amdgcn_fmed3f(up1[j], -limit, limit);
                    s0[j] = __builtin_amdgcn_exp2f(a0[j]); s1[j] = __builtin_amdgcn_exp2f(a1[j]); }
                s0 = s0 + 1.f; s1 = s1 + 1.f;
#pragma unroll
                for (int j = 0; j < 4; ++j) { s0[j] = __builtin_amdgcn_rcpf(s0[j]); s1[j] = __builtin_amdgcn_rcpf(s1[j]); }
                const f32x4 o0 = (up0 * gt0 + gt0) * s0, o1 = (up1 * gt1 + gt1) * s1;
                int w0 = __builtin_amdgcn_cvt_pk_fp8_f32(o0[0], o0[1], 0, false); w0 = __builtin_amdgcn_cvt_pk_fp8_f32(o0[2], o0[3], w0, true);
                int w1 = __builtin_amdgcn_cvt_pk_fp8_f32(o1[0], o1[1], 0, false); w1 = __builtin_amdgcn_cvt_pk_fp8_f32(o1[2], o1[3], w1, true);
                *(unsigned long long*)rowp = (unsigned long long)(unsigned)w0 | ((unsigned long long)(unsigned)w1 << 32); }
    }
};
struct EpiDown {
    static constexpr bool PERM = true, BIAS_LDS = true;
    __device__ __forceinline__ const float* bias_elem(const Unit& u, int i) const { return bias + (size_t)u.e * ncol + u.pl * BM + i; }
    bf16_t* O; const float* bias; int ldc, ncol, skip, pad;
    __device__ __forceinline__ void operator()(f32x4 (&acc)[2][2][4][2], const Unit& u, int wr, int wc, int fr, int fq, const PG8_LAS int* lrow) const {
        if (skip) { for (int ai = 0; ai < 2; ++ai) for (int m = 0; m < 4; ++m) asm volatile("" :: "v"(acc[ai][0][m][0]), "v"(acc[ai][0][m][1]), "v"(acc[ai][1][m][0]), "v"(acc[ai][1][m][1])); return; }
        asm volatile("" : "+v"(fr));
        const int col0 = u.pl * BM + wc * 64 + 8 * fq;
        const PG8_LAS float* bp = (const PG8_LAS float*)(lrow + 3 * BM) + wc * 64 + 8 * fq;
        f32x4 bv[2][2];
#pragma unroll
        for (int bj = 0; bj < 2; ++bj) { bv[bj][0] = *(const PG8_LAS f32x4*)(bp + bj * 32); bv[bj][1] = *(const PG8_LAS f32x4*)(bp + bj * 32 + 4); }
#pragma unroll
        for (int ai = 0; ai < 2; ++ai)
#pragma unroll
            for (int m = 0; m < 4; ++m) { unsigned char* rowp = (unsigned char*)O + (size_t)(u.srow + ai * HALF + wr * 64 + m * 16 + fr) * ldc + col0;
#pragma unroll
                for (int bj = 0; bj < 2; ++bj) { const f32x4 o0 = acc[ai][bj][m][0] + bv[bj][0], o1 = acc[ai][bj][m][1] + bv[bj][1];
                    int w0 = __builtin_amdgcn_cvt_pk_fp8_f32(o0[0], o0[1], 0, false); w0 = __builtin_amdgcn_cvt_pk_fp8_f32(o0[2], o0[3], w0, true);
                    int w1 = __builtin_amdgcn_cvt_pk_fp8_f32(o1[0], o1[1], 0, false); w1 = __builtin_amdgcn_cvt_pk_fp8_f32(o1[2], o1[3], w1, true);
                    *(unsigned long long*)(rowp + bj * 32) = (unsigned long long)(unsigned)w0 | ((unsigned long long)(unsigned)w1 << 32); } }
    }
};
template <bool GATH> struct GroupedOrderT {
    static constexpr bool GATHER = true, FP8 = true, LINROWS = !GATH;
    const PG8_LAS unsigned char* tile_e; const PG8_LAS int* pref; const PG8_LAS int* cnt; PG8_LAS int* lbuf; const int* list; int nN, G, c, nM, lstride, ashift;
    __device__ __forceinline__ bool next(int i, Unit& u) const {
        const int nwg = nM * nN; const long L = (long)i * G + c; if (L >= nwg) return false;
        int wgid = (int)L; { const int q = nwg / NXCD, r = nwg % NXCD, xcd = wgid % NXCD, off = wgid / NXCD; wgid = (xcd < r ? xcd * (q + 1) : r * (q + 1) + (xcd - r) * q) + off; }
        const int nig = WGM * nN, gid = wgid / nig, fm = gid * WGM, gsz = (nM - fm) < WGM ? (nM - fm) : WGM;
        const int mt = fm + ((wgid % nig) % gsz), pl = (wgid % nig) / gsz;
        const int e = tile_e[mt]; const int mtl = mt - pref[e]; const int left = cnt[e] - 256 * mtl;
        u.pm = mtl; u.pn = e * nN + pl; u.e = e; u.pl = pl; u.rows = left < 256 ? left : 256; u.srow = mt * BM; return true;
    }
    __device__ __forceinline__ const int* list_ptr(const Unit& u) const { return list + (size_t)u.e * lstride + u.pm * BM; }
    __device__ __forceinline__ int list_entry(const Unit& u, int r) const { return list_ptr(u)[r < u.rows ? r : u.rows - 1]; }
    __device__ __forceinline__ void a_ready(const Unit&) const {}
    __device__ __forceinline__ void done(const Unit&) const {}
};
struct DualOrder {
    static constexpr bool GATHER = false, FP8 = false, LINROWS = false;
    static constexpr PG8_LAS int* lbuf = nullptr;
    StaticOrder S; int nper;
    __device__ __forceinline__ void init(int M, int N, int G, int c) { S.init(M, N, G, c); nper = (S.nwg - c + G - 1) / G; if (nper < 0) nper = 0; }
    __device__ __forceinline__ bool next(int i, Unit& u) const { if (i >= 2 * nper) return false; const int e = i >= nper ? 1 : 0; const bool ok = S.next(i - e * nper, u); u.e = e; return ok; }
    __device__ __forceinline__ void a_ready(const Unit&) const {}
    __device__ __forceinline__ void done(const Unit&) const {}
};
}

#define GAS __attribute__((address_space(1)))
#define LAS __attribute__((address_space(3)))
typedef unsigned short bf16;
typedef unsigned v4u __attribute__((ext_vector_type(4)));
typedef float f32x4 __attribute__((ext_vector_type(4)));
typedef short bf16x8 __attribute__((ext_vector_type(8)));
typedef GAS unsigned gu32;
typedef GAS unsigned long long gu64;
#define RLX_AGENT __ATOMIC_RELAXED, __HIP_MEMORY_SCOPE_AGENT
#define LDS_WAIT() asm volatile("s_waitcnt lgkmcnt(0)" ::: "memory")
#define VM_WAIT() asm volatile("s_waitcnt vmcnt(0)" ::: "memory")
__device__ __forceinline__ unsigned long long rt() { return __builtin_amdgcn_s_memrealtime(); }
__device__ __forceinline__ unsigned f2bf(float f) { unsigned u = __builtin_bit_cast(unsigned, f); return (u + 0x7fffu + ((u >> 16) & 1u)) >> 16; }
__device__ __forceinline__ unsigned pk2(float lo, float hi) { return f2bf(lo) | (f2bf(hi) << 16); }

#define XB_TMO      128
#define XB_XCNT(j)  (256  + 64 * (j))
#define XB_XSUB(j)  (1280 + 64 * (j))
#define XB_XGEN(j)  (2304 + 64 * (j))
#define XB_TOP      3328
#define XB_TOPGEN   3392
#define XCD_BAR_WORDS 3456
#define XB_SPIN_CAP (1u << 18)

__device__ __forceinline__ unsigned xb_ld(unsigned* p)              { return __hip_atomic_load(p, __ATOMIC_RELAXED, __HIP_MEMORY_SCOPE_AGENT); }
__device__ __forceinline__ unsigned xb_add(unsigned* p, unsigned v) { return __hip_atomic_fetch_add(p, v, __ATOMIC_RELAXED, __HIP_MEMORY_SCOPE_AGENT); }
__device__ __forceinline__ unsigned xb_xcc_id() { return (unsigned)__builtin_amdgcn_s_getreg((3 << 11) | 20) & 0xFu; }
#define XB_SPIN(cond, bar) do { unsigned _sp = 0; while (cond) { __builtin_amdgcn_s_sleep(1); \
    if ((++_sp & 255u) == 0u) { if (xb_ld(&(bar)[XB_TMO])) break; if (_sp > XB_SPIN_CAP) { atomicAdd(&(bar)[XB_TMO], 1u); break; } } } } while (0)

struct XcdBarrier {
    unsigned* bar; unsigned x;
    volatile LAS unsigned* st;
};

__device__ __forceinline__ XcdBarrier xcd_barrier_post(unsigned* bar, volatile LAS unsigned* st) {
    XcdBarrier b; b.bar = bar; b.x = xb_xcc_id(); b.st = st;
    if (threadIdx.x == 0) (void)xb_add(&bar[XB_XCNT(b.x)], 1u);
    return b;
}
__device__ __forceinline__ void xcd_barrier_complete(unsigned* bar, unsigned x, unsigned& nloc, unsigned& nx) {
    const unsigned G = gridDim.x * gridDim.y * gridDim.z;
    unsigned sum, cnt, mine, sp = 0u;
    for (;;) {
        sum = 0u; cnt = 0u; mine = 0u;
#pragma unroll
        for (unsigned j = 0; j < 16; ++j) { const unsigned c = xb_ld(&bar[XB_XCNT(j)]); sum += c; cnt += (c > 0u) ? 1u : 0u; mine = (j == x) ? c : mine; }
        if (sum == G) break;
        __builtin_amdgcn_s_sleep(1);
        if ((++sp & 255u) == 0u) { if (xb_ld(&bar[XB_TMO])) break; if (sp > XB_SPIN_CAP) { atomicAdd(&bar[XB_TMO], 1u); break; } }
    }
    nloc = mine > 0u ? mine : 1u; nx = cnt > 0u ? cnt : 1u;
}

__device__ __forceinline__ void xcd_barrier(const XcdBarrier& b) {
    asm volatile("s_waitcnt vmcnt(0)" ::: "memory");
    __syncthreads();
    if (threadIdx.x == 0) {
        unsigned* bar = b.bar;
        __builtin_amdgcn_s_waitcnt(0);
        unsigned nloc = b.st[0], nx = b.st[1];
        if (nloc == 0u) { xcd_barrier_complete(bar, b.x, nloc, nx); b.st[0] = nloc; b.st[1] = nx; }
        const unsigned old = xb_add(&bar[XB_XSUB(b.x)], 1u);
        const unsigned gen = old / nloc;
        if (old + 1u == (gen + 1u) * nloc) {
            __builtin_amdgcn_fence(__ATOMIC_RELEASE, "agent");
            asm volatile("s_waitcnt vmcnt(0)" ::: "memory");
            const unsigned og = xb_add(&bar[XB_TOP], 1u);
            const unsigned tg = og / nx;
            if (og + 1u == (tg + 1u) * nx) xb_add(&bar[XB_TOPGEN], 1u);
            else XB_SPIN(xb_ld(&bar[XB_TOPGEN]) == tg, bar);
            __builtin_amdgcn_fence(__ATOMIC_ACQUIRE, "agent");
            xb_add(&bar[XB_XGEN(b.x)], 1u);
            asm volatile("s_waitcnt vmcnt(0)" ::: "memory");
        } else {
            XB_SPIN(xb_ld(&bar[XB_XGEN(b.x)]) == gen, bar);
            __builtin_amdgcn_fence(__ATOMIC_ACQUIRE, "agent");
            asm volatile("s_waitcnt vmcnt(0)" ::: "memory");
        }
    }
    __syncthreads();
}

constexpr size_t MiB = 1u << 20;
constexpr size_t WS_CTL = 0;
constexpr size_t CTL_ZERO_BYTES = 65536;
constexpr size_t WS_WIN = 1 * MiB, WS_WGLU = 10 * MiB, WS_WSSM = 14 * MiB, WS_WATT = 16 * MiB, WS_WOUT = 18 * MiB;
constexpr size_t WS_WGU = 20 * MiB, WS_WDN = 148 * MiB;
constexpr float WSCALE = 64.f; constexpr int WSCALE_E8M0 = 127 - 6;
constexpr size_t WS_ROUTE = 216 * MiB;
constexpr size_t WS_H = 224 * MiB;
constexpr size_t WS_PROJ = 288 * MiB;
constexpr size_t WS_S5OUT = 576 * MiB;
constexpr size_t WS_ATTN = 640 * MiB;
constexpr size_t WS_ACT = 704 * MiB;
constexpr size_t WS_BTAB = 976 * MiB, WS_CTAB = 980 * MiB, WS_KTAB = 984 * MiB, WS_A16 = 985 * MiB;
constexpr size_t WS_END = 986 * MiB;
static_assert(WS_PROJ + (size_t)T * IN_W * 2 <= WS_S5OUT && WS_PROJ + (size_t)MAXROWS * 1024 * 2 <= WS_S5OUT && WS_ACT + (size_t)MAXROWS * 1024 <= WS_BTAB, "ws map");
constexpr int CW_CNT = 0;
constexpr int CW_BAR = 4096;
static_assert((CW_BAR + 3 * XCD_BAR_WORDS) * 4 <= (int)CTL_ZERO_BYTES, "ctl map");
constexpr size_t RT_TOPW = 0, RT_LIST = 1 * MiB, RT_APOS = 5 * MiB;

constexpr int LDS_BYTES = 163840;
constexpr int RING_OFF = 0;
constexpr int MISC_OFF = LDS_BYTES - 256;
constexpr int GT_OFF = 131072;

__device__ __forceinline__ float bf2f(bf16 b) { return __uint_as_float((unsigned)b << 16); }
__device__ __forceinline__ float wave_sum(float v) {
#pragma unroll
    for (int o = 1; o < 64; o <<= 1) v += __shfl_xor(v, o);
    return v;
}
__device__ __forceinline__ float wave_max(float v) {
#pragma unroll
    for (int o = 1; o < 64; o <<= 1) v = fmaxf(v, __shfl_xor(v, o));
    return v;
}
__device__ __forceinline__ float gelu_tanh(float x) { const float z = -2.3022081985f * (x + 0.044715f * x * x * x); return x * __builtin_amdgcn_rcpf(1.f + __builtin_amdgcn_exp2f(z)); }
#define WAVE_SYNC() do { __builtin_amdgcn_wave_barrier(); asm volatile("s_waitcnt lgkmcnt(0)" ::: "memory"); } while (0)

struct Args { const float* in[25]; float* out; unsigned char* ws; int ph_lo, ph_hi, bar_idx, sub; };
struct Ctx { int tid, lane, wave, vcu, G, gw, ngw; LAS unsigned char* lds; };

constexpr int TR_SCR = 64 * 65 * 4;
__device__ __forceinline__ void transpose_item(const float* W, int K, int N, bf16* WT, int mode, LAS float* scr, int item, int lane) {
    const int nblk = N / 64, kb = item / nblk, nb = item % nblk, k0 = 64 * kb, n0 = 64 * nb;
#pragma unroll 4
    for (int i = 0; i < 16; ++i) { const int kk = 4 * i + (lane >> 4), nn = 4 * (lane & 15); const f32x4 w = *(const f32x4*)(W + (size_t)(k0 + kk) * N + n0 + nn);
        LAS float* s = scr + kk * 65 + nn; s[0] = w.x; s[1] = w.y; s[2] = w.z; s[3] = w.w; }
    LDS_WAIT(); asm volatile("" ::: "memory");
    const int c = lane & 7;
#pragma unroll
    for (int j = 0; j < 8; ++j) { const int n = (lane >> 3) + 8 * j; const LAS float* s = scr + (8 * c) * 65 + n;
        v4u o; o.x = pk2(s[0 * 65], s[1 * 65]); o.y = pk2(s[2 * 65], s[3 * 65]); o.z = pk2(s[4 * 65], s[5 * 65]); o.w = pk2(s[6 * 65], s[7 * 65]);
        int r = n0 + n;
        if (mode == 1) { const int nh = N / 2, hf = (r >= nh) ? 1 : 0, np = r - hf * nh; r = 256 * (np / 128) + 64 * ((np % 128) / 32) + 32 * hf + (np % 32); }
        *(v4u*)(WT + (size_t)r * K + k0 + 8 * c) = o; }
    LDS_WAIT(); asm volatile("" ::: "memory");
}
constexpr int TR8_SCR = 128 * 33 * 4;
__device__ __forceinline__ void transpose_item_fp8(const float* W, int K, int N, unsigned char* WT, int mode, float wscale, LAS float* scr, int item, int lane) {
    const int nblk = N / 32, kb = item / nblk, nb = item % nblk, k0 = 128 * kb, n0 = 32 * nb;
#pragma unroll 4
    for (int i = 0; i < 16; ++i) { const int kk = 8 * i + (lane >> 3), nn = 4 * (lane & 7); const f32x4 w = *(const f32x4*)(W + (size_t)(k0 + kk) * N + n0 + nn);
        LAS float* s = scr + kk * 33 + nn; s[0] = w.x; s[1] = w.y; s[2] = w.z; s[3] = w.w; }
    LDS_WAIT(); asm volatile("" ::: "memory");
    int rb = n0;
    if (mode == 1) { const int nh = N / 2, hf = (n0 >= nh) ? 1 : 0, np = n0 - hf * nh; rb = 256 * (np / 128) + 64 * ((np % 128) / 32) + 32 * hf; }
    const int c = lane & 7;
#pragma unroll
    for (int j = 0; j < 4; ++j) { const int n = (lane >> 3) + 8 * j; const LAS float* s = scr + (16 * c) * 33 + n;
        v4u o;
#pragma unroll
        for (int q = 0; q < 4; ++q) { int w = __builtin_amdgcn_cvt_pk_fp8_f32(s[(4 * q) * 33] * wscale, s[(4 * q + 1) * 33] * wscale, 0, false); w = __builtin_amdgcn_cvt_pk_fp8_f32(s[(4 * q + 2) * 33] * wscale, s[(4 * q + 3) * 33] * wscale, w, true); o[q] = (unsigned)w; }
        *(v4u*)(WT + (size_t)(rb + n) * K + k0 + 16 * c) = o; }
    LDS_WAIT(); asm volatile("" ::: "memory");
}
__device__ __forceinline__ void transpose_job_fp8(const Ctx& C, const float* W, unsigned char* WT, int K, int N, int mode, int nmat, float wscale) {
    LAS float* scr = (LAS float*)(C.lds + RING_OFF + C.wave * TR8_SCR);
    const int per = (K / 128) * (N / 32); const int total = per * nmat;
    for (int it = C.gw; it < total; it += C.ngw) { const int mat = it / per, item = it % per;
        transpose_item_fp8(W + (size_t)mat * K * N, K, N, WT + (size_t)mat * K * N, mode, wscale, scr, item, C.lane); }
}
__device__ __forceinline__ void transpose_job(const Ctx& C, const float* W, bf16* WT, int K, int N, int mode, int nmat) {
    LAS float* scr = (LAS float*)(C.lds + RING_OFF + C.wave * TR8_SCR);
    const int per = (K / 64) * (N / 64); const int total = per * nmat;
    for (int it = C.gw; it < total; it += C.ngw) { const int mat = it / per, item = it % per;
        transpose_item(W + (size_t)mat * K * N, K, N, WT + (size_t)mat * K * N, mode, scr, item, C.lane); }
}
__device__ __forceinline__ void rmsnorm_rows(const Ctx& C, const float* x, const float* g, bf16* out) {
    f32x4 gg[4];
#pragma unroll
    for (int j = 0; j < 4; ++j) gg[j] = ((const f32x4*)g)[64 * j + C.lane];
    f32x4 vn[4]; int m = C.gw;
    if (m < T) { const f32x4* xr = (const f32x4*)(x + (size_t)m * DM) + C.lane;
#pragma unroll
        for (int j = 0; j < 4; ++j) vn[j] = xr[64 * j]; }
    for (; m < T; m += C.ngw) {
        f32x4 v[4]; float s = 0.f;
#pragma unroll
        for (int j = 0; j < 4; ++j) { v[j] = vn[j]; s += (v[j].x * v[j].x + v[j].y * v[j].y) + (v[j].z * v[j].z + v[j].w * v[j].w); }
        if (m + C.ngw < T) { const f32x4* xr = (const f32x4*)(x + (size_t)(m + C.ngw) * DM) + C.lane;
#pragma unroll
            for (int j = 0; j < 4; ++j) vn[j] = xr[64 * j]; }
        const float rs = rsqrtf(wave_sum(s) * (1.f / DM) + EPS);
        unsigned long long* o8 = (unsigned long long*)(out + (size_t)m * DM) + C.lane;
#pragma unroll
        for (int j = 0; j < 4; ++j) o8[64 * j] = (unsigned long long)pk2(v[j].x * rs * gg[j].x, v[j].y * rs * gg[j].y) | ((unsigned long long)pk2(v[j].z * rs * gg[j].z, v[j].w * rs * gg[j].w) << 32);
    }
}
typedef short rt_bf16x8 __attribute__((ext_vector_type(8)));
typedef float rt_f32x2 __attribute__((ext_vector_type(2))); typedef __bf16 rt_bf16x2 __attribute__((ext_vector_type(2)));
__device__ __forceinline__ unsigned rt_cvtpk(float lo, float hi) { rt_f32x2 v = {lo, hi}; rt_bf16x2 b = __builtin_convertvector(v, rt_bf16x2); return __builtin_bit_cast(unsigned, b); }
__device__ __forceinline__ void rt_split8(const float (&x)[8], rt_bf16x8& hi, rt_bf16x8& lo) {
    v4u h, l;
#pragma unroll
    for (int i = 0; i < 4; ++i) { const unsigned hb = rt_cvtpk(x[2 * i], x[2 * i + 1]); h[i] = hb;
        const float r0 = x[2 * i] - __uint_as_float(hb << 16), r1 = x[2 * i + 1] - __uint_as_float(hb & 0xffff0000u); l[i] = rt_cvtpk(r0, r1); }
    hi = __builtin_bit_cast(rt_bf16x8, h); lo = __builtin_bit_cast(rt_bf16x8, l);
}
constexpr int HN_PITCH = 1032;
__device__ __forceinline__ void router_pass(const Ctx& C, const float* x1, const float* g2, const float* w_router, const float* b_router, unsigned char* h2, float* top_w, int* list, int* apos, unsigned* ctl) {
    LAS float* HN = (LAS float*)(C.lds + RING_OFF); LAS float* PART = HN + 16 * HN_PITCH; LAS float* LOG = PART + 8 * 16 * 32; LAS unsigned* HIST = (LAS unsigned*)(LOG + 16 * 32); LAS unsigned* BASE = HIST + 32; LAS unsigned* RK = BASE + 32;
    LAS unsigned char* EIDS = (LAS unsigned char*)(RK + 32);
    int tid = C.tid; asm volatile("" : "+v"(tid));
    const int lane = tid & 63, wave = C.wave, fr = lane & 15, fq = lane >> 4;
    rt_bf16x8 bhi[4][2], blo[4][2];
#pragma unroll
    for (int ks = 0; ks < 4; ++ks)
#pragma unroll
        for (int nt = 0; nt < 2; ++nt) { float x[8];
#pragma unroll
            for (int j = 0; j < 8; ++j) x[j] = w_router[(size_t)(128 * wave + 32 * ks + 8 * fq + j) * NE + 16 * nt + fr];
            rt_split8(x, bhi[ks][nt], blo[ks][nt]); }
    const float bias = b_router[tid & 31];
    if (tid < 32) HIST[tid] = 0u;
    __syncthreads();
    int nrounds = 0;
    f32x4 vn[2][4];
    if (C.vcu < T / 16) {
#pragma unroll
        for (int q = 0; q < 2; ++q) { const f32x4* xr = (const f32x4*)(x1 + (size_t)(C.vcu * 16 + 2 * wave + q) * DM) + lane;
#pragma unroll
            for (int j = 0; j < 4; ++j) vn[q][j] = xr[64 * j]; } }
    for (int grp = C.vcu; grp < T / 16; grp += C.G, ++nrounds) {
        f32x4 v[2][4];
#pragma unroll
        for (int q = 0; q < 2; ++q)
#pragma unroll
            for (int j = 0; j < 4; ++j) v[q][j] = vn[q][j];
        if (grp + C.G < T / 16) {
#pragma unroll
            for (int q = 0; q < 2; ++q) { const f32x4* xr = (const f32x4*)(x1 + (size_t)((grp + C.G) * 16 + 2 * wave + q) * DM) + lane;
#pragma unroll
                for (int j = 0; j < 4; ++j) vn[q][j] = xr[64 * j]; } }
#pragma unroll
        for (int q = 0; q < 2; ++q) { const int tl = 2 * wave + q; float s = 0.f;
#pragma unroll
            for (int j = 0; j < 4; ++j) s += (v[q][j].x * v[q][j].x + v[q][j].y * v[q][j].y) + (v[q][j].z * v[q][j].z + v[q][j].w * v[q][j].w);
            const float rs = rsqrtf(wave_sum(s) * (1.f / DM) + EPS);
            int* o4 = (int*)(h2 + (size_t)(grp * 16 + tl) * DM) + lane;
#pragma unroll
            for (int j = 0; j < 4; ++j) { const f32x4 gg = ((const f32x4*)g2)[64 * j + lane];
                const f32x4 y = (f32x4){v[q][j].x * rs * gg.x, v[q][j].y * rs * gg.y, v[q][j].z * rs * gg.z, v[q][j].w * rs * gg.w};
                *(LAS f32x4*)(HN + tl * HN_PITCH + 256 * j + 4 * lane) = y;
                int w = __builtin_amdgcn_cvt_pk_fp8_f32(y.x, y.y, 0, false); w = __builtin_amdgcn_cvt_pk_fp8_f32(y.z, y.w, w, true); o4[64 * j] = w; } }
        __syncthreads();
        { pg8::f32x4 acc0 = {0.f, 0.f, 0.f, 0.f}, acc1 = {0.f, 0.f, 0.f, 0.f};
          const LAS float* hb = HN + fr * HN_PITCH + 128 * wave + 8 * fq;
#pragma unroll
          for (int ks = 0; ks < 4; ++ks) { const f32x4 p0 = *(const LAS f32x4*)(hb + 32 * ks), p1 = *(const LAS f32x4*)(hb + 32 * ks + 4);
              const float x[8] = {p0.x, p0.y, p0.z, p0.w, p1.x, p1.y, p1.z, p1.w}; rt_bf16x8 ahi, alo; rt_split8(x, ahi, alo);
              acc0 = __builtin_amdgcn_mfma_f32_16x16x32_bf16(ahi, bhi[ks][0], acc0, 0, 0, 0); acc1 = __builtin_amdgcn_mfma_f32_16x16x32_bf16(ahi, bhi[ks][1], acc1, 0, 0, 0);
              acc0 = __builtin_amdgcn_mfma_f32_16x16x32_bf16(ahi, blo[ks][0], acc0, 0, 0, 0); acc1 = __builtin_amdgcn_mfma_f32_16x16x32_bf16(ahi, blo[ks][1], acc1, 0, 0, 0);
              acc0 = __builtin_amdgcn_mfma_f32_16x16x32_bf16(alo, bhi[ks][0], acc0, 0, 0, 0); acc1 = __builtin_amdgcn_mfma_f32_16x16x32_bf16(alo, bhi[ks][1], acc1, 0, 0, 0); }
          LAS float* pp = PART + (wave * 16 + 4 * fq) * 32 + fr;
#pragma unroll
          for (int r = 0; r < 4; ++r) { pp[r * 32] = acc0[r]; pp[r * 32 + 16] = acc1[r]; } }
        __syncthreads();
        { float a = bias;
#pragma unroll
          for (int w8 = 0; w8 < 8; ++w8) a += PART[(w8 * 16 + (tid >> 5)) * 32 + (tid & 31)];
          LOG[tid] = a; }
        __syncthreads();
        if (lane < 2) { const int tl = 2 * wave + lane; float lg[32];
#pragma unroll
            for (int i = 0; i < 8; ++i) { const f32x4 t4 = *(const LAS f32x4*)(LOG + tl * 32 + 4 * i); lg[4 * i] = t4.x; lg[4 * i + 1] = t4.y; lg[4 * i + 2] = t4.z; lg[4 * i + 3] = t4.w; }
            float tv[4]; int ti[4];
#pragma unroll
            for (int k = 0; k < 4; ++k) { float mx = lg[0]; int mi = 0;
#pragma unroll
                for (int i = 1; i < 32; ++i) { const bool gt = lg[i] > mx; mx = gt ? lg[i] : mx; mi = gt ? i : mi; }
                tv[k] = mx; ti[k] = mi;
#pragma unroll
                for (int i = 0; i < 32; ++i) lg[i] = (i == mi) ? -INFINITY : lg[i]; }
            const float e1 = __expf(tv[1] - tv[0]), e2 = __expf(tv[2] - tv[0]), e3 = __expf(tv[3] - tv[0]); const float inv = 1.f / (1.f + e1 + e2 + e3);
            *(f32x4*)(top_w + (size_t)(grp * 16 + tl) * 4) = (f32x4){inv, e1 * inv, e2 * inv, e3 * inv};
#pragma unroll
            for (int k = 0; k < 4; ++k) { EIDS[(nrounds * 16 + tl) * 4 + k] = (unsigned char)ti[k]; __hip_atomic_fetch_add(HIST + ti[k], 1u, __ATOMIC_RELAXED, __HIP_MEMORY_SCOPE_WORKGROUP); } }
    }
    __syncthreads();
    if (tid < 32) { BASE[tid] = atomicAdd(ctl + CW_CNT + tid, HIST[tid]); RK[tid] = 0u; }
    __syncthreads();
    for (int idx = tid; idx < nrounds * 64; idx += 512) { const int ei = EIDS[idx]; const unsigned rank = __hip_atomic_fetch_add(RK + ei, 1u, __ATOMIC_RELAXED, __HIP_MEMORY_SCOPE_WORKGROUP);
        const int r = idx >> 6, tl = (idx >> 2) & 15, k = idx & 3, a = ((C.vcu + r * C.G) * 16 + tl) * 4 + k; const int slot = (int)(BASE[ei] + rank); list[(size_t)ei * T + slot] = a; apos[a] = (ei << 20) | slot; }
    __syncthreads();
}
__device__ __forceinline__ int grouped_tables(const Ctx& C, const unsigned* ctl) {
    LAS int* cnt = (LAS int*)(C.lds + GT_OFF); LAS int* pref = cnt + 32; LAS unsigned char* tile_e = (LAS unsigned char*)(pref + 36);
    if (C.wave == 0) {
        const int e = C.lane & 31; const int c = (int)__hip_atomic_load(ctl + CW_CNT + e, RLX_AGENT); const int n = (c + 255) >> 8;
        int incl = n;
#pragma unroll
        for (int o = 1; o < 32; o <<= 1) { const int t = __shfl_up(incl, o, 32); if (e >= o) incl += t; }
        const int start = incl - n;
        if (C.lane < 32) { cnt[e] = c; pref[e] = start; if (e == 31) pref[32] = incl; for (int i = 0; i < n; ++i) tile_e[start + i] = (unsigned char)e; }
    }
    __syncthreads();
    return pref[NE];
}
__device__ __forceinline__ void combine_pass(const Ctx& C, float* out, const unsigned char* ys, const float* top_w, const int* apos) {
    const LAS int* pref = (const LAS int*)(C.lds + GT_OFF) + 32;
    const int lane = C.lane;
    int4 apn[2];
    if (C.gw < T / 2) { apn[0] = *(const int4*)(apos + (size_t)(2 * C.gw) * 4); apn[1] = *(const int4*)(apos + (size_t)(2 * C.gw + 1) * 4); }
    for (int pr = C.gw; pr < T / 2; pr += C.ngw) {
        const int4 ap[2] = {apn[0], apn[1]};
        if (pr + C.ngw < T / 2) { apn[0] = *(const int4*)(apos + (size_t)(2 * (pr + C.ngw)) * 4); apn[1] = *(const int4*)(apos + (size_t)(2 * (pr + C.ngw) + 1) * 4); }
        f32x4 acc[2][4]; v4u yv[2][4]; f32x4 wv4[2];
#pragma unroll
        for (int t = 0; t < 2; ++t) { const int tok = 2 * pr + t;
            const f32x4* o = (const f32x4*)(out + (size_t)tok * DM) + 4 * lane;
#pragma unroll
            for (int j = 0; j < 4; ++j) acc[t][j] = o[j];
            wv4[t] = *(const f32x4*)(top_w + (size_t)tok * 4);
#pragma unroll
            for (int k = 0; k < 4; ++k) { const int p = k == 0 ? ap[t].x : k == 1 ? ap[t].y : k == 2 ? ap[t].z : ap[t].w; const int srow = pref[p >> 20] * 256 + (p & 0xFFFFF);
                yv[t][k] = *(const v4u*)(ys + (size_t)srow * DM + 16 * lane); } }
#pragma unroll
        for (int t = 0; t < 2; ++t) { f32x4* o = (f32x4*)(out + (size_t)(2 * pr + t) * DM) + 4 * lane;
#pragma unroll
            for (int k = 0; k < 4; ++k) { const float wv = wv4[t][k];
#pragma unroll
                for (int j = 0; j < 4; ++j) { const unsigned w = yv[t][k][j];
                    const auto lo2 = __builtin_amdgcn_cvt_pk_f32_fp8((int)w, false), hi2 = __builtin_amdgcn_cvt_pk_f32_fp8((int)w, true);
                    acc[t][j].x += wv * lo2[0]; acc[t][j].y += wv * lo2[1]; acc[t][j].z += wv * hi2[0]; acc[t][j].w += wv * hi2[1]; } }
#pragma unroll
            for (int j = 0; j < 4; ++j) o[j] = acc[t][j]; }
    }
}

namespace att {
using bf16x8 = __attribute__((ext_vector_type(8))) short;
using s16x4 = __attribute__((ext_vector_type(4))) short;
using f32x16 = __attribute__((ext_vector_type(16))) float;
using u32x4 = __attribute__((ext_vector_type(4))) unsigned;
typedef float f32x2_t __attribute__((ext_vector_type(2))); typedef __bf16 bf16x2_t __attribute__((ext_vector_type(2)));
constexpr float LOG2E = 1.4426950408889634f, QSCALE = 0.125f * LOG2E;
constexpr int SLOTB = 8192, NSLOT = 4;
constexpr int L_K = 0, L_V = NSLOT * SLOTB, L_WS = 2 * NSLOT * SLOTB, L_OST = L_WS + 8 * 256, L_BYTES = L_OST + 8 * 4096;
__device__ __forceinline__ int crow(int r, int hi) { return (r & 3) + 8 * (r >> 2) + 4 * hi; }
__device__ __forceinline__ void glds16(const void* gsrc, unsigned lds_dst) { unsigned keep;
    asm volatile("s_mov_b32 %0, m0\n\ts_mov_b32 m0, %2\n\ts_nop 0\n\tglobal_load_lds_dwordx4 %1, off\n\ts_mov_b32 m0, %0" : "=&s"(keep) : "v"(gsrc), "s"(lds_dst) : "memory"); }
__device__ __forceinline__ unsigned cvtpk_s(float lo, float hi) { f32x2_t v = {lo, hi}; bf16x2_t b = __builtin_convertvector(v, bf16x2_t); return __builtin_bit_cast(unsigned, b); }
typedef __attribute__((address_space(3))) const char* lds_cptr;
__device__ __forceinline__ void qkt_half(f32x16& p, lds_cptr kb, const bf16x8* qr) {
    const f32x16 z = f32x16{};
#pragma unroll
    for (int d0 = 0; d0 < 4; ++d0) {
        const bf16x8 b0 = *(const __attribute__((address_space(3))) bf16x8*)(kb + d0 * 2048);
        p = __builtin_amdgcn_mfma_f32_32x32x16_bf16(b0, qr[d0], d0 == 0 ? z : p, 0, 0, 0); }
}
__device__ __forceinline__ void pv_half(f32x16* o, int vb, bf16x8 pa0, bf16x8 pa1) {
#pragma unroll
    for (int d0 = 0; d0 < 2; ++d0) { s16x4 lo[2], hi[2];
#pragma unroll
        for (int ks = 0; ks < 2; ++ks) {
            asm volatile("ds_read_b64_tr_b16 %0,%1 offset:%c2" : "=&v"(lo[ks]) : "v"(vb), "i"(d0 * 4096 + ks * 1024) : "memory");
            asm volatile("ds_read_b64_tr_b16 %0,%1 offset:%c2" : "=&v"(hi[ks]) : "v"(vb), "i"(d0 * 4096 + ks * 1024 + 512) : "memory"); }
        asm volatile("s_waitcnt lgkmcnt(0)" ::: "memory"); __builtin_amdgcn_sched_barrier(0);
#define ATT_PK(k) (bf16x8){lo[k][0], lo[k][1], lo[k][2], lo[k][3], hi[k][0], hi[k][1], hi[k][2], hi[k][3]}
        o[d0] = __builtin_amdgcn_mfma_f32_32x32x16_bf16(pa0, ATT_PK(0), o[d0], 0, 0, 0);
        o[d0] = __builtin_amdgcn_mfma_f32_32x32x16_bf16(pa1, ATT_PK(1), o[d0], 0, 0, 0);
#undef ATT_PK
    }
}
__device__ __forceinline__ void dma_tile(const bf16* proj, int b, int kvh, int ti, unsigned lds0, int wid, int lane) {
    const unsigned slot = (unsigned)((ti + 2) & 3) * SLOTB;
    int kr = 64 * ti + lane; kr = kr < 0 ? 0 : kr;
    int vr = 64 * ti + 16 * (wid & 3) + (lane >> 2); vr = vr < 0 ? 0 : vr;
    const bf16* ksrc = proj + (size_t)(b * SEQ + kr) * IN_W + C_K + kvh * 64 + wid * 8;
    const bf16* vsrc = proj + (size_t)(b * SEQ + vr) * IN_W + C_V + kvh * 64 + (wid >> 2) * 32 + (lane & 3) * 8;
    glds16(ksrc, (unsigned)__builtin_amdgcn_readfirstlane(lds0 + L_K + slot + wid * 1024));
    glds16(vsrc, (unsigned)__builtin_amdgcn_readfirstlane(lds0 + L_V + slot + wid * 1024));
}
#define ATT_WAIT_BAR() asm volatile("s_waitcnt vmcnt(0) lgkmcnt(0)\n\ts_barrier" ::: "memory")
__device__ __forceinline__ void attn_run(int b, int kvh, int qb0, int nqb, const bf16* proj, const float* sinks, bf16* O, LAS unsigned char* shm) {
    const int tid = threadIdx.x, lane = tid & 63, r32 = lane & 31, hi = lane >> 5; const int wid = __builtin_amdgcn_readfirstlane(tid >> 6);
    const int h = kvh * 4 + (wid & 3), sub = wid >> 2;
    const unsigned lds0 = (unsigned)(uintptr_t)shm;
    LAS float* wsf = (LAS float*)(shm + L_WS) + wid * 64;
    const lds_cptr shm3 = (lds_cptr)shm;
    const int vb0 = (int)(lds0 + L_V) + ((lane >> 4) & 1) * 32 + (lane & 3) * 8 + (4 * hi + ((lane & 15) >> 2)) * 64;
    const float slope2 = exp2f(-0.5f * (float)(h + 1)) * LOG2E, sink2 = sinks[h] * LOG2E;
    dma_tile(proj, b, kvh, qb0 - 2, lds0, wid, lane); dma_tile(proj, b, kvh, qb0 - 1, lds0, wid, lane); dma_tile(proj, b, kvh, qb0, lds0, wid, lane);
    const bf16* Qw = proj + (size_t)(b * SEQ + qb0 * 64 + 32 * sub + r32) * IN_W + C_Q + h * 64 + hi * 8;
    bf16x8 qn[4];
#pragma unroll
    for (int d0 = 0; d0 < 4; ++d0) qn[d0] = *(const bf16x8*)(Qw + d0 * 16);
    for (int qi = 0; qi < nqb; ++qi) {
        const int qb = qb0 + qi, tq0 = qb * 64 + 32 * sub;
        bf16x8 qr[4];
#pragma unroll
        for (int d0 = 0; d0 < 4; ++d0) qr[d0] = qn[d0];
        ATT_WAIT_BAR();
        if (qi + 1 < nqb) dma_tile(proj, b, kvh, qb + 1, lds0, wid, lane);
        f32x16 p[5];
#pragma unroll
        for (int i = 0; i < 5; ++i) { const int g = i + sub; qkt_half(p[i], shm3 + L_K + ((qb + (g >> 1)) & 3) * SLOTB + (g & 1) * 512 + hi * 1024 + r32 * 16, qr); }
        if (qi + 1 < nqb) {
#pragma unroll
            for (int d0 = 0; d0 < 4; ++d0) qn[d0] = *(const bf16x8*)(Qw + (size_t)(64 * (qi + 1)) * IN_W + d0 * 16); }
        float dbase = (float)(128 + r32 - 4 * hi); asm volatile("" : "+v"(dbase));
        const float dmax = (float)(tq0 + r32);
#pragma unroll
        for (int i = 0; i < 5; ++i)
#pragma unroll
            for (int r = 0; r < 16; ++r) { const float d = dbase - (float)(32 * i + (r & 3) + 8 * (r >> 2));
                float v = p[i][r] - slope2 * d;
                if (i == 0) v = (d < 128.f) ? v : -INFINITY;
                if (i == 4) v = (d >= 0.f) ? v : -INFINITY;
                p[i][r] = v; }
        if (qb < 2) {
#pragma unroll
            for (int i = 0; i < 5; ++i)
#pragma unroll
                for (int r = 0; r < 16; ++r) { const float d = dbase - (float)(32 * i + (r & 3) + 8 * (r >> 2)); p[i][r] = (d <= dmax) ? p[i][r] : -INFINITY; } }
        float mx = -INFINITY;
#pragma unroll
        for (int i = 0; i < 5; ++i)
#pragma unroll
            for (int r = 0; r < 16; ++r) mx = fmaxf(mx, p[i][r]);
        { auto rr = __builtin_amdgcn_permlane32_swap(__float_as_uint(mx), __float_as_uint(mx), false, false); mx = fmaxf(__uint_as_float(rr[0]), __uint_as_float(rr[1])); }
        mx = fmaxf(mx, sink2);
        float ls = 0.f;
        f32x16 o[2]; o[0] = f32x16{}; o[1] = f32x16{};
#pragma unroll
        for (int i = 0; i < 5; ++i) { const int g = i + sub;
#pragma unroll
            for (int r = 0; r < 16; ++r) { const float e = __builtin_amdgcn_exp2f(p[i][r] - mx); p[i][r] = e; ls += e; }
            u32x4 pw0, pw1;
#define ATT_PKW(P, B) cvtpk_s(P[B], P[B + 1])
            pw0 = (u32x4){ATT_PKW(p[i], 0), ATT_PKW(p[i], 2), ATT_PKW(p[i], 4), ATT_PKW(p[i], 6)}; pw1 = (u32x4){ATT_PKW(p[i], 8), ATT_PKW(p[i], 10), ATT_PKW(p[i], 12), ATT_PKW(p[i], 14)};
#undef ATT_PKW
            __builtin_amdgcn_sched_barrier(0);
            pv_half(o, vb0 + ((qb + (g >> 1)) & 3) * SLOTB + (g & 1) * 2048, __builtin_bit_cast(bf16x8, pw0), __builtin_bit_cast(bf16x8, pw1));
        }
        { auto rr = __builtin_amdgcn_permlane32_swap(__float_as_uint(ls), __float_as_uint(ls), false, false); ls = __uint_as_float(rr[0]) + __uint_as_float(rr[1]); }
        ls += __builtin_amdgcn_exp2f(sink2 - mx);
        if (hi == 0) wsf[32 + r32] = ls;
        asm volatile("s_waitcnt lgkmcnt(0)" ::: "memory");
        float rli[16];
#pragma unroll
        for (int r = 0; r < 16; ++r) rli[r] = __builtin_amdgcn_rcpf(wsf[32 + crow(r, hi)]);
        bf16* Ow = O + (size_t)(b * SEQ + tq0) * 1024 + h * 64;
        { LAS bf16* stg = (LAS bf16*)(shm + L_OST) + wid * 2048;
#pragma unroll
            for (int r = 0; r < 16; ++r) { const int orow = crow(r, hi);
#pragma unroll
                for (int d0 = 0; d0 < 2; ++d0) stg[orow * 64 + d0 * 32 + r32] = (bf16)f2bf(o[d0][r] * rli[r]); }
            asm volatile("s_waitcnt lgkmcnt(0)" ::: "memory");
#pragma unroll
            for (int i = 0; i < 4; ++i) { const int row = i * 8 + (lane >> 3), ch = lane & 7; const u32x4 v = *(const LAS u32x4*)(stg + row * 64 + ch * 8); *(u32x4*)(Ow + (size_t)row * 1024 + ch * 8) = v; } }
    }
    ATT_WAIT_BAR();
}
#undef ATT_WAIT_BAR
}

namespace s5 {
using bf16x8 = __attribute__((ext_vector_type(8))) short;
using f32x16 = __attribute__((ext_vector_type(16))) float;
struct cf { float re, im; };
__device__ __forceinline__ cf cmul(cf a, cf b) { return cf{a.re * b.re - a.im * b.im, a.re * b.im + a.im * b.re}; }
__device__ __forceinline__ cf cfma(cf a, cf b, cf c) { return cf{c.re + a.re * b.re - a.im * b.im, c.im + a.re * b.im + a.im * b.re}; }
__device__ __forceinline__ int crow(int r, int hi) { return (r & 3) + 8 * (r >> 2) + 4 * hi; }
__device__ __forceinline__ bf16x8 ldg16(const bf16* ubase, unsigned lane_off) { return *(const bf16x8*)((const char*)ubase + lane_off); }
constexpr size_t BT_G = 128 * 256, KT_G = 16 * 16 * 16, CT_G = 256 * 128;
constexpr int IMG_STRIDE = 136;
constexpr int L_IMG = 0, L_T = 8 * 32 * IMG_STRIDE * 2, L_BYTES = L_T + 8 * 2 * 2 * 32 * 4;

__device__ __forceinline__ void build_tables(int g, int part, const float* a_re, const float* a_im, const float* log_dt, const float* b_re, const float* b_im, const float* c_re, const float* c_im, const float* d_skip,
                                             bf16* Btab, bf16* Ktab, bf16* Ctab, float* A16tab, LAS unsigned char* scr, int tid) {
    LAS double* LA = (LAS double*)scr; LAS double* TH = LA + 64;
    LAS float* bbr = (LAS float*)(scr + 1024); LAS float* bbi = bbr + 1024;
    LAS float* pwr = bbi + 1024; LAS float* pwi = pwr + 17 * 64;
    LAS float* ccr = pwi + 17 * 64; LAS float* cci = ccr + 1024;
    for (int e = tid; e < 1024; e += 512) { ccr[e] = c_re[(size_t)g * 1024 + e]; cci[e] = c_im[(size_t)g * 1024 + e]; }
    if (tid < 64) { const int i = g * NP + tid;
        const double dt = exp((double)log_dt[g]), are = a_re[i], aim = a_im[i];
        const double la = are * dt, th = aim * dt, mag = exp(la), abr = mag * cos(th), abi = mag * sin(th), den = are * are + aim * aim, em1 = abr - 1.0;
        const double qre = (em1 * are + abi * aim) / den, qim = (abi * are - em1 * aim) / den;
        LA[tid] = la; TH[tid] = th;
        for (int h = 0; h < GCH; ++h) { const double br = b_re[i * GCH + h], bi = b_im[i * GCH + h]; bbr[tid * 16 + h] = (float)(qre * br - qim * bi); bbi[tid * 16 + h] = (float)(qre * bi + qim * br); } }
    __syncthreads();
    for (int e = tid; e < 17 * 64; e += 512) { const int n = e >> 6, p = e & 63; const double m = exp((double)n * LA[p]), t = (double)n * TH[p]; pwr[e] = (float)(m * cos(t)); pwi[e] = (float)(m * sin(t)); }
    __syncthreads();
    if (part == 0 && tid < 64) { A16tab[(g * 64 + tid) * 2] = pwr[16 * 64 + tid]; A16tab[(g * 64 + tid) * 2 + 1] = pwi[16 * 64 + tid]; }
    for (int e = tid; e < 32 * 256; e += 512) { const int pl = e >> 8, k = e & 255, j = k >> 4, hp = k & 15, pp = 32 * part + pl, p = pp & 63;
        const float wr = pwr[(15 - j) * 64 + p], wi = pwi[(15 - j) * 64 + p], br = bbr[p * 16 + hp], bi = bbi[p * 16 + hp];
        const float v = (pp < 64) ? (wr * br - wi * bi) : (wr * bi + wi * br);
        Btab[(size_t)g * BT_G + (size_t)pp * 256 + k] = (bf16)f2bf(v); }
    for (int e = tid; e < 64 * 128; e += 512) { const int nl = e >> 7, pp = e & 127, n = 64 * part + nl, i = n >> 4, h = n & 15, p = pp & 63;
        const float cr = ccr[h * NP + p], ci = cci[h * NP + p], wr = pwr[(i + 1) * 64 + p], wi = pwi[(i + 1) * 64 + p];
        const float v = (pp < 64) ? (cr * wr - ci * wi) : -(cr * wi + ci * wr);
        Ctab[(size_t)g * CT_G + (size_t)n * 128 + pp] = (bf16)f2bf(v); }
    for (int e = tid; e < 4 * 256; e += 512) { const int d = 4 * part + (e >> 8), h = (e >> 4) & 15, hp = e & 15; float acc = 0.f;
#pragma unroll 8
        for (int p = 0; p < 64; ++p) { const float cr = ccr[h * NP + p], ci = cci[h * NP + p], wr = pwr[d * 64 + p], wi = pwi[d * 64 + p], br = bbr[p * 16 + hp], bi = bbi[p * 16 + hp];
            const float tr = wr * br - wi * bi, ti = wr * bi + wi * br; acc += cr * tr - ci * ti; }
        if (d == 0 && h == hp) acc += d_skip[g * 16 + h];
        Ktab[(size_t)g * KT_G + (size_t)(d * 16 + h) * 16 + hp] = (bf16)f2bf(acc); }
    __syncthreads();
}

__device__ __forceinline__ void scan_local(f32x16& re, f32x16& im, const cf p1, const cf p4, const int hi, cf (&em)[4], cf& T) {
#pragma unroll
    for (int q = 0; q < 4; ++q)
#pragma unroll
        for (int k = 1; k < 4; ++k) { const int r = 4 * q + k; const cf v = cfma(p1, cf{re[r - 1], im[r - 1]}, cf{re[r], im[r]}); re[r] = v.re; im[r] = v.im; }
    cf E = cf{0.f, 0.f};
#pragma unroll
    for (int q = 0; q < 4; ++q) {
        auto sr = __builtin_amdgcn_permlane32_swap(__float_as_uint(re[4 * q + 3]), __float_as_uint(re[4 * q + 3]), false, false);
        auto si = __builtin_amdgcn_permlane32_swap(__float_as_uint(im[4 * q + 3]), __float_as_uint(im[4 * q + 3]), false, false);
        const cf elo = cf{__uint_as_float(sr[0]), __uint_as_float(si[0])}, ehi = cf{__uint_as_float(sr[1]), __uint_as_float(si[1])};
        const cf Elo = E; E = cfma(p4, E, elo); const cf Ehi = E; E = cfma(p4, E, ehi);
        em[q] = hi ? Ehi : Elo; }
    T = E;
}
__device__ __forceinline__ void scan_finish(f32x16& re, f32x16& im, const cf p1, const cf p2, const cf p3, const cf p4, const cf g2, const int hi, const cf (&em)[4], const cf X) {
    cf cur = hi ? p4 : cf{1.f, 0.f};
#pragma unroll
    for (int q = 0; q < 4; ++q) { const cf carry = cfma(cur, X, em[q]); cur = cmul(cur, g2);
        cf v;
        v = cfma(p1, carry, cf{re[4 * q + 0], im[4 * q + 0]}); re[4 * q + 0] = v.re; im[4 * q + 0] = v.im;
        v = cfma(p2, carry, cf{re[4 * q + 1], im[4 * q + 1]}); re[4 * q + 1] = v.re; im[4 * q + 1] = v.im;
        v = cfma(p3, carry, cf{re[4 * q + 2], im[4 * q + 2]}); re[4 * q + 2] = v.re; im[4 * q + 2] = v.im;
        v = cfma(p4, carry, cf{re[4 * q + 3], im[4 * q + 3]}); re[4 * q + 3] = v.re; im[4 * q + 3] = v.im; }
}

__device__ __forceinline__ void glds16(const void* gsrc, unsigned lds_dst) { unsigned keep;
    asm volatile("s_mov_b32 %0, m0\n\ts_mov_b32 m0, %2\n\ts_nop 0\n\tglobal_load_lds_dwordx4 %1, off\n\ts_mov_b32 m0, %0" : "=&s"(keep) : "v"(gsrc), "s"(lds_dst) : "memory"); }
constexpr int L_TAB = 0, L_TABK = 65536, L_IMG2 = 73728, L_T2 = L_IMG2 + 8 * 32 * IMG_STRIDE * 2, L_BYTES2 = L_T2 + 4096;

__device__ __forceinline__ void s5_unit(int b, int g, const bf16* proj, const bf16* Btab, const bf16* Ktab, const bf16* Ctab, const float* A16tab, bf16* out, LAS unsigned char* shm) {
    int tid = threadIdx.x; asm volatile("" : "+v"(tid));
    const int lane = tid & 63, col = lane & 31, hi = lane >> 5; const int wid = __builtin_amdgcn_readfirstlane(tid >> 6);
    const unsigned lds0 = (unsigned)(uintptr_t)shm;
    { const char* src = (const char*)(Btab + (size_t)g * BT_G);
#pragma unroll
      for (int i = 0; i < 8; ++i) { const int p = wid * 8 + i, row = 2 * p + (lane >> 5), c = (lane & 31) ^ (row & 31);
          glds16(src + row * 512 + c * 16, (unsigned)__builtin_amdgcn_readfirstlane(lds0 + L_TAB + p * 1024)); } }
    const bf16* ub = proj + ((size_t)g * T + (size_t)(b * SEQ + 512 * wid)) * 16;
    const unsigned uoff = (unsigned)(col * 512 + hi * 16);
    bf16x8 ua[16];
#pragma unroll
    for (int j = 0; j < 16; ++j) ua[j] = ldg16(ub + (size_t)j * 16, uoff);
    asm volatile("s_waitcnt vmcnt(0)" ::: "memory"); __syncthreads();
    const LAS unsigned char* tb = shm + L_TAB; const unsigned a0 = (unsigned)(col * 512) | (unsigned)(((hi * 16) ^ (col * 16)));
    f32x16 zt[4];
#pragma unroll
    for (int nt = 0; nt < 4; ++nt) zt[nt] = f32x16{};
#pragma unroll
    for (int j = 0; j < 16; ++j) { const bf16x8 uj = ua[j]; const unsigned aj = a0 ^ (unsigned)(j * 32);
#pragma unroll
        for (int nt = 0; nt < 4; ++nt) { const bf16x8 bfr = *(const LAS bf16x8*)(tb + aj + nt * 16384); zt[nt] = __builtin_amdgcn_mfma_f32_32x32x16_bf16(uj, bfr, zt[nt], 0, 0, 0); } }
    LAS float* Tb = (LAS float*)(shm + L_T2);
    LAS bf16* img = (LAS bf16*)(shm + L_IMG2) + wid * 32 * IMG_STRIDE;
    {
        cf P1[2], P2[2], P3[2], P4[2], G2[2], EM[2][4], TT[2];
#pragma unroll
        for (int s = 0; s < 2; ++s) { const float2 a = ((const float2*)A16tab)[g * 64 + 32 * s + col]; P1[s] = cf{a.x, a.y}; P2[s] = cmul(P1[s], P1[s]); P3[s] = cmul(P2[s], P1[s]); P4[s] = cmul(P2[s], P2[s]); G2[s] = cmul(P4[s], P4[s]); }
        scan_local(zt[0], zt[2], P1[0], P4[0], hi, EM[0], TT[0]);
        scan_local(zt[1], zt[3], P1[1], P4[1], hi, EM[1], TT[1]);
        if (hi == 0) {
#pragma unroll
            for (int s = 0; s < 2; ++s) { Tb[((wid * 2 + s) * 2 + 0) * 32 + col] = TT[s].re; Tb[((wid * 2 + s) * 2 + 1) * 32 + col] = TT[s].im; } }
        asm volatile("s_waitcnt lgkmcnt(0)" ::: "memory"); __syncthreads();
        { const char* src = (const char*)(Ctab + (size_t)g * CT_G);
#pragma unroll
          for (int i = 0; i < 8; ++i) { const int p = wid * 8 + i, row = 4 * p + (lane >> 4), c = (lane & 15) ^ (row & 15);
              glds16(src + row * 256 + c * 16, (unsigned)__builtin_amdgcn_readfirstlane(lds0 + L_TAB + p * 1024)); }
          glds16((const char*)(Ktab + (size_t)g * KT_G) + wid * 1024 + lane * 16, (unsigned)__builtin_amdgcn_readfirstlane(lds0 + L_TABK + wid * 1024)); }
#pragma unroll
        for (int j = 0; j < 16; ++j) ua[j] = ldg16(ub + (size_t)j * 16, uoff);
#pragma unroll
        for (int s = 0; s < 2; ++s) {
            const cf g4 = cmul(G2[s], G2[s]), g8 = cmul(g4, g4);
            cf X = cf{0.f, 0.f};
            for (int v = 0; v < wid; ++v) X = cfma(g8, X, cf{Tb[((v * 2 + s) * 2 + 0) * 32 + col], Tb[((v * 2 + s) * 2 + 1) * 32 + col]});
            scan_finish(zt[s], zt[2 + s], P1[s], P2[s], P3[s], P4[s], G2[s], hi, EM[s], X);
            if (hi == 0) { img[32 * s + col] = (bf16)f2bf(X.re); img[64 + 32 * s + col] = (bf16)f2bf(X.im); }
#pragma unroll
            for (int r = 0; r < 16; ++r) { const int row = crow(r, hi) + 1;
                if (row < 32) { img[row * IMG_STRIDE + 32 * s + col] = (bf16)f2bf(zt[s][r]); img[row * IMG_STRIDE + 64 + 32 * s + col] = (bf16)f2bf(zt[2 + s][r]); } }
        }
    }
    asm volatile("s_waitcnt vmcnt(0) lgkmcnt(0)" ::: "memory"); __syncthreads();
    bf16x8 sa[8];
#pragma unroll
    for (int ks = 0; ks < 8; ++ks) sa[ks] = *(const LAS bf16x8*)(img + col * IMG_STRIDE + 16 * ks + 8 * hi);
    asm volatile("s_waitcnt lgkmcnt(0)" ::: "memory"); __builtin_amdgcn_wave_barrier();
    const int ih = col >> 4, h = col & 15;
    const LAS unsigned char* kb = shm + L_TABK + ih * 512 + h * 32 + hi * 16;
    const unsigned c0 = (unsigned)(col * 256) | (unsigned)((hi * 16) ^ ((col & 15) * 16));
    LAS bf16* stg = img;
    bf16* og = out + ((size_t)g * T + (size_t)(b * SEQ + 512 * wid)) * 16;
#pragma unroll
    for (int ps = 0; ps < 2; ++ps) {
        f32x16 acc[4];
#pragma unroll
        for (int n = 0; n < 4; ++n) acc[n] = f32x16{};
#pragma unroll
        for (int j = 0; j < 8 * ps + 8; ++j) { const bf16x8 uj = ua[j];
#pragma unroll
            for (int n = 0; n < 4; ++n) { const int nt = 4 * ps + n;
                if (j <= 2 * nt + 1) {
                    bf16x8 kf;
                    if (j == 2 * nt + 1) { kf = *(const LAS bf16x8*)(shm + L_TABK + h * 32 + hi * 16); if (ih == 0) kf = bf16x8{}; }
                    else kf = *(const LAS bf16x8*)(kb + (2 * nt - j) * 512);
                    acc[n] = __builtin_amdgcn_mfma_f32_32x32x16_bf16(uj, kf, acc[n], 0, 0, 0); } } }
#pragma unroll
        for (int ks = 0; ks < 8; ++ks) { const unsigned ck = c0 ^ (unsigned)(ks * 32);
#pragma unroll
            for (int n = 0; n < 4; ++n) { const bf16x8 cfr = *(const LAS bf16x8*)(tb + ck + (4 * ps + n) * 8192); acc[n] = __builtin_amdgcn_mfma_f32_32x32x16_bf16(sa[ks], cfr, acc[n], 0, 0, 0); } }
#pragma unroll
        for (int n = 0; n < 4; ++n) {
            const f32x16 x = acc[n], x2 = x * x, z = (x2 * (0.044715f * -2.3022081985f) + -2.3022081985f) * x; f32x16 sg;
#pragma unroll
            for (int r = 0; r < 16; ++r) sg[r] = __builtin_amdgcn_exp2f(z[r]);
            sg = sg + 1.f;
#pragma unroll
            for (int r = 0; r < 16; ++r) sg[r] = __builtin_amdgcn_rcpf(sg[r]);
            const f32x16 y = x * sg;
#pragma unroll
            for (int r = 0; r < 16; r += 2) { const unsigned w = rt_cvtpk(y[r], y[r + 1]); stg[(crow(r, hi) * 8 + 2 * n + ih) * 16 + h] = (bf16)(w & 0xffffu); stg[(crow(r + 1, hi) * 8 + 2 * n + ih) * 16 + h] = (bf16)(w >> 16); } }
        asm volatile("s_waitcnt lgkmcnt(0)" ::: "memory"); __builtin_amdgcn_wave_barrier();
#pragma unroll
        for (int q = 0; q < 8; ++q) { const int pc = q * 64 + lane, chunk = pc >> 4, il = (pc >> 1) & 7, hf = pc & 1;
            const v4u v = *(const LAS v4u*)(stg + (chunk * 8 + il) * 16 + hf * 8);
            *(v4u*)(og + (size_t)(16 * chunk + 8 * ps + il) * 16 + hf * 8) = v; }
        asm volatile("s_waitcnt lgkmcnt(0)" ::: "memory"); __builtin_amdgcn_wave_barrier();
    }
    __syncthreads();
}
}

constexpr int NPH = 10;
__global__ void __launch_bounds__(512, 2) mk_fwd(Args args) {
    extern __shared__ __attribute__((aligned(16))) unsigned char lds_raw[];
    Ctx C; C.lds = (LAS unsigned char*)lds_raw; C.tid = threadIdx.x; C.lane = C.tid & 63; C.wave = __builtin_amdgcn_readfirstlane(C.tid >> 6);
    C.G = gridDim.x; { const int bx = blockIdx.x; C.vcu = (C.G % 8 == 0) ? (bx % 8) * (C.G / 8) + bx / 8 : bx; }
    C.gw = C.vcu * 8 + C.wave; C.ngw = C.G * 8;
    volatile LAS unsigned* MISC = (volatile LAS unsigned*)(C.lds + MISC_OFF);
    if (C.tid < 64) MISC[C.tid] = 0u;
    __syncthreads();
    unsigned char* ws = args.ws; unsigned* ctl = (unsigned*)(ws + WS_CTL);
    const int lo = args.ph_lo, hi = args.ph_hi;
    XcdBarrier bar; bar.bar = ctl + CW_BAR + args.bar_idx * XCD_BAR_WORDS; bar.x = 0; bar.st = nullptr;
    if (hi - lo > 1) bar = xcd_barrier_post(ctl + CW_BAR + args.bar_idx * XCD_BAR_WORDS, MISC + 8);
#define IN(k) (lo <= (k) && (k) < hi)
#define SEAM(k) do { if (IN(k) && IN((k) + 1)) { xcd_barrier(bar); if (args.sub & 8) xcd_barrier(bar); } } while (0)
    const float* x = args.in[0]; float* out = args.out;
    bf16* WIN = (bf16*)(ws + WS_WIN); bf16* WGLU = (bf16*)(ws + WS_WGLU); bf16* WSSM = (bf16*)(ws + WS_WSSM); bf16* WATT = (bf16*)(ws + WS_WATT); bf16* WOUT = (bf16*)(ws + WS_WOUT);
    bf16* WGU = (bf16*)(ws + WS_WGU); bf16* WDN = (bf16*)(ws + WS_WDN); bf16* BTAB = (bf16*)(ws + WS_BTAB); bf16* CTAB = (bf16*)(ws + WS_CTAB); bf16* KTAB = (bf16*)(ws + WS_KTAB); float* A16TAB = (float*)(ws + WS_A16);
    bf16* H = (bf16*)(ws + WS_H); bf16* PROJ = (bf16*)(ws + WS_PROJ); bf16* S5OUT = (bf16*)(ws + WS_S5OUT); bf16* ATTN = (bf16*)(ws + WS_ATTN);
    bf16* GLU = H; bf16* MIXED = S5OUT; bf16* H2 = ATTN; bf16* YS = PROJ; bf16* ACT = (bf16*)(ws + WS_ACT);
    bf16* UGM = (bf16*)(ws + WS_ACT);
    float* top_w = (float*)(ws + WS_ROUTE + RT_TOPW); int* list = (int*)(ws + WS_ROUTE + RT_LIST); int* apos = (int*)(ws + WS_ROUTE + RT_APOS);
    LAS unsigned char* ring = C.lds + RING_OFF;

    if (IN(0)) {
        for (int blk = C.vcu; blk < NG * 4; blk += C.G) s5::build_tables(blk >> 2, blk & 3, args.in[3], args.in[4], args.in[5], args.in[6], args.in[7], args.in[8], args.in[9], args.in[10], BTAB, KTAB, CTAB, A16TAB, ring, C.tid);
        transpose_job(C, args.in[2], WIN, DM, IN_W, 0, 1);
        transpose_job(C, args.in[11], WGLU, 1024, 2048, 1, 1);
        transpose_job(C, args.in[12], WSSM, 1024, 1024, 0, 1);
        transpose_job(C, args.in[16], WATT, 1024, 1024, 0, 1);
        transpose_job(C, args.in[17], WOUT, 1024, 1024, 0, 1);
        transpose_job_fp8(C, args.in[21], (unsigned char*)WGU, 1024, 2048, 1, NE, WSCALE);
        transpose_job_fp8(C, args.in[23], (unsigned char*)WDN, 1024, 1024, 0, NE, WSCALE);
        rmsnorm_rows(C, x, args.in[1], H);
        __syncthreads();
    }
    SEAM(0);
    if (IN(1)) { pg8::Gemm g{}; g.A = H; g.Bt = WIN; g.M = T; g.N = IN_W; g.K = DM; pg8::StaticOrder S; S.init(T, IN_W, C.G, (int)blockIdx.x);
        pg8::EpiProj e{}; e.O = PROJ; e.ldc = IN_W; e.qg = args.in[13]; e.kg = args.in[14]; e.qscale = att::QSCALE; e.nostore = (args.sub >> 2) & 3; e.U = UGM; e.urows = T; e.stage = C.lds + GT_OFF + 8192; pg8::gemm_phase<pg8::EpiProj, pg8::StaticOrder>(ring, g, S, e); }
    SEAM(1);
    if (IN(2)) {
        if (args.sub & 1) for (int uu = C.vcu; uu < BATCH * NG / 2; uu += C.G) for (int i = 0; i < 2; ++i) { const int unit = 2 * uu + i; s5::s5_unit(unit & 7, unit >> 3, UGM, BTAB, KTAB, CTAB, A16TAB, S5OUT, ring); }
        if (args.sub & 2) for (int run = C.vcu; run < BATCH * NKVH * 8; run += C.G) att::attn_run(run >> 5, (run >> 3) & 3, (run & 7) * 8, 8, PROJ, args.in[15], ATTN, ring);
        __syncthreads();
    }
    SEAM(2);
    if (IN(3)) { pg8::Gemm g{}; g.A = S5OUT; g.Bt = WGLU; g.M = T; g.N = 2048; g.K = 1024; g.agm = 1; pg8::StaticOrder S; S.init(T, 2048, C.G, (int)blockIdx.x);
        pg8::EpiGlu e{}; e.O = GLU; e.ldc = 1024; pg8::gemm_phase<pg8::EpiGlu, pg8::StaticOrder>(ring, g, S, e); }
    SEAM(3);
    if (IN(4)) { pg8::Gemm g{}; g.A = GLU; g.Bt = WSSM; g.A2 = ATTN; g.Bt2 = WATT; g.M = T; g.N = 1024; g.K = 1024; pg8::DualOrder S; S.init(T, 1024, C.G, (int)blockIdx.x);
        pg8::EpiGate e{}; e.O = MIXED; e.ldc = 1024; e.G = PROJ; e.ldg = IN_W; e.gcol0 = C_GS; e.gcol1 = C_GA; e.stage = C.lds + GT_OFF + 8192; pg8::gemm_phase<pg8::EpiGate, pg8::DualOrder>(ring, g, S, e); }
    SEAM(4);
    if (IN(5)) { pg8::Gemm g{}; g.A = MIXED; g.Bt = WOUT; g.M = T; g.N = 1024; g.K = 1024; pg8::StaticOrder S; S.init(T, 1024, C.G, (int)blockIdx.x);
        pg8::EpiResid e{}; e.base = x; e.out = out; e.ldc = 1024; e.stage = C.lds + GT_OFF + 8192; pg8::gemm_phase<pg8::EpiResid, pg8::StaticOrder>(ring, g, S, e); }
    SEAM(5);
    if (IN(6)) { router_pass(C, out, args.in[18], args.in[19], args.in[20], (unsigned char*)H2, top_w, list, apos, ctl); }
    SEAM(6);
    if (IN(7)) { const int nM = grouped_tables(C, ctl);
        pg8::Gemm g{}; g.A = H2; g.Bt = WGU; g.M = NA; g.N = 2048; g.K = 1024; g.scaleA = 0x7f7f7f7f; g.scaleB = WSCALE_E8M0 * 0x01010101;
        pg8::GroupedOrderT<true> S; S.cnt = (const LAS int*)(C.lds + GT_OFF); S.pref = S.cnt + 32; S.tile_e = (const LAS unsigned char*)(S.pref + 36); S.lbuf = (LAS int*)(C.lds + GT_OFF + 2048); S.list = list; S.nN = 8; S.G = C.G; S.c = (int)blockIdx.x; S.nM = nM; S.lstride = T; S.ashift = 2;
        pg8::EpiSwiglu e{}; e.O = (unsigned char*)ACT; e.ldc = 1024; e.bias = args.in[22]; e.dff = DFF; e.limit = 7.0f; e.alpha = 1.702f; e.skip = (args.sub >> 4) & 1;
        pg8::gemm_phase<pg8::EpiSwiglu, pg8::GroupedOrderT<true>>(ring, g, S, e); }
    SEAM(7);
    if (IN(8)) { const int nM = grouped_tables(C, ctl);
        pg8::Gemm g{}; g.A = ACT; g.Bt = WDN; g.M = NA; g.N = 1024; g.K = 1024; g.scaleA = 0x7f7f7f7f; g.scaleB = WSCALE_E8M0 * 0x01010101;
        pg8::GroupedOrderT<false> S; S.cnt = (const LAS int*)(C.lds + GT_OFF); S.pref = S.cnt + 32; S.tile_e = (const LAS unsigned char*)(S.pref + 36); S.lbuf = (LAS int*)(C.lds + GT_OFF + 2048); S.list = list; S.nN = 4; S.G = C.G; S.c = (int)blockIdx.x; S.nM = nM; S.lstride = T; S.ashift = 0;
        pg8::EpiDown e{}; e.O = YS; e.ldc = 1024; e.bias = args.in[24]; e.ncol = 1024; e.skip = (args.sub >> 4) & 1;
        pg8::gemm_phase<pg8::EpiDown, pg8::GroupedOrderT<false>>(ring, g, S, e); }
    SEAM(8);
    if (IN(9)) { (void)grouped_tables(C, ctl); combine_pass(C, out, (const unsigned char*)YS, top_w, apos); }
#undef IN
#undef SEAM
}

extern "C" void kernel_launch(void* const* d_in, const int* in_sizes, int n_in, void* d_out, int out_size, void* d_ws, size_t ws_size, hipStream_t stream) {
    static int grid = 0;
    if (grid == 0) {
        if (n_in != 25 || in_sizes[0] != T * DM || out_size != T * DM || ws_size < WS_END) { fprintf(stderr, "kernel_launch: unexpected shapes / workspace (n_in %d, ws %zu)\n", n_in, ws_size); grid = -1; return; }
        int dev = 0, cus = 0, per_cu = 0;
        if (hipGetDevice(&dev) != hipSuccess || hipDeviceGetAttribute(&cus, hipDeviceAttributeMultiprocessorCount, dev) != hipSuccess) { grid = -1; return; }
        if (hipFuncSetAttribute((const void*)mk_fwd, hipFuncAttributeMaxDynamicSharedMemorySize, LDS_BYTES) != hipSuccess) { fprintf(stderr, "kernel_launch: hipFuncSetAttribute failed\n"); grid = -1; return; }
        if (hipOccupancyMaxActiveBlocksPerMultiprocessor(&per_cu, (const void*)mk_fwd, 512, LDS_BYTES) != hipSuccess || per_cu < 1) { fprintf(stderr, "kernel_launch: occupancy query says %d workgroups per CU\n", per_cu); grid = -1; (void)hipGetLastError(); return; }
        grid = cus;
    }
    if (grid < 0) return;
    if (hipMemsetAsync((char*)d_ws + WS_CTL, 0, CTL_ZERO_BYTES, stream) != hipSuccess) return;
    Args a{};
    for (int i = 0; i < 25; ++i) a.in[i] = (const float*)d_in[i];
    a.out = (float*)d_out; a.ws = (unsigned char*)d_ws;
#ifdef MK_RANGES
    { const int rg[] = MK_RANGES; int nb = 0; for (unsigned i = 0; i + 2 < sizeof(rg) / sizeof(int); i += 3) { a.ph_lo = rg[i]; a.ph_hi = rg[i + 1]; a.sub = rg[i + 2]; a.bar_idx = (rg[i + 1] - rg[i] > 1) ? nb++ : 0;
        hipLaunchKernelGGL(mk_fwd, dim3(grid), dim3(512), LDS_BYTES, stream, a); } }
#else
    a.ph_lo = 0; a.ph_hi = NPH; a.bar_idx = 0; a.sub = 3; hipLaunchKernelGGL(mk_fwd, dim3(grid), dim3(512), LDS_BYTES, stream, a);
#endif
}
```

```cpp
#include <hip/hip_runtime.h>
#include <cstdio>
#include <cstdint>
#include <cmath>

constexpr int DM = 1024, BATCH = 8, SEQ = 4096, T = BATCH * SEQ;
constexpr int NG = 64, NP = 64, GCH = 16;
constexpr int HD = 64, NQH = 16, NKVH = 4, WIN = 128;
constexpr int IN_W = 4608;
constexpr int C_U = 0, C_Q = 1024, C_K = 2048, C_V = 2304, C_GS = 2560, C_GA = 3584;
constexpr int NE = 32, TOPK = 4, DFF = 1024, NA = T * TOPK;
constexpr int MAXROWS = NA + NE * 256;
constexpr int MAXMT = MAXROWS / 256;
constexpr float EPS = 1e-5f;

namespace pg8 {
#define PG8_LAS __attribute__((address_space(3)))
typedef unsigned short bf16_t;
typedef short bf16x8 __attribute__((ext_vector_type(8)));
typedef float f32x4 __attribute__((ext_vector_type(4)));
typedef unsigned u32x4 __attribute__((ext_vector_type(4)));
typedef int i32x8 __attribute__((ext_vector_type(8)));
typedef int i32x4 __attribute__((ext_vector_type(4)));
__device__ __forceinline__ i32x8 cat8(bf16x8 lo, bf16x8 hi) { return __builtin_shufflevector(__builtin_bit_cast(i32x4, lo), __builtin_bit_cast(i32x4, hi), 0, 1, 2, 3, 4, 5, 6, 7); }
constexpr int BM = 256, BK = 64, HALF = 128, HTB = HALF * BK * 2  , STAGE_BYTES = 8 * HTB, NXCD = 8, WGM = 8;

__host__ __device__ __forceinline__ int lds_byte(int r, int c) { const int st = (r >> 4) * 2 + (c >> 5), rr = r & 15, cc = c & 31, ob = rr * 64 + cc * 2; return st * 1024 + (ob ^ (((ob >> 9) & 1) << 5)); }
__host__ __device__ __forceinline__ void stage_rc(int b, int& R, int& C) { const int st = b / 1024, sb = b % 1024, swz = sb ^ (((sb >> 9) & 1) << 5); R = (st >> 1) * 16 + swz / 64; C = (st & 1) * 32 + (swz % 64) / 2; }
__host__ __device__ __forceinline__ int perm32(int rho) { const int n = rho >> 4, i = rho & 15; return 8 * (i >> 2) + 4 * n + (i & 3); }

struct Unit { int pm, pn, e, pl, rows, srow; };
struct Gemm { const bf16_t* A; const bf16_t* Bt; const bf16_t* A2; const bf16_t* Bt2; int M, N, K, agm, scaleA, scaleB, pad0, pad1; };

struct StaticOrder {
    static constexpr bool GATHER = false, FP8 = false, LINROWS = false;
    static constexpr PG8_LAS int* lbuf = nullptr;
    int nM, nN, nwg, G, c;
    __host__ __device__ void init(int M, int N, int G_, int c_) { nM = M / BM; nN = N / BM; nwg = nM * nN; G = G_; c = c_; }
    __host__ __device__ bool next(int i, Unit& u) const {
        const long L = (long)i * G + c; if (L >= nwg) return false;
        int wgid = (int)L; { const int q = nwg / NXCD, r = nwg % NXCD, xcd = wgid % NXCD, off = wgid / NXCD; wgid = (xcd < r ? xcd * (q + 1) : r * (q + 1) + (xcd - r) * q) + off; }
        const int nig = WGM * nN, gid = wgid / nig, fm = gid * WGM, gsz = (nM - fm) < WGM ? (nM - fm) : WGM;
        u.pm = fm + ((wgid % nig) % gsz); u.pn = (wgid % nig) / gsz; u.e = 0; u.pl = u.pn; u.rows = BM; u.srow = u.pm * BM; return true;
    }
    __device__ __forceinline__ void a_ready(const Unit&) const {}
    __device__ __forceinline__ void done(const Unit&) const {}
};

template <class Epi, class Sched, bool ALIGN_EPI = true>
__device__ __forceinline__ void gemm_phase(PG8_LAS unsigned char* lds, const Gemm g, const Sched& S, const Epi& E) {
    int tid = threadIdx.x; asm volatile("" : "+v"(tid));
    const int wid = __builtin_amdgcn_readfirstlane(tid >> 6), lane = tid & 63, wr = wid >> 2, wc = wid & 3, fr = lane & 15, fq = lane >> 4;
    constexpr bool GATHER = Sched::GATHER, FP8 = Sched::FP8;
    const int K = g.K, KB = FP8 ? K : 2 * K, nt = KB / 128;
    int RA[2], CA[2]; unsigned voffA0[2], voffA1[2], voffB[2];
#pragma unroll
    for (int i = 0; i < 2; ++i) { int R, C; stage_rc(tid * 16 + i * 8192, R, C); RA[i] = R; CA[i] = C;
        const int Rb = 2 * (R & ~31) + (Epi::PERM ? perm32(R & 31) : (R & 31));
        voffB[i] = (unsigned)(Rb * KB + C * 2);
        if (g.agm) { voffA0[i] = (unsigned)((C >> 4) * g.M * 32 + R * 32 + (C & 15) * 2); voffA1[i] = voffA0[i] + (unsigned)(HALF * 32); }
        else { voffA0[i] = (unsigned)(R * KB + C * 2); voffA1[i] = (unsigned)((R + HALF) * KB + C * 2); } }
    const size_t kstep = (size_t)(BK * 2);
    const size_t hstepB = (size_t)32 * KB;
    const size_t tstep = (size_t)BM * KB;
    const size_t kstepA = g.agm ? (size_t)4 * g.M * 32 : kstep, tstepA = g.agm ? (size_t)BM * 32 : tstep;
    const unsigned ldsw = (unsigned)wid * 1024u;
    const int aoff = lds_byte(wr * 64 + fr, fq * 8), boff = lds_byte(wc * 32 + fr, fq * 8);
    constexpr int KOFF = 1024;
#define PG8_SA(b, h) (((b) * 2 + (h)) * HTB)
#define PG8_SB(b, h) ((4 + (b) * 2 + (h)) * HTB)
#define PG8_STAGE(bufoff, gbase, voff) do { _Pragma("unroll") for (int _i = 0; _i < 2; ++_i) \
        __builtin_amdgcn_global_load_lds((const unsigned*)((const char*)(gbase) + (voff)[_i]), (PG8_LAS unsigned*)(lds + (bufoff) + ldsw + _i * 8192), 16, 0, 0); } while (0)
#define PG8_LDA(dst, b, h) do { _Pragma("unroll") for (int m = 0; m < 4; ++m) _Pragma("unroll") for (int k = 0; k < 2; ++k) dst[m][k] = *(const PG8_LAS bf16x8*)(lds + PG8_SA(b, h) + aoff + m * 2048 + k * KOFF); } while (0)
#define PG8_LDB(dst, b, h) do { _Pragma("unroll") for (int n = 0; n < 2; ++n) _Pragma("unroll") for (int k = 0; k < 2; ++k) dst[n][k] = *(const PG8_LAS bf16x8*)(lds + PG8_SB(b, h) + boff + n * 2048 + k * KOFF); } while (0)
#define PG8_MMA(ai, bj, At, Bt) do { __builtin_amdgcn_s_setprio(1); _Pragma("unroll") for (int m = 0; m < 4; ++m) _Pragma("unroll") for (int n = 0; n < 2; ++n) { \
        if constexpr (FP8) acc[ai][bj][m][n] = __builtin_amdgcn_mfma_scale_f32_16x16x128_f8f6f4(cat8(Bt[n][0], Bt[n][1]), cat8(At[m][0], At[m][1]), acc[ai][bj][m][n], 0, 0, 0, g.scaleB, 0, g.scaleA); \
        else { _Pragma("unroll") for (int k = 0; k < 2; ++k) acc[ai][bj][m][n] = __builtin_amdgcn_mfma_f32_16x16x32_bf16(Bt[n][k], At[m][k], acc[ai][bj][m][n], 0, 0, 0); } } __builtin_amdgcn_s_setprio(0); } while (0)
#define PG8_WAIT_V(n) asm volatile("s_waitcnt vmcnt(" #n ")" ::: "memory")
#define PG8_WAIT_L(n) asm volatile("s_waitcnt lgkmcnt(" #n ")" ::: "memory")
#define PG8_BAR __builtin_amdgcn_s_barrier()
#define PG8_SCHED __builtin_amdgcn_sched_barrier(0)
    Unit cur, nxt; int ui = 0;
    if (!S.next(0, cur)) return;
    f32x4 acc[2][2][4][2];
#pragma unroll
    for (int a = 0; a < 2; ++a)
#pragma unroll
        for (int b = 0; b < 2; ++b)
#pragma unroll
            for (int m = 0; m < 4; ++m)
#pragma unroll
                for (int n = 0; n < 2; ++n) acc[a][b][m][n] = (f32x4){0.f, 0.f, 0.f, 0.f};
    bf16x8 At[4][2], B0[2][2], B1[2][2];
    PG8_LAS int* const lring = S.lbuf;
    if constexpr (Epi::BIAS_LDS) { if (tid < BM) S.lbuf[3 * BM + tid] = __builtin_bit_cast(int, *E.bias_elem(cur, tid));
        asm volatile("s_waitcnt vmcnt(0) lgkmcnt(0)" ::: "memory"); PG8_BAR; asm volatile("" ::: "memory"); }
    constexpr bool LINROWS = Sched::LINROWS;
    if constexpr (GATHER && LINROWS) {
#pragma unroll
        for (int i = 0; i < 2; ++i) { voffA0[i] = (unsigned)(cur.srow + RA[i]) * (unsigned)KB + (unsigned)(CA[i] * 2); voffA1[i] = (unsigned)(cur.srow + HALF + RA[i]) * (unsigned)KB + (unsigned)(CA[i] * 2); } }
    if constexpr (GATHER && !LINROWS) {
        if (tid < BM) lring[tid] = S.list_entry(cur, tid);
        asm volatile("s_waitcnt vmcnt(0) lgkmcnt(0)" ::: "memory"); PG8_BAR; asm volatile("" ::: "memory");
#pragma unroll
        for (int i = 0; i < 2; ++i) { const int r0 = RA[i] < cur.rows ? RA[i] : cur.rows - 1, r1 = HALF + RA[i] < cur.rows ? HALF + RA[i] : cur.rows - 1;
            voffA0[i] = (unsigned)(lring[r0] >> S.ashift) * (unsigned)KB + (unsigned)(CA[i] * 2); voffA1[i] = (unsigned)(lring[r1] >> S.ashift) * (unsigned)KB + (unsigned)(CA[i] * 2); } }
    const char* cA = GATHER ? (const char*)g.A : (const char*)(cur.e && g.A2 ? g.A2 : g.A) + (size_t)cur.pm * tstepA; const char* cB = (const char*)(!GATHER && cur.e && g.Bt2 ? g.Bt2 : g.Bt) + (size_t)cur.pn * tstep;
    S.a_ready(cur);
    PG8_STAGE(PG8_SB(0, 0), cB, voffB); PG8_STAGE(PG8_SB(0, 1), cB + hstepB, voffB); PG8_STAGE(PG8_SA(0, 0), cA, voffA0); PG8_STAGE(PG8_SA(0, 1), cA, voffA1);
    if (wr == 1) PG8_BAR;
    PG8_WAIT_V(2); PG8_BAR;
    PG8_STAGE(PG8_SB(1, 0), cB + kstep, voffB); PG8_STAGE(PG8_SA(1, 0), cA + kstepA, voffA0); PG8_STAGE(PG8_SB(1, 1), cB + hstepB + kstep, voffB);
    PG8_WAIT_V(6); PG8_BAR;
    for (;;) {
        const bool has_next = S.next(ui + 1, nxt);
        const char* nA = GATHER ? cA : (has_next ? (const char*)(nxt.e && g.A2 ? g.A2 : g.A) + (size_t)nxt.pm * tstepA : cA); const char* nB = has_next ? (const char*)(!GATHER && nxt.e && g.Bt2 ? g.Bt2 : g.Bt) + (size_t)nxt.pn * tstep : cB;
        const int slot_cur = (ui % 3) * BM, slot_nxt = ((ui + 1) % 3) * BM;
        if constexpr (Epi::BIAS_LDS) { if (has_next && wid >= 4)
            __builtin_amdgcn_global_load_lds((const unsigned*)E.bias_elem(nxt, (wid - 4) * 64 + lane), (PG8_LAS unsigned*)(lring + 3 * BM + slot_nxt + (wid - 4) * 64), 4, 0, 0); }
        if constexpr (GATHER && !LINROWS) { if (has_next && wid < 4)
            __builtin_amdgcn_global_load_lds((const unsigned*)(S.list_ptr(nxt) + wid * 64 + lane), (PG8_LAS unsigned*)(lring + slot_nxt + wid * 64), 4, 0, 0); }
        for (int t = 0; t < nt; t += 2) {
            const bool last = (t == nt - 2);
            const char* a1 = cA + (size_t)(t + 1) * kstepA;
            const char* a2 = last ? nA : cA + (size_t)(t + 2) * kstepA; const char* b2 = last ? nB : cB + (size_t)(t + 2) * kstep;
            const char* a3 = a2 + kstepA; const char* b3 = b2 + kstep;
            if (last && has_next) S.a_ready(nxt);
            PG8_LDB(B0, 0, 0); PG8_LDB(B1, 0, 1); PG8_SCHED; PG8_LDA(At, 0, 0); PG8_STAGE(PG8_SA(1, 1), a1, voffA1);
            if constexpr (GATHER && LINROWS) { if (last && has_next) {
#pragma unroll
                for (int i = 0; i < 2; ++i) { voffA0[i] = (unsigned)(nxt.srow + RA[i]) * (unsigned)KB + (unsigned)(CA[i] * 2); voffA1[i] = (unsigned)(nxt.srow + HALF + RA[i]) * (unsigned)KB + (unsigned)(CA[i] * 2); } } }
            if constexpr (GATHER && !LINROWS) { if (last && has_next) {
#pragma unroll
                for (int i = 0; i < 2; ++i) { const int r0 = RA[i] < nxt.rows ? RA[i] : nxt.rows - 1, r1 = HALF + RA[i] < nxt.rows ? HALF + RA[i] : nxt.rows - 1;
                    voffA0[i] = (unsigned)(lring[slot_nxt + r0] >> S.ashift) * (unsigned)KB + (unsigned)(CA[i] * 2); voffA1[i] = (unsigned)(lring[slot_nxt + r1] >> S.ashift) * (unsigned)KB + (unsigned)(CA[i] * 2); } } }
            PG8_WAIT_V(8); PG8_WAIT_L(0); PG8_BAR; PG8_MMA(0, 0, At, B0); PG8_MMA(0, 1, At, B1); PG8_BAR; PG8_SCHED;
            PG8_LDA(At, 0, 1); PG8_STAGE(PG8_SB(0, 0), b2, voffB); PG8_STAGE(PG8_SB(0, 1), b2 + hstepB, voffB); PG8_STAGE(PG8_SA(0, 0), a2, voffA0);
            PG8_WAIT_V(8); PG8_WAIT_L(0); PG8_BAR; PG8_MMA(1, 0, At, B0); PG8_MMA(1, 1, At, B1); PG8_BAR; PG8_SCHED;
            PG8_LDB(B0, 1, 0); PG8_LDB(B1, 1, 1); PG8_SCHED; PG8_LDA(At, 1, 0); PG8_STAGE(PG8_SA(0, 1), a2, voffA1);
            PG8_WAIT_V(8); PG8_WAIT_L(0); PG8_BAR; PG8_MMA(0, 0, At, B0); PG8_MMA(0, 1, At, B1); PG8_BAR; PG8_SCHED;
            PG8_LDA(At, 1, 1); PG8_STAGE(PG8_SB(1, 0), b3, voffB); PG8_STAGE(PG8_SB(1, 1), b3 + hstepB, voffB); PG8_STAGE(PG8_SA(1, 0), a3, voffA0);
            PG8_WAIT_V(8); PG8_WAIT_L(0); PG8_BAR; PG8_MMA(1, 0, At, B0); PG8_MMA(1, 1, At, B1); PG8_BAR; PG8_SCHED;
        }
        if constexpr (ALIGN_EPI) { if (wr == 0) PG8_BAR; }
        E(acc, cur, wr, wc, fr, fq, lring + slot_cur); S.done(cur);
        if (!has_next) break;
#pragma unroll
        for (int a = 0; a < 2; ++a)
#pragma unroll
            for (int b = 0; b < 2; ++b)
#pragma unroll
                for (int m = 0; m < 4; ++m)
#pragma unroll
                    for (int n = 0; n < 2; ++n) acc[a][b][m][n] = (f32x4){0.f, 0.f, 0.f, 0.f};
        cur = nxt; cA = nA; cB = nB; ++ui;
        if constexpr (ALIGN_EPI) { if (wr == 1) PG8_BAR; }
    }
    PG8_WAIT_V(0);
    if constexpr (!ALIGN_EPI) { if (wr == 0) PG8_BAR; }
    PG8_BAR;
#undef PG8_SA
#undef PG8_SB
#undef PG8_STAGE
#undef PG8_LDA
#undef PG8_LDB
#undef PG8_MMA
#undef PG8_WAIT_V
#undef PG8_WAIT_L
#undef PG8_BAR
#undef PG8_SCHED
}

__device__ __forceinline__ unsigned cvt_pk_bf16(float lo, float hi) { unsigned r; asm volatile("v_cvt_pk_bf16_f32 %0, %1, %2" : "=v"(r) : "v"(lo), "v"(hi)); return r; }
__device__ __forceinline__ float bf_lo(unsigned w) { return __uint_as_float(w << 16); }
__device__ __forceinline__ float bf_hi(unsigned w) { return __uint_as_float(w & 0xffff0000u); }
__device__ __forceinline__ float sigm(float x) { return __builtin_amdgcn_rcpf(1.f + __builtin_amdgcn_exp2f(-1.4426950408889634f * x)); }
__device__ __forceinline__ f32x4 sigm4(f32x4 x) { f32x4 t = x * -1.4426950408889634f, s;
#pragma unroll
    for (int j = 0; j < 4; ++j) s[j] = __builtin_amdgcn_exp2f(t[j]);
    s = s + 1.f;
#pragma unroll
    for (int j = 0; j < 4; ++j) s[j] = __builtin_amdgcn_rcpf(s[j]);
    return s; }
__device__ __forceinline__ u32x4 pack8(const f32x4 v0, const f32x4 v1) { u32x4 w; w.x = cvt_pk_bf16(v0[0], v0[1]); w.y = cvt_pk_bf16(v0[2], v0[3]); w.z = cvt_pk_bf16(v1[0], v1[1]); w.w = cvt_pk_bf16(v1[2], v1[3]); return w; }
__device__ __forceinline__ void unpack8(const u32x4 w, f32x4& v0, f32x4& v1) { v0 = (f32x4){bf_lo(w.x), bf_hi(w.x), bf_lo(w.y), bf_hi(w.y)}; v1 = (f32x4){bf_lo(w.z), bf_hi(w.z), bf_lo(w.w), bf_hi(w.w)}; }

struct EpiProj {
    static constexpr bool PERM = true, BIAS_LDS = false;
    bf16_t* O; const float* qg; const float* kg; bf16_t* U; PG8_LAS unsigned char* stage; int ldc; float qscale; int nostore, urows, pad;
    __device__ __forceinline__ void operator()(f32x4 (&acc)[2][2][4][2], const Unit& u, int wr, int wc, int fr, int fq, const PG8_LAS int* lrow) const {
        if (nostore & 2) { for (int ai = 0; ai < 2; ++ai) for (int m = 0; m < 4; ++m) asm volatile("" :: "v"(acc[ai][0][m][0]), "v"(acc[ai][0][m][1]), "v"(acc[ai][1][m][0]), "v"(acc[ai][1][m][1])); return; }
        const int row0 = u.pm * BM + wr * 64 + fr, col0 = u.pl * BM + wc * 64 + 8 * fq;
        if (u.pl >= 4 && u.pl <= 8) {
            const float* gp = (u.pl == 8 ? kg : qg) + 8 * fq; const float sc = (u.pl == 8) ? 1.f : qscale;
            f32x4 gv[2][2];
#pragma unroll
            for (int bj = 0; bj < 2; ++bj)
#pragma unroll
                for (int n = 0; n < 2; ++n) gv[bj][n] = *(const f32x4*)(gp + 32 * bj + 4 * n) * sc;
#pragma unroll
            for (int ai = 0; ai < 2; ++ai)
#pragma unroll
                for (int m = 0; m < 4; ++m) { float ss = 0.f;
#pragma unroll
                    for (int bj = 0; bj < 2; ++bj)
#pragma unroll
                        for (int n = 0; n < 2; ++n) { const f32x4 v = acc[ai][bj][m][n]; ss += (v[0] * v[0] + v[1] * v[1]) + (v[2] * v[2] + v[3] * v[3]); }
                    ss += __shfl_xor(ss, 16); ss += __shfl_xor(ss, 32);
                    const float rs = rsqrtf(ss * (1.f / 64.f) + 1e-5f);
#pragma unroll
                    for (int bj = 0; bj < 2; ++bj)
#pragma unroll
                        for (int n = 0; n < 2; ++n) acc[ai][bj][m][n] = acc[ai][bj][m][n] * rs * gv[bj][n]; }
        }
        if (u.pl < 4) {
#pragma unroll
            for (int ai = 0; ai < 2; ++ai)
#pragma unroll
                for (int m = 0; m < 4; ++m)
#pragma unroll
                    for (int bj = 0; bj < 2; ++bj) { const u32x4 w = pack8(acc[ai][bj][m][0], acc[ai][bj][m][1]); const int c = col0 + bj * 32;
                        *(u32x4*)(U + ((size_t)(c >> 4) * urows + (size_t)(row0 + ai * HALF + m * 16)) * 16 + (c & 15)) = w; }
        } else {
            PG8_LAS unsigned char* stg = stage + (wr * 4 + wc) * 2304; const int lane = fq * 16 + fr;
            bf16_t* ob = O + (size_t)(u.pm * BM + wr * 64 + (lane >> 3)) * ldc + u.pl * BM + wc * 64 + 8 * (lane & 7);
#pragma unroll
            for (int ai = 0; ai < 2; ++ai)
#pragma unroll
                for (int m = 0; m < 4; ++m) {
#pragma unroll
                    for (int bj = 0; bj < 2; ++bj) *(PG8_LAS u32x4*)(stg + fr * 144 + bj * 64 + fq * 16) = pack8(acc[ai][bj][m][0], acc[ai][bj][m][1]);
                    asm volatile("s_waitcnt lgkmcnt(0)" ::: "memory");
                    const u32x4 r0 = *(const PG8_LAS u32x4*)(stg + (lane >> 3) * 144 + (lane & 7) * 16), r1 = *(const PG8_LAS u32x4*)(stg + ((lane >> 3) + 8) * 144 + (lane & 7) * 16);
                    asm volatile("s_waitcnt lgkmcnt(0)" ::: "memory");
                    if (!(nostore & 1)) { *(u32x4*)(ob + (size_t)(ai * HALF + m * 16) * ldc) = r0; *(u32x4*)(ob + (size_t)(ai * HALF + m * 16 + 8) * ldc) = r1; } }
        }
    }
};
struct EpiGlu {
    static constexpr bool PERM = true, BIAS_LDS = false;
    bf16_t* O; int ldc, pad;
    __device__ __forceinline__ void operator()(f32x4 (&acc)[2][2][4][2], const Unit& u, int wr, int wc, int fr, int fq, const PG8_LAS int* lrow) const {
        const int row0 = u.pm * BM + wr * 64 + fr, col0 = u.pl * HALF + wc * 32 + 8 * fq;
#pragma unroll
        for (int ai = 0; ai < 2; ++ai)
#pragma unroll
            for (int m = 0; m < 4; ++m) { bf16_t* rowp = O + (size_t)(row0 + ai * HALF + m * 16) * ldc + col0;
                const f32x4 o0 = acc[ai][0][m][0] * sigm4(acc[ai][1][m][0]), o1 = acc[ai][0][m][1] * sigm4(acc[ai][1][m][1]);
                *(u32x4*)rowp = pack8(o0, o1); }
    }
};
struct EpiGate {
    static constexpr bool PERM = true, BIAS_LDS = false;
    bf16_t* O; const bf16_t* G; PG8_LAS unsigned char* stage; int ldc, ldg, gcol0, gcol1;
    __device__ __forceinline__ void operator()(f32x4 (&acc)[2][2][4][2], const Unit& u, int wr, int wc, int fr, int fq, const PG8_LAS int* lrow) const {
        const int row0 = u.pm * BM + wr * 64 + fr, col0 = u.pl * BM + wc * 64 + 8 * fq; const bool add = u.e != 0; const int gcol = add ? gcol1 : gcol0;
        PG8_LAS unsigned char* stg = stage + (wr * 4 + wc) * 2304; const int lane = fq * 16 + fr;
        bf16_t* ob = O + (size_t)(u.pm * BM + wr * 64 + (lane >> 3)) * ldc + u.pl * BM + wc * 64 + 8 * (lane & 7);
#pragma unroll
        for (int ai = 0; ai < 2; ++ai) {
            u32x4 gw[4][2], ow[4][2];
#pragma unroll
            for (int m = 0; m < 4; ++m)
#pragma unroll
                for (int bj = 0; bj < 2; ++bj) { const size_t r = (size_t)(row0 + ai * HALF + m * 16);
                    gw[m][bj] = *(const u32x4*)(G + r * ldg + gcol + col0 + bj * 32);
                    if (add) ow[m][bj] = __builtin_nontemporal_load((const u32x4*)(O + r * ldc + col0 + bj * 32)); else ow[m][bj] = (u32x4){0u, 0u, 0u, 0u}; }
#pragma unroll
            for (int m = 0; m < 4; ++m)
#pragma unroll
                for (int bj = 0; bj < 2; ++bj) { const size_t r = (size_t)(row0 + ai * HALF + m * 16);
                    f32x4 g0, g1; unpack8(gw[m][bj], g0, g1);
                    f32x4 p0, p1; unpack8(ow[m][bj], p0, p1);
                    const f32x4 o0 = sigm4(g0) * acc[ai][bj][m][0] + p0, o1 = sigm4(g1) * acc[ai][bj][m][1] + p1;
                    *(PG8_LAS u32x4*)(stg + fr * 144 + bj * 64 + fq * 16) = pack8(o0, o1);
                    if (bj == 1) {
                        asm volatile("s_waitcnt lgkmcnt(0)" ::: "memory");
                        const u32x4 r0 = *(const PG8_LAS u32x4*)(stg + (lane >> 3) * 144 + (lane & 7) * 16), r1 = *(const PG8_LAS u32x4*)(stg + ((lane >> 3) + 8) * 144 + (lane & 7) * 16);
                        asm volatile("s_waitcnt lgkmcnt(0)" ::: "memory");
                        *(u32x4*)(ob + (size_t)(ai * HALF + m * 16) * ldc) = r0; *(u32x4*)(ob + (size_t)(ai * HALF + m * 16 + 8) * ldc) = r1; } } }
    }
};
struct EpiResid {
    static constexpr bool PERM = false, BIAS_LDS = false;
    const float* base; float* out; PG8_LAS unsigned char* stage; int ldc, pad;
    __device__ __forceinline__ void operator()(f32x4 (&acc)[2][2][4][2], const Unit& u, int wr, int wc, int fr, int fq, const PG8_LAS int* lrow) const {
        PG8_LAS unsigned char* stg = stage + (wr * 4 + wc) * 2304; const int lane = fq * 16 + fr;
        const size_t gb = (size_t)(u.pm * BM + wr * 64 + (lane >> 3)) * ldc + u.pl * BM + wc * 64 + 4 * (lane & 7);
#pragma unroll
        for (int ai = 0; ai < 2; ++ai) {
            f32x4 bv[4][2][2];
#pragma unroll
            for (int m = 0; m < 4; ++m)
#pragma unroll
                for (int bj = 0; bj < 2; ++bj) { const size_t o = gb + (size_t)(ai * HALF + m * 16) * ldc + bj * 32; bv[m][bj][0] = *(const f32x4*)(base + o); bv[m][bj][1] = *(const f32x4*)(base + o + (size_t)8 * ldc); }
#pragma unroll
            for (int m = 0; m < 4; ++m)
#pragma unroll
                for (int bj = 0; bj < 2; ++bj) { const size_t o = gb + (size_t)(ai * HALF + m * 16) * ldc + bj * 32;
#pragma unroll
                    for (int n = 0; n < 2; ++n) *(PG8_LAS f32x4*)(stg + fr * 144 + n * 64 + fq * 16) = acc[ai][bj][m][n];
                    asm volatile("s_waitcnt lgkmcnt(0)" ::: "memory");
                    const f32x4 r0 = *(const PG8_LAS f32x4*)(stg + (lane >> 3) * 144 + (lane & 7) * 16), r1 = *(const PG8_LAS f32x4*)(stg + ((lane >> 3) + 8) * 144 + (lane & 7) * 16);
                    asm volatile("s_waitcnt lgkmcnt(0)" ::: "memory");
                    *(f32x4*)(out + o) = r0 + bv[m][bj][0]; *(f32x4*)(out + o + (size_t)8 * ldc) = r1 + bv[m][bj][1]; } }
    }
};
struct EpiSwiglu {
    static constexpr bool PERM = true, BIAS_LDS = true;
    __device__ __forceinline__ const float* bias_elem(const Unit& u, int i) const { return bias + (size_t)u.e * 2 * dff + u.pl * HALF + (i < HALF ? i : dff + i - HALF); }
    unsigned char* O; const float* bias; int ldc, dff; float limit, alpha; int skip, pad;
    __device__ __forceinline__ void operator()(f32x4 (&acc)[2][2][4][2], const Unit& u, int wr, int wc, int fr, int fq, const PG8_LAS int* lrow) const {
        if (skip) { for (int ai = 0; ai < 2; ++ai) for (int m = 0; m < 4; ++m) asm volatile("" :: "v"(acc[ai][0][m][0]), "v"(acc[ai][0][m][1]), "v"(acc[ai][1][m][0]), "v"(acc[ai][1][m][1])); return; }
        asm volatile("" : "+v"(fr));
        const int col0 = u.pl * HALF + wc * 32 + 8 * fq;
        const PG8_LAS float* bg = (const PG8_LAS float*)(lrow + 3 * BM) + wc * 32 + 8 * fq; const PG8_LAS float* bu = bg + HALF;
        const f32x4 bg0 = *(const PG8_LAS f32x4*)bg, bg1 = *(const PG8_LAS f32x4*)(bg + 4), bu0 = *(const PG8_LAS f32x4*)bu, bu1 = *(const PG8_LAS f32x4*)(bu + 4);
        const float nal2 = -1.4426950408889634f * alpha;
#pragma unroll
        for (int ai = 0; ai < 2; ++ai)
#pragma unroll
            for (int m = 0; m < 4; ++m) { const int r = ai * HALF + wr * 64 + m * 16 + fr; unsigned char* rowp = O + (size_t)(u.srow + r) * ldc + col0;
                const f32x4 gt0 = __builtin_elementwise_min(acc[ai][0][m][0] + bg0, (f32x4){limit, limit, limit, limit}), gt1 = __builtin_elementwise_min(acc[ai][0][m][1] + bg1, (f32x4){limit, limit, limit, limit});
                f32x4 up0 = acc[ai][1][m][0] + bu0, up1 = acc[ai][1][m][1] + bu1, s0, s1;
                const f32x4 a0 = gt0 * nal2, a1 = gt1 * nal2;
#pragma unroll
                for (int j = 0; j < 4; ++j) { up0[j] = __builtin_amdgcn_fmed3f(up0[j], -limit, limit); up1[j] = __builtin_amdgcn_fmed3f(up1[j], -limit, limit);
                    s0[j] = __builtin_amdgcn_exp2f(a0[j]); s1[j] = __builtin_amdgcn_exp2f(a1[j]); }
                s0 = s0 + 1.f; s1 = s1 + 1.f;
#pragma unroll
                for (int j = 0; j < 4; ++j) { s0[j] = __builtin_amdgcn_rcpf(s0[j]); s1[j] = __builtin_amdgcn_rcpf(s1[j]); }
                const f32x4 o0 = (up0 * gt0 + gt0) * s0, o1 = (up1 * gt1 + gt1) * s1;
                int w0 = __builtin_amdgcn_cvt_pk_fp8_f32(o0[0], o0[1], 0, false); w0 = __builtin_amdgcn_cvt_pk_fp8_f32(o0[2], o0[3], w0, true);
                int w1 = __builtin_amdgcn_cvt_pk_fp8_f32(o1[0], o1[1], 0, false); w1 = __builtin_amdgcn_cvt_pk_fp8_f32(o1[2], o1[3], w1, true);
                *(unsigned long long*)rowp = (unsigned long long)(unsigned)w0 | ((unsigned long long)(unsigned)w1 << 32); }
    }
};
struct EpiDown {
    static constexpr bool PERM = true, BIAS_LDS = true;
    __device__ __forceinline__ const float* bias_elem(const Unit& u, int i) const { return bias + (size_t)u.e * ncol + u.pl * BM + i; }
    bf16_t* O; const float* bias; PG8_LAS unsigned char* stage; int ldc, ncol, skip, pad;
    __device__ __forceinline__ void operator()(f32x4 (&acc)[2][2][4][2], const Unit& u, int wr, int wc, int fr, int fq, const PG8_LAS int* lrow) const {
        if (skip) { for (int ai = 0; ai < 2; ++ai) for (int m = 0; m < 4; ++m) asm volatile("" :: "v"(acc[ai][0][m][0]), "v"(acc[ai][0][m][1]), "v"(acc[ai][1][m][0]), "v"(acc[ai][1][m][1])); return; }
        asm volatile("" : "+v"(fr));
        const PG8_LAS float* bp = (const PG8_LAS float*)(lrow + 3 * BM) + wc * 64 + 8 * fq;
        f32x4 bv[2][2];
#pragma unroll
        for (int bj = 0; bj < 2; ++bj) { bv[bj][0] = *(const PG8_LAS f32x4*)(bp + bj * 32); bv[bj][1] = *(const PG8_LAS f32x4*)(bp + bj * 32 + 4); }
        const int lane = fq * 16 + fr;
        unsigned char* ob = (unsigned char*)O + (size_t)(u.srow + wr * 64 + 4 * wc + (lane >> 4)) * ldc + u.pl * BM + 16 * (lane & 15);
#pragma unroll
        for (int ai = 0; ai < 2; ++ai)
#pragma unroll
            for (int m = 0; m < 4; ++m) { const int step = ai * 4 + m; PG8_LAS unsigned char* buf = stage + ((step & 1) * 2 + wr) * 4352;
#pragma unroll
                for (int bj = 0; bj < 2; ++bj) { const f32x4 o0 = acc[ai][bj][m][0] + bv[bj][0], o1 = acc[ai][bj][m][1] + bv[bj][1];
                    int w0 = __builtin_amdgcn_cvt_pk_fp8_f32(o0[0], o0[1], 0, false); w0 = __builtin_amdgcn_cvt_pk_fp8_f32(o0[2], o0[3], w0, true);
                    int w1 = __builtin_amdgcn_cvt_pk_fp8_f32(o1[0], o1[1], 0, false); w1 = __builtin_amdgcn_cvt_pk_fp8_f32(o1[2], o1[3], w1, true);
                    *(PG8_LAS unsigned long long*)(buf + fr * 272 + wc * 64 + bj * 32 + fq * 8) = (unsigned long long)(unsigned)w0 | ((unsigned long long)(unsigned)w1 << 32); }
                asm volatile("s_waitcnt lgkmcnt(0)" ::: "memory"); __builtin_amdgcn_s_barrier(); asm volatile("" ::: "memory");
                const u32x4 r = *(const PG8_LAS u32x4*)(buf + (4 * wc + (lane >> 4)) * 272 + (lane & 15) * 16);
                *(u32x4*)(ob + (size_t)(ai * HALF + m * 16) * ldc) = r; }
    }
};
template <bool GATH> struct GroupedOrderT {
    static constexpr bool GATHER = true, FP8 = true, LINROWS = !GATH;
    const PG8_LAS unsigned char* tile_e; const PG8_LAS int* pref; const PG8_LAS int* cnt; PG8_LAS int* lbuf; const int* list; int nN, G, c, nM, lstride, ashift;
    __device__ __forceinline__ bool next(int i, Unit& u) const {
        const int nwg = nM * nN; const long L = (long)i * G + c; if (L >= nwg) return false;
        int wgid = (int)L; { const int q = nwg / NXCD, r = nwg % NXCD, xcd = wgid % NXCD, off = wgid / NXCD; wgid = (xcd < r ? xcd * (q + 1) : r * (q + 1) + (xcd - r) * q) + off; }
        const int nig = WGM * nN, gid = wgid / nig, fm = gid * WGM, gsz = (nM - fm) < WGM ? (nM - fm) : WGM;
        const int mt = fm + ((wgid % nig) % gsz), pl = (wgid % nig) / gsz;
        const int e = tile_e[mt]; const int mtl = mt - pref[e]; const int left = cnt[e] - 256 * mtl;
        u.pm = mtl; u.pn = e * nN + pl; u.e = e; u.pl = pl; u.rows = left < 256 ? left : 256; u.srow = mt * BM; return true;
    }
    __device__ __forceinline__ const int* list_ptr(const Unit& u) const { return list + (size_t)u.e * lstride + u.pm * BM; }
    __device__ __forceinline__ int list_entry(const Unit& u, int r) const { return list_ptr(u)[r < u.rows ? r : u.rows - 1]; }
    __device__ __forceinline__ void a_ready(const Unit&) const {}
    __device__ __forceinline__ void done(const Unit&) const {}
};
struct DualOrder {
    static constexpr bool GATHER = false, FP8 = false, LINROWS = false;
    static constexpr PG8_LAS int* lbuf = nullptr;
    StaticOrder S; int nper;
    __device__ __forceinline__ void init(int M, int N, int G, int c) { S.init(M, N, G, c); nper = (S.nwg - c + G - 1) / G; if (nper < 0) nper = 0; }
    __device__ __forceinline__ bool next(int i, Unit& u) const { if (i >= 2 * nper) return false; const int e = i >= nper ? 1 : 0; const bool ok = S.next(i - e * nper, u); u.e = e; return ok; }
    __device__ __forceinline__ void a_ready(const Unit&) const {}
    __device__ __forceinline__ void done(const Unit&) const {}
};
}

#define GAS __attribute__((address_space(1)))
#define LAS __attribute__((address_space(3)))
typedef unsigned short bf16;
typedef unsigned v4u __attribute__((ext_vector_type(4)));
typedef float f32x4 __attribute__((ext_vector_type(4)));
typedef short bf16x8 __attribute__((ext_vector_type(8)));
typedef GAS unsigned gu32;
typedef GAS unsigned long long gu64;
#define RLX_AGENT __ATOMIC_RELAXED, __HIP_MEMORY_SCOPE_AGENT
#define LDS_WAIT() asm volatile("s_waitcnt lgkmcnt(0)" ::: "memory")
#define VM_WAIT() asm volatile("s_waitcnt vmcnt(0)" ::: "memory")
__device__ __forceinline__ unsigned long long rt() { return __builtin_amdgcn_s_memrealtime(); }
__device__ __forceinline__ unsigned f2bf(float f) { unsigned u = __builtin_bit_cast(unsigned, f); return (u + 0x7fffu + ((u >> 16) & 1u)) >> 16; }
__device__ __forceinline__ unsigned pk2(float lo, float hi) { return f2bf(lo) | (f2bf(hi) << 16); }

#define XB_TMO      128
#define XB_XCNT(j)  (256  + 64 * (j))
#define XB_XSUB(j)  (1280 + 64 * (j))
#define XB_XGEN(j)  (2304 + 64 * (j))
#define XB_TOP      3328
#define XB_TOPGEN   3392
#define XCD_BAR_WORDS 3456
#define XB_SPIN_CAP (1u << 18)

__device__ __forceinline__ unsigned xb_ld(unsigned* p)              { return __hip_atomic_load(p, __ATOMIC_RELAXED, __HIP_MEMORY_SCOPE_AGENT); }
__device__ __forceinline__ unsigned xb_add(unsigned* p, unsigned v) { return __hip_atomic_fetch_add(p, v, __ATOMIC_RELAXED, __HIP_MEMORY_SCOPE_AGENT); }
__device__ __forceinline__ unsigned xb_xcc_id() { return (unsigned)__builtin_amdgcn_s_getreg((3 << 11) | 20) & 0xFu; }
#define XB_SPIN(cond, bar) do { unsigned _sp = 0; while (cond) { __builtin_amdgcn_s_sleep(1); \
    if ((++_sp & 255u) == 0u) { if (xb_ld(&(bar)[XB_TMO])) break; if (_sp > XB_SPIN_CAP) { atomicAdd(&(bar)[XB_TMO], 1u); break; } } } } while (0)

struct XcdBarrier {
    unsigned* bar; unsigned x;
    volatile LAS unsigned* st;
};

__device__ __forceinline__ XcdBarrier xcd_barrier_post(unsigned* bar, volatile LAS unsigned* st) {
    XcdBarrier b; b.bar = bar; b.x = xb_xcc_id(); b.st = st;
    if (threadIdx.x == 0) (void)xb_add(&bar[XB_XCNT(b.x)], 1u);
    return b;
}
__device__ __forceinline__ void xcd_barrier_complete(unsigned* bar, unsigned x, unsigned& nloc, unsigned& nx) {
    const unsigned G = gridDim.x * gridDim.y * gridDim.z;
    unsigned sum, cnt, mine, sp = 0u;
    for (;;) {
        sum = 0u; cnt = 0u; mine = 0u;
#pragma unroll
        for (unsigned j = 0; j < 16; ++j) { const unsigned c = xb_ld(&bar[XB_XCNT(j)]); sum += c; cnt += (c > 0u) ? 1u : 0u; mine = (j == x) ? c : mine; }
        if (sum == G) break;
        __builtin_amdgcn_s_sleep(1);
        if ((++sp & 255u) == 0u) { if (xb_ld(&bar[XB_TMO])) break; if (sp > XB_SPIN_CAP) { atomicAdd(&bar[XB_TMO], 1u); break; } }
    }
    nloc = mine > 0u ? mine : 1u; nx = cnt > 0u ? cnt : 1u;
}

__device__ __forceinline__ void xcd_barrier(const XcdBarrier& b) {
    asm volatile("s_waitcnt vmcnt(0)" ::: "memory");
    __syncthreads();
    if (threadIdx.x == 0) {
        unsigned* bar = b.bar;
        __builtin_amdgcn_s_waitcnt(0);
        unsigned nloc = b.st[0], nx = b.st[1];
        if (nloc == 0u) { xcd_barrier_complete(bar, b.x, nloc, nx); b.st[0] = nloc; b.st[1] = nx; }
        const unsigned old = xb_add(&bar[XB_XSUB(b.x)], 1u);
        const unsigned gen = old / nloc;
        if (old + 1u == (gen + 1u) * nloc) {
            __builtin_amdgcn_fence(__ATOMIC_RELEASE, "agent");
            asm volatile("s_waitcnt vmcnt(0)" ::: "memory");
            const unsigned og = xb_add(&bar[XB_TOP], 1u);
            const unsigned tg = og / nx;
            if (og + 1u == (tg + 1u) * nx) xb_add(&bar[XB_TOPGEN], 1u);
            else XB_SPIN(xb_ld(&bar[XB_TOPGEN]) == tg, bar);
            __builtin_amdgcn_fence(__ATOMIC_ACQUIRE, "agent");
            xb_add(&bar[XB_XGEN(b.x)], 1u);
            asm volatile("s_waitcnt vmcnt(0)" ::: "memory");
        } else {
            XB_SPIN(xb_ld(&bar[XB_XGEN(b.x)]) == gen, bar);
            __builtin_amdgcn_fence(__ATOMIC_ACQUIRE, "agent");
            asm volatile("s_waitcnt vmcnt(0)" ::: "memory");
        }
    }
    __syncthreads();
}

constexpr size_t MiB = 1u << 20;
constexpr size_t WS_CTL = 0;
constexpr size_t CTL_ZERO_BYTES = 65536;
constexpr size_t WS_WIN = 1 * MiB, WS_WGLU = 10 * MiB, WS_WSSM = 14 * MiB, WS_WATT = 16 * MiB, WS_WOUT = 18 * MiB;
constexpr size_t WS_WGU = 20 * MiB, WS_WDN = 148 * MiB;
constexpr float WSCALE = 64.f; constexpr int WSCALE_E8M0 = 127 - 6;
constexpr size_t WS_ROUTE = 216 * MiB;
constexpr size_t WS_H = 224 * MiB;
constexpr size_t WS_PROJ = 288 * MiB;
constexpr size_t WS_S5OUT = 576 * MiB;
constexpr size_t WS_ATTN = 640 * MiB;
constexpr size_t WS_ACT = 704 * MiB;
constexpr size_t WS_BTAB = 976 * MiB, WS_CTAB = 980 * MiB, WS_KTAB = 984 * MiB, WS_A16 = 985 * MiB;
constexpr size_t WS_END = 986 * MiB;
static_assert(WS_PROJ + (size_t)T * IN_W * 2 <= WS_S5OUT && WS_PROJ + (size_t)MAXROWS * 1024 * 2 <= WS_S5OUT && WS_ACT + (size_t)MAXROWS * 1024 <= WS_BTAB, "ws map");
constexpr int CW_CNT = 0;
constexpr int CW_BAR = 4096;
static_assert((CW_BAR + 3 * XCD_BAR_WORDS) * 4 <= (int)CTL_ZERO_BYTES, "ctl map");
constexpr size_t RT_TOPW = 0, RT_LIST = 1 * MiB, RT_APOS = 5 * MiB;

constexpr int LDS_BYTES = 163840;
constexpr int RING_OFF = 0;
constexpr int MISC_OFF = LDS_BYTES - 256;
constexpr int GT_OFF = 131072;

__device__ __forceinline__ float bf2f(bf16 b) { return __uint_as_float((unsigned)b << 16); }
__device__ __forceinline__ float wave_sum(float v) {
#pragma unroll
    for (int o = 1; o < 64; o <<= 1) v += __shfl_xor(v, o);
    return v;
}
__device__ __forceinline__ float wave_max(float v) {
#pragma unroll
    for (int o = 1; o < 64; o <<= 1) v = fmaxf(v, __shfl_xor(v, o));
    return v;
}
__device__ __forceinline__ float gelu_tanh(float x) { const float z = -2.3022081985f * (x + 0.044715f * x * x * x); return x * __builtin_amdgcn_rcpf(1.f + __builtin_amdgcn_exp2f(z)); }
#define WAVE_SYNC() do { __builtin_amdgcn_wave_barrier(); asm volatile("s_waitcnt lgkmcnt(0)" ::: "memory"); } while (0)

struct Args { const float* in[25]; float* out; unsigned char* ws; int ph_lo, ph_hi, bar_idx, sub; };
struct Ctx { int tid, lane, wave, vcu, G, gw, ngw; LAS unsigned char* lds; };

constexpr int TR_SCR = 64 * 65 * 4;
__device__ __forceinline__ void transpose_item(const float* W, int K, int N, bf16* WT, int mode, LAS float* scr, int item, int lane) {
    const int nblk = N / 64, kb = item / nblk, nb = item % nblk, k0 = 64 * kb, n0 = 64 * nb;
#pragma unroll 4
    for (int i = 0; i < 16; ++i) { const int kk = 4 * i + (lane >> 4), nn = 4 * (lane & 15); const f32x4 w = *(const f32x4*)(W + (size_t)(k0 + kk) * N + n0 + nn);
        LAS float* s = scr + kk * 65 + nn; s[0] = w.x; s[1] = w.y; s[2] = w.z; s[3] = w.w; }
    LDS_WAIT(); asm volatile("" ::: "memory");
    const int c = lane & 7;
#pragma unroll
    for (int j = 0; j < 8; ++j) { const int n = (lane >> 3) + 8 * j; const LAS float* s = scr + (8 * c) * 65 + n;
        v4u o; o.x = pk2(s[0 * 65], s[1 * 65]); o.y = pk2(s[2 * 65], s[3 * 65]); o.z = pk2(s[4 * 65], s[5 * 65]); o.w = pk2(s[6 * 65], s[7 * 65]);
        int r = n0 + n;
        if (mode == 1) { const int nh = N / 2, hf = (r >= nh) ? 1 : 0, np = r - hf * nh; r = 256 * (np / 128) + 64 * ((np % 128) / 32) + 32 * hf + (np % 32); }
        *(v4u*)(WT + (size_t)r * K + k0 + 8 * c) = o; }
    LDS_WAIT(); asm volatile("" ::: "memory");
}
constexpr int TR8_SCR = 128 * 33 * 4;
__device__ __forceinline__ void transpose_item_fp8(const float* W, int K, int N, unsigned char* WT, int mode, float wscale, LAS float* scr, int item, int lane) {
    const int nblk = N / 32, kb = item / nblk, nb = item % nblk, k0 = 128 * kb, n0 = 32 * nb;
#pragma unroll 4
    for (int i = 0; i < 16; ++i) { const int kk = 8 * i + (lane >> 3), nn = 4 * (lane & 7); const f32x4 w = *(const f32x4*)(W + (size_t)(k0 + kk) * N + n0 + nn);
        LAS float* s = scr + kk * 33 + nn; s[0] = w.x; s[1] = w.y; s[2] = w.z; s[3] = w.w; }
    LDS_WAIT(); asm volatile("" ::: "memory");
    int rb = n0;
    if (mode == 1) { const int nh = N / 2, hf = (n0 >= nh) ? 1 : 0, np = n0 - hf * nh; rb = 256 * (np / 128) + 64 * ((np % 128) / 32) + 32 * hf; }
    const int c = lane & 7;
#pragma unroll
    for (int j = 0; j < 4; ++j) { const int n = (lane >> 3) + 8 * j; const LAS float* s = scr + (16 * c) * 33 + n;
        v4u o;
#pragma unroll
        for (int q = 0; q < 4; ++q) { int w = __builtin_amdgcn_cvt_pk_fp8_f32(s[(4 * q) * 33] * wscale, s[(4 * q + 1) * 33] * wscale, 0, false); w = __builtin_amdgcn_cvt_pk_fp8_f32(s[(4 * q + 2) * 33] * wscale, s[(4 * q + 3) * 33] * wscale, w, true); o[q] = (unsigned)w; }
        *(v4u*)(WT + (size_t)(rb + n) * K + k0 + 16 * c) = o; }
    LDS_WAIT(); asm volatile("" ::: "memory");
}
__device__ __forceinline__ void transpose_job_fp8(const Ctx& C, const float* W, unsigned char* WT, int K, int N, int mode, int nmat, float wscale) {
    LAS float* scr = (LAS float*)(C.lds + RING_OFF + C.wave * TR8_SCR);
    const int per = (K / 128) * (N / 32); const int total = per * nmat;
    for (int it = C.gw; it < total; it += C.ngw) { const int mat = it / per, item = it % per;
        transpose_item_fp8(W + (size_t)mat * K * N, K, N, WT + (size_t)mat * K * N, mode, wscale, scr, item, C.lane); }
}
__device__ __forceinline__ void transpose_job(const Ctx& C, const float* W, bf16* WT, int K, int N, int mode, int nmat) {
    LAS float* scr = (LAS float*)(C.lds + RING_OFF + C.wave * TR8_SCR);
    const int per = (K / 64) * (N / 64); const int total = per * nmat;
    for (int it = C.gw; it < total; it += C.ngw) { const int mat = it / per, item = it % per;
        transpose_item(W + (size_t)mat * K * N, K, N, WT + (size_t)mat * K * N, mode, scr, item, C.lane); }
}
__device__ __forceinline__ void rmsnorm_rows(const Ctx& C, const float* x, const float* g, bf16* out) {
    f32x4 gg[4];
#pragma unroll
    for (int j = 0; j < 4; ++j) gg[j] = ((const f32x4*)g)[64 * j + C.lane];
    f32x4 vn[4]; int m = C.gw;
    if (m < T) { const f32x4* xr = (const f32x4*)(x + (size_t)m * DM) + C.lane;
#pragma unroll
        for (int j = 0; j < 4; ++j) vn[j] = xr[64 * j]; }
    for (; m < T; m += C.ngw) {
        f32x4 v[4]; float s = 0.f;
#pragma unroll
        for (int j = 0; j < 4; ++j) { v[j] = vn[j]; s += (v[j].x * v[j].x + v[j].y * v[j].y) + (v[j].z * v[j].z + v[j].w * v[j].w); }
        if (m + C.ngw < T) { const f32x4* xr = (const f32x4*)(x + (size_t)(m + C.ngw) * DM) + C.lane;
#pragma unroll
            for (int j = 0; j < 4; ++j) vn[j] = xr[64 * j]; }
        const float rs = rsqrtf(wave_sum(s) * (1.f / DM) + EPS);
        unsigned long long* o8 = (unsigned long long*)(out + (size_t)m * DM) + C.lane;
#pragma unroll
        for (int j = 0; j < 4; ++j) o8[64 * j] = (unsigned long long)pk2(v[j].x * rs * gg[j].x, v[j].y * rs * gg[j].y) | ((unsigned long long)pk2(v[j].z * rs * gg[j].z, v[j].w * rs * gg[j].w) << 32);
    }
}
typedef short rt_bf16x8 __attribute__((ext_vector_type(8)));
typedef float rt_f32x2 __attribute__((ext_vector_type(2))); typedef __bf16 rt_bf16x2 __attribute__((ext_vector_type(2)));
__device__ __forceinline__ unsigned rt_cvtpk(float lo, float hi) { rt_f32x2 v = {lo, hi}; rt_bf16x2 b = __builtin_convertvector(v, rt_bf16x2); return __builtin_bit_cast(unsigned, b); }
__device__ __forceinline__ void rt_split8(const float (&x)[8], rt_bf16x8& hi, rt_bf16x8& lo) {
    v4u h, l;
#pragma unroll
    for (int i = 0; i < 4; ++i) { const unsigned hb = rt_cvtpk(x[2 * i], x[2 * i + 1]); h[i] = hb;
        const float r0 = x[2 * i] - __uint_as_float(hb << 16), r1 = x[2 * i + 1] - __uint_as_float(hb & 0xffff0000u); l[i] = rt_cvtpk(r0, r1); }
    hi = __builtin_bit_cast(rt_bf16x8, h); lo = __builtin_bit_cast(rt_bf16x8, l);
}
constexpr int HN_PITCH = 1032;
__device__ __forceinline__ void router_pass(const Ctx& C, const float* x1, const float* g2, const float* w_router, const float* b_router, unsigned char* h2, float* top_w, int* list, int* apos, unsigned* ctl) {
    LAS float* HN = (LAS float*)(C.lds + RING_OFF); LAS float* PART = HN + 16 * HN_PITCH; LAS float* LOG = PART + 8 * 16 * 32; LAS unsigned* HIST = (LAS unsigned*)(LOG + 16 * 32); LAS unsigned* BASE = HIST + 32; LAS unsigned* RK = BASE + 32;
    LAS unsigned char* EIDS = (LAS unsigned char*)(RK + 32);
    int tid = C.tid; asm volatile("" : "+v"(tid));
    const int lane = tid & 63, wave = C.wave, fr = lane & 15, fq = lane >> 4;
    rt_bf16x8 bhi[4][2], blo[4][2];
#pragma unroll
    for (int ks = 0; ks < 4; ++ks)
#pragma unroll
        for (int nt = 0; nt < 2; ++nt) { float x[8];
#pragma unroll
            for (int j = 0; j < 8; ++j) x[j] = w_router[(size_t)(128 * wave + 32 * ks + 8 * fq + j) * NE + 16 * nt + fr];
            rt_split8(x, bhi[ks][nt], blo[ks][nt]); }
    const float bias = b_router[tid & 31];
    if (tid < 32) HIST[tid] = 0u;
    __syncthreads();
    int nrounds = 0;
    f32x4 vn[2][4];
    if (C.vcu < T / 16) {
#pragma unroll
        for (int q = 0; q < 2; ++q) { const f32x4* xr = (const f32x4*)(x1 + (size_t)(C.vcu * 16 + 2 * wave + q) * DM) + lane;
#pragma unroll
            for (int j = 0; j < 4; ++j) vn[q][j] = xr[64 * j]; } }
    for (int grp = C.vcu; grp < T / 16; grp += C.G, ++nrounds) {
        f32x4 v[2][4];
#pragma unroll
        for (int q = 0; q < 2; ++q)
#pragma unroll
            for (int j = 0; j < 4; ++j) v[q][j] = vn[q][j];
        if (grp + C.G < T / 16) {
#pragma unroll
            for (int q = 0; q < 2; ++q) { const f32x4* xr = (const f32x4*)(x1 + (size_t)((grp + C.G) * 16 + 2 * wave + q) * DM) + lane;
#pragma unroll
                for (int j = 0; j < 4; ++j) vn[q][j] = xr[64 * j]; } }
#pragma unroll
        for (int q = 0; q < 2; ++q) { const int tl = 2 * wave + q; float s = 0.f;
#pragma unroll
            for (int j = 0; j < 4; ++j) s += (v[q][j].x * v[q][j].x + v[q][j].y * v[q][j].y) + (v[q][j].z * v[q][j].z + v[q][j].w * v[q][j].w);
            const float rs = rsqrtf(wave_sum(s) * (1.f / DM) + EPS);
            int* o4 = (int*)(h2 + (size_t)(grp * 16 + tl) * DM) + lane;
#pragma unroll
            for (int j = 0; j < 4; ++j) { const f32x4 gg = ((const f32x4*)g2)[64 * j + lane];
                const f32x4 y = (f32x4){v[q][j].x * rs * gg.x, v[q][j].y * rs * gg.y, v[q][j].z * rs * gg.z, v[q][j].w * rs * gg.w};
                *(LAS f32x4*)(HN + tl * HN_PITCH + 256 * j + 4 * lane) = y;
                int w = __builtin_amdgcn_cvt_pk_fp8_f32(y.x, y.y, 0, false); w = __builtin_amdgcn_cvt_pk_fp8_f32(y.z, y.w, w, true); o4[64 * j] = w; } }
        __syncthreads();
        { pg8::f32x4 acc0 = {0.f, 0.f, 0.f, 0.f}, acc1 = {0.f, 0.f, 0.f, 0.f};
          const LAS float* hb = HN + fr * HN_PITCH + 128 * wave + 8 * fq;
#pragma unroll
          for (int ks = 0; ks < 4; ++ks) { const f32x4 p0 = *(const LAS f32x4*)(hb + 32 * ks), p1 = *(const LAS f32x4*)(hb + 32 * ks + 4);
              const float x[8] = {p0.x, p0.y, p0.z, p0.w, p1.x, p1.y, p1.z, p1.w}; rt_bf16x8 ahi, alo; rt_split8(x, ahi, alo);
              acc0 = __builtin_amdgcn_mfma_f32_16x16x32_bf16(ahi, bhi[ks][0], acc0, 0, 0, 0); acc1 = __builtin_amdgcn_mfma_f32_16x16x32_bf16(ahi, bhi[ks][1], acc1, 0, 0, 0);
              acc0 = __builtin_amdgcn_mfma_f32_16x16x32_bf16(ahi, blo[ks][0], acc0, 0, 0, 0); acc1 = __builtin_amdgcn_mfma_f32_16x16x32_bf16(ahi, blo[ks][1], acc1, 0, 0, 0);
              acc0 = __builtin_amdgcn_mfma_f32_16x16x32_bf16(alo, bhi[ks][0], acc0, 0, 0, 0); acc1 = __builtin_amdgcn_mfma_f32_16x16x32_bf16(alo, bhi[ks][1], acc1, 0, 0, 0); }
          LAS float* pp = PART + (wave * 16 + 4 * fq) * 32 + fr;
#pragma unroll
          for (int r = 0; r < 4; ++r) { pp[r * 32] = acc0[r]; pp[r * 32 + 16] = acc1[r]; } }
        __syncthreads();
        { float a = bias;
#pragma unroll
          for (int w8 = 0; w8 < 8; ++w8) a += PART[(w8 * 16 + (tid >> 5)) * 32 + (tid & 31)];
          LOG[tid] = a; }
        __syncthreads();
        if (lane < 2) { const int tl = 2 * wave + lane; float lg[32];
#pragma unroll
            for (int i = 0; i < 8; ++i) { const f32x4 t4 = *(const LAS f32x4*)(LOG + tl * 32 + 4 * i); lg[4 * i] = t4.x; lg[4 * i + 1] = t4.y; lg[4 * i + 2] = t4.z; lg[4 * i + 3] = t4.w; }
            float tv[4]; int ti[4];
#pragma unroll
            for (int k = 0; k < 4; ++k) { float mx = lg[0]; int mi = 0;
#pragma unroll
                for (int i = 1; i < 32; ++i) { const bool gt = lg[i] > mx; mx = gt ? lg[i] : mx; mi = gt ? i : mi; }
                tv[k] = mx; ti[k] = mi;
#pragma unroll
                for (int i = 0; i < 32; ++i) lg[i] = (i == mi) ? -INFINITY : lg[i]; }
            const float e1 = __expf(tv[1] - tv[0]), e2 = __expf(tv[2] - tv[0]), e3 = __expf(tv[3] - tv[0]); const float inv = 1.f / (1.f + e1 + e2 + e3);
            *(f32x4*)(top_w + (size_t)(grp * 16 + tl) * 4) = (f32x4){inv, e1 * inv, e2 * inv, e3 * inv};
#pragma unroll
            for (int k = 0; k < 4; ++k) { EIDS[(nrounds * 16 + tl) * 4 + k] = (unsigned char)ti[k]; __hip_atomic_fetch_add(HIST + ti[k], 1u, __ATOMIC_RELAXED, __HIP_MEMORY_SCOPE_WORKGROUP); } }
    }
    __syncthreads();
    if (tid < 32) { BASE[tid] = atomicAdd(ctl + CW_CNT + tid, HIST[tid]); RK[tid] = 0u; }
    __syncthreads();
    for (int idx = tid; idx < nrounds * 64; idx += 512) { const int ei = EIDS[idx]; const unsigned rank = __hip_atomic_fetch_add(RK + ei, 1u, __ATOMIC_RELAXED, __HIP_MEMORY_SCOPE_WORKGROUP);
        const int r = idx >> 6, tl = (idx >> 2) & 15, k = idx & 3, a = ((C.vcu + r * C.G) * 16 + tl) * 4 + k; const int slot = (int)(BASE[ei] + rank); list[(size_t)ei * T + slot] = a; apos[a] = (ei << 20) | slot; }
    __syncthreads();
}
__device__ __forceinline__ int grouped_tables(const Ctx& C, const unsigned* ctl) {
    LAS int* cnt = (LAS int*)(C.lds + GT_OFF); LAS int* pref = cnt + 32; LAS unsigned char* tile_e = (LAS unsigned char*)(pref + 36);
    if (C.wave == 0) {
        const int e = C.lane & 31; const int c = (int)__hip_atomic_load(ctl + CW_CNT + e, RLX_AGENT); const int n = (c + 255) >> 8;
        int incl = n;
#pragma unroll
        for (int o = 1; o < 32; o <<= 1) { const int t = __shfl_up(incl, o, 32); if (e >= o) incl += t; }
        const int start = incl - n;
        if (C.lane < 32) { cnt[e] = c; pref[e] = start; if (e == 31) pref[32] = incl; for (int i = 0; i < n; ++i) tile_e[start + i] = (unsigned char)e; }
    }
    __syncthreads();
    return pref[NE];
}
__device__ __forceinline__ void combine_pass(const Ctx& C, float* out, const unsigned char* ys, const float* top_w, const int* apos) {
    const LAS int* pref = (const LAS int*)(C.lds + GT_OFF) + 32;
    const int lane = C.lane;
    int4 apn[2];
    if (C.gw < T / 2) { apn[0] = *(const int4*)(apos + (size_t)(2 * C.gw) * 4); apn[1] = *(const int4*)(apos + (size_t)(2 * C.gw + 1) * 4); }
    for (int pr = C.gw; pr < T / 2; pr += C.ngw) {
        const int4 ap[2] = {apn[0], apn[1]};
        if (pr + C.ngw < T / 2) { apn[0] = *(const int4*)(apos + (size_t)(2 * (pr + C.ngw)) * 4); apn[1] = *(const int4*)(apos + (size_t)(2 * (pr + C.ngw) + 1) * 4); }
        f32x4 acc[2][4]; v4u yv[2][4]; f32x4 wv4[2];
#pragma unroll
        for (int t = 0; t < 2; ++t) { const int tok = 2 * pr + t;
            const f32x4* o = (const f32x4*)(out + (size_t)tok * DM) + 4 * lane;
#pragma unroll
            for (int j = 0; j < 4; ++j) acc[t][j] = o[j];
            wv4[t] = *(const f32x4*)(top_w + (size_t)tok * 4);
#pragma unroll
            for (int k = 0; k < 4; ++k) { const int p = k == 0 ? ap[t].x : k == 1 ? ap[t].y : k == 2 ? ap[t].z : ap[t].w; const int srow = pref[p >> 20] * 256 + (p & 0xFFFFF);
                yv[t][k] = *(const v4u*)(ys + (size_t)srow * DM + 16 * lane); } }
#pragma unroll
        for (int t = 0; t < 2; ++t) { f32x4* o = (f32x4*)(out + (size_t)(2 * pr + t) * DM) + 4 * lane;
#pragma unroll
            for (int k = 0; k < 4; ++k) { const float wv = wv4[t][k];
#pragma unroll
                for (int j = 0; j < 4; ++j) { const unsigned w = yv[t][k][j];
                    const auto lo2 = __builtin_amdgcn_cvt_pk_f32_fp8((int)w, false), hi2 = __builtin_amdgcn_cvt_pk_f32_fp8((int)w, true);
                    acc[t][j].x += wv * lo2[0]; acc[t][j].y += wv * lo2[1]; acc[t][j].z += wv * hi2[0]; acc[t][j].w += wv * hi2[1]; } }
#pragma unroll
            for (int j = 0; j < 4; ++j) o[j] = acc[t][j]; }
    }
}

namespace att {
using bf16x8 = __attribute__((ext_vector_type(8))) short;
using s16x4 = __attribute__((ext_vector_type(4))) short;
using f32x16 = __attribute__((ext_vector_type(16))) float;
using u32x4 = __attribute__((ext_vector_type(4))) unsigned;
typedef float f32x2_t __attribute__((ext_vector_type(2))); typedef __bf16 bf16x2_t __attribute__((ext_vector_type(2)));
constexpr float LOG2E = 1.4426950408889634f, QSCALE = 0.125f * LOG2E;
constexpr int SLOTB = 8192, NSLOT = 4;
constexpr int L_K = 0, L_V = NSLOT * SLOTB, L_WS = 2 * NSLOT * SLOTB, L_OST = L_WS + 8 * 256, L_BYTES = L_OST + 8 * 4096;
__device__ __forceinline__ int crow(int r, int hi) { return (r & 3) + 8 * (r >> 2) + 4 * hi; }
__device__ __forceinline__ void glds16(const void* gsrc, unsigned lds_dst) { unsigned keep;
    asm volatile("s_mov_b32 %0, m0\n\ts_mov_b32 m0, %2\n\ts_nop 0\n\tglobal_load_lds_dwordx4 %1, off\n\ts_mov_b32 m0, %0" : "=&s"(keep) : "v"(gsrc), "s"(lds_dst) : "memory"); }
__device__ __forceinline__ unsigned cvtpk_s(float lo, float hi) { f32x2_t v = {lo, hi}; bf16x2_t b = __builtin_convertvector(v, bf16x2_t); return __builtin_bit_cast(unsigned, b); }
typedef __attribute__((address_space(3))) const char* lds_cptr;
__device__ __forceinline__ void qkt_half(f32x16& p, lds_cptr kb, const bf16x8* qr) {
    const f32x16 z = f32x16{};
#pragma unroll
    for (int d0 = 0; d0 < 4; ++d0) {
        const bf16x8 b0 = *(const __attribute__((address_space(3))) bf16x8*)(kb + d0 * 2048);
        p = __builtin_amdgcn_mfma_f32_32x32x16_bf16(b0, qr[d0], d0 == 0 ? z : p, 0, 0, 0); }
}
__device__ __forceinline__ void pv_half(f32x16* o, int vb, bf16x8 pa0, bf16x8 pa1) {
#pragma unroll
    for (int d0 = 0; d0 < 2; ++d0) { s16x4 lo[2], hi[2];
#pragma unroll
        for (int ks = 0; ks < 2; ++ks) {
            asm volatile("ds_read_b64_tr_b16 %0,%1 offset:%c2" : "=&v"(lo[ks]) : "v"(vb), "i"(d0 * 4096 + ks * 1024) : "memory");
            asm volatile("ds_read_b64_tr_b16 %0,%1 offset:%c2" : "=&v"(hi[ks]) : "v"(vb), "i"(d0 * 4096 + ks * 1024 + 512) : "memory"); }
        asm volatile("s_waitcnt lgkmcnt(0)" ::: "memory"); __builtin_amdgcn_sched_barrier(0);
#define ATT_PK(k) (bf16x8){lo[k][0], lo[k][1], lo[k][2], lo[k][3], hi[k][0], hi[k][1], hi[k][2], hi[k][3]}
        o[d0] = __builtin_amdgcn_mfma_f32_32x32x16_bf16(pa0, ATT_PK(0), o[d0], 0, 0, 0);
        o[d0] = __builtin_amdgcn_mfma_f32_32x32x16_bf16(pa1, ATT_PK(1), o[d0], 0, 0, 0);
#undef ATT_PK
    }
}
__device__ __forceinline__ void dma_tile(const bf16* proj, int b, int kvh, int ti, unsigned lds0, int wid, int lane) {
    const unsigned slot = (unsigned)((ti + 2) & 3) * SLOTB;
    int kr = 64 * ti + lane; kr = kr < 0 ? 0 : kr;
    int vr = 64 * ti + 16 * (wid & 3) + (lane >> 2); vr = vr < 0 ? 0 : vr;
    const bf16* ksrc = proj + (size_t)(b * SEQ + kr) * IN_W + C_K + kvh * 64 + wid * 8;
    const bf16* vsrc = proj + (size_t)(b * SEQ + vr) * IN_W + C_V + kvh * 64 + (wid >> 2) * 32 + (lane & 3) * 8;
    glds16(ksrc, (unsigned)__builtin_amdgcn_readfirstlane(lds0 + L_K + slot + wid * 1024));
    glds16(vsrc, (unsigned)__builtin_amdgcn_readfirstlane(lds0 + L_V + slot + wid * 1024));
}
#define ATT_WAIT_BAR() asm volatile("s_waitcnt vmcnt(0) lgkmcnt(0)\n\ts_barrier" ::: "memory")
__device__ __forceinline__ void attn_run(int b, int kvh, int qb0, int nqb, const bf16* proj, const float* sinks, bf16* O, LAS unsigned char* shm) {
    const int tid = threadIdx.x, lane = tid & 63, r32 = lane & 31, hi = lane >> 5; const int wid = __builtin_amdgcn_readfirstlane(tid >> 6);
    const int h = kvh * 4 + (wid & 3), sub = wid >> 2;
    const unsigned lds0 = (unsigned)(uintptr_t)shm;
    LAS float* wsf = (LAS float*)(shm + L_WS) + wid * 64;
    const lds_cptr shm3 = (lds_cptr)shm;
    const int vb0 = (int)(lds0 + L_V) + ((lane >> 4) & 1) * 32 + (lane & 3) * 8 + (4 * hi + ((lane & 15) >> 2)) * 64;
    const float slope2 = exp2f(-0.5f * (float)(h + 1)) * LOG2E, sink2 = sinks[h] * LOG2E;
    dma_tile(proj, b, kvh, qb0 - 2, lds0, wid, lane); dma_tile(proj, b, kvh, qb0 - 1, lds0, wid, lane); dma_tile(proj, b, kvh, qb0, lds0, wid, lane);
    const bf16* Qw = proj + (size_t)(b * SEQ + qb0 * 64 + 32 * sub + r32) * IN_W + C_Q + h * 64 + hi * 8;
    bf16x8 qn[4];
#pragma unroll
    for (int d0 = 0; d0 < 4; ++d0) qn[d0] = *(const bf16x8*)(Qw + d0 * 16);
    for (int qi = 0; qi < nqb; ++qi) {
        const int qb = qb0 + qi, tq0 = qb * 64 + 32 * sub;
        bf16x8 qr[4];
#pragma unroll
        for (int d0 = 0; d0 < 4; ++d0) qr[d0] = qn[d0];
        ATT_WAIT_BAR();
        if (qi + 1 < nqb) dma_tile(proj, b, kvh, qb + 1, lds0, wid, lane);
        f32x16 p[5];
#pragma unroll
        for (int i = 0; i < 5; ++i) { const int g = i + sub; qkt_half(p[i], shm3 + L_K + ((qb + (g >> 1)) & 3) * SLOTB + (g & 1) * 512 + hi * 1024 + r32 * 16, qr); }
        if (qi + 1 < nqb) {
#pragma unroll
            for (int d0 = 0; d0 < 4; ++d0) qn[d0] = *(const bf16x8*)(Qw + (size_t)(64 * (qi + 1)) * IN_W + d0 * 16); }
        float dbase = (float)(128 + r32 - 4 * hi); asm volatile("" : "+v"(dbase));
        const float dmax = (float)(tq0 + r32);
#pragma unroll
        for (int i = 0; i < 5; ++i)
#pragma unroll
            for (int r = 0; r < 16; ++r) { const float d = dbase - (float)(32 * i + (r & 3) + 8 * (r >> 2));
                float v = p[i][r] - slope2 * d;
                if (i == 0) v = (d < 128.f) ? v : -INFINITY;
                if (i == 4) v = (d >= 0.f) ? v : -INFINITY;
                p[i][r] = v; }
        if (qb < 2) {
#pragma unroll
            for (int i = 0; i < 5; ++i)
#pragma unroll
                for (int r = 0; r < 16; ++r) { const float d = dbase - (float)(32 * i + (r & 3) + 8 * (r >> 2)); p[i][r] = (d <= dmax) ? p[i][r] : -INFINITY; } }
        float mx = -INFINITY;
#pragma unroll
        for (int i = 0; i < 5; ++i)
#pragma unroll
            for (int r = 0; r < 16; ++r) mx = fmaxf(mx, p[i][r]);
        { auto rr = __builtin_amdgcn_permlane32_swap(__float_as_uint(mx), __float_as_uint(mx), false, false); mx = fmaxf(__uint_as_float(rr[0]), __uint_as_float(rr[1])); }
        mx = fmaxf(mx, sink2);
        float ls = 0.f;
        f32x16 o[2]; o[0] = f32x16{}; o[1] = f32x16{};
#pragma unroll
        for (int i = 0; i < 5; ++i) { const int g = i + sub;
#pragma unroll
            for (int r = 0; r < 16; ++r) { const float e = __builtin_amdgcn_exp2f(p[i][r] - mx); p[i][r] = e; ls += e; }
            u32x4 pw0, pw1;
#define ATT_PKW(P, B) cvtpk_s(P[B], P[B + 1])
            pw0 = (u32x4){ATT_PKW(p[i], 0), ATT_PKW(p[i], 2), ATT_PKW(p[i], 4), ATT_PKW(p[i], 6)}; pw1 = (u32x4){ATT_PKW(p[i], 8), ATT_PKW(p[i], 10), ATT_PKW(p[i], 12), ATT_PKW(p[i], 14)};
#undef ATT_PKW
            __builtin_amdgcn_sched_barrier(0);
            pv_half(o, vb0 + ((qb + (g >> 1)) & 3) * SLOTB + (g & 1) * 2048, __builtin_bit_cast(bf16x8, pw0), __builtin_bit_cast(bf16x8, pw1));
        }
        { auto rr = __builtin_amdgcn_permlane32_swap(__float_as_uint(ls), __float_as_uint(ls), false, false); ls = __uint_as_float(rr[0]) + __uint_as_float(rr[1]); }
        ls += __builtin_amdgcn_exp2f(sink2 - mx);
        if (hi == 0) wsf[32 + r32] = ls;
        asm volatile("s_waitcnt lgkmcnt(0)" ::: "memory");
        float rli[16];
#pragma unroll
        for (int r = 0; r < 16; ++r) rli[r] = __builtin_amdgcn_rcpf(wsf[32 + crow(r, hi)]);
        bf16* Ow = O + (size_t)(b * SEQ + tq0) * 1024 + h * 64;
        { LAS bf16* stg = (LAS bf16*)(shm + L_OST) + wid * 2048;
#pragma unroll
            for (int r = 0; r < 16; ++r) { const int orow = crow(r, hi);
#pragma unroll
                for (int d0 = 0; d0 < 2; ++d0) stg[orow * 64 + d0 * 32 + r32] = (bf16)f2bf(o[d0][r] * rli[r]); }
            asm volatile("s_waitcnt lgkmcnt(0)" ::: "memory");
#pragma unroll
            for (int i = 0; i < 4; ++i) { const int row = i * 8 + (lane >> 3), ch = lane & 7; const u32x4 v = *(const LAS u32x4*)(stg + row * 64 + ch * 8); *(u32x4*)(Ow + (size_t)row * 1024 + ch * 8) = v; } }
    }
    ATT_WAIT_BAR();
}
#undef ATT_WAIT_BAR
}

namespace s5 {
using bf16x8 = __attribute__((ext_vector_type(8))) short;
using f32x16 = __attribute__((ext_vector_type(16))) float;
struct cf { float re, im; };
__device__ __forceinline__ cf cmul(cf a, cf b) { return cf{a.re * b.re - a.im * b.im, a.re * b.im + a.im * b.re}; }
__device__ __forceinline__ cf cfma(cf a, cf b, cf c) { return cf{c.re + a.re * b.re - a.im * b.im, c.im + a.re * b.im + a.im * b.re}; }
__device__ __forceinline__ int crow(int r, int hi) { return (r & 3) + 8 * (r >> 2) + 4 * hi; }
__device__ __forceinline__ bf16x8 ldg16(const bf16* ubase, unsigned lane_off) { return *(const bf16x8*)((const char*)ubase + lane_off); }
constexpr size_t BT_G = 128 * 256, KT_G = 16 * 16 * 16, CT_G = 256 * 128;
constexpr int IMG_STRIDE = 136;
constexpr int L_IMG = 0, L_T = 8 * 32 * IMG_STRIDE * 2, L_BYTES = L_T + 8 * 2 * 2 * 32 * 4;

__device__ __forceinline__ void build_tables(int g, int part, const float* a_re, const float* a_im, const float* log_dt, const float* b_re, const float* b_im, const float* c_re, const float* c_im, const float* d_skip,
                                             bf16* Btab, bf16* Ktab, bf16* Ctab, float* A16tab, LAS unsigned char* scr, int tid) {
    LAS double* LA = (LAS double*)scr; LAS double* TH = LA + 64;
    LAS float* bbr = (LAS float*)(scr + 1024); LAS float* bbi = bbr + 1024;
    LAS float* pwr = bbi + 1024; LAS float* pwi = pwr + 17 * 64;
    LAS float* ccr = pwi + 17 * 64; LAS float* cci = ccr + 1024;
    for (int e = tid; e < 1024; e += 512) { ccr[e] = c_re[(size_t)g * 1024 + e]; cci[e] = c_im[(size_t)g * 1024 + e]; }
    if (tid < 64) { const int i = g * NP + tid;
        const double dt = exp((double)log_dt[g]), are = a_re[i], aim = a_im[i];
        const double la = are * dt, th = aim * dt, mag = exp(la), abr = mag * cos(th), abi = mag * sin(th), den = are * are + aim * aim, em1 = abr - 1.0;
        const double qre = (em1 * are + abi * aim) / den, qim = (abi * are - em1 * aim) / den;
        LA[tid] = la; TH[tid] = th;
        for (int h = 0; h < GCH; ++h) { const double br = b_re[i * GCH + h], bi = b_im[i * GCH + h]; bbr[tid * 16 + h] = (float)(qre * br - qim * bi); bbi[tid * 16 + h] = (float)(qre * bi + qim * br); } }
    __syncthreads();
    for (int e = tid; e < 17 * 64; e += 512) { const int n = e >> 6, p = e & 63; const double m = exp((double)n * LA[p]), t = (double)n * TH[p]; pwr[e] = (float)(m * cos(t)); pwi[e] = (float)(m * sin(t)); }
    __syncthreads();
    if (part == 0 && tid < 64) { A16tab[(g * 64 + tid) * 2] = pwr[16 * 64 + tid]; A16tab[(g * 64 + tid) * 2 + 1] = pwi[16 * 64 + tid]; }
    for (int e = tid; e < 32 * 256; e += 512) { const int pl = e >> 8, k = e & 255, j = k >> 4, hp = k & 15, pp = 32 * part + pl, p = pp & 63;
        const float wr = pwr[(15 - j) * 64 + p], wi = pwi[(15 - j) * 64 + p], br = bbr[p * 16 + hp], bi = bbi[p * 16 + hp];
        const float v = (pp < 64) ? (wr * br - wi * bi) : (wr * bi + wi * br);
        Btab[(size_t)g * BT_G + (size_t)pp * 256 + k] = (bf16)f2bf(v); }
    for (int e = tid; e < 64 * 128; e += 512) { const int nl = e >> 7, pp = e & 127, n = 64 * part + nl, i = n >> 4, h = n & 15, p = pp & 63;
        const float cr = ccr[h * NP + p], ci = cci[h * NP + p], wr = pwr[(i + 1) * 64 + p], wi = pwi[(i + 1) * 64 + p];
        const float v = (pp < 64) ? (cr * wr - ci * wi) : -(cr * wi + ci * wr);
        Ctab[(size_t)g * CT_G + (size_t)n * 128 + pp] = (bf16)f2bf(v); }
    for (int e = tid; e < 4 * 256; e += 512) { const int d = 4 * part + (e >> 8), h = (e >> 4) & 15, hp = e & 15; float acc = 0.f;
#pragma unroll 8
        for (int p = 0; p < 64; ++p) { const float cr = ccr[h * NP + p], ci = cci[h * NP + p], wr = pwr[d * 64 + p], wi = pwi[d * 64 + p], br = bbr[p * 16 + hp], bi = bbi[p * 16 + hp];
            const float tr = wr * br - wi * bi, ti = wr * bi + wi * br; acc += cr * tr - ci * ti; }
        if (d == 0 && h == hp) acc += d_skip[g * 16 + h];
        Ktab[(size_t)g * KT_G + (size_t)(d * 16 + h) * 16 + hp] = (bf16)f2bf(acc); }
    __syncthreads();
}

__device__ __forceinline__ void scan_local(f32x16& re, f32x16& im, const cf p1, const cf p4, const int hi, cf (&em)[4], cf& T) {
#pragma unroll
    for (int q = 0; q < 4; ++q)
#pragma unroll
        for (int k = 1; k < 4; ++k) { const int r = 4 * q + k; const cf v = cfma(p1, cf{re[r - 1], im[r - 1]}, cf{re[r], im[r]}); re[r] = v.re; im[r] = v.im; }
    cf E = cf{0.f, 0.f};
#pragma unroll
    for (int q = 0; q < 4; ++q) {
        auto sr = __builtin_amdgcn_permlane32_swap(__float_as_uint(re[4 * q + 3]), __float_as_uint(re[4 * q + 3]), false, false);
        auto si = __builtin_amdgcn_permlane32_swap(__float_as_uint(im[4 * q + 3]), __float_as_uint(im[4 * q + 3]), false, false);
        const cf elo = cf{__uint_as_float(sr[0]), __uint_as_float(si[0])}, ehi = cf{__uint_as_float(sr[1]), __uint_as_float(si[1])};
        const cf Elo = E; E = cfma(p4, E, elo); const cf Ehi = E; E = cfma(p4, E, ehi);
        em[q] = hi ? Ehi : Elo; }
    T = E;
}
__device__ __forceinline__ void scan_finish(f32x16& re, f32x16& im, const cf p1, const cf p2, const cf p3, const cf p4, const cf g2, const int hi, const cf (&em)[4], const cf X) {
    cf cur = hi ? p4 : cf{1.f, 0.f};
#pragma unroll
    for (int q = 0; q < 4; ++q) { const cf carry = cfma(cur, X, em[q]); cur = cmul(cur, g2);
        cf v;
        v = cfma(p1, carry, cf{re[4 * q + 0], im[4 * q + 0]}); re[4 * q + 0] = v.re; im[4 * q + 0] = v.im;
        v = cfma(p2, carry, cf{re[4 * q + 1], im[4 * q + 1]}); re[4 * q + 1] = v.re; im[4 * q + 1] = v.im;
        v = cfma(p3, carry, cf{re[4 * q + 2], im[4 * q + 2]}); re[4 * q + 2] = v.re; im[4 * q + 2] = v.im;
        v = cfma(p4, carry, cf{re[4 * q + 3], im[4 * q + 3]}); re[4 * q + 3] = v.re; im[4 * q + 3] = v.im; }
}

__device__ __forceinline__ void glds16(const void* gsrc, unsigned lds_dst) { unsigned keep;
    asm volatile("s_mov_b32 %0, m0\n\ts_mov_b32 m0, %2\n\ts_nop 0\n\tglobal_load_lds_dwordx4 %1, off\n\ts_mov_b32 m0, %0" : "=&s"(keep) : "v"(gsrc), "s"(lds_dst) : "memory"); }
constexpr int L_TAB = 0, L_TABK = 65536, L_IMG2 = 73728, L_T2 = L_IMG2 + 8 * 32 * IMG_STRIDE * 2, L_BYTES2 = L_T2 + 4096;

__device__ __forceinline__ void s5_unit(int b, int g, const bf16* proj, const bf16* Btab, const bf16* Ktab, const bf16* Ctab, const float* A16tab, bf16* out, LAS unsigned char* shm) {
    int tid = threadIdx.x; asm volatile("" : "+v"(tid));
    const int lane = tid & 63, col = lane & 31, hi = lane >> 5; const int wid = __builtin_amdgcn_readfirstlane(tid >> 6);
    const unsigned lds0 = (unsigned)(uintptr_t)shm;
    { const char* src = (const char*)(Btab + (size_t)g * BT_G);
#pragma unroll
      for (int i = 0; i < 8; ++i) { const int p = wid * 8 + i, row = 2 * p + (lane >> 5), c = (lane & 31) ^ (row & 31);
          glds16(src + row * 512 + c * 16, (unsigned)__builtin_amdgcn_readfirstlane(lds0 + L_TAB + p * 1024)); } }
    const bf16* ub = proj + ((size_t)g * T + (size_t)(b * SEQ + 512 * wid)) * 16;
    const unsigned uoff = (unsigned)(col * 512 + hi * 16);
    bf16x8 ua[16];
#pragma unroll
    for (int j = 0; j < 16; ++j) ua[j] = ldg16(ub + (size_t)j * 16, uoff);
    asm volatile("s_waitcnt vmcnt(0)" ::: "memory"); __syncthreads();
    const LAS unsigned char* tb = shm + L_TAB; const unsigned a0 = (unsigned)(col * 512) | (unsigned)(((hi * 16) ^ (col * 16)));
    f32x16 zt[4];
#pragma unroll
    for (int nt = 0; nt < 4; ++nt) zt[nt] = f32x16{};
#pragma unroll
    for (int j = 0; j < 16; ++j) { const bf16x8 uj = ua[j]; const unsigned aj = a0 ^ (unsigned)(j * 32);
#pragma unroll
        for (int nt = 0; nt < 4; ++nt) { const bf16x8 bfr = *(const LAS bf16x8*)(tb + aj + nt * 16384); zt[nt] = __builtin_amdgcn_mfma_f32_32x32x16_bf16(uj, bfr, zt[nt], 0, 0, 0); } }
    LAS float* Tb = (LAS float*)(shm + L_T2);
    LAS bf16* img = (LAS bf16*)(shm + L_IMG2) + wid * 32 * IMG_STRIDE;
    {
        cf P1[2], P2[2], P3[2], P4[2], G2[2], EM[2][4], TT[2];
#pragma unroll
        for (int s = 0; s < 2; ++s) { const float2 a = ((const float2*)A16tab)[g * 64 + 32 * s + col]; P1[s] = cf{a.x, a.y}; P2[s] = cmul(P1[s], P1[s]); P3[s] = cmul(P2[s], P1[s]); P4[s] = cmul(P2[s], P2[s]); G2[s] = cmul(P4[s], P4[s]); }
        scan_local(zt[0], zt[2], P1[0], P4[0], hi, EM[0], TT[0]);
        scan_local(zt[1], zt[3], P1[1], P4[1], hi, EM[1], TT[1]);
        if (hi == 0) {
#pragma unroll
            for (int s = 0; s < 2; ++s) { Tb[((wid * 2 + s) * 2 + 0) * 32 + col] = TT[s].re; Tb[((wid * 2 + s) * 2 + 1) * 32 + col] = TT[s].im; } }
        asm volatile("s_waitcnt lgkmcnt(0)" ::: "memory"); __syncthreads();
        { const char* src = (const char*)(Ctab + (size_t)g * CT_G);
#pragma unroll
          for (int i = 0; i < 8; ++i) { const int p = wid * 8 + i, row = 4 * p + (lane >> 4), c = (lane & 15) ^ (row & 15);
              glds16(src + row * 256 + c * 16, (unsigned)__builtin_amdgcn_readfirstlane(lds0 + L_TAB + p * 1024)); }
          glds16((const char*)(Ktab + (size_t)g * KT_G) + wid * 1024 + lane * 16, (unsigned)__builtin_amdgcn_readfirstlane(lds0 + L_TABK + wid * 1024)); }
#pragma unroll
        for (int j = 0; j < 16; ++j) ua[j] = ldg16(ub + (size_t)j * 16, uoff);
#pragma unroll
        for (int s = 0; s < 2; ++s) {
            const cf g4 = cmul(G2[s], G2[s]), g8 = cmul(g4, g4);
            cf X = cf{0.f, 0.f};
            for (int v = 0; v < wid; ++v) X = cfma(g8, X, cf{Tb[((v * 2 + s) * 2 + 0) * 32 + col], Tb[((v * 2 + s) * 2 + 1) * 32 + col]});
            scan_finish(zt[s], zt[2 + s], P1[s], P2[s], P3[s], P4[s], G2[s], hi, EM[s], X);
            if (hi == 0) { img[32 * s + col] = (bf16)f2bf(X.re); img[64 + 32 * s + col] = (bf16)f2bf(X.im); }
#pragma unroll
            for (int r = 0; r < 16; ++r) { const int row = crow(r, hi) + 1;
                if (row < 32) { img[row * IMG_STRIDE + 32 * s + col] = (bf16)f2bf(zt[s][r]); img[row * IMG_STRIDE + 64 + 32 * s + col] = (bf16)f2bf(zt[2 + s][r]); } }
        }
    }
    asm volatile("s_waitcnt vmcnt(0) lgkmcnt(0)" ::: "memory"); __syncthreads();
    bf16x8 sa[8];
#pragma unroll
    for (int ks = 0; ks < 8; ++ks) sa[ks] = *(const LAS bf16x8*)(img + col * IMG_STRIDE + 16 * ks + 8 * hi);
    asm volatile("s_waitcnt lgkmcnt(0)" ::: "memory"); __builtin_amdgcn_wave_barrier();
    const int ih = col >> 4, h = col & 15;
    const LAS unsigned char* kb = shm + L_TABK + ih * 512 + h * 32 + hi * 16;
    const unsigned c0 = (unsigned)(col * 256) | (unsigned)((hi * 16) ^ ((col & 15) * 16));
    LAS bf16* stg = img;
    bf16* og = out + ((size_t)g * T + (size_t)(b * SEQ + 512 * wid)) * 16;
#pragma unroll
    for (int ps = 0; ps < 2; ++ps) {
        f32x16 acc[4];
#pragma unroll
        for (int n = 0; n < 4; ++n) acc[n] = f32x16{};
#pragma unroll
        for (int j = 0; j < 8 * ps + 8; ++j) { const bf16x8 uj = ua[j];
#pragma unroll
            for (int n = 0; n < 4; ++n) { const int nt = 4 * ps + n;
                if (j <= 2 * nt + 1) {
                    bf16x8 kf;
                    if (j == 2 * nt + 1) { kf = *(const LAS bf16x8*)(shm + L_TABK + h * 32 + hi * 16); if (ih == 0) kf = bf16x8{}; }
                    else kf = *(const LAS bf16x8*)(kb + (2 * nt - j) * 512);
                    acc[n] = __builtin_amdgcn_mfma_f32_32x32x16_bf16(uj, kf, acc[n], 0, 0, 0); } } }
#pragma unroll
        for (int ks = 0; ks < 8; ++ks) { const unsigned ck = c0 ^ (unsigned)(ks * 32);
#pragma unroll
            for (int n = 0; n < 4; ++n) { const bf16x8 cfr = *(const LAS bf16x8*)(tb + ck + (4 * ps + n) * 8192); acc[n] = __builtin_amdgcn_mfma_f32_32x32x16_bf16(sa[ks], cfr, acc[n], 0, 0, 0); } }
#pragma unroll
        for (int n = 0; n < 4; ++n) {
            const f32x16 x = acc[n], x2 = x * x, z = (x2 * (0.044715f * -2.3022081985f) + -2.3022081985f) * x; f32x16 sg;
#pragma unroll
            for (int r = 0; r < 16; ++r) sg[r] = __builtin_amdgcn_exp2f(z[r]);
            sg = sg + 1.f;
#pragma unroll
            for (int r = 0; r < 16; ++r) sg[r] = __builtin_amdgcn_rcpf(sg[r]);
            const f32x16 y = x * sg;
#pragma unroll
            for (int r = 0; r < 16; r += 2) { const unsigned w = rt_cvtpk(y[r], y[r + 1]); stg[(crow(r, hi) * 8 + 2 * n + ih) * 16 + h] = (bf16)(w & 0xffffu); stg[(crow(r + 1, hi) * 8 + 2 * n + ih) * 16 + h] = (bf16)(w >> 16); } }
        asm volatile("s_waitcnt lgkmcnt(0)" ::: "memory"); __builtin_amdgcn_wave_barrier();
#pragma unroll
        for (int q = 0; q < 8; ++q) { const int pc = q * 64 + lane, chunk = pc >> 4, il = (pc >> 1) & 7, hf = pc & 1;
            const v4u v = *(const LAS v4u*)(stg + (chunk * 8 + il) * 16 + hf * 8);
            *(v4u*)(og + (size_t)(16 * chunk + 8 * ps + il) * 16 + hf * 8) = v; }
        asm volatile("s_waitcnt lgkmcnt(0)" ::: "memory"); __builtin_amdgcn_wave_barrier();
    }
    __syncthreads();
}
}

constexpr int NPH = 10;
__global__ void __launch_bounds__(512, 2) mk_fwd(Args args) {
    extern __shared__ __attribute__((aligned(16))) unsigned char lds_raw[];
    Ctx C; C.lds = (LAS unsigned char*)lds_raw; C.tid = threadIdx.x; C.lane = C.tid & 63; C.wave = __builtin_amdgcn_readfirstlane(C.tid >> 6);
    C.G = gridDim.x; { const int bx = blockIdx.x; C.vcu = (C.G % 8 == 0) ? (bx % 8) * (C.G / 8) + bx / 8 : bx; }
    C.gw = C.vcu * 8 + C.wave; C.ngw = C.G * 8;
    volatile LAS unsigned* MISC = (volatile LAS unsigned*)(C.lds + MISC_OFF);
    if (C.tid < 64) MISC[C.tid] = 0u;
    __syncthreads();
    unsigned char* ws = args.ws; unsigned* ctl = (unsigned*)(ws + WS_CTL);
    const int lo = args.ph_lo, hi = args.ph_hi;
    XcdBarrier bar; bar.bar = ctl + CW_BAR + args.bar_idx * XCD_BAR_WORDS; bar.x = 0; bar.st = nullptr;
    if (hi - lo > 1) bar = xcd_barrier_post(ctl + CW_BAR + args.bar_idx * XCD_BAR_WORDS, MISC + 8);
#define IN(k) (lo <= (k) && (k) < hi)
#define SEAM(k) do { if (IN(k) && IN((k) + 1)) { xcd_barrier(bar); if (args.sub & 8) xcd_barrier(bar); } } while (0)
    const float* x = args.in[0]; float* out = args.out;
    bf16* WIN = (bf16*)(ws + WS_WIN); bf16* WGLU = (bf16*)(ws + WS_WGLU); bf16* WSSM = (bf16*)(ws + WS_WSSM); bf16* WATT = (bf16*)(ws + WS_WATT); bf16* WOUT = (bf16*)(ws + WS_WOUT);
    bf16* WGU = (bf16*)(ws + WS_WGU); bf16* WDN = (bf16*)(ws + WS_WDN); bf16* BTAB = (bf16*)(ws + WS_BTAB); bf16* CTAB = (bf16*)(ws + WS_CTAB); bf16* KTAB = (bf16*)(ws + WS_KTAB); float* A16TAB = (float*)(ws + WS_A16);
    bf16* H = (bf16*)(ws + WS_H); bf16* PROJ = (bf16*)(ws + WS_PROJ); bf16* S5OUT = (bf16*)(ws + WS_S5OUT); bf16* ATTN = (bf16*)(ws + WS_ATTN);
    bf16* GLU = H; bf16* MIXED = S5OUT; bf16* H2 = ATTN; bf16* YS = PROJ; bf16* ACT = (bf16*)(ws + WS_ACT);
    bf16* UGM = (bf16*)(ws + WS_ACT);
    float* top_w = (float*)(ws + WS_ROUTE + RT_TOPW); int* list = (int*)(ws + WS_ROUTE + RT_LIST); int* apos = (int*)(ws + WS_ROUTE + RT_APOS);
    LAS unsigned char* ring = C.lds + RING_OFF;

    if (IN(0)) {
        for (int blk = C.vcu; blk < NG * 4; blk += C.G) s5::build_tables(blk >> 2, blk & 3, args.in[3], args.in[4], args.in[5], args.in[6], args.in[7], args.in[8], args.in[9], args.in[10], BTAB, KTAB, CTAB, A16TAB, ring, C.tid);
        transpose_job(C, args.in[2], WIN, DM, IN_W, 0, 1);
        transpose_job(C, args.in[11], WGLU, 1024, 2048, 1, 1);
        transpose_job(C, args.in[12], WSSM, 1024, 1024, 0, 1);
        transpose_job(C, args.in[16], WATT, 1024, 1024, 0, 1);
        transpose_job(C, args.in[17], WOUT, 1024, 1024, 0, 1);
        transpose_job_fp8(C, args.in[21], (unsigned char*)WGU, 1024, 2048, 1, NE, WSCALE);
        transpose_job_fp8(C, args.in[23], (unsigned char*)WDN, 1024, 1024, 0, NE, WSCALE);
        rmsnorm_rows(C, x, args.in[1], H);
        __syncthreads();
    }
    SEAM(0);
    if (IN(1)) { pg8::Gemm g{}; g.A = H; g.Bt = WIN; g.M = T; g.N = IN_W; g.K = DM; pg8::StaticOrder S; S.init(T, IN_W, C.G, (int)blockIdx.x);
        pg8::EpiProj e{}; e.O = PROJ; e.ldc = IN_W; e.qg = args.in[13]; e.kg = args.in[14]; e.qscale = att::QSCALE; e.nostore = (args.sub >> 2) & 3; e.U = UGM; e.urows = T; e.stage = C.lds + GT_OFF + 8192; pg8::gemm_phase<pg8::EpiProj, pg8::StaticOrder>(ring, g, S, e); }
    SEAM(1);
    if (IN(2)) {
        if (args.sub & 1) for (int uu = C.vcu; uu < BATCH * NG / 2; uu += C.G) for (int i = 0; i < 2; ++i) { const int unit = 2 * uu + i; s5::s5_unit(unit & 7, unit >> 3, UGM, BTAB, KTAB, CTAB, A16TAB, S5OUT, ring); }
        if (args.sub & 2) for (int run = C.vcu; run < BATCH * NKVH * 8; run += C.G) att::attn_run(run >> 5, (run >> 3) & 3, (run & 7) * 8, 8, PROJ, args.in[15], ATTN, ring);
        __syncthreads();
    }
    SEAM(2);
    if (IN(3)) { pg8::Gemm g{}; g.A = S5OUT; g.Bt = WGLU; g.M = T; g.N = 2048; g.K = 1024; g.agm = 1; pg8::StaticOrder S; S.init(T, 2048, C.G, (int)blockIdx.x);
        pg8::EpiGlu e{}; e.O = GLU; e.ldc = 1024; pg8::gemm_phase<pg8::EpiGlu, pg8::StaticOrder>(ring, g, S, e); }
    SEAM(3);
    if (IN(4)) { pg8::Gemm g{}; g.A = GLU; g.Bt = WSSM; g.A2 = ATTN; g.Bt2 = WATT; g.M = T; g.N = 1024; g.K = 1024; pg8::DualOrder S; S.init(T, 1024, C.G, (int)blockIdx.x);
        pg8::EpiGate e{}; e.O = MIXED; e.ldc = 1024; e.G = PROJ; e.ldg = IN_W; e.gcol0 = C_GS; e.gcol1 = C_GA; e.stage = C.lds + GT_OFF + 8192; pg8::gemm_phase<pg8::EpiGate, pg8::DualOrder>(ring, g, S, e); }
    SEAM(4);
    if (IN(5)) { pg8::Gemm g{}; g.A = MIXED; g.Bt = WOUT; g.M = T; g.N = 1024; g.K = 1024; pg8::StaticOrder S; S.init(T, 1024, C.G, (int)blockIdx.x);
        pg8::EpiResid e{}; e.base = x; e.out = out; e.ldc = 1024; e.stage = C.lds + GT_OFF + 8192; pg8::gemm_phase<pg8::EpiResid, pg8::StaticOrder>(ring, g, S, e); }
    SEAM(5);
    if (IN(6)) { router_pass(C, out, args.in[18], args.in[19], args.in[20], (unsigned char*)H2, top_w, list, apos, ctl); }
    SEAM(6);
    if (IN(7)) { const int nM = grouped_tables(C, ctl);
        pg8::Gemm g{}; g.A = H2; g.Bt = WGU; g.M = NA; g.N = 2048; g.K = 1024; g.scaleA = 0x7f7f7f7f; g.scaleB = WSCALE_E8M0 * 0x01010101;
        pg8::GroupedOrderT<true> S; S.cnt = (const LAS int*)(C.lds + GT_OFF); S.pref = S.cnt + 32; S.tile_e = (const LAS unsigned char*)(S.pref + 36); S.lbuf = (LAS int*)(C.lds + GT_OFF + 2048); S.list = list; S.nN = 8; S.G = C.G; S.c = (int)blockIdx.x; S.nM = nM; S.lstride = T; S.ashift = 2;
        pg8::EpiSwiglu e{}; e.O = (unsigned char*)ACT; e.ldc = 1024; e.bias = args.in[22]; e.dff = DFF; e.limit = 7.0f; e.alpha = 1.702f; e.skip = (args.sub >> 4) & 1;
        pg8::gemm_phase<pg8::EpiSwiglu, pg8::GroupedOrderT<true>>(ring, g, S, e); }
    SEAM(7);
    if (IN(8)) { const int nM = grouped_tables(C, ctl);
        pg8::Gemm g{}; g.A = ACT; g.Bt = WDN; g.M = NA; g.N = 1024; g.K = 1024; g.scaleA = 0x7f7f7f7f; g.scaleB = WSCALE_E8M0 * 0x01010101;
        pg8::GroupedOrderT<false> S; S.cnt = (const LAS int*)(C.lds + GT_OFF); S.pref = S.cnt + 32; S.tile_e = (const LAS unsigned char*)(S.pref + 36); S.lbuf = (LAS int*)(C.lds + GT_OFF + 2048); S.list = list; S.nN = 4; S.G = C.G; S.c = (int)blockIdx.x; S.nM = nM; S.lstride = T; S.ashift = 0;
        pg8::EpiDown e{}; e.O = YS; e.ldc = 1024; e.bias = args.in[24]; e.stage = C.lds + GT_OFF + 8192; e.ncol = 1024; e.skip = (args.sub >> 4) & 1;
        pg8::gemm_phase<pg8::EpiDown, pg8::GroupedOrderT<false>>(ring, g, S, e); }
    SEAM(8);
    if (IN(9)) { (void)grouped_tables(C, ctl); combine_pass(C, out, (const unsigned char*)YS, top_w, apos); }
#undef IN
#undef SEAM
}

extern "C" void kernel_launch(void* const* d_in, const int* in_sizes, int n_in, void* d_out, int out_size, void* d_ws, size_t ws_size, hipStream_t stream) {
    static int grid = 0;
    if (grid == 0) {
        if (n_in != 25 || in_sizes[0] != T * DM || out_size != T * DM || ws_size < WS_END) { fprintf(stderr, "kernel_launch: unexpected shapes / workspace (n_in %d, ws %zu)\n", n_in, ws_size); grid = -1; return; }
        int dev = 0, cus = 0, per_cu = 0;
        if (hipGetDevice(&dev) != hipSuccess || hipDeviceGetAttribute(&cus, hipDeviceAttributeMultiprocessorCount, dev) != hipSuccess) { grid = -1; return; }
        if (hipFuncSetAttribute((const void*)mk_fwd, hipFuncAttributeMaxDynamicSharedMemorySize, LDS_BYTES) != hipSuccess) { fprintf(stderr, "kernel_launch: hipFuncSetAttribute failed\n"); grid = -1; return; }
        if (hipOccupancyMaxActiveBlocksPerMultiprocessor(&per_cu, (const void*)mk_fwd, 512, LDS_BYTES) != hipSuccess || per_cu < 1) { fprintf(stderr, "kernel_launch: occupancy query says %d workgroups per CU\n", per_cu); grid = -1; (void)hipGetLastError(); return; }
        grid = cus;
    }
    if (grid < 0) return;
    if (hipMemsetAsync((char*)d_ws + WS_CTL, 0, CTL_ZERO_BYTES, stream) != hipSuccess) return;
    Args a{};
    for (int i = 0; i < 25; ++i) a.in[i] = (const float*)d_in[i];
    a.out = (float*)d_out; a.ws = (unsigned char*)d_ws;
#ifdef MK_RANGES
    { const int rg[] = MK_RANGES; int nb = 0; for (unsigned i = 0; i + 2 < sizeof(rg) / sizeof(int); i += 3) { a.ph_lo = rg[i]; a.ph_hi = rg[i + 1]; a.sub = rg[i + 2]; a.bar_idx = (rg[i + 1] - rg[i] > 1) ? nb++ : 0;
        hipLaunchKernelGGL(mk_fwd, dim3(grid), dim3(512), LDS_BYTES, stream, a); } }
#else
    a.ph_lo = 0; a.ph_hi = NPH; a.bar_idx = 0; a.sub = 3; hipLaunchKernelGGL(mk_fwd, dim3(grid), dim3(512), LDS_BYTES, stream, a);
#endif
}
```

```cpp
#include <hip/hip_runtime.h>
#include <cstdio>
#include <cstdint>
#include <cmath>

constexpr int DM = 1024, BATCH = 8, SEQ = 4096, T = BATCH * SEQ;
constexpr int NG = 64, NP = 64, GCH = 16;
constexpr int HD = 64, NQH = 16, NKVH = 4, WIN = 128;
constexpr int IN_W = 4608;
constexpr int C_U = 0, C_Q = 1024, C_K = 2048, C_V = 2304, C_GS = 2560, C_GA = 3584;
constexpr int NE = 32, TOPK = 4, DFF = 1024, NA = T * TOPK;
constexpr int MAXROWS = NA + NE * 256;
constexpr int MAXMT = MAXROWS / 256;
constexpr float EPS = 1e-5f;

namespace pg8 {
#define PG8_LAS __attribute__((address_space(3)))
typedef unsigned short bf16_t;
typedef short bf16x8 __attribute__((ext_vector_type(8)));
typedef float f32x4 __attribute__((ext_vector_type(4)));
typedef unsigned u32x4 __attribute__((ext_vector_type(4)));
typedef int i32x8 __attribute__((ext_vector_type(8)));
typedef int i32x4 __attribute__((ext_vector_type(4)));
__device__ __forceinline__ i32x8 cat8(bf16x8 lo, bf16x8 hi) { return __builtin_shufflevector(__builtin_bit_cast(i32x4, lo), __builtin_bit_cast(i32x4, hi), 0, 1, 2, 3, 4, 5, 6, 7); }
constexpr int BM = 256, BK = 64, HALF = 128, HTB = HALF * BK * 2  , STAGE_BYTES = 8 * HTB, NXCD = 8, WGM = 8;

__host__ __device__ __forceinline__ int lds_byte(int r, int c) { const int st = (r >> 4) * 2 + (c >> 5), rr = r & 15, cc = c & 31, ob = rr * 64 + cc * 2; return st * 1024 + (ob ^ (((ob >> 9) & 1) << 5)); }
__host__ __device__ __forceinline__ void stage_rc(int b, int& R, int& C) { const int st = b / 1024, sb = b % 1024, swz = sb ^ (((sb >> 9) & 1) << 5); R = (st >> 1) * 16 + swz / 64; C = (st & 1) * 32 + (swz % 64) / 2; }
__host__ __device__ __forceinline__ int perm32(int rho) { const int n = rho >> 4, i = rho & 15; return 8 * (i >> 2) + 4 * n + (i & 3); }

struct Unit { int pm, pn, e, pl, rows, srow; };
struct Gemm { const bf16_t* A; const bf16_t* Bt; const bf16_t* A2; const bf16_t* Bt2; int M, N, K, agm, scaleA, scaleB, pad0, pad1; };

struct StaticOrder {
    static constexpr bool GATHER = false, FP8 = false, LINROWS = false;
    static constexpr PG8_LAS int* lbuf = nullptr;
    int nM, nN, nwg, G, c;
    __host__ __device__ void init(int M, int N, int G_, int c_) { nM = M / BM; nN = N / BM; nwg = nM * nN; G = G_; c = c_; }
    __host__ __device__ bool next(int i, Unit& u) const {
        const long L = (long)i * G + c; if (L >= nwg) return false;
        int wgid = (int)L; { const int q = nwg / NXCD, r = nwg % NXCD, xcd = wgid % NXCD, off = wgid / NXCD; wgid = (xcd < r ? xcd * (q + 1) : r * (q + 1) + (xcd - r) * q) + off; }
        const int nig = WGM * nN, gid = wgid / nig, fm = gid * WGM, gsz = (nM - fm) < WGM ? (nM - fm) : WGM;
        u.pm = fm + ((wgid % nig) % gsz); u.pn = (wgid % nig) / gsz; u.e = 0; u.pl = u.pn; u.rows = BM; u.srow = u.pm * BM; return true;
    }
    __device__ __forceinline__ void a_ready(const Unit&) const {}
    __device__ __forceinline__ void done(const Unit&) const {}
};

template <class Epi, class Sched, bool ALIGN_EPI = true>
__device__ __forceinline__ void gemm_phase(PG8_LAS unsigned char* lds, const Gemm g, const Sched& S, const Epi& E) {
    int tid = threadIdx.x; asm volatile("" : "+v"(tid));
    const int wid = __builtin_amdgcn_readfirstlane(tid >> 6), lane = tid & 63, wr = wid >> 2, wc = wid & 3, fr = lane & 15, fq = lane >> 4;
    constexpr bool GATHER = Sched::GATHER, FP8 = Sched::FP8;
    const int K = g.K, KB = FP8 ? K : 2 * K, nt = KB / 128;
    int RA[2], CA[2]; unsigned voffA0[2], voffA1[2], voffB[2];
#pragma unroll
    for (int i = 0; i < 2; ++i) { int R, C; stage_rc(tid * 16 + i * 8192, R, C); RA[i] = R; CA[i] = C;
        const int Rb = 2 * (R & ~31) + (Epi::PERM ? perm32(R & 31) : (R & 31));
        voffB[i] = (unsigned)(Rb * KB + C * 2);
        if (g.agm) { voffA0[i] = (unsigned)((C >> 4) * g.M * 32 + R * 32 + (C & 15) * 2); voffA1[i] = voffA0[i] + (unsigned)(HALF * 32); }
        else { voffA0[i] = (unsigned)(R * KB + C * 2); voffA1[i] = (unsigned)((R + HALF) * KB + C * 2); } }
    const size_t kstep = (size_t)(BK * 2);
    const size_t hstepB = (size_t)32 * KB;
    const size_t tstep = (size_t)BM * KB;
    const size_t kstepA = g.agm ? (size_t)4 * g.M * 32 : kstep, tstepA = g.agm ? (size_t)BM * 32 : tstep;
    const unsigned ldsw = (unsigned)wid * 1024u;
    const int aoff = lds_byte(wr * 64 + fr, fq * 8), boff = lds_byte(wc * 32 + fr, fq * 8);
    constexpr int KOFF = 1024;
#define PG8_SA(b, h) (((b) * 2 + (h)) * HTB)
#define PG8_SB(b, h) ((4 + (b) * 2 + (h)) * HTB)
#define PG8_STAGE(bufoff, gbase, voff) do { _Pragma("unroll") for (int _i = 0; _i < 2; ++_i) \
        __builtin_amdgcn_global_load_lds((const unsigned*)((const char*)(gbase) + (voff)[_i]), (PG8_LAS unsigned*)(lds + (bufoff) + ldsw + _i * 8192), 16, 0, 0); } while (0)
#define PG8_LDA(dst, b, h) do { _Pragma("unroll") for (int m = 0; m < 4; ++m) _Pragma("unroll") for (int k = 0; k < 2; ++k) dst[m][k] = *(const PG8_LAS bf16x8*)(lds + PG8_SA(b, h) + aoff + m * 2048 + k * KOFF); } while (0)
#define PG8_LDB(dst, b, h) do { _Pragma("unroll") for (int n = 0; n < 2; ++n) _Pragma("unroll") for (int k = 0; k < 2; ++k) dst[n][k] = *(const PG8_LAS bf16x8*)(lds + PG8_SB(b, h) + boff + n * 2048 + k * KOFF); } while (0)
#define PG8_MMA(ai, bj, At, Bt) do { __builtin_amdgcn_s_setprio(1); _Pragma("unroll") for (int m = 0; m < 4; ++m) _Pragma("unroll") for (int n = 0; n < 2; ++n) { \
        if constexpr (FP8) acc[ai][bj][m][n] = __builtin_amdgcn_mfma_scale_f32_16x16x128_f8f6f4(cat8(Bt[n][0], Bt[n][1]), cat8(At[m][0], At[m][1]), acc[ai][bj][m][n], 0, 0, 0, g.scaleB, 0, g.scaleA); \
        else { _Pragma("unroll") for (int k = 0; k < 2; ++k) acc[ai][bj][m][n] = __builtin_amdgcn_mfma_f32_16x16x32_bf16(Bt[n][k], At[m][k], acc[ai][bj][m][n], 0, 0, 0); } } __builtin_amdgcn_s_setprio(0); } while (0)
#define PG8_WAIT_V(n) asm volatile("s_waitcnt vmcnt(" #n ")" ::: "memory")
#define PG8_WAIT_L(n) asm volatile("s_waitcnt lgkmcnt(" #n ")" ::: "memory")
#define PG8_BAR __builtin_amdgcn_s_barrier()
#define PG8_SCHED __builtin_amdgcn_sched_barrier(0)
    Unit cur, nxt; int ui = 0;
    if (!S.next(0, cur)) return;
    f32x4 acc[2][2][4][2];
#pragma unroll
    for (int a = 0; a < 2; ++a)
#pragma unroll
        for (int b = 0; b < 2; ++b)
#pragma unroll
            for (int m = 0; m < 4; ++m)
#pragma unroll
                for (int n = 0; n < 2; ++n) acc[a][b][m][n] = (f32x4){0.f, 0.f, 0.f, 0.f};
    bf16x8 At[4][2], B0[2][2], B1[2][2];
    PG8_LAS int* const lring = S.lbuf;
    if constexpr (Epi::BIAS_LDS) { if (tid < BM) S.lbuf[3 * BM + tid] = __builtin_bit_cast(int, *E.bias_elem(cur, tid));
        asm volatile("s_waitcnt vmcnt(0) lgkmcnt(0)" ::: "memory"); PG8_BAR; asm volatile("" ::: "memory"); }
    constexpr bool LINROWS = Sched::LINROWS;
    if constexpr (GATHER && LINROWS) {
#pragma unroll
        for (int i = 0; i < 2; ++i) { voffA0[i] = (unsigned)(cur.srow + RA[i]) * (unsigned)KB + (unsigned)(CA[i] * 2); voffA1[i] = (unsigned)(cur.srow + HALF + RA[i]) * (unsigned)KB + (unsigned)(CA[i] * 2); } }
    if constexpr (GATHER && !LINROWS) {
        if (tid < BM) lring[tid] = S.list_entry(cur, tid);
        asm volatile("s_waitcnt vmcnt(0) lgkmcnt(0)" ::: "memory"); PG8_BAR; asm volatile("" ::: "memory");
#pragma unroll
        for (int i = 0; i < 2; ++i) { const int r0 = RA[i] < cur.rows ? RA[i] : cur.rows - 1, r1 = HALF + RA[i] < cur.rows ? HALF + RA[i] : cur.rows - 1;
            voffA0[i] = (unsigned)(lring[r0] >> S.ashift) * (unsigned)KB + (unsigned)(CA[i] * 2); voffA1[i] = (unsigned)(lring[r1] >> S.ashift) * (unsigned)KB + (unsigned)(CA[i] * 2); } }
    const char* cA = GATHER ? (const char*)g.A : (const char*)(cur.e && g.A2 ? g.A2 : g.A) + (size_t)cur.pm * tstepA; const char* cB = (const char*)(!GATHER && cur.e && g.Bt2 ? g.Bt2 : g.Bt) + (size_t)cur.pn * tstep;
    S.a_ready(cur);
    PG8_STAGE(PG8_SB(0, 0), cB, voffB); PG8_STAGE(PG8_SB(0, 1), cB + hstepB, voffB); PG8_STAGE(PG8_SA(0, 0), cA, voffA0); PG8_STAGE(PG8_SA(0, 1), cA, voffA1);
    if (wr == 1) PG8_BAR;
    PG8_WAIT_V(2); PG8_BAR;
    PG8_STAGE(PG8_SB(1, 0), cB + kstep, voffB); PG8_STAGE(PG8_SA(1, 0), cA + kstepA, voffA0); PG8_STAGE(PG8_SB(1, 1), cB + hstepB + kstep, voffB);
    PG8_WAIT_V(6); PG8_BAR;
    for (;;) {
        const bool has_next = S.next(ui + 1, nxt);
        const char* nA = GATHER ? cA : (has_next ? (const char*)(nxt.e && g.A2 ? g.A2 : g.A) + (size_t)nxt.pm * tstepA : cA); const char* nB = has_next ? (const char*)(!GATHER && nxt.e && g.Bt2 ? g.Bt2 : g.Bt) + (size_t)nxt.pn * tstep : cB;
        const int slot_cur = (ui % 3) * BM, slot_nxt = ((ui + 1) % 3) * BM;
        if constexpr (Epi::BIAS_LDS) { if (has_next && wid >= 4)
            __builtin_amdgcn_global_load_lds((const unsigned*)E.bias_elem(nxt, (wid - 4) * 64 + lane), (PG8_LAS unsigned*)(lring + 3 * BM + slot_nxt + (wid - 4) * 64), 4, 0, 0); }
        if constexpr (GATHER && !LINROWS) { if (has_next && wid < 4)
            __builtin_amdgcn_global_load_lds((const unsigned*)(S.list_ptr(nxt) + wid * 64 + lane), (PG8_LAS unsigned*)(lring + slot_nxt + wid * 64), 4, 0, 0); }
        for (int t = 0; t < nt; t += 2) {
            const bool last = (t == nt - 2);
            const char* a1 = cA + (size_t)(t + 1) * kstepA;
            const char* a2 = last ? nA : cA + (size_t)(t + 2) * kstepA; const char* b2 = last ? nB : cB + (size_t)(t + 2) * kstep;
            const char* a3 = a2 + kstepA; const char* b3 = b2 + kstep;
            if (last && has_next) S.a_ready(nxt);
            PG8_LDB(B0, 0, 0); PG8_LDB(B1, 0, 1); PG8_SCHED; PG8_LDA(At, 0, 0); PG8_STAGE(PG8_SA(1, 1), a1, voffA1);
            if constexpr (GATHER && LINROWS) { if (last && has_next) {
#pragma unroll
                for (int i = 0; i < 2; ++i) { voffA0[i] = (unsigned)(nxt.srow + RA[i]) * (unsigned)KB + (unsigned)(CA[i] * 2); voffA1[i] = (unsigned)(nxt.srow + HALF + RA[i]) * (unsigned)KB + (unsigned)(CA[i] * 2); } } }
            if constexpr (GATHER && !LINROWS) { if (last && has_next) {
#pragma unroll
                for (int i = 0; i < 2; ++i) { const int r0 = RA[i] < nxt.rows ? RA[i] : nxt.rows - 1, r1 = HALF + RA[i] < nxt.rows ? HALF + RA[i] : nxt.rows - 1;
                    voffA0[i] = (unsigned)(lring[slot_nxt + r0] >> S.ashift) * (unsigned)KB + (unsigned)(CA[i] * 2); voffA1[i] = (unsigned)(lring[slot_nxt + r1] >> S.ashift) * (unsigned)KB + (unsigned)(CA[i] * 2); } } }
            PG8_WAIT_V(8); PG8_WAIT_L(0); PG8_BAR; PG8_MMA(0, 0, At, B0); PG8_MMA(0, 1, At, B1); PG8_BAR; PG8_SCHED;
            PG8_LDA(At, 0, 1); PG8_STAGE(PG8_SB(0, 0), b2, voffB); PG8_STAGE(PG8_SB(0, 1), b2 + hstepB, voffB); PG8_STAGE(PG8_SA(0, 0), a2, voffA0);
            PG8_WAIT_V(8); PG8_WAIT_L(0); PG8_BAR; PG8_MMA(1, 0, At, B0); PG8_MMA(1, 1, At, B1); PG8_BAR; PG8_SCHED;
            PG8_LDB(B0, 1, 0); PG8_LDB(B1, 1, 1); PG8_SCHED; PG8_LDA(At, 1, 0); PG8_STAGE(PG8_SA(0, 1), a2, voffA1);
            PG8_WAIT_V(8); PG8_WAIT_L(0); PG8_BAR; PG8_MMA(0, 0, At, B0); PG8_MMA(0, 1, At, B1); PG8_BAR; PG8_SCHED;
            PG8_LDA(At, 1, 1); PG8_STAGE(PG8_SB(1, 0), b3, voffB); PG8_STAGE(PG8_SB(1, 1), b3 + hstepB, voffB); PG8_STAGE(PG8_SA(1, 0), a3, voffA0);
            PG8_WAIT_V(8); PG8_WAIT_L(0); PG8_BAR; PG8_MMA(1, 0, At, B0); PG8_MMA(1, 1, At, B1); PG8_BAR; PG8_SCHED;
        }
        if constexpr (ALIGN_EPI) { if (wr == 0) PG8_BAR; }
        E(acc, cur, wr, wc, fr, fq, lring + slot_cur); S.done(cur);
        if (!has_next) break;
#pragma unroll
        for (int a = 0; a < 2; ++a)
#pragma unroll
            for (int b = 0; b < 2; ++b)
#pragma unroll
                for (int m = 0; m < 4; ++m)
#pragma unroll
                    for (int n = 0; n < 2; ++n) acc[a][b][m][n] = (f32x4){0.f, 0.f, 0.f, 0.f};
        cur = nxt; cA = nA; cB = nB; ++ui;
        if constexpr (ALIGN_EPI) { if (wr == 1) PG8_BAR; }
    }
    PG8_WAIT_V(0);
    if constexpr (!ALIGN_EPI) { if (wr == 0) PG8_BAR; }
    PG8_BAR;
#undef PG8_SA
#undef PG8_SB
#undef PG8_STAGE
#undef PG8_LDA
#undef PG8_LDB
#undef PG8_MMA
#undef PG8_WAIT_V
#undef PG8_WAIT_L
#undef PG8_BAR
#undef PG8_SCHED
}

__device__ __forceinline__ unsigned cvt_pk_bf16(float lo, float hi) { unsigned r; asm volatile("v_cvt_pk_bf16_f32 %0, %1, %2" : "=v"(r) : "v"(lo), "v"(hi)); return r; }
__device__ __forceinline__ float bf_lo(unsigned w) { return __uint_as_float(w << 16); }
__device__ __forceinline__ float bf_hi(unsigned w) { return __uint_as_float(w & 0xffff0000u); }
__device__ __forceinline__ float sigm(float x) { return __builtin_amdgcn_rcpf(1.f + __builtin_amdgcn_exp2f(-1.4426950408889634f * x)); }
__device__ __forceinline__ f32x4 sigm4(f32x4 x) { f32x4 t = x * -1.4426950408889634f, s;
#pragma unroll
    for (int j = 0; j < 4; ++j) s[j] = __builtin_amdgcn_exp2f(t[j]);
    s = s + 1.f;
#pragma unroll
    for (int j = 0; j < 4; ++j) s[j] = __builtin_amdgcn_rcpf(s[j]);
    return s; }
__device__ __forceinline__ u32x4 pack8(const f32x4 v0, const f32x4 v1) { u32x4 w; w.x = cvt_pk_bf16(v0[0], v0[1]); w.y = cvt_pk_bf16(v0[2], v0[3]); w.z = cvt_pk_bf16(v1[0], v1[1]); w.w = cvt_pk_bf16(v1[2], v1[3]); return w; }
__device__ __forceinline__ void unpack8(const u32x4 w, f32x4& v0, f32x4& v1) { v0 = (f32x4){bf_lo(w.x), bf_hi(w.x), bf_lo(w.y), bf_hi(w.y)}; v1 = (f32x4){bf_lo(w.z), bf_hi(w.z), bf_lo(w.w), bf_hi(w.w)}; }

struct EpiProj {
    static constexpr bool PERM = true, BIAS_LDS = false;
    bf16_t* O; const float* qg; const float* kg; bf16_t* U; PG8_LAS unsigned char* stage; int ldc; float qscale; int nostore, urows, pad;
    __device__ __forceinline__ void operator()(f32x4 (&acc)[2][2][4][2], const Unit& u, int wr, int wc, int fr, int fq, const PG8_LAS int* lrow) const {
        if (nostore & 2) { for (int ai = 0; ai < 2; ++ai) for (int m = 0; m < 4; ++m) asm volatile("" :: "v"(acc[ai][0][m][0]), "v"(acc[ai][0][m][1]), "v"(acc[ai][1][m][0]), "v"(acc[ai][1][m][1])); return; }
        const int row0 = u.pm * BM + wr * 64 + fr, col0 = u.pl * BM + wc * 64 + 8 * fq;
        if (u.pl >= 4 && u.pl <= 8) {
            const float* gp = (u.pl == 8 ? kg : qg) + 8 * fq; const float sc = (u.pl == 8) ? 1.f : qscale;
            f32x4 gv[2][2];
#pragma unroll
            for (int bj = 0; bj < 2; ++bj)
#pragma unroll
                for (int n = 0; n < 2; ++n) gv[bj][n] = *(const f32x4*)(gp + 32 * bj + 4 * n) * sc;
#pragma unroll
            for (int ai = 0; ai < 2; ++ai)
#pragma unroll
                for (int m = 0; m < 4; ++m) { float ss = 0.f;
#pragma unroll
                    for (int bj = 0; bj < 2; ++bj)
#pragma unroll
                        for (int n = 0; n < 2; ++n) { const f32x4 v = acc[ai][bj][m][n]; ss += (v[0] * v[0] + v[1] * v[1]) + (v[2] * v[2] + v[3] * v[3]); }
                    ss += __shfl_xor(ss, 16); ss += __shfl_xor(ss, 32);
                    const float rs = rsqrtf(ss * (1.f / 64.f) + 1e-5f);
#pragma unroll
                    for (int bj = 0; bj < 2; ++bj)
#pragma unroll
                        for (int n = 0; n < 2; ++n) acc[ai][bj][m][n] = acc[ai][bj][m][n] * rs * gv[bj][n]; }
        }
        if (u.pl < 4) {
#pragma unroll
            for (int ai = 0; ai < 2; ++ai)
#pragma unroll
                for (int m = 0; m < 4; ++m)
#pragma unroll
                    for (int bj = 0; bj < 2; ++bj) { const u32x4 w = pack8(acc[ai][bj][m][0], acc[ai][bj][m][1]); const int c = col0 + bj * 32;
                        *(u32x4*)(U + ((size_t)(c >> 4) * urows + (size_t)(row0 + ai * HALF + m * 16)) * 16 + (c & 15)) = w; }
        } else {
            PG8_LAS unsigned char* stg = stage + (wr * 4 + wc) * 2304; const int lane = fq * 16 + fr;
            bf16_t* ob = O + (size_t)(u.pm * BM + wr * 64 + (lane >> 3)) * ldc + u.pl * BM + wc * 64 + 8 * (lane & 7);
#pragma unroll
            for (int ai = 0; ai < 2; ++ai)
#pragma unroll
                for (int m = 0; m < 4; ++m) {
#pragma unroll
                    for (int bj = 0; bj < 2; ++bj) *(PG8_LAS u32x4*)(stg + fr * 144 + bj * 64 + fq * 16) = pack8(acc[ai][bj][m][0], acc[ai][bj][m][1]);
                    asm volatile("s_waitcnt lgkmcnt(0)" ::: "memory");
                    const u32x4 r0 = *(const PG8_LAS u32x4*)(stg + (lane >> 3) * 144 + (lane & 7) * 16), r1 = *(const PG8_LAS u32x4*)(stg + ((lane >> 3) + 8) * 144 + (lane & 7) * 16);
                    asm volatile("s_waitcnt lgkmcnt(0)" ::: "memory");
                    if (!(nostore & 1)) { *(u32x4*)(ob + (size_t)(ai * HALF + m * 16) * ldc) = r0; *(u32x4*)(ob + (size_t)(ai * HALF + m * 16 + 8) * ldc) = r1; } }
        }
    }
};
struct EpiGlu {
    static constexpr bool PERM = true, BIAS_LDS = false;
    bf16_t* O; int ldc, pad;
    __device__ __forceinline__ void operator()(f32x4 (&acc)[2][2][4][2], const Unit& u, int wr, int wc, int fr, int fq, const PG8_LAS int* lrow) const {
        const int row0 = u.pm * BM + wr * 64 + fr, col0 = u.pl * HALF + wc * 32 + 8 * fq;
#pragma unroll
        for (int ai = 0; ai < 2; ++ai)
#pragma unroll
            for (int m = 0; m < 4; ++m) { bf16_t* rowp = O + (size_t)(row0 + ai * HALF + m * 16) * ldc + col0;
                const f32x4 o0 = acc[ai][0][m][0] * sigm4(acc[ai][1][m][0]), o1 = acc[ai][0][m][1] * sigm4(acc[ai][1][m][1]);
                *(u32x4*)rowp = pack8(o0, o1); }
    }
};
struct EpiGate {
    static constexpr bool PERM = true, BIAS_LDS = false;
    bf16_t* O; const bf16_t* G; PG8_LAS unsigned char* stage; int ldc, ldg, gcol0, gcol1;
    __device__ __forceinline__ void operator()(f32x4 (&acc)[2][2][4][2], const Unit& u, int wr, int wc, int fr, int fq, const PG8_LAS int* lrow) const {
        const int row0 = u.pm * BM + wr * 64 + fr, col0 = u.pl * BM + wc * 64 + 8 * fq; const bool add = u.e != 0; const int gcol = add ? gcol1 : gcol0;
        PG8_LAS unsigned char* stg = stage + (wr * 4 + wc) * 2304; const int lane = fq * 16 + fr;
        bf16_t* ob = O + (size_t)(u.pm * BM + wr * 64 + (lane >> 3)) * ldc + u.pl * BM + wc * 64 + 8 * (lane & 7);
#pragma unroll
        for (int ai = 0; ai < 2; ++ai) {
            u32x4 gw[4][2], ow[4][2];
#pragma unroll
            for (int m = 0; m < 4; ++m)
#pragma unroll
                for (int bj = 0; bj < 2; ++bj) { const size_t r = (size_t)(row0 + ai * HALF + m * 16);
                    gw[m][bj] = *(const u32x4*)(G + r * ldg + gcol + col0 + bj * 32);
                    if (add) ow[m][bj] = __builtin_nontemporal_load((const u32x4*)(O + r * ldc + col0 + bj * 32)); else ow[m][bj] = (u32x4){0u, 0u, 0u, 0u}; }
#pragma unroll
            for (int m = 0; m < 4; ++m)
#pragma unroll
                for (int bj = 0; bj < 2; ++bj) { const size_t r = (size_t)(row0 + ai * HALF + m * 16);
                    f32x4 g0, g1; unpack8(gw[m][bj], g0, g1);
                    f32x4 p0, p1; unpack8(ow[m][bj], p0, p1);
                    const f32x4 o0 = sigm4(g0) * acc[ai][bj][m][0] + p0, o1 = sigm4(g1) * acc[ai][bj][m][1] + p1;
                    *(PG8_LAS u32x4*)(stg + fr * 144 + bj * 64 + fq * 16) = pack8(o0, o1);
                    if (bj == 1) {
                        asm volatile("s_waitcnt lgkmcnt(0)" ::: "memory");
                        const u32x4 r0 = *(const PG8_LAS u32x4*)(stg + (lane >> 3) * 144 + (lane & 7) * 16), r1 = *(const PG8_LAS u32x4*)(stg + ((lane >> 3) + 8) * 144 + (lane & 7) * 16);
                        asm volatile("s_waitcnt lgkmcnt(0)" ::: "memory");
                        *(u32x4*)(ob + (size_t)(ai * HALF + m * 16) * ldc) = r0; *(u32x4*)(ob + (size_t)(ai * HALF + m * 16 + 8) * ldc) = r1; } } }
    }
};
struct EpiResid {
    static constexpr bool PERM = true, BIAS_LDS = false;
    const float* base; bf16_t* out; PG8_LAS unsigned char* stage; int ldc, pad;
    __device__ __forceinline__ void operator()(f32x4 (&acc)[2][2][4][2], const Unit& u, int wr, int wc, int fr, int fq, const PG8_LAS int* lrow) const {
        const int row0 = u.pm * BM + wr * 64 + fr, col0 = u.pl * BM + wc * 64 + 8 * fq;
        PG8_LAS unsigned char* stg = stage + (wr * 4 + wc) * 2304; const int lane = fq * 16 + fr;
        bf16_t* ob = out + (size_t)(u.pm * BM + wr * 64 + (lane >> 3)) * ldc + u.pl * BM + wc * 64 + 8 * (lane & 7);
#pragma unroll
        for (int ai = 0; ai < 2; ++ai) {
            f32x4 bv[4][2][2];
#pragma unroll
            for (int m = 0; m < 4; ++m)
#pragma unroll
                for (int bj = 0; bj < 2; ++bj) { const float* bp = base + (size_t)(row0 + ai * HALF + m * 16) * ldc + col0 + bj * 32; bv[m][bj][0] = *(const f32x4*)bp; bv[m][bj][1] = *(const f32x4*)(bp + 4); }
#pragma unroll
            for (int m = 0; m < 4; ++m) {
#pragma unroll
                for (int bj = 0; bj < 2; ++bj) *(PG8_LAS u32x4*)(stg + fr * 144 + bj * 64 + fq * 16) = pack8(acc[ai][bj][m][0] + bv[m][bj][0], acc[ai][bj][m][1] + bv[m][bj][1]);
                asm volatile("s_waitcnt lgkmcnt(0)" ::: "memory");
                const u32x4 r0 = *(const PG8_LAS u32x4*)(stg + (lane >> 3) * 144 + (lane & 7) * 16), r1 = *(const PG8_LAS u32x4*)(stg + ((lane >> 3) + 8) * 144 + (lane & 7) * 16);
                asm volatile("s_waitcnt lgkmcnt(0)" ::: "memory");
                *(u32x4*)(ob + (size_t)(ai * HALF + m * 16) * ldc) = r0; *(u32x4*)(ob + (size_t)(ai * HALF + m * 16 + 8) * ldc) = r1; } }
    }
};
struct EpiSwiglu {
    static constexpr bool PERM = true, BIAS_LDS = true;
    __device__ __forceinline__ const float* bias_elem(const Unit& u, int i) const { return bias + (size_t)u.e * 2 * dff + u.pl * HALF + (i < HALF ? i : dff + i - HALF); }
    unsigned char* O; const float* bias; int ldc, dff; float limit, alpha; int skip, pad;
    __device__ __forceinline__ void operator()(f32x4 (&acc)[2][2][4][2], const Unit& u, int wr, int wc, int fr, int fq, const PG8_LAS int* lrow) const {
        if (skip) { for (int ai = 0; ai < 2; ++ai) for (int m = 0; m < 4; ++m) asm volatile("" :: "v"(acc[ai][0][m][0]), "v"(acc[ai][0][m][1]), "v"(acc[ai][1][m][0]), "v"(acc[ai][1][m][1])); return; }
        asm volatile("" : "+v"(fr));
        const int col0 = u.pl * HALF + wc * 32 + 8 * fq;
        const PG8_LAS float* bg = (const PG8_LAS float*)(lrow + 3 * BM) + wc * 32 + 8 * fq; const PG8_LAS float* bu = bg + HALF;
        const f32x4 bg0 = *(const PG8_LAS f32x4*)bg, bg1 = *(const PG8_LAS f32x4*)(bg + 4), bu0 = *(const PG8_LAS f32x4*)bu, bu1 = *(const PG8_LAS f32x4*)(bu + 4);
        const float nal2 = -1.4426950408889634f * alpha;
#pragma unroll
        for (int ai = 0; ai < 2; ++ai)
#pragma unroll
            for (int m = 0; m < 4; ++m) { const int r = ai * HALF + wr * 64 + m * 16 + fr; unsigned char* rowp = O + (size_t)(u.srow + r) * ldc + col0;
                const f32x4 gt0 = __builtin_elementwise_min(acc[ai][0][m][0] + bg0, (f32x4){limit, limit, limit, limit}), gt1 = __builtin_elementwise_min(acc[ai][0][m][1] + bg1, (f32x4){limit, limit, limit, limit});
                f32x4 up0 = acc[ai][1][m][0] + bu0, up1 = acc[ai][1][m][1] + bu1, s0, s1;
                const f32x4 a0 = gt0 * nal2, a1 = gt1 * nal2;
#pragma unroll
                for (int j = 0; j < 4; ++j) { up0[j] = __builtin_amdgcn_fmed3f(up0[j], -limit, limit); up1[j] = __builtin_amdgcn_fmed3f(up1[j], -limit, limit);
                    s0[j] = __builtin_amdgcn_exp2f(a0[j]); s1[j] = __builtin_amdgcn_exp2f(a1[j]); }
                s0 = s0 + 1.f; s1 = s1 + 1.f;
#pragma unroll
                for (int j = 0; j < 4; ++j) { s0[j] = __builtin_amdgcn_rcpf(s0[j]); s1[j] = __builtin_amdgcn_rcpf(s1[j]); }
                const f32x4 o0 = (up0 * gt0 + gt0) * s0, o1 = (up1 * gt1 + gt1) * s1;
                int w0 = __builtin_amdgcn_cvt_pk_fp8_f32(o0[0], o0[1], 0, false); w0 = __builtin_amdgcn_cvt_pk_fp8_f32(o0[2], o0[3], w0, true);
                int w1 = __builtin_amdgcn_cvt_pk_fp8_f32(o1[0], o1[1], 0, false); w1 = __builtin_amdgcn_cvt_pk_fp8_f32(o1[2], o1[3], w1, true);
                *(unsigned long long*)rowp = (unsigned long long)(unsigned)w0 | ((unsigned long long)(unsigned)w1 << 32); }
    }
};
struct EpiDown {
    static constexpr bool PERM = true, BIAS_LDS = true;
    __device__ __forceinline__ const float* bias_elem(const Unit& u, int i) const { return bias + (size_t)u.e * ncol + u.pl * BM + i; }
    bf16_t* O; const float* bias; PG8_LAS unsigned char* stage; int ldc, ncol, skip, pad;
    __device__ __forceinline__ void operator()(f32x4 (&acc)[2][2][4][2], const Unit& u, int wr, int wc, int fr, int fq, const PG8_LAS int* lrow) const {
        if (skip) { for (int ai = 0; ai < 2; ++ai) for (int m = 0; m < 4; ++m) asm volatile("" :: "v"(acc[ai][0][m][0]), "v"(acc[ai][0][m][1]), "v"(acc[ai][1][m][0]), "v"(acc[ai][1][m][1])); return; }
        asm volatile("" : "+v"(fr));
        const PG8_LAS float* bp = (const PG8_LAS float*)(lrow + 3 * BM) + wc * 64 + 8 * fq;
        f32x4 bv[2][2];
#pragma unroll
        for (int bj = 0; bj < 2; ++bj) { bv[bj][0] = *(const PG8_LAS f32x4*)(bp + bj * 32); bv[bj][1] = *(const PG8_LAS f32x4*)(bp + bj * 32 + 4); }
        const int lane = fq * 16 + fr;
        unsigned char* ob = (unsigned char*)O + (size_t)(u.srow + wr * 64 + 4 * wc + (lane >> 4)) * ldc + u.pl * BM + 16 * (lane & 15);
#pragma unroll
        for (int ai = 0; ai < 2; ++ai)
#pragma unroll
            for (int m = 0; m < 4; ++m) { const int step = ai * 4 + m; PG8_LAS unsigned char* buf = stage + ((step & 1) * 2 + wr) * 4352;
#pragma unroll
                for (int bj = 0; bj < 2; ++bj) { const f32x4 o0 = acc[ai][bj][m][0] + bv[bj][0], o1 = acc[ai][bj][m][1] + bv[bj][1];
                    int w0 = __builtin_amdgcn_cvt_pk_fp8_f32(o0[0], o0[1], 0, false); w0 = __builtin_amdgcn_cvt_pk_fp8_f32(o0[2], o0[3], w0, true);
                    int w1 = __builtin_amdgcn_cvt_pk_fp8_f32(o1[0], o1[1], 0, false); w1 = __builtin_amdgcn_cvt_pk_fp8_f32(o1[2], o1[3], w1, true);
                    *(PG8_LAS unsigned long long*)(buf + fr * 272 + wc * 64 + bj * 32 + fq * 8) = (unsigned long long)(unsigned)w0 | ((unsigned long long)(unsigned)w1 << 32); }
                asm volatile("s_waitcnt lgkmcnt(0)" ::: "memory"); __builtin_amdgcn_s_barrier(); asm volatile("" ::: "memory");
                const u32x4 r = *(const PG8_LAS u32x4*)(buf + (4 * wc + (lane >> 4)) * 272 + (lane & 15) * 16);
                *(u32x4*)(ob + (size_t)(ai * HALF + m * 16) * ldc) = r; }
    }
};
template <bool GATH> struct GroupedOrderT {
    static constexpr bool GATHER = true, FP8 = true, LINROWS = !GATH;
    const PG8_LAS unsigned char* tile_e; const PG8_LAS int* pref; const PG8_LAS int* cnt; PG8_LAS int* lbuf; const int* list; int nN, G, c, nM, lstride, ashift;
    __device__ __forceinline__ bool next(int i, Unit& u) const {
        const int nwg = nM * nN; const long L = (long)i * G + c; if (L >= nwg) return false;
        int wgid = (int)L; { const int q = nwg / NXCD, r = nwg % NXCD, xcd = wgid % NXCD, off = wgid / NXCD; wgid = (xcd < r ? xcd * (q + 1) : r * (q + 1) + (xcd - r) * q) + off; }
        const int nig = WGM * nN, gid = wgid / nig, fm = gid * WGM, gsz = (nM - fm) < WGM ? (nM - fm) : WGM;
        const int mt = fm + ((wgid % nig) % gsz), pl = (wgid % nig) / gsz;
        const int e = tile_e[mt]; const int mtl = mt - pref[e]; const int left = cnt[e] - 256 * mtl;
        u.pm = mtl; u.pn = e * nN + pl; u.e = e; u.pl = pl; u.rows = left < 256 ? left : 256; u.srow = mt * BM; return true;
    }
    __device__ __forceinline__ const int* list_ptr(const Unit& u) const { return list + (size_t)u.e * lstride + u.pm * BM; }
    __device__ __forceinline__ int list_entry(const Unit& u, int r) const { return list_ptr(u)[r < u.rows ? r : u.rows - 1]; }
    __device__ __forceinline__ void a_ready(const Unit&) const {}
    __device__ __forceinline__ void done(const Unit&) const {}
};
struct DualOrder {
    static constexpr bool GATHER = false, FP8 = false, LINROWS = false;
    static constexpr PG8_LAS int* lbuf = nullptr;
    StaticOrder S; int nper;
    __device__ __forceinline__ void init(int M, int N, int G, int c) { S.init(M, N, G, c); nper = (S.nwg - c + G - 1) / G; if (nper < 0) nper = 0; }
    __device__ __forceinline__ bool next(int i, Unit& u) const { if (i >= 2 * nper) return false; const int e = i >= nper ? 1 : 0; const bool ok = S.next(i - e * nper, u); u.e = e; return ok; }
    __device__ __forceinline__ void a_ready(const Unit&) const {}
    __device__ __forceinline__ void done(const Unit&) const {}
};
}

#define GAS __attribute__((address_space(1)))
#define LAS __attribute__((address_space(3)))
typedef unsigned short bf16;
typedef unsigned v4u __attribute__((ext_vector_type(4)));
typedef float f32x4 __attribute__((ext_vector_type(4)));
typedef short bf16x8 __attribute__((ext_vector_type(8)));
typedef GAS unsigned gu32;
typedef GAS unsigned long long gu64;
#define RLX_AGENT __ATOMIC_RELAXED, __HIP_MEMORY_SCOPE_AGENT
#define LDS_WAIT() asm volatile("s_waitcnt lgkmcnt(0)" ::: "memory")
#define VM_WAIT() asm volatile("s_waitcnt vmcnt(0)" ::: "memory")
__device__ __forceinline__ unsigned long long rt() { return __builtin_amdgcn_s_memrealtime(); }
__device__ __forceinline__ unsigned f2bf(float f) { unsigned u = __builtin_bit_cast(unsigned, f); return (u + 0x7fffu + ((u >> 16) & 1u)) >> 16; }
__device__ __forceinline__ unsigned pk2(float lo, float hi) { return f2bf(lo) | (f2bf(hi) << 16); }

#define XB_TMO      128
#define XB_XCNT(j)  (256  + 64 * (j))
#define XB_XSUB(j)  (1280 + 64 * (j))
#define XB_XGEN(j)  (2304 + 64 * (j))
#define XB_TOP      3328
#define XB_TOPGEN   3392
#define XCD_BAR_WORDS 3456
#define XB_SPIN_CAP (1u << 18)

__device__ __forceinline__ unsigned xb_ld(unsigned* p)              { return __hip_atomic_load(p, __ATOMIC_RELAXED, __HIP_MEMORY_SCOPE_AGENT); }
__device__ __forceinline__ unsigned xb_add(unsigned* p, unsigned v) { return __hip_atomic_fetch_add(p, v, __ATOMIC_RELAXED, __HIP_MEMORY_SCOPE_AGENT); }
__device__ __forceinline__ unsigned xb_xcc_id() { return (unsigned)__builtin_amdgcn_s_getreg((3 << 11) | 20) & 0xFu; }
#define XB_SPIN(cond, bar) do { unsigned _sp = 0; while (cond) { __builtin_amdgcn_s_sleep(1); \
    if ((++_sp & 255u) == 0u) { if (xb_ld(&(bar)[XB_TMO])) break; if (_sp > XB_SPIN_CAP) { atomicAdd(&(bar)[XB_TMO], 1u); break; } } } } while (0)

struct XcdBarrier {
    unsigned* bar; unsigned x;
    volatile LAS unsigned* st;
};

__device__ __forceinline__ XcdBarrier xcd_barrier_post(unsigned* bar, volatile LAS unsigned* st) {
    XcdBarrier b; b.bar = bar; b.x = xb_xcc_id(); b.st = st;
    if (threadIdx.x == 0) (void)xb_add(&bar[XB_XCNT(b.x)], 1u);
    return b;
}
__device__ __forceinline__ void xcd_barrier_complete(unsigned* bar, unsigned x, unsigned& nloc, unsigned& nx) {
    const unsigned G = gridDim.x * gridDim.y * gridDim.z;
    unsigned sum, cnt, mine, sp = 0u;
    for (;;) {
        sum = 0u; cnt = 0u; mine = 0u;
#pragma unroll
        for (unsigned j = 0; j < 16; ++j) { const unsigned c = xb_ld(&bar[XB_XCNT(j)]); sum += c; cnt += (c > 0u) ? 1u : 0u; mine = (j == x) ? c : mine; }
        if (sum == G) break;
        __builtin_amdgcn_s_sleep(1);
        if ((++sp & 255u) == 0u) { if (xb_ld(&bar[XB_TMO])) break; if (sp > XB_SPIN_CAP) { atomicAdd(&bar[XB_TMO], 1u); break; } }
    }
    nloc = mine > 0u ? mine : 1u; nx = cnt > 0u ? cnt : 1u;
}

__device__ __forceinline__ void xcd_barrier(const XcdBarrier& b) {
    asm volatile("s_waitcnt vmcnt(0)" ::: "memory");
    __syncthreads();
    if (threadIdx.x == 0) {
        unsigned* bar = b.bar;
        __builtin_amdgcn_s_waitcnt(0);
        unsigned nloc = b.st[0], nx = b.st[1];
        if (nloc == 0u) { xcd_barrier_complete(bar, b.x, nloc, nx); b.st[0] = nloc; b.st[1] = nx; }
        const unsigned old = xb_add(&bar[XB_XSUB(b.x)], 1u);
        const unsigned gen = old / nloc;
        if (old + 1u == (gen + 1u) * nloc) {
            __builtin_amdgcn_fence(__ATOMIC_RELEASE, "agent");
            asm volatile("s_waitcnt vmcnt(0)" ::: "memory");
            const unsigned og = xb_add(&bar[XB_TOP], 1u);
            const unsigned tg = og / nx;
            if (og + 1u == (tg + 1u) * nx) xb_add(&bar[XB_TOPGEN], 1u);
            else XB_SPIN(xb_ld(&bar[XB_TOPGEN]) == tg, bar);
            __builtin_amdgcn_fence(__ATOMIC_ACQUIRE, "agent");
            xb_add(&bar[XB_XGEN(b.x)], 1u);
            asm volatile("s_waitcnt vmcnt(0)" ::: "memory");
        } else {
            XB_SPIN(xb_ld(&bar[XB_XGEN(b.x)]) == gen, bar);
            __builtin_amdgcn_fence(__ATOMIC_ACQUIRE, "agent");
            asm volatile("s_waitcnt vmcnt(0)" ::: "memory");
        }
    }
    __syncthreads();
}

constexpr size_t MiB = 1u << 20;
constexpr size_t WS_CTL = 0;
constexpr size_t CTL_ZERO_BYTES = 65536;
constexpr size_t WS_WIN = 1 * MiB, WS_WGLU = 10 * MiB, WS_WSSM = 14 * MiB, WS_WATT = 16 * MiB, WS_WOUT = 18 * MiB;
constexpr size_t WS_WGU = 20 * MiB, WS_WDN = 148 * MiB;
constexpr float WSCALE = 64.f; constexpr int WSCALE_E8M0 = 127 - 6;
constexpr size_t WS_ROUTE = 216 * MiB;
constexpr size_t WS_H = 224 * MiB;
constexpr size_t WS_PROJ = 288 * MiB;
constexpr size_t WS_S5OUT = 576 * MiB;
constexpr size_t WS_ATTN = 640 * MiB;
constexpr size_t WS_ACT = 704 * MiB;
constexpr size_t WS_BTAB = 976 * MiB, WS_CTAB = 980 * MiB, WS_KTAB = 984 * MiB, WS_A16 = 985 * MiB;
constexpr size_t WS_END = 986 * MiB;
static_assert(WS_PROJ + (size_t)T * IN_W * 2 <= WS_S5OUT && WS_PROJ + (size_t)MAXROWS * 1024 * 2 <= WS_S5OUT && WS_ACT + (size_t)MAXROWS * 1024 <= WS_BTAB, "ws map");
constexpr int CW_CNT = 0;
constexpr int CW_BAR = 4096;
static_assert((CW_BAR + 3 * XCD_BAR_WORDS) * 4 <= (int)CTL_ZERO_BYTES, "ctl map");
constexpr size_t RT_TOPW = 0, RT_LIST = 1 * MiB, RT_APOS = 5 * MiB;

constexpr int LDS_BYTES = 163840;
constexpr int RING_OFF = 0;
constexpr int MISC_OFF = LDS_BYTES - 256;
constexpr int GT_OFF = 131072;

__device__ __forceinline__ float bf2f(bf16 b) { return __uint_as_float((unsigned)b << 16); }
__device__ __forceinline__ float wave_sum(float v) {
#pragma unroll
    for (int o = 1; o < 64; o <<= 1) v += __shfl_xor(v, o);
    return v;
}
__device__ __forceinline__ float wave_max(float v) {
#pragma unroll
    for (int o = 1; o < 64; o <<= 1) v = fmaxf(v, __shfl_xor(v, o));
    return v;
}
__device__ __forceinline__ float gelu_tanh(float x) { const float z = -2.3022081985f * (x + 0.044715f * x * x * x); return x * __builtin_amdgcn_rcpf(1.f + __builtin_amdgcn_exp2f(z)); }
#define WAVE_SYNC() do { __builtin_amdgcn_wave_barrier(); asm volatile("s_waitcnt lgkmcnt(0)" ::: "memory"); } while (0)

struct Args { const float* in[25]; float* out; unsigned char* ws; int ph_lo, ph_hi, bar_idx, sub; };
struct Ctx { int tid, lane, wave, vcu, G, gw, ngw; LAS unsigned char* lds; };

constexpr int TR_SCR = 64 * 65 * 4;
__device__ __forceinline__ void transpose_item(const float* W, int K, int N, bf16* WT, int mode, LAS float* scr, int item, int lane) {
    const int nblk = N / 64, kb = item / nblk, nb = item % nblk, k0 = 64 * kb, n0 = 64 * nb;
#pragma unroll 4
    for (int i = 0; i < 16; ++i) { const int kk = 4 * i + (lane >> 4), nn = 4 * (lane & 15); const f32x4 w = *(const f32x4*)(W + (size_t)(k0 + kk) * N + n0 + nn);
        LAS float* s = scr + kk * 65 + nn; s[0] = w.x; s[1] = w.y; s[2] = w.z; s[3] = w.w; }
    LDS_WAIT(); asm volatile("" ::: "memory");
    const int c = lane & 7;
#pragma unroll
    for (int j = 0; j < 8; ++j) { const int n = (lane >> 3) + 8 * j; const LAS float* s = scr + (8 * c) * 65 + n;
        v4u o; o.x = pk2(s[0 * 65], s[1 * 65]); o.y = pk2(s[2 * 65], s[3 * 65]); o.z = pk2(s[4 * 65], s[5 * 65]); o.w = pk2(s[6 * 65], s[7 * 65]);
        int r = n0 + n;
        if (mode == 1) { const int nh = N / 2, hf = (r >= nh) ? 1 : 0, np = r - hf * nh; r = 256 * (np / 128) + 64 * ((np % 128) / 32) + 32 * hf + (np % 32); }
        *(v4u*)(WT + (size_t)r * K + k0 + 8 * c) = o; }
    LDS_WAIT(); asm volatile("" ::: "memory");
}
constexpr int TR8_SCR = 128 * 33 * 4;
__device__ __forceinline__ void transpose_item_fp8(const float* W, int K, int N, unsigned char* WT, int mode, float wscale, LAS float* scr, int item, int lane) {
    const int nblk = N / 32, kb = item / nblk, nb = item % nblk, k0 = 128 * kb, n0 = 32 * nb;
#pragma unroll 4
    for (int i = 0; i < 16; ++i) { const int kk = 8 * i + (lane >> 3), nn = 4 * (lane & 7); const f32x4 w = *(const f32x4*)(W + (size_t)(k0 + kk) * N + n0 + nn);
        LAS float* s = scr + kk * 33 + nn; s[0] = w.x; s[1] = w.y; s[2] = w.z; s[3] = w.w; }
    LDS_WAIT(); asm volatile("" ::: "memory");
    int rb = n0;
    if (mode == 1) { const int nh = N / 2, hf = (n0 >= nh) ? 1 : 0, np = n0 - hf * nh; rb = 256 * (np / 128) + 64 * ((np % 128) / 32) + 32 * hf; }
    const int c = lane & 7;
#pragma unroll
    for (int j = 0; j < 4; ++j) { const int n = (lane >> 3) + 8 * j; const LAS float* s = scr + (16 * c) * 33 + n;
        v4u o;
#pragma unroll
        for (int q = 0; q < 4; ++q) { int w = __builtin_amdgcn_cvt_pk_fp8_f32(s[(4 * q) * 33] * wscale, s[(4 * q + 1) * 33] * wscale, 0, false); w = __builtin_amdgcn_cvt_pk_fp8_f32(s[(4 * q + 2) * 33] * wscale, s[(4 * q + 3) * 33] * wscale, w, true); o[q] = (unsigned)w; }
        *(v4u*)(WT + (size_t)(rb + n) * K + k0 + 16 * c) = o; }
    LDS_WAIT(); asm volatile("" ::: "memory");
}
__device__ __forceinline__ void transpose_job_fp8(const Ctx& C, const float* W, unsigned char* WT, int K, int N, int mode, int nmat, float wscale) {
    LAS float* scr = (LAS float*)(C.lds + RING_OFF + C.wave * TR8_SCR);
    const int per = (K / 128) * (N / 32); const int total = per * nmat;
    for (int it = C.gw; it < total; it += C.ngw) { const int mat = it / per, item = it % per;
        transpose_item_fp8(W + (size_t)mat * K * N, K, N, WT + (size_t)mat * K * N, mode, wscale, scr, item, C.lane); }
}
__device__ __forceinline__ void transpose_job(const Ctx& C, const float* W, bf16* WT, int K, int N, int mode, int nmat) {
    LAS float* scr = (LAS float*)(C.lds + RING_OFF + C.wave * TR8_SCR);
    const int per = (K / 64) * (N / 64); const int total = per * nmat;
    for (int it = C.gw; it < total; it += C.ngw) { const int mat = it / per, item = it % per;
        transpose_item(W + (size_t)mat * K * N, K, N, WT + (size_t)mat * K * N, mode, scr, item, C.lane); }
}
__device__ __forceinline__ void rmsnorm_rows(const Ctx& C, const float* x, const float* g, bf16* out) {
    f32x4 gg[4];
#pragma unroll
    for (int j = 0; j < 4; ++j) gg[j] = ((const f32x4*)g)[64 * j + C.lane];
    f32x4 vn[4]; int m = C.gw;
    if (m < T) { const f32x4* xr = (const f32x4*)(x + (size_t)m * DM) + C.lane;
#pragma unroll
        for (int j = 0; j < 4; ++j) vn[j] = xr[64 * j]; }
    for (; m < T; m += C.ngw) {
        f32x4 v[4]; float s = 0.f;
#pragma unroll
        for (int j = 0; j < 4; ++j) { v[j] = vn[j]; s += (v[j].x * v[j].x + v[j].y * v[j].y) + (v[j].z * v[j].z + v[j].w * v[j].w); }
        if (m + C.ngw < T) { const f32x4* xr = (const f32x4*)(x + (size_t)(m + C.ngw) * DM) + C.lane;
#pragma unroll
            for (int j = 0; j < 4; ++j) vn[j] = xr[64 * j]; }
        const float rs = rsqrtf(wave_sum(s) * (1.f / DM) + EPS);
        unsigned long long* o8 = (unsigned long long*)(out + (size_t)m * DM) + C.lane;
#pragma unroll
        for (int j = 0; j < 4; ++j) o8[64 * j] = (unsigned long long)pk2(v[j].x * rs * gg[j].x, v[j].y * rs * gg[j].y) | ((unsigned long long)pk2(v[j].z * rs * gg[j].z, v[j].w * rs * gg[j].w) << 32);
    }
}
typedef short rt_bf16x8 __attribute__((ext_vector_type(8)));
typedef float rt_f32x2 __attribute__((ext_vector_type(2))); typedef __bf16 rt_bf16x2 __attribute__((ext_vector_type(2)));
__device__ __forceinline__ unsigned rt_cvtpk(float lo, float hi) { rt_f32x2 v = {lo, hi}; rt_bf16x2 b = __builtin_convertvector(v, rt_bf16x2); return __builtin_bit_cast(unsigned, b); }
__device__ __forceinline__ void rt_split8(const float (&x)[8], rt_bf16x8& hi, rt_bf16x8& lo) {
    v4u h, l;
#pragma unroll
    for (int i = 0; i < 4; ++i) { const unsigned hb = rt_cvtpk(x[2 * i], x[2 * i + 1]); h[i] = hb;
        const float r0 = x[2 * i] - __uint_as_float(hb << 16), r1 = x[2 * i + 1] - __uint_as_float(hb & 0xffff0000u); l[i] = rt_cvtpk(r0, r1); }
    hi = __builtin_bit_cast(rt_bf16x8, h); lo = __builtin_bit_cast(rt_bf16x8, l);
}
constexpr int HN_PITCH = 1032;
__device__ __forceinline__ void router_pass(const Ctx& C, const bf16* x1, const float* g2, const float* w_router, const float* b_router, unsigned char* h2, float* top_w, int* list, int* apos, unsigned* ctl) {
    LAS float* HN = (LAS float*)(C.lds + RING_OFF); LAS float* PART = HN + 16 * HN_PITCH; LAS float* LOG = PART + 8 * 16 * 32; LAS unsigned* HIST = (LAS unsigned*)(LOG + 16 * 32); LAS unsigned* BASE = HIST + 32; LAS unsigned* RK = BASE + 32;
    LAS unsigned char* EIDS = (LAS unsigned char*)(RK + 32);
    int tid = C.tid; asm volatile("" : "+v"(tid));
    const int lane = tid & 63, wave = C.wave, fr = lane & 15, fq = lane >> 4;
    rt_bf16x8 bhi[4][2], blo[4][2];
#pragma unroll
    for (int ks = 0; ks < 4; ++ks)
#pragma unroll
        for (int nt = 0; nt < 2; ++nt) { float x[8];
#pragma unroll
            for (int j = 0; j < 8; ++j) x[j] = w_router[(size_t)(128 * wave + 32 * ks + 8 * fq + j) * NE + 16 * nt + fr];
            rt_split8(x, bhi[ks][nt], blo[ks][nt]); }
    const float bias = b_router[tid & 31];
    if (tid < 32) HIST[tid] = 0u;
    __syncthreads();
    int nrounds = 0;
    v4u vn[2][2];
    if (C.vcu < T / 16) {
#pragma unroll
        for (int q = 0; q < 2; ++q) { const v4u* xr = (const v4u*)(x1 + (size_t)(C.vcu * 16 + 2 * wave + q) * DM) + 2 * lane; vn[q][0] = xr[0]; vn[q][1] = xr[1]; } }
    for (int grp = C.vcu; grp < T / 16; grp += C.G, ++nrounds) {
        f32x4 v[2][4];
#pragma unroll
        for (int q = 0; q < 2; ++q)
#pragma unroll
            for (int j = 0; j < 4; ++j) { const unsigned w0 = vn[q][j >> 1][2 * (j & 1)], w1 = vn[q][j >> 1][2 * (j & 1) + 1];
                v[q][j] = (f32x4){__uint_as_float(w0 << 16), __uint_as_float(w0 & 0xffff0000u), __uint_as_float(w1 << 16), __uint_as_float(w1 & 0xffff0000u)}; }
        if (grp + C.G < T / 16) {
#pragma unroll
            for (int q = 0; q < 2; ++q) { const v4u* xr = (const v4u*)(x1 + (size_t)((grp + C.G) * 16 + 2 * wave + q) * DM) + 2 * lane; vn[q][0] = xr[0]; vn[q][1] = xr[1]; } }
#pragma unroll
        for (int q = 0; q < 2; ++q) { const int tl = 2 * wave + q; float s = 0.f;
#pragma unroll
            for (int j = 0; j < 4; ++j) s += (v[q][j].x * v[q][j].x + v[q][j].y * v[q][j].y) + (v[q][j].z * v[q][j].z + v[q][j].w * v[q][j].w);
            const float rs = rsqrtf(wave_sum(s) * (1.f / DM) + EPS);
            v4u hw;
#pragma unroll
            for (int j = 0; j < 4; ++j) { const f32x4 gg = ((const f32x4*)g2)[4 * lane + j];
                const f32x4 y = (f32x4){v[q][j].x * rs * gg.x, v[q][j].y * rs * gg.y, v[q][j].z * rs * gg.z, v[q][j].w * rs * gg.w};
                *(LAS f32x4*)(HN + tl * HN_PITCH + 16 * lane + 4 * j) = y;
                int w = __builtin_amdgcn_cvt_pk_fp8_f32(y.x, y.y, 0, false); w = __builtin_amdgcn_cvt_pk_fp8_f32(y.z, y.w, w, true); hw[j] = (unsigned)w; }
            *(v4u*)(h2 + (size_t)(grp * 16 + tl) * DM + 16 * lane) = hw; }
        __syncthreads();
        { pg8::f32x4 acc0 = {0.f, 0.f, 0.f, 0.f}, acc1 = {0.f, 0.f, 0.f, 0.f};
          const LAS float* hb = HN + fr * HN_PITCH + 128 * wave + 8 * fq;
#pragma unroll
          for (int ks = 0; ks < 4; ++ks) { const f32x4 p0 = *(const LAS f32x4*)(hb + 32 * ks), p1 = *(const LAS f32x4*)(hb + 32 * ks + 4);
              const float x[8] = {p0.x, p0.y, p0.z, p0.w, p1.x, p1.y, p1.z, p1.w}; rt_bf16x8 ahi, alo; rt_split8(x, ahi, alo);
              acc0 = __builtin_amdgcn_mfma_f32_16x16x32_bf16(ahi, bhi[ks][0], acc0, 0, 0, 0); acc1 = __builtin_amdgcn_mfma_f32_16x16x32_bf16(ahi, bhi[ks][1], acc1, 0, 0, 0);
              acc0 = __builtin_amdgcn_mfma_f32_16x16x32_bf16(ahi, blo[ks][0], acc0, 0, 0, 0); acc1 = __builtin_amdgcn_mfma_f32_16x16x32_bf16(ahi, blo[ks][1], acc1, 0, 0, 0);
              acc0 = __builtin_amdgcn_mfma_f32_16x16x32_bf16(alo, bhi[ks][0], acc0, 0, 0, 0); acc1 = __builtin_amdgcn_mfma_f32_16x16x32_bf16(alo, bhi[ks][1], acc1, 0, 0, 0); }
          LAS float* pp = PART + (wave * 16 + 4 * fq) * 32 + fr;
#pragma unroll
          for (int r = 0; r < 4; ++r) { pp[r * 32] = acc0[r]; pp[r * 32 + 16] = acc1[r]; } }
        __syncthreads();
        { float a = bias;
#pragma unroll
          for (int w8 = 0; w8 < 8; ++w8) a += PART[(w8 * 16 + (tid >> 5)) * 32 + (tid & 31)];
          LOG[tid] = a; }
        __syncthreads();
        if (lane < 2) { const int tl = 2 * wave + lane; float lg[32];
#pragma unroll
            for (int i = 0; i < 8; ++i) { const f32x4 t4 = *(const LAS f32x4*)(LOG + tl * 32 + 4 * i); lg[4 * i] = t4.x; lg[4 * i + 1] = t4.y; lg[4 * i + 2] = t4.z; lg[4 * i + 3] = t4.w; }
            float tv[4]; int ti[4];
#pragma unroll
            for (int k = 0; k < 4; ++k) { float mx = lg[0]; int mi = 0;
#pragma unroll
                for (int i = 1; i < 32; ++i) { const bool gt = lg[i] > mx; mx = gt ? lg[i] : mx; mi = gt ? i : mi; }
                tv[k] = mx; ti[k] = mi;
#pragma unroll
                for (int i = 0; i < 32; ++i) lg[i] = (i == mi) ? -INFINITY : lg[i]; }
            const float e1 = __expf(tv[1] - tv[0]), e2 = __expf(tv[2] - tv[0]), e3 = __expf(tv[3] - tv[0]); const float inv = 1.f / (1.f + e1 + e2 + e3);
            *(f32x4*)(top_w + (size_t)(grp * 16 + tl) * 4) = (f32x4){inv, e1 * inv, e2 * inv, e3 * inv};
#pragma unroll
            for (int k = 0; k < 4; ++k) { EIDS[(nrounds * 16 + tl) * 4 + k] = (unsigned char)ti[k]; __hip_atomic_fetch_add(HIST + ti[k], 1u, __ATOMIC_RELAXED, __HIP_MEMORY_SCOPE_WORKGROUP); } }
    }
    __syncthreads();
    if (tid < 32) { BASE[tid] = atomicAdd(ctl + CW_CNT + tid, HIST[tid]); RK[tid] = 0u; }
    __syncthreads();
    for (int idx = tid; idx < nrounds * 64; idx += 512) { const int ei = EIDS[idx]; const unsigned rank = __hip_atomic_fetch_add(RK + ei, 1u, __ATOMIC_RELAXED, __HIP_MEMORY_SCOPE_WORKGROUP);
        const int r = idx >> 6, tl = (idx >> 2) & 15, k = idx & 3, a = ((C.vcu + r * C.G) * 16 + tl) * 4 + k; const int slot = (int)(BASE[ei] + rank); list[(size_t)ei * T + slot] = a; apos[a] = (ei << 20) | slot; }
    __syncthreads();
}
__device__ __forceinline__ int grouped_tables(const Ctx& C, const unsigned* ctl) {
    LAS int* cnt = (LAS int*)(C.lds + GT_OFF); LAS int* pref = cnt + 32; LAS unsigned char* tile_e = (LAS unsigned char*)(pref + 36);
    if (C.wave == 0) {
        const int e = C.lane & 31; const int c = (int)__hip_atomic_load(ctl + CW_CNT + e, RLX_AGENT); const int n = (c + 255) >> 8;
        int incl = n;
#pragma unroll
        for (int o = 1; o < 32; o <<= 1) { const int t = __shfl_up(incl, o, 32); if (e >= o) incl += t; }
        const int start = incl - n;
        if (C.lane < 32) { cnt[e] = c; pref[e] = start; if (e == 31) pref[32] = incl; for (int i = 0; i < n; ++i) tile_e[start + i] = (unsigned char)e; }
    }
    __syncthreads();
    return pref[NE];
}
__device__ __forceinline__ void combine_pass(const Ctx& C, float* out, const bf16* x1, const unsigned char* ys, const float* top_w, const int* apos) {
    const LAS int* pref = (const LAS int*)(C.lds + GT_OFF) + 32;
    const int lane = C.lane;
    int4 apn[2];
    if (C.gw < T / 2) { apn[0] = *(const int4*)(apos + (size_t)(2 * C.gw) * 4); apn[1] = *(const int4*)(apos + (size_t)(2 * C.gw + 1) * 4); }
    for (int pr = C.gw; pr < T / 2; pr += C.ngw) {
        const int4 ap[2] = {apn[0], apn[1]};
        if (pr + C.ngw < T / 2) { apn[0] = *(const int4*)(apos + (size_t)(2 * (pr + C.ngw)) * 4); apn[1] = *(const int4*)(apos + (size_t)(2 * (pr + C.ngw) + 1) * 4); }
        f32x4 acc[2][4]; v4u yv[2][4]; f32x4 wv4[2];
#pragma unroll
        for (int t = 0; t < 2; ++t) { const int tok = 2 * pr + t;
            const v4u* xr = (const v4u*)(x1 + (size_t)tok * DM) + 2 * lane;
            const v4u x0 = xr[0], x1v = xr[1];
#pragma unroll
            for (int j = 0; j < 4; ++j) { const unsigned w0 = (j < 2 ? x0 : x1v)[2 * (j & 1)], w1 = (j < 2 ? x0 : x1v)[2 * (j & 1) + 1];
                acc[t][j] = (f32x4){__uint_as_float(w0 << 16), __uint_as_float(w0 & 0xffff0000u), __uint_as_float(w1 << 16), __uint_as_float(w1 & 0xffff0000u)}; }
            wv4[t] = *(const f32x4*)(top_w + (size_t)tok * 4);
#pragma unroll
            for (int k = 0; k < 4; ++k) { const int p = k == 0 ? ap[t].x : k == 1 ? ap[t].y : k == 2 ? ap[t].z : ap[t].w; const int srow = pref[p >> 20] * 256 + (p & 0xFFFFF);
                yv[t][k] = *(const v4u*)(ys + (size_t)srow * DM + 16 * lane); } }
#pragma unroll
        for (int t = 0; t < 2; ++t) { f32x4* o = (f32x4*)(out + (size_t)(2 * pr + t) * DM) + 4 * lane;
#pragma unroll
            for (int k = 0; k < 4; ++k) { const float wv = wv4[t][k];
#pragma unroll
                for (int j = 0; j < 4; ++j) { const unsigned w = yv[t][k][j];
                    const auto lo2 = __builtin_amdgcn_cvt_pk_f32_fp8((int)w, false), hi2 = __builtin_amdgcn_cvt_pk_f32_fp8((int)w, true);
                    acc[t][j].x += wv * lo2[0]; acc[t][j].y += wv * lo2[1]; acc[t][j].z += wv * hi2[0]; acc[t][j].w += wv * hi2[1]; } }
#pragma unroll
            for (int j = 0; j < 4; ++j) o[j] = acc[t][j]; }
    }
}

namespace att {
using bf16x8 = __attribute__((ext_vector_type(8))) short;
using s16x4 = __attribute__((ext_vector_type(4))) short;
using f32x16 = __attribute__((ext_vector_type(16))) float;
using u32x4 = __attribute__((ext_vector_type(4))) unsigned;
typedef float f32x2_t __attribute__((ext_vector_type(2))); typedef __bf16 bf16x2_t __attribute__((ext_vector_type(2)));
constexpr float LOG2E = 1.4426950408889634f, QSCALE = 0.125f * LOG2E;
constexpr int SLOTB = 8192, NSLOT = 4;
constexpr int L_K = 0, L_V = NSLOT * SLOTB, L_WS = 2 * NSLOT * SLOTB, L_OST = L_WS + 8 * 256, L_BYTES = L_OST + 8 * 4096;
__device__ __forceinline__ int crow(int r, int hi) { return (r & 3) + 8 * (r >> 2) + 4 * hi; }
__device__ __forceinline__ void glds16(const void* gsrc, unsigned lds_dst) { unsigned keep;
    asm volatile("s_mov_b32 %0, m0\n\ts_mov_b32 m0, %2\n\ts_nop 0\n\tglobal_load_lds_dwordx4 %1, off\n\ts_mov_b32 m0, %0" : "=&s"(keep) : "v"(gsrc), "s"(lds_dst) : "memory"); }
__device__ __forceinline__ unsigned cvtpk_s(float lo, float hi) { f32x2_t v = {lo, hi}; bf16x2_t b = __builtin_convertvector(v, bf16x2_t); return __builtin_bit_cast(unsigned, b); }
typedef __attribute__((address_space(3))) const char* lds_cptr;
__device__ __forceinline__ void qkt_half(f32x16& p, lds_cptr kb, const bf16x8* qr) {
    const f32x16 z = f32x16{};
#pragma unroll
    for (int d0 = 0; d0 < 4; ++d0) {
        const bf16x8 b0 = *(const __attribute__((address_space(3))) bf16x8*)(kb + d0 * 2048);
        p = __builtin_amdgcn_mfma_f32_32x32x16_bf16(b0, qr[d0], d0 == 0 ? z : p, 0, 0, 0); }
}
__device__ __forceinline__ void pv_half(f32x16* o, int vb, bf16x8 pa0, bf16x8 pa1) {
#pragma unroll
    for (int d0 = 0; d0 < 2; ++d0) { s16x4 lo[2], hi[2];
#pragma unroll
        for (int ks = 0; ks < 2; ++ks) {
            asm volatile("ds_read_b64_tr_b16 %0,%1 offset:%c2" : "=&v"(lo[ks]) : "v"(vb), "i"(d0 * 4096 + ks * 1024) : "memory");
            asm volatile("ds_read_b64_tr_b16 %0,%1 offset:%c2" : "=&v"(hi[ks]) : "v"(vb), "i"(d0 * 4096 + ks * 1024 + 512) : "memory"); }
        asm volatile("s_waitcnt lgkmcnt(0)" ::: "memory"); __builtin_amdgcn_sched_barrier(0);
#define ATT_PK(k) (bf16x8){lo[k][0], lo[k][1], lo[k][2], lo[k][3], hi[k][0], hi[k][1], hi[k][2], hi[k][3]}
        o[d0] = __builtin_amdgcn_mfma_f32_32x32x16_bf16(pa0, ATT_PK(0), o[d0], 0, 0, 0);
        o[d0] = __builtin_amdgcn_mfma_f32_32x32x16_bf16(pa1, ATT_PK(1), o[d0], 0, 0, 0);
#undef ATT_PK
    }
}
__device__ __forceinline__ void dma_tile(const bf16* proj, int b, int kvh, int ti, unsigned lds0, int wid, int lane) {
    const unsigned slot = (unsigned)((ti + 2) & 3) * SLOTB;
    int kr = 64 * ti + lane; kr = kr < 0 ? 0 : kr;
    int vr = 64 * ti + 16 * (wid & 3) + (lane >> 2); vr = vr < 0 ? 0 : vr;
    const bf16* ksrc = proj + (size_t)(b * SEQ + kr) * IN_W + C_K + kvh * 64 + wid * 8;
    const bf16* vsrc = proj + (size_t)(b * SEQ + vr) * IN_W + C_V + kvh * 64 + (wid >> 2) * 32 + (lane & 3) * 8;
    glds16(ksrc, (unsigned)__builtin_amdgcn_readfirstlane(lds0 + L_K + slot + wid * 1024));
    glds16(vsrc, (unsigned)__builtin_amdgcn_readfirstlane(lds0 + L_V + slot + wid * 1024));
}
#define ATT_WAIT_BAR() asm volatile("s_waitcnt vmcnt(0) lgkmcnt(0)\n\ts_barrier" ::: "memory")
__device__ __forceinline__ void attn_run(int b, int kvh, int qb0, int nqb, const bf16* proj, const float* sinks, bf16* O, LAS unsigned char* shm) {
    const int tid = threadIdx.x, lane = tid & 63, r32 = lane & 31, hi = lane >> 5; const int wid = __builtin_amdgcn_readfirstlane(tid >> 6);
    const int h = kvh * 4 + (wid & 3), sub = wid >> 2;
    const unsigned lds0 = (unsigned)(uintptr_t)shm;
    LAS float* wsf = (LAS float*)(shm + L_WS) + wid * 64;
    const lds_cptr shm3 = (lds_cptr)shm;
    const int vb0 = (int)(lds0 + L_V) + ((lane >> 4) & 1) * 32 + (lane & 3) * 8 + (4 * hi + ((lane & 15) >> 2)) * 64;
    const float slope2 = exp2f(-0.5f * (float)(h + 1)) * LOG2E, sink2 = sinks[h] * LOG2E;
    dma_tile(proj, b, kvh, qb0 - 2, lds0, wid, lane); dma_tile(proj, b, kvh, qb0 - 1, lds0, wid, lane); dma_tile(proj, b, kvh, qb0, lds0, wid, lane);
    const bf16* Qw = proj + (size_t)(b * SEQ + qb0 * 64 + 32 * sub + r32) * IN_W + C_Q + h * 64 + hi * 8;
    bf16x8 qn[4];
#pragma unroll
    for (int d0 = 0; d0 < 4; ++d0) qn[d0] = *(const bf16x8*)(Qw + d0 * 16);
    for (int qi = 0; qi < nqb; ++qi) {
        const int qb = qb0 + qi, tq0 = qb * 64 + 32 * sub;
        bf16x8 qr[4];
#pragma unroll
        for (int d0 = 0; d0 < 4; ++d0) qr[d0] = qn[d0];
        ATT_WAIT_BAR();
        if (qi + 1 < nqb) dma_tile(proj, b, kvh, qb + 1, lds0, wid, lane);
        f32x16 p[5];
#pragma unroll
        for (int i = 0; i < 5; ++i) { const int g = i + sub; qkt_half(p[i], shm3 + L_K + ((qb + (g >> 1)) & 3) * SLOTB + (g & 1) * 512 + hi * 1024 + r32 * 16, qr); }
        if (qi + 1 < nqb) {
#pragma unroll
            for (int d0 = 0; d0 < 4; ++d0) qn[d0] = *(const bf16x8*)(Qw + (size_t)(64 * (qi + 1)) * IN_W + d0 * 16); }
        float dbase = (float)(128 + r32 - 4 * hi); asm volatile("" : "+v"(dbase));
        const float dmax = (float)(tq0 + r32);
#pragma unroll
        for (int i = 0; i < 5; ++i)
#pragma unroll
            for (int r = 0; r < 16; ++r) { const float d = dbase - (float)(32 * i + (r & 3) + 8 * (r >> 2));
                float v = p[i][r] - slope2 * d;
                if (i == 0) v = (d < 128.f) ? v : -INFINITY;
                if (i == 4) v = (d >= 0.f) ? v : -INFINITY;
                p[i][r] = v; }
        if (qb < 2) {
#pragma unroll
            for (int i = 0; i < 5; ++i)
#pragma unroll
                for (int r = 0; r < 16; ++r) { const float d = dbase - (float)(32 * i + (r & 3) + 8 * (r >> 2)); p[i][r] = (d <= dmax) ? p[i][r] : -INFINITY; } }
        float mx = -INFINITY;
#pragma unroll
        for (int i = 0; i < 5; ++i)
#pragma unroll
            for (int r = 0; r < 16; ++r) mx = fmaxf(mx, p[i][r]);
        { auto rr = __builtin_amdgcn_permlane32_swap(__float_as_uint(mx), __float_as_uint(mx), false, false); mx = fmaxf(__uint_as_float(rr[0]), __uint_as_float(rr[1])); }
        mx = fmaxf(mx, sink2);
        float ls = 0.f;
        f32x16 o[2]; o[0] = f32x16{}; o[1] = f32x16{};
#pragma unroll
        for (int i = 0; i < 5; ++i) { const int g = i + sub;
#pragma unroll
            for (int r = 0; r < 16; ++r) { const float e = __builtin_amdgcn_exp2f(p[i][r] - mx); p[i][r] = e; ls += e; }
            u32x4 pw0, pw1;
#define ATT_PKW(P, B) cvtpk_s(P[B], P[B + 1])
            pw0 = (u32x4){ATT_PKW(p[i], 0), ATT_PKW(p[i], 2), ATT_PKW(p[i], 4), ATT_PKW(p[i], 6)}; pw1 = (u32x4){ATT_PKW(p[i], 8), ATT_PKW(p[i], 10), ATT_PKW(p[i], 12), ATT_PKW(p[i], 14)};
#undef ATT_PKW
            __builtin_amdgcn_sched_barrier(0);
            pv_half(o, vb0 + ((qb + (g >> 1)) & 3) * SLOTB + (g & 1) * 2048, __builtin_bit_cast(bf16x8, pw0), __builtin_bit_cast(bf16x8, pw1));
        }
        { auto rr = __builtin_amdgcn_permlane32_swap(__float_as_uint(ls), __float_as_uint(ls), false, false); ls = __uint_as_float(rr[0]) + __uint_as_float(rr[1]); }
        ls += __builtin_amdgcn_exp2f(sink2 - mx);
        if (hi == 0) wsf[32 + r32] = ls;
        asm volatile("s_waitcnt lgkmcnt(0)" ::: "memory");
        float rli[16];
#pragma unroll
        for (int r = 0; r < 16; ++r) rli[r] = __builtin_amdgcn_rcpf(wsf[32 + crow(r, hi)]);
        bf16* Ow = O + (size_t)(b * SEQ + tq0) * 1024 + h * 64;
        { LAS bf16* stg = (LAS bf16*)(shm + L_OST) + wid * 2048;
#pragma unroll
            for (int r = 0; r < 16; ++r) { const int orow = crow(r, hi);
#pragma unroll
                for (int d0 = 0; d0 < 2; ++d0) stg[orow * 64 + d0 * 32 + r32] = (bf16)f2bf(o[d0][r] * rli[r]); }
            asm volatile("s_waitcnt lgkmcnt(0)" ::: "memory");
#pragma unroll
            for (int i = 0; i < 4; ++i) { const int row = i * 8 + (lane >> 3), ch = lane & 7; const u32x4 v = *(const LAS u32x4*)(stg + row * 64 + ch * 8); *(u32x4*)(Ow + (size_t)row * 1024 + ch * 8) = v; } }
    }
    ATT_WAIT_BAR();
}
#undef ATT_WAIT_BAR
}

namespace s5 {
using bf16x8 = __attribute__((ext_vector_type(8))) short;
using f32x16 = __attribute__((ext_vector_type(16))) float;
struct cf { float re, im; };
__device__ __forceinline__ cf cmul(cf a, cf b) { return cf{a.re * b.re - a.im * b.im, a.re * b.im + a.im * b.re}; }
__device__ __forceinline__ cf cfma(cf a, cf b, cf c) { return cf{c.re + a.re * b.re - a.im * b.im, c.im + a.re * b.im + a.im * b.re}; }
__device__ __forceinline__ int crow(int r, int hi) { return (r & 3) + 8 * (r >> 2) + 4 * hi; }
__device__ __forceinline__ bf16x8 ldg16(const bf16* ubase, unsigned lane_off) { return *(const bf16x8*)((const char*)ubase + lane_off); }
constexpr size_t BT_G = 128 * 256, KT_G = 16 * 16 * 16, CT_G = 256 * 128;
constexpr int IMG_STRIDE = 136;
constexpr int L_IMG = 0, L_T = 8 * 32 * IMG_STRIDE * 2, L_BYTES = L_T + 8 * 2 * 2 * 32 * 4;

__device__ __forceinline__ void build_tables(int g, int part, const float* a_re, const float* a_im, const float* log_dt, const float* b_re, const float* b_im, const float* c_re, const float* c_im, const float* d_skip,
                                             bf16* Btab, bf16* Ktab, bf16* Ctab, float* A16tab, LAS unsigned char* scr, int tid) {
    LAS double* LA = (LAS double*)scr; LAS double* TH = LA + 64;
    LAS float* bbr = (LAS float*)(scr + 1024); LAS float* bbi = bbr + 1024;
    LAS float* pwr = bbi + 1024; LAS float* pwi = pwr + 17 * 64;
    LAS float* ccr = pwi + 17 * 64; LAS float* cci = ccr + 1024;
    for (int e = tid; e < 1024; e += 512) { ccr[e] = c_re[(size_t)g * 1024 + e]; cci[e] = c_im[(size_t)g * 1024 + e]; }
    if (tid < 64) { const int i = g * NP + tid;
        const double dt = exp((double)log_dt[g]), are = a_re[i], aim = a_im[i];
        const double la = are * dt, th = aim * dt, mag = exp(la), abr = mag * cos(th), abi = mag * sin(th), den = are * are + aim * aim, em1 = abr - 1.0;
        const double qre = (em1 * are + abi * aim) / den, qim = (abi * are - em1 * aim) / den;
        LA[tid] = la; TH[tid] = th;
        for (int h = 0; h < GCH; ++h) { const double br = b_re[i * GCH + h], bi = b_im[i * GCH + h]; bbr[tid * 16 + h] = (float)(qre * br - qim * bi); bbi[tid * 16 + h] = (float)(qre * bi + qim * br); } }
    __syncthreads();
    for (int e = tid; e < 17 * 64; e += 512) { const int n = e >> 6, p = e & 63; const double m = exp((double)n * LA[p]), t = (double)n * TH[p]; pwr[e] = (float)(m * cos(t)); pwi[e] = (float)(m * sin(t)); }
    __syncthreads();
    if (part == 0 && tid < 64) { A16tab[(g * 64 + tid) * 2] = pwr[16 * 64 + tid]; A16tab[(g * 64 + tid) * 2 + 1] = pwi[16 * 64 + tid]; }
    for (int e = tid; e < 32 * 256; e += 512) { const int pl = e >> 8, k = e & 255, j = k >> 4, hp = k & 15, pp = 32 * part + pl, p = pp & 63;
        const float wr = pwr[(15 - j) * 64 + p], wi = pwi[(15 - j) * 64 + p], br = bbr[p * 16 + hp], bi = bbi[p * 16 + hp];
        const float v = (pp < 64) ? (wr * br - wi * bi) : (wr * bi + wi * br);
        Btab[(size_t)g * BT_G + (size_t)pp * 256 + k] = (bf16)f2bf(v); }
    for (int e = tid; e < 64 * 128; e += 512) { const int nl = e >> 7, pp = e & 127, n = 64 * part + nl, i = n >> 4, h = n & 15, p = pp & 63;
        const float cr = ccr[h * NP + p], ci = cci[h * NP + p], wr = pwr[(i + 1) * 64 + p], wi = pwi[(i + 1) * 64 + p];
        const float v = (pp < 64) ? (cr * wr - ci * wi) : -(cr * wi + ci * wr);
        Ctab[(size_t)g * CT_G + (size_t)n * 128 + pp] = (bf16)f2bf(v); }
    for (int e = tid; e < 4 * 256; e += 512) { const int d = 4 * part + (e >> 8), h = (e >> 4) & 15, hp = e & 15; float acc = 0.f;
#pragma unroll 8
        for (int p = 0; p < 64; ++p) { const float cr = ccr[h * NP + p], ci = cci[h * NP + p], wr = pwr[d * 64 + p], wi = pwi[d * 64 + p], br = bbr[p * 16 + hp], bi = bbi[p * 16 + hp];
            const float tr = wr * br - wi * bi, ti = wr * bi + wi * br; acc += cr * tr - ci * ti; }
        if (d == 0 && h == hp) acc += d_skip[g * 16 + h];
        Ktab[(size_t)g * KT_G + (size_t)(d * 16 + h) * 16 + hp] = (bf16)f2bf(acc); }
    __syncthreads();
}

__device__ __forceinline__ void scan_local(f32x16& re, f32x16& im, const cf p1, const cf p4, const int hi, cf (&em)[4], cf& T) {
#pragma unroll
    for (int q = 0; q < 4; ++q)
#pragma unroll
        for (int k = 1; k < 4; ++k) { const int r = 4 * q + k; const cf v = cfma(p1, cf{re[r - 1], im[r - 1]}, cf{re[r], im[r]}); re[r] = v.re; im[r] = v.im; }
    cf E = cf{0.f, 0.f};
#pragma unroll
    for (int q = 0; q < 4; ++q) {
        auto sr = __builtin_amdgcn_permlane32_swap(__float_as_uint(re[4 * q + 3]), __float_as_uint(re[4 * q + 3]), false, false);
        auto si = __builtin_amdgcn_permlane32_swap(__float_as_uint(im[4 * q + 3]), __float_as_uint(im[4 * q + 3]), false, false);
        const cf elo = cf{__uint_as_float(sr[0]), __uint_as_float(si[0])}, ehi = cf{__uint_as_float(sr[1]), __uint_as_float(si[1])};
        const cf Elo = E; E = cfma(p4, E, elo); const cf Ehi = E; E = cfma(p4, E, ehi);
        em[q] = hi ? Ehi : Elo; }
    T = E;
}
__device__ __forceinline__ void scan_finish(f32x16& re, f32x16& im, const cf p1, const cf p2, const cf p3, const cf p4, const cf g2, const int hi, const cf (&em)[4], const cf X) {
    cf cur = hi ? p4 : cf{1.f, 0.f};
#pragma unroll
    for (int q = 0; q < 4; ++q) { const cf carry = cfma(cur, X, em[q]); cur = cmul(cur, g2);
        cf v;
        v = cfma(p1, carry, cf{re[4 * q + 0], im[4 * q + 0]}); re[4 * q + 0] = v.re; im[4 * q + 0] = v.im;
        v = cfma(p2, carry, cf{re[4 * q + 1], im[4 * q + 1]}); re[4 * q + 1] = v.re; im[4 * q + 1] = v.im;
        v = cfma(p3, carry, cf{re[4 * q + 2], im[4 * q + 2]}); re[4 * q + 2] = v.re; im[4 * q + 2] = v.im;
        v = cfma(p4, carry, cf{re[4 * q + 3], im[4 * q + 3]}); re[4 * q + 3] = v.re; im[4 * q + 3] = v.im; }
}

__device__ __forceinline__ void glds16(const void* gsrc, unsigned lds_dst) { unsigned keep;
    asm volatile("s_mov_b32 %0, m0\n\ts_mov_b32 m0, %2\n\ts_nop 0\n\tglobal_load_lds_dwordx4 %1, off\n\ts_mov_b32 m0, %0" : "=&s"(keep) : "v"(gsrc), "s"(lds_dst) : "memory"); }
constexpr int L_TAB = 0, L_TABK = 65536, L_IMG2 = 73728, L_T2 = L_IMG2 + 8 * 32 * IMG_STRIDE * 2, L_BYTES2 = L_T2 + 4096;

__device__ __forceinline__ void s5_unit(int b, int g, const bf16* proj, const bf16* Btab, const bf16* Ktab, const bf16* Ctab, const float* A16tab, bf16* out, LAS unsigned char* shm) {
    int tid = threadIdx.x; asm volatile("" : "+v"(tid));
    const int lane = tid & 63, col = lane & 31, hi = lane >> 5; const int wid = __builtin_amdgcn_readfirstlane(tid >> 6);
    const unsigned lds0 = (unsigned)(uintptr_t)shm;
    { const char* src = (const char*)(Btab + (size_t)g * BT_G);
#pragma unroll
      for (int i = 0; i < 8; ++i) { const int p = wid * 8 + i, row = 2 * p + (lane >> 5), c = (lane & 31) ^ (row & 31);
          glds16(src + row * 512 + c * 16, (unsigned)__builtin_amdgcn_readfirstlane(lds0 + L_TAB + p * 1024)); } }
    const bf16* ub = proj + ((size_t)g * T + (size_t)(b * SEQ + 512 * wid)) * 16;
    const unsigned uoff = (unsigned)(col * 512 + hi * 16);
    bf16x8 ua[16];
#pragma unroll
    for (int j = 0; j < 16; ++j) ua[j] = ldg16(ub + (size_t)j * 16, uoff);
    asm volatile("s_waitcnt vmcnt(0)" ::: "memory"); __syncthreads();
    const LAS unsigned char* tb = shm + L_TAB; const unsigned a0 = (unsigned)(col * 512) | (unsigned)(((hi * 16) ^ (col * 16)));
    f32x16 zt[4];
#pragma unroll
    for (int nt = 0; nt < 4; ++nt) zt[nt] = f32x16{};
#pragma unroll
    for (int j = 0; j < 16; ++j) { const bf16x8 uj = ua[j]; const unsigned aj = a0 ^ (unsigned)(j * 32);
#pragma unroll
        for (int nt = 0; nt < 4; ++nt) { const bf16x8 bfr = *(const LAS bf16x8*)(tb + aj + nt * 16384); zt[nt] = __builtin_amdgcn_mfma_f32_32x32x16_bf16(uj, bfr, zt[nt], 0, 0, 0); } }
    LAS float* Tb = (LAS float*)(shm + L_T2);
    LAS bf16* img = (LAS bf16*)(shm + L_IMG2) + wid * 32 * IMG_STRIDE;
    {
        cf P1[2], P2[2], P3[2], P4[2], G2[2], EM[2][4], TT[2];
#pragma unroll
        for (int s = 0; s < 2; ++s) { const float2 a = ((const float2*)A16tab)[g * 64 + 32 * s + col]; P1[s] = cf{a.x, a.y}; P2[s] = cmul(P1[s], P1[s]); P3[s] = cmul(P2[s], P1[s]); P4[s] = cmul(P2[s], P2[s]); G2[s] = cmul(P4[s], P4[s]); }
        scan_local(zt[0], zt[2], P1[0], P4[0], hi, EM[0], TT[0]);
        scan_local(zt[1], zt[3], P1[1], P4[1], hi, EM[1], TT[1]);
        if (hi == 0) {
#pragma unroll
            for (int s = 0; s < 2; ++s) { Tb[((wid * 2 + s) * 2 + 0) * 32 + col] = TT[s].re; Tb[((wid * 2 + s) * 2 + 1) * 32 + col] = TT[s].im; } }
        asm volatile("s_waitcnt lgkmcnt(0)" ::: "memory"); __syncthreads();
        { const char* src = (const char*)(Ctab + (size_t)g * CT_G);
#pragma unroll
          for (int i = 0; i < 8; ++i) { const int p = wid * 8 + i, row = 4 * p + (lane >> 4), c = (lane & 15) ^ (row & 15);
              glds16(src + row * 256 + c * 16, (unsigned)__builtin_amdgcn_readfirstlane(lds0 + L_TAB + p * 1024)); }
          glds16((const char*)(Ktab + (size_t)g * KT_G) + wid * 1024 + lane * 16, (unsigned)__builtin_amdgcn_readfirstlane(lds0 + L_TABK + wid * 1024)); }
#pragma unroll
        for (int j = 0; j < 16; ++j) ua[j] = ldg16(ub + (size_t)j * 16, uoff);
#pragma unroll
        for (int s = 0; s < 2; ++s) {
            const cf g4 = cmul(G2[s], G2[s]), g8 = cmul(g4, g4);
            cf X = cf{0.f, 0.f};
            for (int v = 0; v < wid; ++v) X = cfma(g8, X, cf{Tb[((v * 2 + s) * 2 + 0) * 32 + col], Tb[((v * 2 + s) * 2 + 1) * 32 + col]});
            scan_finish(zt[s], zt[2 + s], P1[s], P2[s], P3[s], P4[s], G2[s], hi, EM[s], X);
            if (hi == 0) { img[32 * s + col] = (bf16)f2bf(X.re); img[64 + 32 * s + col] = (bf16)f2bf(X.im); }
#pragma unroll
            for (int r = 0; r < 16; ++r) { const int row = crow(r, hi) + 1;
                if (row < 32) { img[row * IMG_STRIDE + 32 * s + col] = (bf16)f2bf(zt[s][r]); img[row * IMG_STRIDE + 64 + 32 * s + col] = (bf16)f2bf(zt[2 + s][r]); } }
        }
    }
    asm volatile("s_waitcnt vmcnt(0) lgkmcnt(0)" ::: "memory"); __syncthreads();
    bf16x8 sa[8];
#pragma unroll
    for (int ks = 0; ks < 8; ++ks) sa[ks] = *(const LAS bf16x8*)(img + col * IMG_STRIDE + 16 * ks + 8 * hi);
    asm volatile("s_waitcnt lgkmcnt(0)" ::: "memory"); __builtin_amdgcn_wave_barrier();
    const int ih = col >> 4, h = col & 15;
    const LAS unsigned char* kb = shm + L_TABK + ih * 512 + h * 32 + hi * 16;
    const unsigned c0 = (unsigned)(col * 256) | (unsigned)((hi * 16) ^ ((col & 15) * 16));
    LAS bf16* stg = img;
    bf16* og = out + ((size_t)g * T + (size_t)(b * SEQ + 512 * wid)) * 16;
#pragma unroll
    for (int ps = 0; ps < 2; ++ps) {
        f32x16 acc[4];
#pragma unroll
        for (int n = 0; n < 4; ++n) acc[n] = f32x16{};
#pragma unroll
        for (int j = 0; j < 8 * ps + 8; ++j) { const bf16x8 uj = ua[j];
#pragma unroll
            for (int n = 0; n < 4; ++n) { const int nt = 4 * ps + n;
                if (j <= 2 * nt + 1) {
                    bf16x8 kf;
                    if (j == 2 * nt + 1) { kf = *(const LAS bf16x8*)(shm + L_TABK + h * 32 + hi * 16); if (ih == 0) kf = bf16x8{}; }
                    else kf = *(const LAS bf16x8*)(kb + (2 * nt - j) * 512);
                    acc[n] = __builtin_amdgcn_mfma_f32_32x32x16_bf16(uj, kf, acc[n], 0, 0, 0); } } }
#pragma unroll
        for (int ks = 0; ks < 8; ++ks) { const unsigned ck = c0 ^ (unsigned)(ks * 32);
#pragma unroll
            for (int n = 0; n < 4; ++n) { const bf16x8 cfr = *(const LAS bf16x8*)(tb + ck + (4 * ps + n) * 8192); acc[n] = __builtin_amdgcn_mfma_f32_32x32x16_bf16(sa[ks], cfr, acc[n], 0, 0, 0); } }
#pragma unroll
        for (int n = 0; n < 4; ++n) {
            const f32x16 x = acc[n], x2 = x * x, z = (x2 * (0.044715f * -2.3022081985f) + -2.3022081985f) * x; f32x16 sg;
#pragma unroll
            for (int r = 0; r < 16; ++r) sg[r] = __builtin_amdgcn_exp2f(z[r]);
            sg = sg + 1.f;
#pragma unroll
            for (int r = 0; r < 16; ++r) sg[r] = __builtin_amdgcn_rcpf(sg[r]);
            const f32x16 y = x * sg;
#pragma unroll
            for (int r = 0; r < 16; r += 2) { const unsigned w = rt_cvtpk(y[r], y[r + 1]); stg[(crow(r, hi) * 8 + 2 * n + ih) * 16 + h] = (bf16)(w & 0xffffu); stg[(crow(r + 1, hi) * 8 + 2 * n + ih) * 16 + h] = (bf16)(w >> 16); } }
        asm volatile("s_waitcnt lgkmcnt(0)" ::: "memory"); __builtin_amdgcn_wave_barrier();
#pragma unroll
        for (int q = 0; q < 8; ++q) { const int pc = q * 64 + lane, chunk = pc >> 4, il = (pc >> 1) & 7, hf = pc & 1;
            const v4u v = *(const LAS v4u*)(stg + (chunk * 8 + il) * 16 + hf * 8);
            *(v4u*)(og + (size_t)(16 * chunk + 8 * ps + il) * 16 + hf * 8) = v; }
        asm volatile("s_waitcnt lgkmcnt(0)" ::: "memory"); __builtin_amdgcn_wave_barrier();
    }
    __syncthreads();
}
}

constexpr int NPH = 10;
__global__ void __launch_bounds__(512, 2) mk_fwd(Args args) {
    extern __shared__ __attribute__((aligned(16))) unsigned char lds_raw[];
    Ctx C; C.lds = (LAS unsigned char*)lds_raw; C.tid = threadIdx.x; C.lane = C.tid & 63; C.wave = __builtin_amdgcn_readfirstlane(C.tid >> 6);
    C.G = gridDim.x; { const int bx = blockIdx.x; C.vcu = (C.G % 8 == 0) ? (bx % 8) * (C.G / 8) + bx / 8 : bx; }
    C.gw = C.vcu * 8 + C.wave; C.ngw = C.G * 8;
    volatile LAS unsigned* MISC = (volatile LAS unsigned*)(C.lds + MISC_OFF);
    if (C.tid < 64) MISC[C.tid] = 0u;
    __syncthreads();
    unsigned char* ws = args.ws; unsigned* ctl = (unsigned*)(ws + WS_CTL);
    const int lo = args.ph_lo, hi = args.ph_hi;
    XcdBarrier bar; bar.bar = ctl + CW_BAR + args.bar_idx * XCD_BAR_WORDS; bar.x = 0; bar.st = nullptr;
    if (hi - lo > 1) bar = xcd_barrier_post(ctl + CW_BAR + args.bar_idx * XCD_BAR_WORDS, MISC + 8);
#define IN(k) (lo <= (k) && (k) < hi)
#define SEAM(k) do { if (IN(k) && IN((k) + 1)) { xcd_barrier(bar); if (args.sub & 8) xcd_barrier(bar); } } while (0)
    const float* x = args.in[0]; float* out = args.out;
    bf16* WIN = (bf16*)(ws + WS_WIN); bf16* WGLU = (bf16*)(ws + WS_WGLU); bf16* WSSM = (bf16*)(ws + WS_WSSM); bf16* WATT = (bf16*)(ws + WS_WATT); bf16* WOUT = (bf16*)(ws + WS_WOUT);
    bf16* WGU = (bf16*)(ws + WS_WGU); bf16* WDN = (bf16*)(ws + WS_WDN); bf16* BTAB = (bf16*)(ws + WS_BTAB); bf16* CTAB = (bf16*)(ws + WS_CTAB); bf16* KTAB = (bf16*)(ws + WS_KTAB); float* A16TAB = (float*)(ws + WS_A16);
    bf16* H = (bf16*)(ws + WS_H); bf16* PROJ = (bf16*)(ws + WS_PROJ); bf16* S5OUT = (bf16*)(ws + WS_S5OUT); bf16* ATTN = (bf16*)(ws + WS_ATTN);
    bf16* GLU = H; bf16* MIXED = S5OUT; bf16* H2 = ATTN; bf16* YS = PROJ; bf16* ACT = (bf16*)(ws + WS_ACT);
    bf16* X1B = H;
    bf16* UGM = (bf16*)(ws + WS_ACT);
    float* top_w = (float*)(ws + WS_ROUTE + RT_TOPW); int* list = (int*)(ws + WS_ROUTE + RT_LIST); int* apos = (int*)(ws + WS_ROUTE + RT_APOS);
    LAS unsigned char* ring = C.lds + RING_OFF;

    if (IN(0)) {
        for (int blk = C.vcu; blk < NG * 4; blk += C.G) s5::build_tables(blk >> 2, blk & 3, args.in[3], args.in[4], args.in[5], args.in[6], args.in[7], args.in[8], args.in[9], args.in[10], BTAB, KTAB, CTAB, A16TAB, ring, C.tid);
        transpose_job(C, args.in[2], WIN, DM, IN_W, 0, 1);
        transpose_job(C, args.in[11], WGLU, 1024, 2048, 1, 1);
        transpose_job(C, args.in[12], WSSM, 1024, 1024, 0, 1);
        transpose_job(C, args.in[16], WATT, 1024, 1024, 0, 1);
        transpose_job(C, args.in[17], WOUT, 1024, 1024, 0, 1);
        transpose_job_fp8(C, args.in[21], (unsigned char*)WGU, 1024, 2048, 1, NE, WSCALE);
        transpose_job_fp8(C, args.in[23], (unsigned char*)WDN, 1024, 1024, 0, NE, WSCALE);
        rmsnorm_rows(C, x, args.in[1], H);
        __syncthreads();
    }
    SEAM(0);
    if (IN(1)) { pg8::Gemm g{}; g.A = H; g.Bt = WIN; g.M = T; g.N = IN_W; g.K = DM; pg8::StaticOrder S; S.init(T, IN_W, C.G, (int)blockIdx.x);
        pg8::EpiProj e{}; e.O = PROJ; e.ldc = IN_W; e.qg = args.in[13]; e.kg = args.in[14]; e.qscale = att::QSCALE; e.nostore = (args.sub >> 2) & 3; e.U = UGM; e.urows = T; e.stage = C.lds + GT_OFF + 8192; pg8::gemm_phase<pg8::EpiProj, pg8::StaticOrder>(ring, g, S, e); }
    SEAM(1);
    if (IN(2)) {
        if (args.sub & 1) for (int uu = C.vcu; uu < BATCH * NG / 2; uu += C.G) for (int i = 0; i < 2; ++i) { const int unit = 2 * uu + i; s5::s5_unit(unit & 7, unit >> 3, UGM, BTAB, KTAB, CTAB, A16TAB, S5OUT, ring); }
        if (args.sub & 2) for (int run = C.vcu; run < BATCH * NKVH * 8; run += C.G) att::attn_run(run >> 5, (run >> 3) & 3, (run & 7) * 8, 8, PROJ, args.in[15], ATTN, ring);
        __syncthreads();
    }
    SEAM(2);
    if (IN(3)) { pg8::Gemm g{}; g.A = S5OUT; g.Bt = WGLU; g.M = T; g.N = 2048; g.K = 1024; g.agm = 1; pg8::StaticOrder S; S.init(T, 2048, C.G, (int)blockIdx.x);
        pg8::EpiGlu e{}; e.O = GLU; e.ldc = 1024; pg8::gemm_phase<pg8::EpiGlu, pg8::StaticOrder>(ring, g, S, e); }
    SEAM(3);
    if (IN(4)) { pg8::Gemm g{}; g.A = GLU; g.Bt = WSSM; g.A2 = ATTN; g.Bt2 = WATT; g.M = T; g.N = 1024; g.K = 1024; pg8::DualOrder S; S.init(T, 1024, C.G, (int)blockIdx.x);
        pg8::EpiGate e{}; e.O = MIXED; e.ldc = 1024; e.G = PROJ; e.ldg = IN_W; e.gcol0 = C_GS; e.gcol1 = C_GA; e.stage = C.lds + GT_OFF + 8192; pg8::gemm_phase<pg8::EpiGate, pg8::DualOrder>(ring, g, S, e); }
    SEAM(4);
    if (IN(5)) { pg8::Gemm g{}; g.A = MIXED; g.Bt = WOUT; g.M = T; g.N = 1024; g.K = 1024; pg8::StaticOrder S; S.init(T, 1024, C.G, (int)blockIdx.x);
        pg8::EpiResid e{}; e.base = x; e.out = X1B; e.ldc = 1024; e.stage = C.lds + GT_OFF + 8192; pg8::gemm_phase<pg8::EpiResid, pg8::StaticOrder>(ring, g, S, e); }
    SEAM(5);
    if (IN(6)) { router_pass(C, X1B, args.in[18], args.in[19], args.in[20], (unsigned char*)H2, top_w, list, apos, ctl); }
    SEAM(6);
    if (IN(7)) { const int nM = grouped_tables(C, ctl);
        pg8::Gemm g{}; g.A = H2; g.Bt = WGU; g.M = NA; g.N = 2048; g.K = 1024; g.scaleA = 0x7f7f7f7f; g.scaleB = WSCALE_E8M0 * 0x01010101;
        pg8::GroupedOrderT<true> S; S.cnt = (const LAS int*)(C.lds + GT_OFF); S.pref = S.cnt + 32; S.tile_e = (const LAS unsigned char*)(S.pref + 36); S.lbuf = (LAS int*)(C.lds + GT_OFF + 2048); S.list = list; S.nN = 8; S.G = C.G; S.c = (int)blockIdx.x; S.nM = nM; S.lstride = T; S.ashift = 2;
        pg8::EpiSwiglu e{}; e.O = (unsigned char*)ACT; e.ldc = 1024; e.bias = args.in[22]; e.dff = DFF; e.limit = 7.0f; e.alpha = 1.702f; e.skip = (args.sub >> 4) & 1;
        pg8::gemm_phase<pg8::EpiSwiglu, pg8::GroupedOrderT<true>>(ring, g, S, e); }
    SEAM(7);
    if (IN(8)) { const int nM = grouped_tables(C, ctl);
        pg8::Gemm g{}; g.A = ACT; g.Bt = WDN; g.M = NA; g.N = 1024; g.K = 1024; g.scaleA = 0x7f7f7f7f; g.scaleB = WSCALE_E8M0 * 0x01010101;
        pg8::GroupedOrderT<false> S; S.cnt = (const LAS int*)(C.lds + GT_OFF); S.pref = S.cnt + 32; S.tile_e = (const LAS unsigned char*)(S.pref + 36); S.lbuf = (LAS int*)(C.lds + GT_OFF + 2048); S.list = list; S.nN = 4; S.G = C.G; S.c = (int)blockIdx.x; S.nM = nM; S.lstride = T; S.ashift = 0;
        pg8::EpiDown e{}; e.O = YS; e.ldc = 1024; e.bias = args.in[24]; e.stage = C.lds + GT_OFF + 8192; e.ncol = 1024; e.skip = (args.sub >> 4) & 1;
        pg8::gemm_phase<pg8::EpiDown, pg8::GroupedOrderT<false>>(ring, g, S, e); }
    SEAM(8);
    if (IN(9)) { (void)grouped_tables(C, ctl); combine_pass(C, out, X1B, (const unsigned char*)YS, top_w, apos); }
#undef IN
#undef SEAM
}

extern "C" void kernel_launch(void* const* d_in, const int* in_sizes, int n_in, void* d_out, int out_size, void* d_ws, size_t ws_size, hipStream_t stream) {
    static int grid = 0;
    if (grid == 0) {
        if (n_in != 25 || in_sizes[0] != T * DM || out_size != T * DM || ws_size < WS_END) { fprintf(stderr, "kernel_launch: unexpected shapes / workspace (n_in %d, ws %zu)\n", n_in, ws_size); grid = -1; return; }
        int dev = 0, cus = 0, per_cu = 0;
        if (hipGetDevice(&dev) != hipSuccess || hipDeviceGetAttribute(&cus, hipDeviceAttributeMultiprocessorCount, dev) != hipSuccess) { grid = -1; return; }
        if (hipFuncSetAttribute((const void*)mk_fwd, hipFuncAttributeMaxDynamicSharedMemorySize, LDS_BYTES) != hipSuccess) { fprintf(stderr, "kernel_launch: hipFuncSetAttribute failed\n"); grid = -1; return; }
        if (hipOccupancyMaxActiveBlocksPerMultiprocessor(&per_cu, (const void*)mk_fwd, 512, LDS_BYTES) != hipSuccess || per_cu < 1) { fprintf(stderr, "kernel_launch: occupancy query says %d workgroups per CU\n", per_cu); grid = -1; (void)hipGetLastError(); return; }
        grid = cus;
    }
    if (grid < 0) return;
    if (hipMemsetAsync((char*)d_ws + WS_CTL, 0, CTL_ZERO_BYTES, stream) != hipSuccess) return;
    Args a{};
    for (int i = 0; i < 25; ++i) a.in[i] = (const float*)d_in[i];
    a.out = (float*)d_out; a.ws = (unsigned char*)d_ws;
#ifdef MK_RANGES
    { const int rg[] = MK_RANGES; int nb = 0; for (unsigned i = 0; i + 2 < sizeof(rg) / sizeof(int); i += 3) { a.ph_lo = rg[i]; a.ph_hi = rg[i + 1]; a.sub = rg[i + 2]; a.bar_idx = (rg[i + 1] - rg[i] > 1) ? nb++ : 0;
        hipLaunchKernelGGL(mk_fwd, dim3(grid), dim3(512), LDS_BYTES, stream, a); } }
#else
    a.ph_lo = 0; a.ph_hi = NPH; a.bar_idx = 0; a.sub = 3; hipLaunchKernelGGL(mk_fwd, dim3(grid), dim3(512), LDS_BYTES, stream, a);
#endif
}
```

```cpp
#include <hip/hip_runtime.h>
#include <cstdio>
#include <cstdint>
#include <cmath>

constexpr int DM = 1024, BATCH = 8, SEQ = 4096, T = BATCH * SEQ;
constexpr int NG = 64, NP = 64, GCH = 16;
constexpr int HD = 64, NQH = 16, NKVH = 4, WIN = 128;
constexpr int IN_W = 4608;
constexpr int C_U = 0, C_Q = 1024, C_K = 2048, C_V = 2304, C_GS = 2560, C_GA = 3584;
constexpr int NE = 32, TOPK = 4, DFF = 1024, NA = T * TOPK;
constexpr int MAXROWS = NA + NE * 256;
constexpr int MAXMT = MAXROWS / 256;
constexpr float EPS = 1e-5f;

namespace pg8 {
#define PG8_LAS __attribute__((address_space(3)))
typedef unsigned short bf16_t;
typedef short bf16x8 __attribute__((ext_vector_type(8)));
typedef float f32x4 __attribute__((ext_vector_type(4)));
typedef unsigned u32x4 __attribute__((ext_vector_type(4)));
typedef int i32x8 __attribute__((ext_vector_type(8)));
typedef int i32x4 __attribute__((ext_vector_type(4)));
__device__ __forceinline__ i32x8 cat8(bf16x8 lo, bf16x8 hi) { return __builtin_shufflevector(__builtin_bit_cast(i32x4, lo), __builtin_bit_cast(i32x4, hi), 0, 1, 2, 3, 4, 5, 6, 7); }
constexpr int BM = 256, BK = 64, HALF = 128, HTB = HALF * BK * 2  , STAGE_BYTES = 8 * HTB, NXCD = 8, WGM = 4;

__host__ __device__ __forceinline__ int lds_byte(int r, int c) { const int st = (r >> 4) * 2 + (c >> 5), rr = r & 15, cc = c & 31, ob = rr * 64 + cc * 2; return st * 1024 + (ob ^ (((ob >> 9) & 1) << 5)); }
__host__ __device__ __forceinline__ void stage_rc(int b, int& R, int& C) { const int st = b / 1024, sb = b % 1024, swz = sb ^ (((sb >> 9) & 1) << 5); R = (st >> 1) * 16 + swz / 64; C = (st & 1) * 32 + (swz % 64) / 2; }
__host__ __device__ __forceinline__ int perm32(int rho) { const int n = rho >> 4, i = rho & 15; return 8 * (i >> 2) + 4 * n + (i & 3); }

struct Unit { int pm, pn, e, pl, rows, srow; };
struct Gemm { const bf16_t* A; const bf16_t* Bt; const bf16_t* A2; const bf16_t* Bt2; int M, N, K, agm, scaleA, scaleB, pad0, pad1; };

struct StaticOrder {
    static constexpr bool GATHER = false, FP8 = false, LINROWS = false;
    static constexpr PG8_LAS int* lbuf = nullptr;
    int nM, nN, nwg, G, c;
    __host__ __device__ void init(int M, int N, int G_, int c_) { nM = M / BM; nN = N / BM; nwg = nM * nN; G = G_; c = c_; }
    __host__ __device__ bool next(int i, Unit& u) const {
        const long L = (long)i * G + c; if (L >= nwg) return false;
        int wgid = (int)L; { const int q = nwg / NXCD, r = nwg % NXCD, xcd = wgid % NXCD, off = wgid / NXCD; wgid = (xcd < r ? xcd * (q + 1) : r * (q + 1) + (xcd - r) * q) + off; }
        const int nig = WGM * nN, gid = wgid / nig, fm = gid * WGM, gsz = (nM - fm) < WGM ? (nM - fm) : WGM;
        u.pm = fm + ((wgid % nig) % gsz); u.pn = (wgid % nig) / gsz; u.e = 0; u.pl = u.pn; u.rows = BM; u.srow = u.pm * BM; return true;
    }
    __device__ __forceinline__ void a_ready(const Unit&) const {}
    __device__ __forceinline__ void done(const Unit&) const {}
};

template <class Epi, class Sched, bool ALIGN_EPI = true>
__device__ __forceinline__ void gemm_phase(PG8_LAS unsigned char* lds, const Gemm g, const Sched& S, const Epi& E) {
    int tid = threadIdx.x; asm volatile("" : "+v"(tid));
    const int wid = __builtin_amdgcn_readfirstlane(tid >> 6), lane = tid & 63, wr = wid >> 2, wc = wid & 3, fr = lane & 15, fq = lane >> 4;
    constexpr bool GATHER = Sched::GATHER, FP8 = Sched::FP8;
    const int K = g.K, KB = FP8 ? K : 2 * K, nt = KB / 128;
    int RA[2], CA[2]; unsigned voffA0[2], voffA1[2], voffB[2];
#pragma unroll
    for (int i = 0; i < 2; ++i) { int R, C; stage_rc(tid * 16 + i * 8192, R, C); RA[i] = R; CA[i] = C;
        const int Rb = 2 * (R & ~31) + (Epi::PERM ? perm32(R & 31) : (R & 31));
        voffB[i] = (unsigned)(Rb * KB + C * 2);
        if (g.agm) { voffA0[i] = (unsigned)((C >> 4) * g.M * 32 + R * 32 + (C & 15) * 2); voffA1[i] = voffA0[i] + (unsigned)(HALF * 32); }
        else { voffA0[i] = (unsigned)(R * KB + C * 2); voffA1[i] = (unsigned)((R + HALF) * KB + C * 2); } }
    const size_t kstep = (size_t)(BK * 2);
    const size_t hstepB = (size_t)32 * KB;
    const size_t tstep = (size_t)BM * KB;
    const size_t kstepA = g.agm ? (size_t)4 * g.M * 32 : kstep, tstepA = g.agm ? (size_t)BM * 32 : tstep;
    const unsigned ldsw = (unsigned)wid * 1024u;
    const int aoff = lds_byte(wr * 64 + fr, fq * 8), boff = lds_byte(wc * 32 + fr, fq * 8);
    constexpr int KOFF = 1024;
#define PG8_SA(b, h) (((b) * 2 + (h)) * HTB)
#define PG8_SB(b, h) ((4 + (b) * 2 + (h)) * HTB)
#define PG8_STAGE(bufoff, gbase, voff) do { _Pragma("unroll") for (int _i = 0; _i < 2; ++_i) \
        __builtin_amdgcn_global_load_lds((const unsigned*)((const char*)(gbase) + (voff)[_i]), (PG8_LAS unsigned*)(lds + (bufoff) + ldsw + _i * 8192), 16, 0, 0); } while (0)
#define PG8_LDA(dst, b, h) do { _Pragma("unroll") for (int m = 0; m < 4; ++m) _Pragma("unroll") for (int k = 0; k < 2; ++k) dst[m][k] = *(const PG8_LAS bf16x8*)(lds + PG8_SA(b, h) + aoff + m * 2048 + k * KOFF); } while (0)
#define PG8_LDB(dst, b, h) do { _Pragma("unroll") for (int n = 0; n < 2; ++n) _Pragma("unroll") for (int k = 0; k < 2; ++k) dst[n][k] = *(const PG8_LAS bf16x8*)(lds + PG8_SB(b, h) + boff + n * 2048 + k * KOFF); } while (0)
#define PG8_MMA(ai, bj, At, Bt) do { __builtin_amdgcn_s_setprio(1); _Pragma("unroll") for (int m = 0; m < 4; ++m) _Pragma("unroll") for (int n = 0; n < 2; ++n) { \
        if constexpr (FP8) acc[ai][bj][m][n] = __builtin_amdgcn_mfma_scale_f32_16x16x128_f8f6f4(cat8(Bt[n][0], Bt[n][1]), cat8(At[m][0], At[m][1]), acc[ai][bj][m][n], 0, 0, 0, g.scaleB, 0, g.scaleA); \
        else { _Pragma("unroll") for (int k = 0; k < 2; ++k) acc[ai][bj][m][n] = __builtin_amdgcn_mfma_f32_16x16x32_bf16(Bt[n][k], At[m][k], acc[ai][bj][m][n], 0, 0, 0); } } __builtin_amdgcn_s_setprio(0); } while (0)
#define PG8_WAIT_V(n) asm volatile("s_waitcnt vmcnt(" #n ")" ::: "memory")
#define PG8_WAIT_L(n) asm volatile("s_waitcnt lgkmcnt(" #n ")" ::: "memory")
#define PG8_BAR __builtin_amdgcn_s_barrier()
#define PG8_SCHED __builtin_amdgcn_sched_barrier(0)
    Unit cur, nxt; int ui = 0;
    if (!S.next(0, cur)) return;
    f32x4 acc[2][2][4][2];
#pragma unroll
    for (int a = 0; a < 2; ++a)
#pragma unroll
        for (int b = 0; b < 2; ++b)
#pragma unroll
            for (int m = 0; m < 4; ++m)
#pragma unroll
                for (int n = 0; n < 2; ++n) acc[a][b][m][n] = (f32x4){0.f, 0.f, 0.f, 0.f};
    bf16x8 At[4][2], B0[2][2], B1[2][2];
    PG8_LAS int* const lring = S.lbuf;
    if constexpr (Epi::BIAS_LDS) { if (tid < BM) S.lbuf[3 * BM + tid] = __builtin_bit_cast(int, *E.bias_elem(cur, tid));
        asm volatile("s_waitcnt vmcnt(0) lgkmcnt(0)" ::: "memory"); PG8_BAR; asm volatile("" ::: "memory"); }
    constexpr bool LINROWS = Sched::LINROWS;
    if constexpr (GATHER && LINROWS) {
#pragma unroll
        for (int i = 0; i < 2; ++i) { voffA0[i] = (unsigned)(cur.srow + RA[i]) * (unsigned)KB + (unsigned)(CA[i] * 2); voffA1[i] = (unsigned)(cur.srow + HALF + RA[i]) * (unsigned)KB + (unsigned)(CA[i] * 2); } }
    if constexpr (GATHER && !LINROWS) {
        if (tid < BM) lring[tid] = S.list_entry(cur, tid);
        asm volatile("s_waitcnt vmcnt(0) lgkmcnt(0)" ::: "memory"); PG8_BAR; asm volatile("" ::: "memory");
#pragma unroll
        for (int i = 0; i < 2; ++i) { const int r0 = RA[i] < cur.rows ? RA[i] : cur.rows - 1, r1 = HALF + RA[i] < cur.rows ? HALF + RA[i] : cur.rows - 1;
            voffA0[i] = (unsigned)(lring[r0] >> S.ashift) * (unsigned)KB + (unsigned)(CA[i] * 2); voffA1[i] = (unsigned)(lring[r1] >> S.ashift) * (unsigned)KB + (unsigned)(CA[i] * 2); } }
    const char* cA = GATHER ? (const char*)g.A : (const char*)(cur.e && g.A2 ? g.A2 : g.A) + (size_t)cur.pm * tstepA; const char* cB = (const char*)(!GATHER && cur.e && g.Bt2 ? g.Bt2 : g.Bt) + (size_t)cur.pn * tstep;
    S.a_ready(cur);
    PG8_STAGE(PG8_SB(0, 0), cB, voffB); PG8_STAGE(PG8_SB(0, 1), cB + hstepB, voffB); PG8_STAGE(PG8_SA(0, 0), cA, voffA0); PG8_STAGE(PG8_SA(0, 1), cA, voffA1);
    if (wr == 1) PG8_BAR;
    PG8_WAIT_V(2); PG8_BAR;
    PG8_STAGE(PG8_SB(1, 0), cB + kstep, voffB); PG8_STAGE(PG8_SA(1, 0), cA + kstepA, voffA0); PG8_STAGE(PG8_SB(1, 1), cB + hstepB + kstep, voffB);
    PG8_WAIT_V(6); PG8_BAR;
    for (;;) {
        const bool has_next = S.next(ui + 1, nxt);
        const char* nA = GATHER ? cA : (has_next ? (const char*)(nxt.e && g.A2 ? g.A2 : g.A) + (size_t)nxt.pm * tstepA : cA); const char* nB = has_next ? (const char*)(!GATHER && nxt.e && g.Bt2 ? g.Bt2 : g.Bt) + (size_t)nxt.pn * tstep : cB;
        const int slot_cur = (ui % 3) * BM, slot_nxt = ((ui + 1) % 3) * BM;
        if constexpr (Epi::BIAS_LDS) { if (has_next && wid >= 4)
            __builtin_amdgcn_global_load_lds((const unsigned*)E.bias_elem(nxt, (wid - 4) * 64 + lane), (PG8_LAS unsigned*)(lring + 3 * BM + slot_nxt + (wid - 4) * 64), 4, 0, 0); }
        if constexpr (GATHER && !LINROWS) { if (has_next && wid < 4)
            __builtin_amdgcn_global_load_lds((const unsigned*)(S.list_ptr(nxt) + wid * 64 + lane), (PG8_LAS unsigned*)(lring + slot_nxt + wid * 64), 4, 0, 0); }
        for (int t = 0; t < nt; t += 2) {
            const bool last = (t == nt - 2);
            const char* a1 = cA + (size_t)(t + 1) * kstepA;
            const char* a2 = last ? nA : cA + (size_t)(t + 2) * kstepA; const char* b2 = last ? nB : cB + (size_t)(t + 2) * kstep;
            const char* a3 = a2 + kstepA; const char* b3 = b2 + kstep;
            if (last && has_next) S.a_ready(nxt);
            PG8_LDB(B0, 0, 0); PG8_LDB(B1, 0, 1); PG8_SCHED; PG8_LDA(At, 0, 0); PG8_STAGE(PG8_SA(1, 1), a1, voffA1);
            if constexpr (GATHER && LINROWS) { if (last && has_next) {
#pragma unroll
                for (int i = 0; i < 2; ++i) { voffA0[i] = (unsigned)(nxt.srow + RA[i]) * (unsigned)KB + (unsigned)(CA[i] * 2); voffA1[i] = (unsigned)(nxt.srow + HALF + RA[i]) * (unsigned)KB + (unsigned)(CA[i] * 2); } } }
            if constexpr (GATHER && !LINROWS) { if (last && has_next) {
#pragma unroll
                for (int i = 0; i < 2; ++i) { const int r0 = RA[i] < nxt.rows ? RA[i] : nxt.rows - 1, r1 = HALF + RA[i] < nxt.rows ? HALF + RA[i] : nxt.rows - 1;
                    voffA0[i] = (unsigned)(lring[slot_nxt + r0] >> S.ashift) * (unsigned)KB + (unsigned)(CA[i] * 2); voffA1[i] = (unsigned)(lring[slot_nxt + r1] >> S.ashift) * (unsigned)KB + (unsigned)(CA[i] * 2); } } }
            PG8_WAIT_V(8); PG8_WAIT_L(0); PG8_BAR; PG8_MMA(0, 0, At, B0); PG8_MMA(0, 1, At, B1); PG8_BAR; PG8_SCHED;
            PG8_LDA(At, 0, 1); PG8_STAGE(PG8_SB(0, 0), b2, voffB); PG8_STAGE(PG8_SB(0, 1), b2 + hstepB, voffB); PG8_STAGE(PG8_SA(0, 0), a2, voffA0);
            PG8_WAIT_V(8); PG8_WAIT_L(0); PG8_BAR; PG8_MMA(1, 0, At, B0); PG8_MMA(1, 1, At, B1); PG8_BAR; PG8_SCHED;
            PG8_LDB(B0, 1, 0); PG8_LDB(B1, 1, 1); PG8_SCHED; PG8_LDA(At, 1, 0); PG8_STAGE(PG8_SA(0, 1), a2, voffA1);
            PG8_WAIT_V(8); PG8_WAIT_L(0); PG8_BAR; PG8_MMA(0, 0, At, B0); PG8_MMA(0, 1, At, B1); PG8_BAR; PG8_SCHED;
            PG8_LDA(At, 1, 1); PG8_STAGE(PG8_SB(1, 0), b3, voffB); PG8_STAGE(PG8_SB(1, 1), b3 + hstepB, voffB); PG8_STAGE(PG8_SA(1, 0), a3, voffA0);
            PG8_WAIT_V(8); PG8_WAIT_L(0); PG8_BAR; PG8_MMA(1, 0, At, B0); PG8_MMA(1, 1, At, B1); PG8_BAR; PG8_SCHED;
        }
        if constexpr (ALIGN_EPI) { if (wr == 0) PG8_BAR; }
        E(acc, cur, wr, wc, fr, fq, lring + slot_cur); S.done(cur);
        if (!has_next) break;
#pragma unroll
        for (int a = 0; a < 2; ++a)
#pragma unroll
            for (int b = 0; b < 2; ++b)
#pragma unroll
                for (int m = 0; m < 4; ++m)
#pragma unroll
                    for (int n = 0; n < 2; ++n) acc[a][b][m][n] = (f32x4){0.f, 0.f, 0.f, 0.f};
        cur = nxt; cA = nA; cB = nB; ++ui;
        if constexpr (ALIGN_EPI) { if (wr == 1) PG8_BAR; }
    }
    PG8_WAIT_V(0);
    if constexpr (!ALIGN_EPI) { if (wr == 0) PG8_BAR; }
    PG8_BAR;
#undef PG8_SA
#undef PG8_SB
#undef PG8_STAGE
#undef PG8_LDA
#undef PG8_LDB
#undef PG8_MMA
#undef PG8_WAIT_V
#undef PG8_WAIT_L
#undef PG8_BAR
#undef PG8_SCHED
}

__device__ __forceinline__ unsigned cvt_pk_bf16(float lo, float hi) { unsigned r; asm volatile("v_cvt_pk_bf16_f32 %0, %1, %2" : "=v"(r) : "v"(lo), "v"(hi)); return r; }
__device__ __forceinline__ float bf_lo(unsigned w) { return __uint_as_float(w << 16); }
__device__ __forceinline__ float bf_hi(unsigned w) { return __uint_as_float(w & 0xffff0000u); }
__device__ __forceinline__ float sigm(float x) { return __builtin_amdgcn_rcpf(1.f + __builtin_amdgcn_exp2f(-1.4426950408889634f * x)); }
__device__ __forceinline__ f32x4 sigm4(f32x4 x) { f32x4 t = x * -1.4426950408889634f, s;
#pragma unroll
    for (int j = 0; j < 4; ++j) s[j] = __builtin_amdgcn_exp2f(t[j]);
    s = s + 1.f;
#pragma unroll
    for (int j = 0; j < 4; ++j) s[j] = __builtin_amdgcn_rcpf(s[j]);
    return s; }
__device__ __forceinline__ u32x4 pack8(const f32x4 v0, const f32x4 v1) { u32x4 w; w.x = cvt_pk_bf16(v0[0], v0[1]); w.y = cvt_pk_bf16(v0[2], v0[3]); w.z = cvt_pk_bf16(v1[0], v1[1]); w.w = cvt_pk_bf16(v1[2], v1[3]); return w; }
__device__ __forceinline__ void unpack8(const u32x4 w, f32x4& v0, f32x4& v1) { v0 = (f32x4){bf_lo(w.x), bf_hi(w.x), bf_lo(w.y), bf_hi(w.y)}; v1 = (f32x4){bf_lo(w.z), bf_hi(w.z), bf_lo(w.w), bf_hi(w.w)}; }

struct EpiProj {
    static constexpr bool PERM = true, BIAS_LDS = false;
    bf16_t* O; const float* qg; const float* kg; bf16_t* U; PG8_LAS unsigned char* stage; int ldc; float qscale; int nostore, urows, pad;
    __device__ __forceinline__ void operator()(f32x4 (&acc)[2][2][4][2], const Unit& u, int wr, int wc, int fr, int fq, const PG8_LAS int* lrow) const {
        if (nostore & 2) { for (int ai = 0; ai < 2; ++ai) for (int m = 0; m < 4; ++m) asm volatile("" :: "v"(acc[ai][0][m][0]), "v"(acc[ai][0][m][1]), "v"(acc[ai][1][m][0]), "v"(acc[ai][1][m][1])); return; }
        const int row0 = u.pm * BM + wr * 64 + fr, col0 = u.pl * BM + wc * 64 + 8 * fq;
        if (u.pl >= 4 && u.pl <= 8) {
            const float* gp = (u.pl == 8 ? kg : qg) + 8 * fq; const float sc = (u.pl == 8) ? 1.f : qscale;
            f32x4 gv[2][2];
#pragma unroll
            for (int bj = 0; bj < 2; ++bj)
#pragma unroll
                for (int n = 0; n < 2; ++n) gv[bj][n] = *(const f32x4*)(gp + 32 * bj + 4 * n) * sc;
#pragma unroll
            for (int ai = 0; ai < 2; ++ai)
#pragma unroll
                for (int m = 0; m < 4; ++m) { float ss = 0.f;
#pragma unroll
                    for (int bj = 0; bj < 2; ++bj)
#pragma unroll
                        for (int n = 0; n < 2; ++n) { const f32x4 v = acc[ai][bj][m][n]; ss += (v[0] * v[0] + v[1] * v[1]) + (v[2] * v[2] + v[3] * v[3]); }
                    ss += __shfl_xor(ss, 16); ss += __shfl_xor(ss, 32);
                    const float rs = rsqrtf(ss * (1.f / 64.f) + 1e-5f);
#pragma unroll
                    for (int bj = 0; bj < 2; ++bj)
#pragma unroll
                        for (int n = 0; n < 2; ++n) acc[ai][bj][m][n] = acc[ai][bj][m][n] * rs * gv[bj][n]; }
        }
        if (u.pl < 4) {
#pragma unroll
            for (int ai = 0; ai < 2; ++ai)
#pragma unroll
                for (int m = 0; m < 4; ++m)
#pragma unroll
                    for (int bj = 0; bj < 2; ++bj) { const u32x4 w = pack8(acc[ai][bj][m][0], acc[ai][bj][m][1]); const int c = col0 + bj * 32;
                        *(u32x4*)(U + ((size_t)(c >> 4) * urows + (size_t)(row0 + ai * HALF + m * 16)) * 16 + (c & 15)) = w; }
        } else {
            PG8_LAS unsigned char* stg = stage + (wr * 4 + wc) * 2304; const int lane = fq * 16 + fr;
            bf16_t* ob = O + (size_t)(u.pm * BM + wr * 64 + (lane >> 3)) * ldc + u.pl * BM + wc * 64 + 8 * (lane & 7);
#pragma unroll
            for (int ai = 0; ai < 2; ++ai)
#pragma unroll
                for (int m = 0; m < 4; ++m) {
#pragma unroll
                    for (int bj = 0; bj < 2; ++bj) *(PG8_LAS u32x4*)(stg + fr * 144 + bj * 64 + fq * 16) = pack8(acc[ai][bj][m][0], acc[ai][bj][m][1]);
                    asm volatile("s_waitcnt lgkmcnt(0)" ::: "memory");
                    const u32x4 r0 = *(const PG8_LAS u32x4*)(stg + (lane >> 3) * 144 + (lane & 7) * 16), r1 = *(const PG8_LAS u32x4*)(stg + ((lane >> 3) + 8) * 144 + (lane & 7) * 16);
                    asm volatile("s_waitcnt lgkmcnt(0)" ::: "memory");
                    if (!(nostore & 1)) { *(u32x4*)(ob + (size_t)(ai * HALF + m * 16) * ldc) = r0; *(u32x4*)(ob + (size_t)(ai * HALF + m * 16 + 8) * ldc) = r1; } }
        }
    }
};
struct EpiGlu {
    static constexpr bool PERM = true, BIAS_LDS = false;
    bf16_t* O; int ldc, pad;
    __device__ __forceinline__ void operator()(f32x4 (&acc)[2][2][4][2], const Unit& u, int wr, int wc, int fr, int fq, const PG8_LAS int* lrow) const {
        const int row0 = u.pm * BM + wr * 64 + fr, col0 = u.pl * HALF + wc * 32 + 8 * fq;
#pragma unroll
        for (int ai = 0; ai < 2; ++ai)
#pragma unroll
            for (int m = 0; m < 4; ++m) { bf16_t* rowp = O + (size_t)(row0 + ai * HALF + m * 16) * ldc + col0;
                const f32x4 o0 = acc[ai][0][m][0] * sigm4(acc[ai][1][m][0]), o1 = acc[ai][0][m][1] * sigm4(acc[ai][1][m][1]);
                *(u32x4*)rowp = pack8(o0, o1); }
    }
};
struct EpiGate {
    static constexpr bool PERM = true, BIAS_LDS = false;
    bf16_t* O; const bf16_t* G; PG8_LAS unsigned char* stage; int ldc, ldg, gcol0, gcol1;
    __device__ __forceinline__ void operator()(f32x4 (&acc)[2][2][4][2], const Unit& u, int wr, int wc, int fr, int fq, const PG8_LAS int* lrow) const {
        const int row0 = u.pm * BM + wr * 64 + fr, col0 = u.pl * BM + wc * 64 + 8 * fq; const bool add = u.e != 0; const int gcol = add ? gcol1 : gcol0;
        PG8_LAS unsigned char* stg = stage + (wr * 4 + wc) * 2304; const int lane = fq * 16 + fr;
        bf16_t* ob = O + (size_t)(u.pm * BM + wr * 64 + (lane >> 3)) * ldc + u.pl * BM + wc * 64 + 8 * (lane & 7);
#pragma unroll
        for (int ai = 0; ai < 2; ++ai) {
            u32x4 gw[4][2], ow[4][2];
#pragma unroll
            for (int m = 0; m < 4; ++m)
#pragma unroll
                for (int bj = 0; bj < 2; ++bj) { const size_t r = (size_t)(row0 + ai * HALF + m * 16);
                    gw[m][bj] = *(const u32x4*)(G + r * ldg + gcol + col0 + bj * 32);
                    if (add) ow[m][bj] = __builtin_nontemporal_load((const u32x4*)(O + r * ldc + col0 + bj * 32)); else ow[m][bj] = (u32x4){0u, 0u, 0u, 0u}; }
#pragma unroll
            for (int m = 0; m < 4; ++m)
#pragma unroll
                for (int bj = 0; bj < 2; ++bj) { const size_t r = (size_t)(row0 + ai * HALF + m * 16);
                    f32x4 g0, g1; unpack8(gw[m][bj], g0, g1);
                    f32x4 p0, p1; unpack8(ow[m][bj], p0, p1);
                    const f32x4 o0 = sigm4(g0) * acc[ai][bj][m][0] + p0, o1 = sigm4(g1) * acc[ai][bj][m][1] + p1;
                    *(PG8_LAS u32x4*)(stg + fr * 144 + bj * 64 + fq * 16) = pack8(o0, o1);
                    if (bj == 1) {
                        asm volatile("s_waitcnt lgkmcnt(0)" ::: "memory");
                        const u32x4 r0 = *(const PG8_LAS u32x4*)(stg + (lane >> 3) * 144 + (lane & 7) * 16), r1 = *(const PG8_LAS u32x4*)(stg + ((lane >> 3) + 8) * 144 + (lane & 7) * 16);
                        asm volatile("s_waitcnt lgkmcnt(0)" ::: "memory");
                        *(u32x4*)(ob + (size_t)(ai * HALF + m * 16) * ldc) = r0; *(u32x4*)(ob + (size_t)(ai * HALF + m * 16 + 8) * ldc) = r1; } } }
    }
};
struct EpiResid {
    static constexpr bool PERM = true, BIAS_LDS = false;
    const float* base; bf16_t* out; PG8_LAS unsigned char* stage; int ldc, pad;
    __device__ __forceinline__ void operator()(f32x4 (&acc)[2][2][4][2], const Unit& u, int wr, int wc, int fr, int fq, const PG8_LAS int* lrow) const {
        const int row0 = u.pm * BM + wr * 64 + fr, col0 = u.pl * BM + wc * 64 + 8 * fq;
        PG8_LAS unsigned char* stg = stage + (wr * 4 + wc) * 2304; const int lane = fq * 16 + fr;
        bf16_t* ob = out + (size_t)(u.pm * BM + wr * 64 + (lane >> 3)) * ldc + u.pl * BM + wc * 64 + 8 * (lane & 7);
#pragma unroll
        for (int ai = 0; ai < 2; ++ai) {
            f32x4 bv[4][2][2];
#pragma unroll
            for (int m = 0; m < 4; ++m)
#pragma unroll
                for (int bj = 0; bj < 2; ++bj) { const float* bp = base + (size_t)(row0 + ai * HALF + m * 16) * ldc + col0 + bj * 32; bv[m][bj][0] = *(const f32x4*)bp; bv[m][bj][1] = *(const f32x4*)(bp + 4); }
#pragma unroll
            for (int m = 0; m < 4; ++m) {
#pragma unroll
                for (int bj = 0; bj < 2; ++bj) *(PG8_LAS u32x4*)(stg + fr * 144 + bj * 64 + fq * 16) = pack8(acc[ai][bj][m][0] + bv[m][bj][0], acc[ai][bj][m][1] + bv[m][bj][1]);
                asm volatile("s_waitcnt lgkmcnt(0)" ::: "memory");
                const u32x4 r0 = *(const PG8_LAS u32x4*)(stg + (lane >> 3) * 144 + (lane & 7) * 16), r1 = *(const PG8_LAS u32x4*)(stg + ((lane >> 3) + 8) * 144 + (lane & 7) * 16);
                asm volatile("s_waitcnt lgkmcnt(0)" ::: "memory");
                *(u32x4*)(ob + (size_t)(ai * HALF + m * 16) * ldc) = r0; *(u32x4*)(ob + (size_t)(ai * HALF + m * 16 + 8) * ldc) = r1; } }
    }
};
struct EpiSwiglu {
    static constexpr bool PERM = true, BIAS_LDS = true;
    __device__ __forceinline__ const float* bias_elem(const Unit& u, int i) const { return bias + (size_t)u.e * 2 * dff + u.pl * HALF + (i < HALF ? i : dff + i - HALF); }
    unsigned char* O; const float* bias; int ldc, dff; float limit, alpha; int skip, pad;
    __device__ __forceinline__ void operator()(f32x4 (&acc)[2][2][4][2], const Unit& u, int wr, int wc, int fr, int fq, const PG8_LAS int* lrow) const {
        if (skip) { for (int ai = 0; ai < 2; ++ai) for (int m = 0; m < 4; ++m) asm volatile("" :: "v"(acc[ai][0][m][0]), "v"(acc[ai][0][m][1]), "v"(acc[ai][1][m][0]), "v"(acc[ai][1][m][1])); return; }
        asm volatile("" : "+v"(fr));
        const int col0 = u.pl * HALF + wc * 32 + 8 * fq;
        const PG8_LAS float* bg = (const PG8_LAS float*)(lrow + 3 * BM) + wc * 32 + 8 * fq; const PG8_LAS float* bu = bg + HALF;
        const f32x4 bg0 = *(const PG8_LAS f32x4*)bg, bg1 = *(const PG8_LAS f32x4*)(bg + 4), bu0 = *(const PG8_LAS f32x4*)bu, bu1 = *(const PG8_LAS f32x4*)(bu + 4);
        const float nal2 = -1.4426950408889634f * alpha;
#pragma unroll
        for (int ai = 0; ai < 2; ++ai)
#pragma unroll
            for (int m = 0; m < 4; ++m) { const int r = ai * HALF + wr * 64 + m * 16 + fr; unsigned char* rowp = O + (size_t)(u.srow + r) * ldc + col0;
                const f32x4 gt0 = __builtin_elementwise_min(acc[ai][0][m][0] + bg0, (f32x4){limit, limit, limit, limit}), gt1 = __builtin_elementwise_min(acc[ai][0][m][1] + bg1, (f32x4){limit, limit, limit, limit});
                f32x4 up0 = acc[ai][1][m][0] + bu0, up1 = acc[ai][1][m][1] + bu1, s0, s1;
                const f32x4 a0 = gt0 * nal2, a1 = gt1 * nal2;
#pragma unroll
                for (int j = 0; j < 4; ++j) { up0[j] = __builtin_amdgcn_fmed3f(up0[j], -limit, limit); up1[j] = __builtin_amdgcn_fmed3f(up1[j], -limit, limit);
                    s0[j] = __builtin_amdgcn_exp2f(a0[j]); s1[j] = __builtin_amdgcn_exp2f(a1[j]); }
                s0 = s0 + 1.f; s1 = s1 + 1.f;
#pragma unroll
                for (int j = 0; j < 4; ++j) { s0[j] = __builtin_amdgcn_rcpf(s0[j]); s1[j] = __builtin_amdgcn_rcpf(s1[j]); }
                const f32x4 o0 = (up0 * gt0 + gt0) * s0, o1 = (up1 * gt1 + gt1) * s1;
                int w0 = __builtin_amdgcn_cvt_pk_fp8_f32(o0[0], o0[1], 0, false); w0 = __builtin_amdgcn_cvt_pk_fp8_f32(o0[2], o0[3], w0, true);
                int w1 = __builtin_amdgcn_cvt_pk_fp8_f32(o1[0], o1[1], 0, false); w1 = __builtin_amdgcn_cvt_pk_fp8_f32(o1[2], o1[3], w1, true);
                *(unsigned long long*)rowp = (unsigned long long)(unsigned)w0 | ((unsigned long long)(unsigned)w1 << 32); }
    }
};
struct EpiDown {
    static constexpr bool PERM = true, BIAS_LDS = true;
    __device__ __forceinline__ const float* bias_elem(const Unit& u, int i) const { return bias + (size_t)u.e * ncol + u.pl * BM + i; }
    bf16_t* O; const float* bias; PG8_LAS unsigned char* stage; int ldc, ncol, skip, pad;
    __device__ __forceinline__ void operator()(f32x4 (&acc)[2][2][4][2], const Unit& u, int wr, int wc, int fr, int fq, const PG8_LAS int* lrow) const {
        if (skip) { for (int ai = 0; ai < 2; ++ai) for (int m = 0; m < 4; ++m) asm volatile("" :: "v"(acc[ai][0][m][0]), "v"(acc[ai][0][m][1]), "v"(acc[ai][1][m][0]), "v"(acc[ai][1][m][1])); return; }
        asm volatile("" : "+v"(fr));
        const PG8_LAS float* bp = (const PG8_LAS float*)(lrow + 3 * BM) + wc * 64 + 8 * fq;
        f32x4 bv[2][2];
#pragma unroll
        for (int bj = 0; bj < 2; ++bj) { bv[bj][0] = *(const PG8_LAS f32x4*)(bp + bj * 32); bv[bj][1] = *(const PG8_LAS f32x4*)(bp + bj * 32 + 4); }
        const int lane = fq * 16 + fr;
        unsigned char* ob = (unsigned char*)O + (size_t)(u.srow + wr * 64 + 4 * wc + (lane >> 4)) * ldc + u.pl * BM + 16 * (lane & 15);
#pragma unroll
        for (int ai = 0; ai < 2; ++ai)
#pragma unroll
            for (int m = 0; m < 4; ++m) { const int step = ai * 4 + m; PG8_LAS unsigned char* buf = stage + ((step & 1) * 2 + wr) * 4352;
#pragma unroll
                for (int bj = 0; bj < 2; ++bj) { const f32x4 o0 = acc[ai][bj][m][0] + bv[bj][0], o1 = acc[ai][bj][m][1] + bv[bj][1];
                    int w0 = __builtin_amdgcn_cvt_pk_fp8_f32(o0[0], o0[1], 0, false); w0 = __builtin_amdgcn_cvt_pk_fp8_f32(o0[2], o0[3], w0, true);
                    int w1 = __builtin_amdgcn_cvt_pk_fp8_f32(o1[0], o1[1], 0, false); w1 = __builtin_amdgcn_cvt_pk_fp8_f32(o1[2], o1[3], w1, true);
                    *(PG8_LAS unsigned long long*)(buf + fr * 272 + wc * 64 + bj * 32 + fq * 8) = (unsigned long long)(unsigned)w0 | ((unsigned long long)(unsigned)w1 << 32); }
                asm volatile("s_waitcnt lgkmcnt(0)" ::: "memory"); __builtin_amdgcn_s_barrier(); asm volatile("" ::: "memory");
                const u32x4 r = *(const PG8_LAS u32x4*)(buf + (4 * wc + (lane >> 4)) * 272 + (lane & 15) * 16);
                *(u32x4*)(ob + (size_t)(ai * HALF + m * 16) * ldc) = r; }
    }
};
template <bool GATH> struct GroupedOrderT {
    static constexpr bool GATHER = true, FP8 = true, LINROWS = !GATH;
    const PG8_LAS unsigned char* tile_e; const PG8_LAS int* pref; const PG8_LAS int* cnt; PG8_LAS int* lbuf; const int* list; int nN, G, c, nM, lstride, ashift;
    __device__ __forceinline__ bool next(int i, Unit& u) const {
        const int nwg = nM * nN; const long L = (long)i * G + c; if (L >= nwg) return false;
        int wgid = (int)L; { const int q = nwg / NXCD, r = nwg % NXCD, xcd = wgid % NXCD, off = wgid / NXCD; wgid = (xcd < r ? xcd * (q + 1) : r * (q + 1) + (xcd - r) * q) + off; }
        const int nig = WGM * nN, gid = wgid / nig, fm = gid * WGM, gsz = (nM - fm) < WGM ? (nM - fm) : WGM;
        const int mt = fm + ((wgid % nig) % gsz), pl = (wgid % nig) / gsz;
        const int e = tile_e[mt]; const int mtl = mt - pref[e]; const int left = cnt[e] - 256 * mtl;
        u.pm = mtl; u.pn = e * nN + pl; u.e = e; u.pl = pl; u.rows = left < 256 ? left : 256; u.srow = mt * BM; return true;
    }
    __device__ __forceinline__ const int* list_ptr(const Unit& u) const { return list + (size_t)u.e * lstride + u.pm * BM; }
    __device__ __forceinline__ int list_entry(const Unit& u, int r) const { return list_ptr(u)[r < u.rows ? r : u.rows - 1]; }
    __device__ __forceinline__ void a_ready(const Unit&) const {}
    __device__ __forceinline__ void done(const Unit&) const {}
};
struct DualOrder {
    static constexpr bool GATHER = false, FP8 = false, LINROWS = false;
    static constexpr PG8_LAS int* lbuf = nullptr;
    StaticOrder S; int nper;
    __device__ __forceinline__ void init(int M, int N, int G, int c) { S.init(M, N, G, c); nper = (S.nwg - c + G - 1) / G; if (nper < 0) nper = 0; }
    __device__ __forceinline__ bool next(int i, Unit& u) const { if (i >= 2 * nper) return false; const int e = i >= nper ? 1 : 0; const bool ok = S.next(i - e * nper, u); u.e = e; return ok; }
    __device__ __forceinline__ void a_ready(const Unit&) const {}
    __device__ __forceinline__ void done(const Unit&) const {}
};
}

#define GAS __attribute__((address_space(1)))
#define LAS __attribute__((address_space(3)))
typedef unsigned short bf16;
typedef unsigned v4u __attribute__((ext_vector_type(4)));
typedef float f32x4 __attribute__((ext_vector_type(4)));
typedef short bf16x8 __attribute__((ext_vector_type(8)));
typedef GAS unsigned gu32;
typedef GAS unsigned long long gu64;
#define RLX_AGENT __ATOMIC_RELAXED, __HIP_MEMORY_SCOPE_AGENT
#define LDS_WAIT() asm volatile("s_waitcnt lgkmcnt(0)" ::: "memory")
#define VM_WAIT() asm volatile("s_waitcnt vmcnt(0)" ::: "memory")
__device__ __forceinline__ unsigned long long rt() { return __builtin_amdgcn_s_memrealtime(); }
__device__ __forceinline__ unsigned f2bf(float f) { unsigned u = __builtin_bit_cast(unsigned, f); return (u + 0x7fffu + ((u >> 16) & 1u)) >> 16; }
__device__ __forceinline__ unsigned pk2(float lo, float hi) { return f2bf(lo) | (f2bf(hi) << 16); }

#define XB_TMO      128
#define XB_XCNT(j)  (256  + 64 * (j))
#define XB_XSUB(j)  (1280 + 64 * (j))
#define XB_XGEN(j)  (2304 + 64 * (j))
#define XB_TOP      3328
#define XB_TOPGEN   3392
#define XCD_BAR_WORDS 3456
#define XB_SPIN_CAP (1u << 18)

__device__ __forceinline__ unsigned xb_ld(unsigned* p)              { return __hip_atomic_load(p, __ATOMIC_RELAXED, __HIP_MEMORY_SCOPE_AGENT); }
__device__ __forceinline__ unsigned xb_add(unsigned* p, unsigned v) { return __hip_atomic_fetch_add(p, v, __ATOMIC_RELAXED, __HIP_MEMORY_SCOPE_AGENT); }
__device__ __forceinline__ unsigned xb_xcc_id() { return (unsigned)__builtin_amdgcn_s_getreg((3 << 11) | 20) & 0xFu; }
#define XB_SPIN(cond, bar) do { unsigned _sp = 0; while (cond) { __builtin_amdgcn_s_sleep(1); \
    if ((++_sp & 255u) == 0u) { if (xb_ld(&(bar)[XB_TMO])) break; if (_sp > XB_SPIN_CAP) { atomicAdd(&(bar)[XB_TMO], 1u); break; } } } } while (0)

struct XcdBarrier {
    unsigned* bar; unsigned x;
    volatile LAS unsigned* st;
};

__device__ __forceinline__ XcdBarrier xcd_barrier_post(unsigned* bar, volatile LAS unsigned* st) {
    XcdBarrier b; b.bar = bar; b.x = xb_xcc_id(); b.st = st;
    if (threadIdx.x == 0) (void)xb_add(&bar[XB_XCNT(b.x)], 1u);
    return b;
}
__device__ __forceinline__ void xcd_barrier_complete(unsigned* bar, unsigned x, unsigned& nloc, unsigned& nx) {
    const unsigned G = gridDim.x * gridDim.y * gridDim.z;
    unsigned sum, cnt, mine, sp = 0u;
    for (;;) {
        sum = 0u; cnt = 0u; mine = 0u;
#pragma unroll
        for (unsigned j = 0; j < 16; ++j) { const unsigned c = xb_ld(&bar[XB_XCNT(j)]); sum += c; cnt += (c > 0u) ? 1u : 0u; mine = (j == x) ? c : mine; }
        if (sum == G) break;
        __builtin_amdgcn_s_sleep(1);
        if ((++sp & 255u) == 0u) { if (xb_ld(&bar[XB_TMO])) break; if (sp > XB_SPIN_CAP) { atomicAdd(&bar[XB_TMO], 1u); break; } }
    }
    nloc = mine > 0u ? mine : 1u; nx = cnt > 0u ? cnt : 1u;
}

__device__ __forceinline__ void xcd_barrier(const XcdBarrier& b) {
    asm volatile("s_waitcnt vmcnt(0)" ::: "memory");
    __syncthreads();
    if (threadIdx.x == 0) {
        unsigned* bar = b.bar;
        __builtin_amdgcn_s_waitcnt(0);
        unsigned nloc = b.st[0], nx = b.st[1];
        if (nloc == 0u) { xcd_barrier_complete(bar, b.x, nloc, nx); b.st[0] = nloc; b.st[1] = nx; }
        const unsigned old = xb_add(&bar[XB_XSUB(b.x)], 1u);
        const unsigned gen = old / nloc;
        if (old + 1u == (gen + 1u) * nloc) {
            __builtin_amdgcn_fence(__ATOMIC_RELEASE, "agent");
            asm volatile("s_waitcnt vmcnt(0)" ::: "memory");
            const unsigned og = xb_add(&bar[XB_TOP], 1u);
            const unsigned tg = og / nx;
            if (og + 1u == (tg + 1u) * nx) xb_add(&bar[XB_TOPGEN], 1u);
            else XB_SPIN(xb_ld(&bar[XB_TOPGEN]) == tg, bar);
            __builtin_amdgcn_fence(__ATOMIC_ACQUIRE, "agent");
            xb_add(&bar[XB_XGEN(b.x)], 1u);
            asm volatile("s_waitcnt vmcnt(0)" ::: "memory");
        } else {
            XB_SPIN(xb_ld(&bar[XB_XGEN(b.x)]) == gen, bar);
            __builtin_amdgcn_fence(__ATOMIC_ACQUIRE, "agent");
            asm volatile("s_waitcnt vmcnt(0)" ::: "memory");
        }
    }
    __syncthreads();
}

constexpr size_t MiB = 1u << 20;
constexpr size_t WS_CTL = 0;
constexpr size_t CTL_ZERO_BYTES = 65536;
constexpr size_t WS_WIN = 1 * MiB, WS_WGLU = 10 * MiB, WS_WSSM = 14 * MiB, WS_WATT = 16 * MiB, WS_WOUT = 18 * MiB;
constexpr size_t WS_WGU = 20 * MiB, WS_WDN = 148 * MiB;
constexpr float WSCALE = 64.f; constexpr int WSCALE_E8M0 = 127 - 6;
constexpr size_t WS_ROUTE = 216 * MiB;
constexpr size_t WS_H = 224 * MiB;
constexpr size_t WS_PROJ = 288 * MiB;
constexpr size_t WS_S5OUT = 576 * MiB;
constexpr size_t WS_ATTN = 640 * MiB;
constexpr size_t WS_ACT = 704 * MiB;
constexpr size_t WS_BTAB = 976 * MiB, WS_CTAB = 980 * MiB, WS_KTAB = 984 * MiB, WS_A16 = 985 * MiB;
constexpr size_t WS_END = 986 * MiB;
static_assert(WS_PROJ + (size_t)T * IN_W * 2 <= WS_S5OUT && WS_PROJ + (size_t)MAXROWS * 1024 * 2 <= WS_S5OUT && WS_ACT + (size_t)MAXROWS * 1024 <= WS_BTAB, "ws map");
constexpr int CW_CNT = 0;
constexpr int CW_BAR = 4096;
static_assert((CW_BAR + 3 * XCD_BAR_WORDS) * 4 <= (int)CTL_ZERO_BYTES, "ctl map");
constexpr size_t RT_TOPW = 0, RT_LIST = 1 * MiB, RT_APOS = 5 * MiB;

constexpr int LDS_BYTES = 163840;
constexpr int RING_OFF = 0;
constexpr int MISC_OFF = LDS_BYTES - 256;
constexpr int GT_OFF = 131072;

__device__ __forceinline__ float bf2f(bf16 b) { return __uint_as_float((unsigned)b << 16); }
__device__ __forceinline__ float wave_sum(float v) {
#pragma unroll
    for (int o = 1; o < 64; o <<= 1) v += __shfl_xor(v, o);
    return v;
}
__device__ __forceinline__ float wave_max(float v) {
#pragma unroll
    for (int o = 1; o < 64; o <<= 1) v = fmaxf(v, __shfl_xor(v, o));
    return v;
}
__device__ __forceinline__ float gelu_tanh(float x) { const float z = -2.3022081985f * (x + 0.044715f * x * x * x); return x * __builtin_amdgcn_rcpf(1.f + __builtin_amdgcn_exp2f(z)); }
#define WAVE_SYNC() do { __builtin_amdgcn_wave_barrier(); asm volatile("s_waitcnt lgkmcnt(0)" ::: "memory"); } while (0)

struct Args { const float* in[25]; float* out; unsigned char* ws; int ph_lo, ph_hi, bar_idx, sub; };
struct Ctx { int tid, lane, wave, vcu, G, gw, ngw; LAS unsigned char* lds; };

constexpr int TR_SCR = 64 * 65 * 4;
__device__ __forceinline__ void transpose_item(const float* W, int K, int N, bf16* WT, int mode, LAS float* scr, int item, int lane) {
    const int nblk = N / 64, kb = item / nblk, nb = item % nblk, k0 = 64 * kb, n0 = 64 * nb;
#pragma unroll 4
    for (int i = 0; i < 16; ++i) { const int kk = 4 * i + (lane >> 4), nn = 4 * (lane & 15); const f32x4 w = *(const f32x4*)(W + (size_t)(k0 + kk) * N + n0 + nn);
        LAS float* s = scr + kk * 65 + nn; s[0] = w.x; s[1] = w.y; s[2] = w.z; s[3] = w.w; }
    LDS_WAIT(); asm volatile("" ::: "memory");
    const int c = lane & 7;
#pragma unroll
    for (int j = 0; j < 8; ++j) { const int n = (lane >> 3) + 8 * j; const LAS float* s = scr + (8 * c) * 65 + n;
        v4u o; o.x = pk2(s[0 * 65], s[1 * 65]); o.y = pk2(s[2 * 65], s[3 * 65]); o.z = pk2(s[4 * 65], s[5 * 65]); o.w = pk2(s[6 * 65], s[7 * 65]);
        int r = n0 + n;
        if (mode == 1) { const int nh = N / 2, hf = (r >= nh) ? 1 : 0, np = r - hf * nh; r = 256 * (np / 128) + 64 * ((np % 128) / 32) + 32 * hf + (np % 32); }
        *(v4u*)(WT + (size_t)r * K + k0 + 8 * c) = o; }
    LDS_WAIT(); asm volatile("" ::: "memory");
}
constexpr int TR8_SCR = 128 * 33 * 4;
__device__ __forceinline__ void transpose_item_fp8(const float* W, int K, int N, unsigned char* WT, int mode, float wscale, LAS float* scr, int item, int lane) {
    const int nblk = N / 32, kb = item / nblk, nb = item % nblk, k0 = 128 * kb, n0 = 32 * nb;
#pragma unroll 4
    for (int i = 0; i < 16; ++i) { const int kk = 8 * i + (lane >> 3), nn = 4 * (lane & 7); const f32x4 w = *(const f32x4*)(W + (size_t)(k0 + kk) * N + n0 + nn);
        LAS float* s = scr + kk * 33 + nn; s[0] = w.x; s[1] = w.y; s[2] = w.z; s[3] = w.w; }
    LDS_WAIT(); asm volatile("" ::: "memory");
    int rb = n0;
    if (mode == 1) { const int nh = N / 2, hf = (n0 >= nh) ? 1 : 0, np = n0 - hf * nh; rb = 256 * (np / 128) + 64 * ((np % 128) / 32) + 32 * hf; }
    const int c = lane & 7;
#pragma unroll
    for (int j = 0; j < 4; ++j) { const int n = (lane >> 3) + 8 * j; const LAS float* s = scr + (16 * c) * 33 + n;
        v4u o;
#pragma unroll
        for (int q = 0; q < 4; ++q) { int w = __builtin_amdgcn_cvt_pk_fp8_f32(s[(4 * q) * 33] * wscale, s[(4 * q + 1) * 33] * wscale, 0, false); w = __builtin_amdgcn_cvt_pk_fp8_f32(s[(4 * q + 2) * 33] * wscale, s[(4 * q + 3) * 33] * wscale, w, true); o[q] = (unsigned)w; }
        *(v4u*)(WT + (size_t)(rb + n) * K + k0 + 16 * c) = o; }
    LDS_WAIT(); asm volatile("" ::: "memory");
}
__device__ __forceinline__ void transpose_job_fp8(const Ctx& C, const float* W, unsigned char* WT, int K, int N, int mode, int nmat, float wscale) {
    LAS float* scr = (LAS float*)(C.lds + RING_OFF + C.wave * TR8_SCR);
    const int per = (K / 128) * (N / 32); const int total = per * nmat;
    for (int it = C.gw; it < total; it += C.ngw) { const int mat = it / per, item = it % per;
        transpose_item_fp8(W + (size_t)mat * K * N, K, N, WT + (size_t)mat * K * N, mode, wscale, scr, item, C.lane); }
}
__device__ __forceinline__ void transpose_job(const Ctx& C, const float* W, bf16* WT, int K, int N, int mode, int nmat) {
    LAS float* scr = (LAS float*)(C.lds + RING_OFF + C.wave * TR8_SCR);
    const int per = (K / 64) * (N / 64); const int total = per * nmat;
    for (int it = C.gw; it < total; it += C.ngw) { const int mat = it / per, item = it % per;
        transpose_item(W + (size_t)mat * K * N, K, N, WT + (size_t)mat * K * N, mode, scr, item, C.lane); }
}
__device__ __forceinline__ void rmsnorm_rows(const Ctx& C, const float* x, const float* g, bf16* out) {
    f32x4 gg[4];
#pragma unroll
    for (int j = 0; j < 4; ++j) gg[j] = ((const f32x4*)g)[64 * j + C.lane];
    f32x4 vn[4]; int m = C.gw;
    if (m < T) { const f32x4* xr = (const f32x4*)(x + (size_t)m * DM) + C.lane;
#pragma unroll
        for (int j = 0; j < 4; ++j) vn[j] = xr[64 * j]; }
    for (; m < T; m += C.ngw) {
        f32x4 v[4]; float s = 0.f;
#pragma unroll
        for (int j = 0; j < 4; ++j) { v[j] = vn[j]; s += (v[j].x * v[j].x + v[j].y * v[j].y) + (v[j].z * v[j].z + v[j].w * v[j].w); }
        if (m + C.ngw < T) { const f32x4* xr = (const f32x4*)(x + (size_t)(m + C.ngw) * DM) + C.lane;
#pragma unroll
            for (int j = 0; j < 4; ++j) vn[j] = xr[64 * j]; }
        const float rs = rsqrtf(wave_sum(s) * (1.f / DM) + EPS);
        unsigned long long* o8 = (unsigned long long*)(out + (size_t)m * DM) + C.lane;
#pragma unroll
        for (int j = 0; j < 4; ++j) o8[64 * j] = (unsigned long long)pk2(v[j].x * rs * gg[j].x, v[j].y * rs * gg[j].y) | ((unsigned long long)pk2(v[j].z * rs * gg[j].z, v[j].w * rs * gg[j].w) << 32);
    }
}
typedef short rt_bf16x8 __attribute__((ext_vector_type(8)));
typedef float rt_f32x2 __attribute__((ext_vector_type(2))); typedef __bf16 rt_bf16x2 __attribute__((ext_vector_type(2)));
__device__ __forceinline__ unsigned rt_cvtpk(float lo, float hi) { rt_f32x2 v = {lo, hi}; rt_bf16x2 b = __builtin_convertvector(v, rt_bf16x2); return __builtin_bit_cast(unsigned, b); }
__device__ __forceinline__ void rt_split8(const float (&x)[8], rt_bf16x8& hi, rt_bf16x8& lo) {
    v4u h, l;
#pragma unroll
    for (int i = 0; i < 4; ++i) { const unsigned hb = rt_cvtpk(x[2 * i], x[2 * i + 1]); h[i] = hb;
        const float r0 = x[2 * i] - __uint_as_float(hb << 16), r1 = x[2 * i + 1] - __uint_as_float(hb & 0xffff0000u); l[i] = rt_cvtpk(r0, r1); }
    hi = __builtin_bit_cast(rt_bf16x8, h); lo = __builtin_bit_cast(rt_bf16x8, l);
}
constexpr int HN_PITCH = 1032;
__device__ __forceinline__ void router_pass(const Ctx& C, const bf16* x1, const float* g2, const float* w_router, const float* b_router, unsigned char* h2, float* top_w, int* list, int* apos, unsigned* ctl) {
    LAS float* HN = (LAS float*)(C.lds + RING_OFF); LAS float* PART = HN + 16 * HN_PITCH; LAS float* LOG = PART + 8 * 16 * 32; LAS unsigned* HIST = (LAS unsigned*)(LOG + 16 * 32); LAS unsigned* BASE = HIST + 32; LAS unsigned* RK = BASE + 32;
    LAS unsigned char* EIDS = (LAS unsigned char*)(RK + 32);
    int tid = C.tid; asm volatile("" : "+v"(tid));
    const int lane = tid & 63, wave = C.wave, fr = lane & 15, fq = lane >> 4;
    rt_bf16x8 bhi[4][2], blo[4][2];
#pragma unroll
    for (int ks = 0; ks < 4; ++ks)
#pragma unroll
        for (int nt = 0; nt < 2; ++nt) { float x[8];
#pragma unroll
            for (int j = 0; j < 8; ++j) x[j] = w_router[(size_t)(128 * wave + 32 * ks + 8 * fq + j) * NE + 16 * nt + fr];
            rt_split8(x, bhi[ks][nt], blo[ks][nt]); }
    const float bias = b_router[tid & 31];
    if (tid < 32) HIST[tid] = 0u;
    __syncthreads();
    int nrounds = 0;
    v4u vn[2][2];
    if (C.vcu < T / 16) {
#pragma unroll
        for (int q = 0; q < 2; ++q) { const v4u* xr = (const v4u*)(x1 + (size_t)(C.vcu * 16 + 2 * wave + q) * DM) + 2 * lane; vn[q][0] = xr[0]; vn[q][1] = xr[1]; } }
    for (int grp = C.vcu; grp < T / 16; grp += C.G, ++nrounds) {
        f32x4 v[2][4];
#pragma unroll
        for (int q = 0; q < 2; ++q)
#pragma unroll
            for (int j = 0; j < 4; ++j) { const unsigned w0 = vn[q][j >> 1][2 * (j & 1)], w1 = vn[q][j >> 1][2 * (j & 1) + 1];
                v[q][j] = (f32x4){__uint_as_float(w0 << 16), __uint_as_float(w0 & 0xffff0000u), __uint_as_float(w1 << 16), __uint_as_float(w1 & 0xffff0000u)}; }
        if (grp + C.G < T / 16) {
#pragma unroll
            for (int q = 0; q < 2; ++q) { const v4u* xr = (const v4u*)(x1 + (size_t)((grp + C.G) * 16 + 2 * wave + q) * DM) + 2 * lane; vn[q][0] = xr[0]; vn[q][1] = xr[1]; } }
#pragma unroll
        for (int q = 0; q < 2; ++q) { const int tl = 2 * wave + q; float s = 0.f;
#pragma unroll
            for (int j = 0; j < 4; ++j) s += (v[q][j].x * v[q][j].x + v[q][j].y * v[q][j].y) + (v[q][j].z * v[q][j].z + v[q][j].w * v[q][j].w);
            const float rs = rsqrtf(wave_sum(s) * (1.f / DM) + EPS);
            v4u hw;
#pragma unroll
            for (int j = 0; j < 4; ++j) { const f32x4 gg = ((const f32x4*)g2)[4 * lane + j];
                const f32x4 y = (f32x4){v[q][j].x * rs * gg.x, v[q][j].y * rs * gg.y, v[q][j].z * rs * gg.z, v[q][j].w * rs * gg.w};
                *(LAS f32x4*)(HN + tl * HN_PITCH + 16 * lane + 4 * j) = y;
                int w = __builtin_amdgcn_cvt_pk_fp8_f32(y.x, y.y, 0, false); w = __builtin_amdgcn_cvt_pk_fp8_f32(y.z, y.w, w, true); hw[j] = (unsigned)w; }
            *(v4u*)(h2 + (size_t)(grp * 16 + tl) * DM + 16 * lane) = hw; }
        __syncthreads();
        { pg8::f32x4 acc0 = {0.f, 0.f, 0.f, 0.f}, acc1 = {0.f, 0.f, 0.f, 0.f};
          const LAS float* hb = HN + fr * HN_PITCH + 128 * wave + 8 * fq;
#pragma unroll
          for (int ks = 0; ks < 4; ++ks) { const f32x4 p0 = *(const LAS f32x4*)(hb + 32 * ks), p1 = *(const LAS f32x4*)(hb + 32 * ks + 4);
              const float x[8] = {p0.x, p0.y, p0.z, p0.w, p1.x, p1.y, p1.z, p1.w}; rt_bf16x8 ahi, alo; rt_split8(x, ahi, alo);
              acc0 = __builtin_amdgcn_mfma_f32_16x16x32_bf16(ahi, bhi[ks][0], acc0, 0, 0, 0); acc1 = __builtin_amdgcn_mfma_f32_16x16x32_bf16(ahi, bhi[ks][1], acc1, 0, 0, 0);
              acc0 = __builtin_amdgcn_mfma_f32_16x16x32_bf16(ahi, blo[ks][0], acc0, 0, 0, 0); acc1 = __builtin_amdgcn_mfma_f32_16x16x32_bf16(ahi, blo[ks][1], acc1, 0, 0, 0);
              acc0 = __builtin_amdgcn_mfma_f32_16x16x32_bf16(alo, bhi[ks][0], acc0, 0, 0, 0); acc1 = __builtin_amdgcn_mfma_f32_16x16x32_bf16(alo, bhi[ks][1], acc1, 0, 0, 0); }
          LAS float* pp = PART + (wave * 16 + 4 * fq) * 32 + fr;
#pragma unroll
          for (int r = 0; r < 4; ++r) { pp[r * 32] = acc0[r]; pp[r * 32 + 16] = acc1[r]; } }
        __syncthreads();
        { float a = bias;
#pragma unroll
          for (int w8 = 0; w8 < 8; ++w8) a += PART[(w8 * 16 + (tid >> 5)) * 32 + (tid & 31)];
          LOG[tid] = a; }
        __syncthreads();
        if (lane < 2) { const int tl = 2 * wave + lane; float lg[32];
#pragma unroll
            for (int i = 0; i < 8; ++i) { const f32x4 t4 = *(const LAS f32x4*)(LOG + tl * 32 + 4 * i); lg[4 * i] = t4.x; lg[4 * i + 1] = t4.y; lg[4 * i + 2] = t4.z; lg[4 * i + 3] = t4.w; }
            float tv[4]; int ti[4];
#pragma unroll
            for (int k = 0; k < 4; ++k) { float mx = lg[0]; int mi = 0;
#pragma unroll
                for (int i = 1; i < 32; ++i) { const bool gt = lg[i] > mx; mx = gt ? lg[i] : mx; mi = gt ? i : mi; }
                tv[k] = mx; ti[k] = mi;
#pragma unroll
                for (int i = 0; i < 32; ++i) lg[i] = (i == mi) ? -INFINITY : lg[i]; }
            const float e1 = __expf(tv[1] - tv[0]), e2 = __expf(tv[2] - tv[0]), e3 = __expf(tv[3] - tv[0]); const float inv = 1.f / (1.f + e1 + e2 + e3);
            *(f32x4*)(top_w + (size_t)(grp * 16 + tl) * 4) = (f32x4){inv, e1 * inv, e2 * inv, e3 * inv};
#pragma unroll
            for (int k = 0; k < 4; ++k) { EIDS[(nrounds * 16 + tl) * 4 + k] = (unsigned char)ti[k]; __hip_atomic_fetch_add(HIST + ti[k], 1u, __ATOMIC_RELAXED, __HIP_MEMORY_SCOPE_WORKGROUP); } }
    }
    __syncthreads();
    if (tid < 32) { BASE[tid] = atomicAdd(ctl + CW_CNT + tid, HIST[tid]); RK[tid] = 0u; }
    __syncthreads();
    for (int idx = tid; idx < nrounds * 64; idx += 512) { const int ei = EIDS[idx]; const unsigned rank = __hip_atomic_fetch_add(RK + ei, 1u, __ATOMIC_RELAXED, __HIP_MEMORY_SCOPE_WORKGROUP);
        const int r = idx >> 6, tl = (idx >> 2) & 15, k = idx & 3, a = ((C.vcu + r * C.G) * 16 + tl) * 4 + k; const int slot = (int)(BASE[ei] + rank); list[(size_t)ei * T + slot] = a; apos[a] = (ei << 20) | slot; }
    __syncthreads();
}
__device__ __forceinline__ int grouped_tables(const Ctx& C, const unsigned* ctl) {
    LAS int* cnt = (LAS int*)(C.lds + GT_OFF); LAS int* pref = cnt + 32; LAS unsigned char* tile_e = (LAS unsigned char*)(pref + 36);
    if (C.wave == 0) {
        const int e = C.lane & 31; const int c = (int)__hip_atomic_load(ctl + CW_CNT + e, RLX_AGENT); const int n = (c + 255) >> 8;
        int incl = n;
#pragma unroll
        for (int o = 1; o < 32; o <<= 1) { const int t = __shfl_up(incl, o, 32); if (e >= o) incl += t; }
        const int start = incl - n;
        if (C.lane < 32) { cnt[e] = c; pref[e] = start; if (e == 31) pref[32] = incl; for (int i = 0; i < n; ++i) tile_e[start + i] = (unsigned char)e; }
    }
    __syncthreads();
    return pref[NE];
}
__device__ __forceinline__ void combine_pass(const Ctx& C, float* out, const bf16* x1, const unsigned char* ys, const float* top_w, const int* apos) {
    const LAS int* pref = (const LAS int*)(C.lds + GT_OFF) + 32;
    const int lane = C.lane;
    int4 apn[2];
    if (C.gw < T / 2) { apn[0] = *(const int4*)(apos + (size_t)(2 * C.gw) * 4); apn[1] = *(const int4*)(apos + (size_t)(2 * C.gw + 1) * 4); }
    for (int pr = C.gw; pr < T / 2; pr += C.ngw) {
        const int4 ap[2] = {apn[0], apn[1]};
        if (pr + C.ngw < T / 2) { apn[0] = *(const int4*)(apos + (size_t)(2 * (pr + C.ngw)) * 4); apn[1] = *(const int4*)(apos + (size_t)(2 * (pr + C.ngw) + 1) * 4); }
        f32x4 acc[2][4]; v4u yv[2][4]; f32x4 wv4[2];
#pragma unroll
        for (int t = 0; t < 2; ++t) { const int tok = 2 * pr + t;
            const v4u* xr = (const v4u*)(x1 + (size_t)tok * DM) + 2 * lane;
            const v4u x0 = xr[0], x1v = xr[1];
#pragma unroll
            for (int j = 0; j < 4; ++j) { const unsigned w0 = (j < 2 ? x0 : x1v)[2 * (j & 1)], w1 = (j < 2 ? x0 : x1v)[2 * (j & 1) + 1];
                acc[t][j] = (f32x4){__uint_as_float(w0 << 16), __uint_as_float(w0 & 0xffff0000u), __uint_as_float(w1 << 16), __uint_as_float(w1 & 0xffff0000u)}; }
            wv4[t] = *(const f32x4*)(top_w + (size_t)tok * 4);
#pragma unroll
            for (int k = 0; k < 4; ++k) { const int p = k == 0 ? ap[t].x : k == 1 ? ap[t].y : k == 2 ? ap[t].z : ap[t].w; const int srow = pref[p >> 20] * 256 + (p & 0xFFFFF);
                yv[t][k] = *(const v4u*)(ys + (size_t)srow * DM + 16 * lane); } }
#pragma unroll
        for (int t = 0; t < 2; ++t) { f32x4* o = (f32x4*)(out + (size_t)(2 * pr + t) * DM) + 4 * lane;
#pragma unroll
            for (int k = 0; k < 4; ++k) { const float wv = wv4[t][k];
#pragma unroll
                for (int j = 0; j < 4; ++j) { const unsigned w = yv[t][k][j];
                    const auto lo2 = __builtin_amdgcn_cvt_pk_f32_fp8((int)w, false), hi2 = __builtin_amdgcn_cvt_pk_f32_fp8((int)w, true);
                    acc[t][j].x += wv * lo2[0]; acc[t][j].y += wv * lo2[1]; acc[t][j].z += wv * hi2[0]; acc[t][j].w += wv * hi2[1]; } }
#pragma unroll
            for (int j = 0; j < 4; ++j) o[j] = acc[t][j]; }
    }
}

namespace att {
using bf16x8 = __attribute__((ext_vector_type(8))) short;
using s16x4 = __attribute__((ext_vector_type(4))) short;
using f32x16 = __attribute__((ext_vector_type(16))) float;
using u32x4 = __attribute__((ext_vector_type(4))) unsigned;
typedef float f32x2_t __attribute__((ext_vector_type(2))); typedef __bf16 bf16x2_t __attribute__((ext_vector_type(2)));
constexpr float LOG2E = 1.4426950408889634f, QSCALE = 0.125f * LOG2E;
constexpr int SLOTB = 8192, NSLOT = 4;
constexpr int L_K = 0, L_V = NSLOT * SLOTB, L_WS = 2 * NSLOT * SLOTB, L_OST = L_WS + 8 * 256, L_BYTES = L_OST + 8 * 4096;
__device__ __forceinline__ int crow(int r, int hi) { return (r & 3) + 8 * (r >> 2) + 4 * hi; }
__device__ __forceinline__ void glds16(const void* gsrc, unsigned lds_dst) { unsigned keep;
    asm volatile("s_mov_b32 %0, m0\n\ts_mov_b32 m0, %2\n\ts_nop 0\n\tglobal_load_lds_dwordx4 %1, off\n\ts_mov_b32 m0, %0" : "=&s"(keep) : "v"(gsrc), "s"(lds_dst) : "memory"); }
__device__ __forceinline__ unsigned cvtpk_s(float lo, float hi) { f32x2_t v = {lo, hi}; bf16x2_t b = __builtin_convertvector(v, bf16x2_t); return __builtin_bit_cast(unsigned, b); }
typedef __attribute__((address_space(3))) const char* lds_cptr;
__device__ __forceinline__ void qkt_half(f32x16& p, lds_cptr kb, const bf16x8* qr) {
    const f32x16 z = f32x16{};
#pragma unroll
    for (int d0 = 0; d0 < 4; ++d0) {
        const bf16x8 b0 = *(const __attribute__((address_space(3))) bf16x8*)(kb + d0 * 2048);
        p = __builtin_amdgcn_mfma_f32_32x32x16_bf16(b0, qr[d0], d0 == 0 ? z : p, 0, 0, 0); }
}
__device__ __forceinline__ void pv_half(f32x16* o, int vb, bf16x8 pa0, bf16x8 pa1) {
#pragma unroll
    for (int d0 = 0; d0 < 2; ++d0) { s16x4 lo[2], hi[2];
#pragma unroll
        for (int ks = 0; ks < 2; ++ks) {
            asm volatile("ds_read_b64_tr_b16 %0,%1 offset:%c2" : "=&v"(lo[ks]) : "v"(vb), "i"(d0 * 4096 + ks * 1024) : "memory");
            asm volatile("ds_read_b64_tr_b16 %0,%1 offset:%c2" : "=&v"(hi[ks]) : "v"(vb), "i"(d0 * 4096 + ks * 1024 + 512) : "memory"); }
        asm volatile("s_waitcnt lgkmcnt(0)" ::: "memory"); __builtin_amdgcn_sched_barrier(0);
#define ATT_PK(k) (bf16x8){lo[k][0], lo[k][1], lo[k][2], lo[k][3], hi[k][0], hi[k][1], hi[k][2], hi[k][3]}
        o[d0] = __builtin_amdgcn_mfma_f32_32x32x16_bf16(pa0, ATT_PK(0), o[d0], 0, 0, 0);
        o[d0] = __builtin_amdgcn_mfma_f32_32x32x16_bf16(pa1, ATT_PK(1), o[d0], 0, 0, 0);
#undef ATT_PK
    }
}
__device__ __forceinline__ void dma_tile(const bf16* proj, int b, int kvh, int ti, unsigned lds0, int wid, int lane) {
    const unsigned slot = (unsigned)((ti + 2) & 3) * SLOTB;
    int kr = 64 * ti + lane; kr = kr < 0 ? 0 : kr;
    int vr = 64 * ti + 16 * (wid & 3) + (lane >> 2); vr = vr < 0 ? 0 : vr;
    const bf16* ksrc = proj + (size_t)(b * SEQ + kr) * IN_W + C_K + kvh * 64 + wid * 8;
    const bf16* vsrc = proj + (size_t)(b * SEQ + vr) * IN_W + C_V + kvh * 64 + (wid >> 2) * 32 + (lane & 3) * 8;
    glds16(ksrc, (unsigned)__builtin_amdgcn_readfirstlane(lds0 + L_K + slot + wid * 1024));
    glds16(vsrc, (unsigned)__builtin_amdgcn_readfirstlane(lds0 + L_V + slot + wid * 1024));
}
#define ATT_WAIT_BAR() asm volatile("s_waitcnt vmcnt(0) lgkmcnt(0)\n\ts_barrier" ::: "memory")
__device__ __forceinline__ void attn_run(int b, int kvh, int qb0, int nqb, const bf16* proj, const float* sinks, bf16* O, LAS unsigned char* shm) {
    const int tid = threadIdx.x, lane = tid & 63, r32 = lane & 31, hi = lane >> 5; const int wid = __builtin_amdgcn_readfirstlane(tid >> 6);
    const int h = kvh * 4 + (wid & 3), sub = wid >> 2;
    const unsigned lds0 = (unsigned)(uintptr_t)shm;
    LAS float* wsf = (LAS float*)(shm + L_WS) + wid * 64;
    const lds_cptr shm3 = (lds_cptr)shm;
    const int vb0 = (int)(lds0 + L_V) + ((lane >> 4) & 1) * 32 + (lane & 3) * 8 + (4 * hi + ((lane & 15) >> 2)) * 64;
    const float slope2 = exp2f(-0.5f * (float)(h + 1)) * LOG2E, sink2 = sinks[h] * LOG2E;
    dma_tile(proj, b, kvh, qb0 - 2, lds0, wid, lane); dma_tile(proj, b, kvh, qb0 - 1, lds0, wid, lane); dma_tile(proj, b, kvh, qb0, lds0, wid, lane);
    const bf16* Qw = proj + (size_t)(b * SEQ + qb0 * 64 + 32 * sub + r32) * IN_W + C_Q + h * 64 + hi * 8;
    bf16x8 qn[4];
#pragma unroll
    for (int d0 = 0; d0 < 4; ++d0) qn[d0] = *(const bf16x8*)(Qw + d0 * 16);
    for (int qi = 0; qi < nqb; ++qi) {
        const int qb = qb0 + qi, tq0 = qb * 64 + 32 * sub;
        bf16x8 qr[4];
#pragma unroll
        for (int d0 = 0; d0 < 4; ++d0) qr[d0] = qn[d0];
        ATT_WAIT_BAR();
        if (qi + 1 < nqb) dma_tile(proj, b, kvh, qb + 1, lds0, wid, lane);
        f32x16 p[5];
#pragma unroll
        for (int i = 0; i < 5; ++i) { const int g = i + sub; qkt_half(p[i], shm3 + L_K + ((qb + (g >> 1)) & 3) * SLOTB + (g & 1) * 512 + hi * 1024 + r32 * 16, qr); }
        if (qi + 1 < nqb) {
#pragma unroll
            for (int d0 = 0; d0 < 4; ++d0) qn[d0] = *(const bf16x8*)(Qw + (size_t)(64 * (qi + 1)) * IN_W + d0 * 16); }
        float dbase = (float)(128 + r32 - 4 * hi); asm volatile("" : "+v"(dbase));
        const float dmax = (float)(tq0 + r32);
#pragma unroll
        for (int i = 0; i < 5; ++i)
#pragma unroll
            for (int r = 0; r < 16; ++r) { const float d = dbase - (float)(32 * i + (r & 3) + 8 * (r >> 2));
                float v = p[i][r] - slope2 * d;
                if (i == 0) v = (d < 128.f) ? v : -INFINITY;
                if (i == 4) v = (d >= 0.f) ? v : -INFINITY;
                p[i][r] = v; }
        if (qb < 2) {
#pragma unroll
            for (int i = 0; i < 5; ++i)
#pragma unroll
                for (int r = 0; r < 16; ++r) { const float d = dbase - (float)(32 * i + (r & 3) + 8 * (r >> 2)); p[i][r] = (d <= dmax) ? p[i][r] : -INFINITY; } }
        float mx = -INFINITY;
#pragma unroll
        for (int i = 0; i < 5; ++i)
#pragma unroll
            for (int r = 0; r < 16; ++r) mx = fmaxf(mx, p[i][r]);
        { auto rr = __builtin_amdgcn_permlane32_swap(__float_as_uint(mx), __float_as_uint(mx), false, false); mx = fmaxf(__uint_as_float(rr[0]), __uint_as_float(rr[1])); }
        mx = fmaxf(mx, sink2);
        float ls = 0.f;
        f32x16 o[2]; o[0] = f32x16{}; o[1] = f32x16{};
#pragma unroll
        for (int i = 0; i < 5; ++i) { const int g = i + sub;
#pragma unroll
            for (int r = 0; r < 16; ++r) { const float e = __builtin_amdgcn_exp2f(p[i][r] - mx); p[i][r] = e; ls += e; }
            u32x4 pw0, pw1;
#define ATT_PKW(P, B) cvtpk_s(P[B], P[B + 1])
            pw0 = (u32x4){ATT_PKW(p[i], 0), ATT_PKW(p[i], 2), ATT_PKW(p[i], 4), ATT_PKW(p[i], 6)}; pw1 = (u32x4){ATT_PKW(p[i], 8), ATT_PKW(p[i], 10), ATT_PKW(p[i], 12), ATT_PKW(p[i], 14)};
#undef ATT_PKW
            __builtin_amdgcn_sched_barrier(0);
            pv_half(o, vb0 + ((qb + (g >> 1)) & 3) * SLOTB + (g & 1) * 2048, __builtin_bit_cast(bf16x8, pw0), __builtin_bit_cast(bf16x8, pw1));
        }
        { auto rr = __builtin_amdgcn_permlane32_swap(__float_as_uint(ls), __float_as_uint(ls), false, false); ls = __uint_as_float(rr[0]) + __uint_as_float(rr[1]); }
        ls += __builtin_amdgcn_exp2f(sink2 - mx);
        if (hi == 0) wsf[32 + r32] = ls;
        asm volatile("s_waitcnt lgkmcnt(0)" ::: "memory");
        float rli[16];
#pragma unroll
        for (int r = 0; r < 16; ++r) rli[r] = __builtin_amdgcn_rcpf(wsf[32 + crow(r, hi)]);
        bf16* Ow = O + (size_t)(b * SEQ + tq0) * 1024 + h * 64;
        { LAS bf16* stg = (LAS bf16*)(shm + L_OST) + wid * 2048;
#pragma unroll
            for (int r = 0; r < 16; ++r) { const int orow = crow(r, hi);
#pragma unroll
                for (int d0 = 0; d0 < 2; ++d0) stg[orow * 64 + d0 * 32 + r32] = (bf16)f2bf(o[d0][r] * rli[r]); }
            asm volatile("s_waitcnt lgkmcnt(0)" ::: "memory");
#pragma unroll
            for (int i = 0; i < 4; ++i) { const int row = i * 8 + (lane >> 3), ch = lane & 7; const u32x4 v = *(const LAS u32x4*)(stg + row * 64 + ch * 8); *(u32x4*)(Ow + (size_t)row * 1024 + ch * 8) = v; } }
    }
    ATT_WAIT_BAR();
}
#undef ATT_WAIT_BAR
}

namespace s5 {
using bf16x8 = __attribute__((ext_vector_type(8))) short;
using f32x16 = __attribute__((ext_vector_type(16))) float;
struct cf { float re, im; };
__device__ __forceinline__ cf cmul(cf a, cf b) { return cf{a.re * b.re - a.im * b.im, a.re * b.im + a.im * b.re}; }
__device__ __forceinline__ cf cfma(cf a, cf b, cf c) { return cf{c.re + a.re * b.re - a.im * b.im, c.im + a.re * b.im + a.im * b.re}; }
__device__ __forceinline__ int crow(int r, int hi) { return (r & 3) + 8 * (r >> 2) + 4 * hi; }
__device__ __forceinline__ bf16x8 ldg16(const bf16* ubase, unsigned lane_off) { return *(const bf16x8*)((const char*)ubase + lane_off); }
constexpr size_t BT_G = 128 * 256, KT_G = 16 * 16 * 16, CT_G = 256 * 128;
constexpr int IMG_STRIDE = 136;
constexpr int L_IMG = 0, L_T = 8 * 32 * IMG_STRIDE * 2, L_BYTES = L_T + 8 * 2 * 2 * 32 * 4;

__device__ __forceinline__ void build_tables(int g, int part, const float* a_re, const float* a_im, const float* log_dt, const float* b_re, const float* b_im, const float* c_re, const float* c_im, const float* d_skip,
                                             bf16* Btab, bf16* Ktab, bf16* Ctab, float* A16tab, LAS unsigned char* scr, int tid) {
    LAS double* LA = (LAS double*)scr; LAS double* TH = LA + 64;
    LAS float* bbr = (LAS float*)(scr + 1024); LAS float* bbi = bbr + 1024;
    LAS float* pwr = bbi + 1024; LAS float* pwi = pwr + 17 * 64;
    LAS float* ccr = pwi + 17 * 64; LAS float* cci = ccr + 1024;
    for (int e = tid; e < 1024; e += 512) { ccr[e] = c_re[(size_t)g * 1024 + e]; cci[e] = c_im[(size_t)g * 1024 + e]; }
    if (tid < 64) { const int i = g * NP + tid;
        const double dt = exp((double)log_dt[g]), are = a_re[i], aim = a_im[i];
        const double la = are * dt, th = aim * dt, mag = exp(la), abr = mag * cos(th), abi = mag * sin(th), den = are * are + aim * aim, em1 = abr - 1.0;
        const double qre = (em1 * are + abi * aim) / den, qim = (abi * are - em1 * aim) / den;
        LA[tid] = la; TH[tid] = th;
        for (int h = 0; h < GCH; ++h) { const double br = b_re[i * GCH + h], bi = b_im[i * GCH + h]; bbr[tid * 16 + h] = (float)(qre * br - qim * bi); bbi[tid * 16 + h] = (float)(qre * bi + qim * br); } }
    __syncthreads();
    for (int e = tid; e < 17 * 64; e += 512) { const int n = e >> 6, p = e & 63; const double m = exp((double)n * LA[p]), t = (double)n * TH[p]; pwr[e] = (float)(m * cos(t)); pwi[e] = (float)(m * sin(t)); }
    __syncthreads();
    if (part == 0 && tid < 64) { A16tab[(g * 64 + tid) * 2] = pwr[16 * 64 + tid]; A16tab[(g * 64 + tid) * 2 + 1] = pwi[16 * 64 + tid]; }
    for (int e = tid; e < 32 * 256; e += 512) { const int pl = e >> 8, k = e & 255, j = k >> 4, hp = k & 15, pp = 32 * part + pl, p = pp & 63;
        const float wr = pwr[(15 - j) * 64 + p], wi = pwi[(15 - j) * 64 + p], br = bbr[p * 16 + hp], bi = bbi[p * 16 + hp];
        const float v = (pp < 64) ? (wr * br - wi * bi) : (wr * bi + wi * br);
        Btab[(size_t)g * BT_G + (size_t)pp * 256 + k] = (bf16)f2bf(v); }
    for (int e = tid; e < 64 * 128; e += 512) { const int nl = e >> 7, pp = e & 127, n = 64 * part + nl, i = n >> 4, h = n & 15, p = pp & 63;
        const float cr = ccr[h * NP + p], ci = cci[h * NP + p], wr = pwr[(i + 1) * 64 + p], wi = pwi[(i + 1) * 64 + p];
        const float v = (pp < 64) ? (cr * wr - ci * wi) : -(cr * wi + ci * wr);
        Ctab[(size_t)g * CT_G + (size_t)n * 128 + pp] = (bf16)f2bf(v); }
    for (int e = tid; e < 4 * 256; e += 512) { const int d = 4 * part + (e >> 8), h = (e >> 4) & 15, hp = e & 15; float acc = 0.f;
#pragma unroll 8
        for (int p = 0; p < 64; ++p) { const float cr = ccr[h * NP + p], ci = cci[h * NP + p], wr = pwr[d * 64 + p], wi = pwi[d * 64 + p], br = bbr[p * 16 + hp], bi = bbi[p * 16 + hp];
            const float tr = wr * br - wi * bi, ti = wr * bi + wi * br; acc += cr * tr - ci * ti; }
        if (d == 0 && h == hp) acc += d_skip[g * 16 + h];
        Ktab[(size_t)g * KT_G + (size_t)(d * 16 + h) * 16 + hp] = (bf16)f2bf(acc); }
    __syncthreads();
}

__device__ __forceinline__ void scan_local(f32x16& re, f32x16& im, const cf p1, const cf p4, const int hi, cf (&em)[4], cf& T) {
#pragma unroll
    for (int q = 0; q < 4; ++q)
#pragma unroll
        for (int k = 1; k < 4; ++k) { const int r = 4 * q + k; const cf v = cfma(p1, cf{re[r - 1], im[r - 1]}, cf{re[r], im[r]}); re[r] = v.re; im[r] = v.im; }
    cf E = cf{0.f, 0.f};
#pragma unroll
    for (int q = 0; q < 4; ++q) {
        auto sr = __builtin_amdgcn_permlane32_swap(__float_as_uint(re[4 * q + 3]), __float_as_uint(re[4 * q + 3]), false, false);
        auto si = __builtin_amdgcn_permlane32_swap(__float_as_uint(im[4 * q + 3]), __float_as_uint(im[4 * q + 3]), false, false);
        const cf elo = cf{__uint_as_float(sr[0]), __uint_as_float(si[0])}, ehi = cf{__uint_as_float(sr[1]), __uint_as_float(si[1])};
        const cf Elo = E; E = cfma(p4, E, elo); const cf Ehi = E; E = cfma(p4, E, ehi);
        em[q] = hi ? Ehi : Elo; }
    T = E;
}
__device__ __forceinline__ void scan_finish(f32x16& re, f32x16& im, const cf p1, const cf p2, const cf p3, const cf p4, const cf g2, const int hi, const cf (&em)[4], const cf X) {
    cf cur = hi ? p4 : cf{1.f, 0.f};
#pragma unroll
    for (int q = 0; q < 4; ++q) { const cf carry = cfma(cur, X, em[q]); cur = cmul(cur, g2);
        cf v;
        v = cfma(p1, carry, cf{re[4 * q + 0], im[4 * q + 0]}); re[4 * q + 0] = v.re; im[4 * q + 0] = v.im;
        v = cfma(p2, carry, cf{re[4 * q + 1], im[4 * q + 1]}); re[4 * q + 1] = v.re; im[4 * q + 1] = v.im;
        v = cfma(p3, carry, cf{re[4 * q + 2], im[4 * q + 2]}); re[4 * q + 2] = v.re; im[4 * q + 2] = v.im;
        v = cfma(p4, carry, cf{re[4 * q + 3], im[4 * q + 3]}); re[4 * q + 3] = v.re; im[4 * q + 3] = v.im; }
}

__device__ __forceinline__ void glds16(const void* gsrc, unsigned lds_dst) { unsigned keep;
    asm volatile("s_mov_b32 %0, m0\n\ts_mov_b32 m0, %2\n\ts_nop 0\n\tglobal_load_lds_dwordx4 %1, off\n\ts_mov_b32 m0, %0" : "=&s"(keep) : "v"(gsrc), "s"(lds_dst) : "memory"); }
constexpr int L_TAB = 0, L_TABK = 65536, L_IMG2 = 73728, L_T2 = L_IMG2 + 8 * 32 * IMG_STRIDE * 2, L_BYTES2 = L_T2 + 4096;

__device__ __forceinline__ void s5_unit(int b, int g, const bf16* proj, const bf16* Btab, const bf16* Ktab, const bf16* Ctab, const float* A16tab, bf16* out, LAS unsigned char* shm) {
    int tid = threadIdx.x; asm volatile("" : "+v"(tid));
    const int lane = tid & 63, col = lane & 31, hi = lane >> 5; const int wid = __builtin_amdgcn_readfirstlane(tid >> 6);
    const unsigned lds0 = (unsigned)(uintptr_t)shm;
    { const char* src = (const char*)(Btab + (size_t)g * BT_G);
#pragma unroll
      for (int i = 0; i < 8; ++i) { const int p = wid * 8 + i, row = 2 * p + (lane >> 5), c = (lane & 31) ^ (row & 31);
          glds16(src + row * 512 + c * 16, (unsigned)__builtin_amdgcn_readfirstlane(lds0 + L_TAB + p * 1024)); } }
    const bf16* ub = proj + ((size_t)g * T + (size_t)(b * SEQ + 512 * wid)) * 16;
    const unsigned uoff = (unsigned)(col * 512 + hi * 16);
    bf16x8 ua[16];
#pragma unroll
    for (int j = 0; j < 16; ++j) ua[j] = ldg16(ub + (size_t)j * 16, uoff);
    asm volatile("s_waitcnt vmcnt(0)" ::: "memory"); __syncthreads();
    const LAS unsigned char* tb = shm + L_TAB; const unsigned a0 = (unsigned)(col * 512) | (unsigned)(((hi * 16) ^ (col * 16)));
    f32x16 zt[4];
#pragma unroll
    for (int nt = 0; nt < 4; ++nt) zt[nt] = f32x16{};
#pragma unroll
    for (int j = 0; j < 16; ++j) { const bf16x8 uj = ua[j]; const unsigned aj = a0 ^ (unsigned)(j * 32);
#pragma unroll
        for (int nt = 0; nt < 4; ++nt) { const bf16x8 bfr = *(const LAS bf16x8*)(tb + aj + nt * 16384); zt[nt] = __builtin_amdgcn_mfma_f32_32x32x16_bf16(uj, bfr, zt[nt], 0, 0, 0); } }
    LAS float* Tb = (LAS float*)(shm + L_T2);
    LAS bf16* img = (LAS bf16*)(shm + L_IMG2) + wid * 32 * IMG_STRIDE;
    {
        cf P1[2], P2[2], P3[2], P4[2], G2[2], EM[2][4], TT[2];
#pragma unroll
        for (int s = 0; s < 2; ++s) { const float2 a = ((const float2*)A16tab)[g * 64 + 32 * s + col]; P1[s] = cf{a.x, a.y}; P2[s] = cmul(P1[s], P1[s]); P3[s] = cmul(P2[s], P1[s]); P4[s] = cmul(P2[s], P2[s]); G2[s] = cmul(P4[s], P4[s]); }
        scan_local(zt[0], zt[2], P1[0], P4[0], hi, EM[0], TT[0]);
        scan_local(zt[1], zt[3], P1[1], P4[1], hi, EM[1], TT[1]);
        if (hi == 0) {
#pragma unroll
            for (int s = 0; s < 2; ++s) { Tb[((wid * 2 + s) * 2 + 0) * 32 + col] = TT[s].re; Tb[((wid * 2 + s) * 2 + 1) * 32 + col] = TT[s].im; } }
        asm volatile("s_waitcnt lgkmcnt(0)" ::: "memory"); __syncthreads();
        { const char* src = (const char*)(Ctab + (size_t)g * CT_G);
#pragma unroll
          for (int i = 0; i < 8; ++i) { const int p = wid * 8 + i, row = 4 * p + (lane >> 4), c = (lane & 15) ^ (row & 15);
              glds16(src + row * 256 + c * 16, (unsigned)__builtin_amdgcn_readfirstlane(lds0 + L_TAB + p * 1024)); }
          glds16((const char*)(Ktab + (size_t)g * KT_G) + wid * 1024 + lane * 16, (unsigned)__builtin_amdgcn_readfirstlane(lds0 + L_TABK + wid * 1024)); }
#pragma unroll
        for (int j = 0; j < 16; ++j) ua[j] = ldg16(ub + (size_t)j * 16, uoff);
#pragma unroll
        for (int s = 0; s < 2; ++s) {
            const cf g4 = cmul(G2[s], G2[s]), g8 = cmul(g4, g4);
            cf X = cf{0.f, 0.f};
            for (int v = 0; v < wid; ++v) X = cfma(g8, X, cf{Tb[((v * 2 + s) * 2 + 0) * 32 + col], Tb[((v * 2 + s) * 2 + 1) * 32 + col]});
            scan_finish(zt[s], zt[2 + s], P1[s], P2[s], P3[s], P4[s], G2[s], hi, EM[s], X);
            if (hi == 0) { img[32 * s + col] = (bf16)f2bf(X.re); img[64 + 32 * s + col] = (bf16)f2bf(X.im); }
#pragma unroll
            for (int r = 0; r < 16; ++r) { const int row = crow(r, hi) + 1;
                if (row < 32) { img[row * IMG_STRIDE + 32 * s + col] = (bf16)f2bf(zt[s][r]); img[row * IMG_STRIDE + 64 + 32 * s + col] = (bf16)f2bf(zt[2 + s][r]); } }
        }
    }
    asm volatile("s_waitcnt vmcnt(0) lgkmcnt(0)" ::: "memory"); __syncthreads();
    bf16x8 sa[8];
#pragma unroll
    for (int ks = 0; ks < 8; ++ks) sa[ks] = *(const LAS bf16x8*)(img + col * IMG_STRIDE + 16 * ks + 8 * hi);
    asm volatile("s_waitcnt lgkmcnt(0)" ::: "memory"); __builtin_amdgcn_wave_barrier();
    const int ih = col >> 4, h = col & 15;
    const LAS unsigned char* kb = shm + L_TABK + ih * 512 + h * 32 + hi * 16;
    const unsigned c0 = (unsigned)(col * 256) | (unsigned)((hi * 16) ^ ((col & 15) * 16));
    LAS bf16* stg = img;
    bf16* og = out + ((size_t)g * T + (size_t)(b * SEQ + 512 * wid)) * 16;
#pragma unroll
    for (int ps = 0; ps < 2; ++ps) {
        f32x16 acc[4];
#pragma unroll
        for (int n = 0; n < 4; ++n) acc[n] = f32x16{};
#pragma unroll
        for (int j = 0; j < 8 * ps + 8; ++j) { const bf16x8 uj = ua[j];
#pragma unroll
            for (int n = 0; n < 4; ++n) { const int nt = 4 * ps + n;
                if (j <= 2 * nt + 1) {
                    bf16x8 kf;
                    if (j == 2 * nt + 1) { kf = *(const LAS bf16x8*)(shm + L_TABK + h * 32 + hi * 16); if (ih == 0) kf = bf16x8{}; }
                    else kf = *(const LAS bf16x8*)(kb + (2 * nt - j) * 512);
                    acc[n] = __builtin_amdgcn_mfma_f32_32x32x16_bf16(uj, kf, acc[n], 0, 0, 0); } } }
#pragma unroll
        for (int ks = 0; ks < 8; ++ks) { const unsigned ck = c0 ^ (unsigned)(ks * 32);
#pragma unroll
            for (int n = 0; n < 4; ++n) { const bf16x8 cfr = *(const LAS bf16x8*)(tb + ck + (4 * ps + n) * 8192); acc[n] = __builtin_amdgcn_mfma_f32_32x32x16_bf16(sa[ks], cfr, acc[n], 0, 0, 0); } }
#pragma unroll
        for (int n = 0; n < 4; ++n) {
            const f32x16 x = acc[n], x2 = x * x, z = (x2 * (0.044715f * -2.3022081985f) + -2.3022081985f) * x; f32x16 sg;
#pragma unroll
            for (int r = 0; r < 16; ++r) sg[r] = __builtin_amdgcn_exp2f(z[r]);
            sg = sg + 1.f;
#pragma unroll
            for (int r = 0; r < 16; ++r) sg[r] = __builtin_amdgcn_rcpf(sg[r]);
            const f32x16 y = x * sg;
#pragma unroll
            for (int r = 0; r < 16; r += 2) { const unsigned w = rt_cvtpk(y[r], y[r + 1]); stg[(crow(r, hi) * 8 + 2 * n + ih) * 16 + h] = (bf16)(w & 0xffffu); stg[(crow(r + 1, hi) * 8 + 2 * n + ih) * 16 + h] = (bf16)(w >> 16); } }
        asm volatile("s_waitcnt lgkmcnt(0)" ::: "memory"); __builtin_amdgcn_wave_barrier();
#pragma unroll
        for (int q = 0; q < 8; ++q) { const int pc = q * 64 + lane, chunk = pc >> 4, il = (pc >> 1) & 7, hf = pc & 1;
            const v4u v = *(const LAS v4u*)(stg + (chunk * 8 + il) * 16 + hf * 8);
            *(v4u*)(og + (size_t)(16 * chunk + 8 * ps + il) * 16 + hf * 8) = v; }
        asm volatile("s_waitcnt lgkmcnt(0)" ::: "memory"); __builtin_amdgcn_wave_barrier();
    }
    __syncthreads();
}
}

constexpr int NPH = 10;
__global__ void __launch_bounds__(512, 2) mk_fwd(Args args) {
    extern __shared__ __attribute__((aligned(16))) unsigned char lds_raw[];
    Ctx C; C.lds = (LAS unsigned char*)lds_raw; C.tid = threadIdx.x; C.lane = C.tid & 63; C.wave = __builtin_amdgcn_readfirstlane(C.tid >> 6);
    C.G = gridDim.x; { const int bx = blockIdx.x; C.vcu = (C.G % 8 == 0) ? (bx % 8) * (C.G / 8) + bx / 8 : bx; }
    C.gw = C.vcu * 8 + C.wave; C.ngw = C.G * 8;
    volatile LAS unsigned* MISC = (volatile LAS unsigned*)(C.lds + MISC_OFF);
    if (C.tid < 64) MISC[C.tid] = 0u;
    __syncthreads();
    unsigned char* ws = args.ws; unsigned* ctl = (unsigned*)(ws + WS_CTL);
    const int lo = args.ph_lo, hi = args.ph_hi;
    XcdBarrier bar; bar.bar = ctl + CW_BAR + args.bar_idx * XCD_BAR_WORDS; bar.x = 0; bar.st = nullptr;
    if (hi - lo > 1) bar = xcd_barrier_post(ctl + CW_BAR + args.bar_idx * XCD_BAR_WORDS, MISC + 8);
#define IN(k) (lo <= (k) && (k) < hi)
#define SEAM(k) do { if (IN(k) && IN((k) + 1)) { xcd_barrier(bar); if (args.sub & 8) xcd_barrier(bar); } } while (0)
    const float* x = args.in[0]; float* out = args.out;
    bf16* WIN = (bf16*)(ws + WS_WIN); bf16* WGLU = (bf16*)(ws + WS_WGLU); bf16* WSSM = (bf16*)(ws + WS_WSSM); bf16* WATT = (bf16*)(ws + WS_WATT); bf16* WOUT = (bf16*)(ws + WS_WOUT);
    bf16* WGU = (bf16*)(ws + WS_WGU); bf16* WDN = (bf16*)(ws + WS_WDN); bf16* BTAB = (bf16*)(ws + WS_BTAB); bf16* CTAB = (bf16*)(ws + WS_CTAB); bf16* KTAB = (bf16*)(ws + WS_KTAB); float* A16TAB = (float*)(ws + WS_A16);
    bf16* H = (bf16*)(ws + WS_H); bf16* PROJ = (bf16*)(ws + WS_PROJ); bf16* S5OUT = (bf16*)(ws + WS_S5OUT); bf16* ATTN = (bf16*)(ws + WS_ATTN);
    bf16* GLU = H; bf16* MIXED = S5OUT; bf16* H2 = ATTN; bf16* YS = PROJ; bf16* ACT = (bf16*)(ws + WS_ACT);
    bf16* X1B = H;
    bf16* UGM = (bf16*)(ws + WS_ACT);
    float* top_w = (float*)(ws + WS_ROUTE + RT_TOPW); int* list = (int*)(ws + WS_ROUTE + RT_LIST); int* apos = (int*)(ws + WS_ROUTE + RT_APOS);
    LAS unsigned char* ring = C.lds + RING_OFF;

    if (IN(0)) {
        for (int blk = C.vcu; blk < NG * 4; blk += C.G) s5::build_tables(blk >> 2, blk & 3, args.in[3], args.in[4], args.in[5], args.in[6], args.in[7], args.in[8], args.in[9], args.in[10], BTAB, KTAB, CTAB, A16TAB, ring, C.tid);
        transpose_job(C, args.in[2], WIN, DM, IN_W, 0, 1);
        transpose_job(C, args.in[11], WGLU, 1024, 2048, 1, 1);
        transpose_job(C, args.in[12], WSSM, 1024, 1024, 0, 1);
        transpose_job(C, args.in[16], WATT, 1024, 1024, 0, 1);
        transpose_job(C, args.in[17], WOUT, 1024, 1024, 0, 1);
        transpose_job_fp8(C, args.in[21], (unsigned char*)WGU, 1024, 2048, 1, NE, WSCALE);
        transpose_job_fp8(C, args.in[23], (unsigned char*)WDN, 1024, 1024, 0, NE, WSCALE);
        rmsnorm_rows(C, x, args.in[1], H);
        __syncthreads();
    }
    SEAM(0);
    if (IN(1)) { pg8::Gemm g{}; g.A = H; g.Bt = WIN; g.M = T; g.N = IN_W; g.K = DM; pg8::StaticOrder S; S.init(T, IN_W, C.G, (int)blockIdx.x);
        pg8::EpiProj e{}; e.O = PROJ; e.ldc = IN_W; e.qg = args.in[13]; e.kg = args.in[14]; e.qscale = att::QSCALE; e.nostore = (args.sub >> 2) & 3; e.U = UGM; e.urows = T; e.stage = C.lds + GT_OFF + 8192; pg8::gemm_phase<pg8::EpiProj, pg8::StaticOrder>(ring, g, S, e); }
    SEAM(1);
    if (IN(2)) {
        if (args.sub & 1) for (int uu = C.vcu; uu < BATCH * NG / 2; uu += C.G) for (int i = 0; i < 2; ++i) { const int unit = 2 * uu + i; s5::s5_unit(unit & 7, unit >> 3, UGM, BTAB, KTAB, CTAB, A16TAB, S5OUT, ring); }
        if (args.sub & 2) for (int run = C.vcu; run < BATCH * NKVH * 8; run += C.G) att::attn_run(run >> 5, (run >> 3) & 3, (run & 7) * 8, 8, PROJ, args.in[15], ATTN, ring);
        __syncthreads();
    }
    SEAM(2);
    if (IN(3)) { pg8::Gemm g{}; g.A = S5OUT; g.Bt = WGLU; g.M = T; g.N = 2048; g.K = 1024; g.agm = 1; pg8::StaticOrder S; S.init(T, 2048, C.G, (int)blockIdx.x);
        pg8::EpiGlu e{}; e.O = GLU; e.ldc = 1024; pg8::gemm_phase<pg8::EpiGlu, pg8::StaticOrder>(ring, g, S, e); }
    SEAM(3);
    if (IN(4)) { pg8::Gemm g{}; g.A = GLU; g.Bt = WSSM; g.A2 = ATTN; g.Bt2 = WATT; g.M = T; g.N = 1024; g.K = 1024; pg8::DualOrder S; S.init(T, 1024, C.G, (int)blockIdx.x);
        pg8::EpiGate e{}; e.O = MIXED; e.ldc = 1024; e.G = PROJ; e.ldg = IN_W; e.gcol0 = C_GS; e.gcol1 = C_GA; e.stage = C.lds + GT_OFF + 8192; pg8::gemm_phase<pg8::EpiGate, pg8::DualOrder>(ring, g, S, e); }
    SEAM(4);
    if (IN(5)) { pg8::Gemm g{}; g.A = MIXED; g.Bt = WOUT; g.M = T; g.N = 1024; g.K = 1024; pg8::StaticOrder S; S.init(T, 1024, C.G, (int)blockIdx.x);
        pg8::EpiResid e{}; e.base = x; e.out = X1B; e.ldc = 1024; e.stage = C.lds + GT_OFF + 8192; pg8::gemm_phase<pg8::EpiResid, pg8::StaticOrder>(ring, g, S, e); }
    SEAM(5);
    if (IN(6)) { router_pass(C, X1B, args.in[18], args.in[19], args.in[20], (unsigned char*)H2, top_w, list, apos, ctl); }
    SEAM(6);
    if (IN(7)) { const int nM = grouped_tables(C, ctl);
        pg8::Gemm g{}; g.A = H2; g.Bt = WGU; g.M = NA; g.N = 2048; g.K = 1024; g.scaleA = 0x7f7f7f7f; g.scaleB = WSCALE_E8M0 * 0x01010101;
        pg8::GroupedOrderT<true> S; S.cnt = (const LAS int*)(C.lds + GT_OFF); S.pref = S.cnt + 32; S.tile_e = (const LAS unsigned char*)(S.pref + 36); S.lbuf = (LAS int*)(C.lds + GT_OFF + 2048); S.list = list; S.nN = 8; S.G = C.G; S.c = (int)blockIdx.x; S.nM = nM; S.lstride = T; S.ashift = 2;
        pg8::EpiSwiglu e{}; e.O = (unsigned char*)ACT; e.ldc = 1024; e.bias = args.in[22]; e.dff = DFF; e.limit = 7.0f; e.alpha = 1.702f; e.skip = (args.sub >> 4) & 1;
        pg8::gemm_phase<pg8::EpiSwiglu, pg8::GroupedOrderT<true>>(ring, g, S, e); }
    SEAM(7);
    if (IN(8)) { const int nM = grouped_tables(C, ctl);
        pg8::Gemm g{}; g.A = ACT; g.Bt = WDN; g.M = NA; g.N = 1024; g.K = 1024; g.scaleA = 0x7f7f7f7f; g.scaleB = WSCALE_E8M0 * 0x01010101;
        pg8::GroupedOrderT<false> S; S.cnt = (const LAS int*)(C.lds + GT_OFF); S.pref = S.cnt + 32; S.tile_e = (const LAS unsigned char*)(S.pref + 36); S.lbuf = (LAS int*)(C.lds + GT_OFF + 2048); S.list = list; S.nN = 4; S.G = C.G; S.c = (int)blockIdx.x; S.nM = nM; S.lstride = T; S.ashift = 0;
        pg8::EpiDown e{}; e.O = YS; e.ldc = 1024; e.bias = args.in[24]; e.stage = C.lds + GT_OFF + 8192; e.ncol = 1024; e.skip = (args.sub >> 4) & 1;
        pg8::gemm_phase<pg8::EpiDown, pg8::GroupedOrderT<false>>(ring, g, S, e); }
    SEAM(8);
    if (IN(9)) { (void)grouped_tables(C, ctl); combine_pass(C, out, X1B, (const unsigned char*)YS, top_w, apos); }
#undef IN
#undef SEAM
}

extern "C" void kernel_launch(void* const* d_in, const int* in_sizes, int n_in, void* d_out, int out_size, void* d_ws, size_t ws_size, hipStream_t stream) {
    static int grid = 0;
    if (grid == 0) {
        if (n_in != 25 || in_sizes[0] != T * DM || out_size != T * DM || ws_size < WS_END) { fprintf(stderr, "kernel_launch: unexpected shapes / workspace (n_in %d, ws %zu)\n", n_in, ws_size); grid = -1; return; }
        int dev = 0, cus = 0, per_cu = 0;
        if (hipGetDevice(&dev) != hipSuccess || hipDeviceGetAttribute(&cus, hipDeviceAttributeMultiprocessorCount, dev) != hipSuccess) { grid = -1; return; }
        if (hipFuncSetAttribute((const void*)mk_fwd, hipFuncAttributeMaxDynamicSharedMemorySize, LDS_BYTES) != hipSuccess) { fprintf(stderr, "kernel_launch: hipFuncSetAttribute failed\n"); grid = -1; return; }
        if (hipOccupancyMaxActiveBlocksPerMultiprocessor(&per_cu, (const void*)mk_fwd, 512, LDS_BYTES) != hipSuccess || per_cu < 1) { fprintf(stderr, "kernel_launch: occupancy query says %d workgroups per CU\n", per_cu); grid = -1; (void)hipGetLastError(); return; }
        grid = cus;
    }
    if (grid < 0) return;
    if (hipMemsetAsync((char*)d_ws + WS_CTL, 0, CTL_ZERO_BYTES, stream) != hipSuccess) return;
    Args a{};
    for (int i = 0; i < 25; ++i) a.in[i] = (const float*)d_in[i];
    a.out = (float*)d_out; a.ws = (unsigned char*)d_ws;
#ifdef MK_RANGES
    { const int rg[] = MK_RANGES; int nb = 0; for (unsigned i = 0; i + 2 < sizeof(rg) / sizeof(int); i += 3) { a.ph_lo = rg[i]; a.ph_hi = rg[i + 1]; a.sub = rg[i + 2]; a.bar_idx = (rg[i + 1] - rg[i] > 1) ? nb++ : 0;
        hipLaunchKernelGGL(mk_fwd, dim3(grid), dim3(512), LDS_BYTES, stream, a); } }
#else
    a.ph_lo = 0; a.ph_hi = NPH; a.bar_idx = 0; a.sub = 3; hipLaunchKernelGGL(mk_fwd, dim3(grid), dim3(512), LDS_BYTES, stream, a);
#endif
}
```
